# Optimizing an MI355X kernel written in HIP

```python
import math
import jax
import jax.numpy as jnp
from jax import lax
import numpy as np

D_MODEL = 1024
BATCH = 1
SEQ = 16384
DEPTH = 1

HEAD_DIM = 64
FOX_HEADS = 6
DIL_CONFIGS = ((128, 1), (512, 4), (2048, 16))
DIL_HEADS_PER_GROUP = 2
DIL_GROUPS = len(DIL_CONFIGS)
DIL_HEADS = DIL_HEADS_PER_GROUP * DIL_GROUPS
MEM_HEADS = 4
MEM_LEN = 256
FOX_W = FOX_HEADS * HEAD_DIM
DIL_W = DIL_HEADS * HEAD_DIM
MEM_W = MEM_HEADS * HEAD_DIM
N_BRANCHES = 3
QBLK = 128
DBLK = 128
T5_BUCKETS = 32
T5_MAX_EXACT = T5_BUCKETS // 2
T5_MAX_DISTANCE = 2048
N_EXPERTS = 32
TOP_K = 4
D_FF_EXPERT = D_MODEL
SWIGLU_LIMIT = 7.0
SWIGLU_ALPHA = 1.702
EBLK = 128
LN_EPS = 1e-5
DEEPNORM_ALPHA = (2 * DEPTH) ** 0.25
DEEPNORM_BETA = (8 * DEPTH) ** -0.25

OFF_FOX_QKV = 0
OFF_FOX_F = OFF_FOX_QKV + 3 * FOX_W
OFF_DIL_QKV = OFF_FOX_F + FOX_HEADS
OFF_MEM_Q = OFF_DIL_QKV + 3 * DIL_W
OFF_GATES = OFF_MEM_Q + MEM_W
D_IN = OFF_GATES + N_BRANCHES * D_MODEL

kernel_name = 'hybrid_fox_dilated_mem_moe_block'


def layer_norm(x, g, b):
    xf = x.astype(jnp.float32)
    mu = jnp.mean(xf, axis=-1, keepdims=True)
    var = jnp.mean(jnp.square(xf - mu), axis=-1, keepdims=True)
    y = (xf - mu) * lax.rsqrt(var + LN_EPS) * g.astype(jnp.float32) + b.astype(jnp.float32)
    return y.astype(x.dtype)


def t5_bucket(dist):
    is_small = dist < T5_MAX_EXACT
    nf = jnp.maximum(dist, T5_MAX_EXACT).astype(jnp.float32)
    large = T5_MAX_EXACT + (jnp.log(nf / T5_MAX_EXACT) / math.log(T5_MAX_DISTANCE / T5_MAX_EXACT)
                            * (T5_BUCKETS - T5_MAX_EXACT)).astype(jnp.int32)
    large = jnp.minimum(large, T5_BUCKETS - 1)
    return jnp.where(is_small, dist, large)


def fox_attention(q, k, v, log_f):
    B, S, H, Dh = q.shape
    nblk = S // QBLK
    scale = Dh ** -0.5
    c = jnp.cumsum(log_f, axis=1)
    c_keys = c.transpose(0, 2, 1)
    qb = jnp.moveaxis(q.reshape(B, nblk, QBLK, H, Dh), 1, 0)
    cb = jnp.moveaxis(c_keys.reshape(B, H, nblk, QBLK), 2, 0)
    key_pos = jnp.arange(S)

    def block(args):
        n, qn, cn = args
        s = jnp.einsum('bqhd,bkhd->bhqk', qn, k, preferred_element_type=jnp.float32) * scale
        s = s + (cn[..., :, None] - c_keys[:, :, None, :])
        q_pos = n * QBLK + jnp.arange(QBLK)
        causal = key_pos[None, :] <= q_pos[:, None]
        s = jnp.where(causal, s, -jnp.inf)
        p = jax.nn.softmax(s, axis=-1)
        return jnp.einsum('bhqk,bkhd->bqhd', p.astype(v.dtype), v)

    out = lax.map(block, (jnp.arange(nblk), qb, cb))
    return jnp.moveaxis(out, 0, 1).reshape(B, S, H, Dh)


def dilated_group(q, k, v, table, window, dil):
    B, S, H, Dh = q.shape
    n_back = window // dil
    unit = dil * DBLK
    Sp = -(-S // unit) * unit
    M = Sp // dil
    nb = M // DBLK
    scale = Dh ** -0.5

    def to_blocks(a):
        a = jnp.pad(a, ((0, 0), (0, Sp - S), (0, 0), (0, 0)))
        a = a.reshape(B, M, dil, H, Dh).transpose(0, 2, 1, 3, 4)
        return a.reshape(B, dil, nb, DBLK, H, Dh)

    def with_prev(a):
        prev = jnp.pad(a, ((0, 0), (0, 0), (1, 0), (0, 0), (0, 0), (0, 0)))[:, :, :-1]
        return jnp.concatenate([prev, a], axis=3)

    qb = to_blocks(q)
    kc = with_prev(to_blocks(k))
    vc = with_prev(to_blocks(v))
    s = jnp.einsum('brnqhd,brnkhd->brnhqk', qb, kc, preferred_element_type=jnp.float32) * scale

    i = np.arange(DBLK, dtype=np.int32)[:, None]
    j = np.arange(2 * DBLK, dtype=np.int32)[None, :]
    rel = DBLK + i - j
    in_window = (rel >= 0) & (rel <= n_back)
    bucket = t5_bucket(jnp.asarray(np.clip(rel, 0, None) * dil, dtype=jnp.int32))
    bias = table[bucket].astype(jnp.float32).transpose(2, 0, 1)
    s = s + bias
    has_prev = np.arange(nb)[:, None, None] > 0
    mask = in_window[None] & (has_prev | (j >= DBLK)[None])
    s = jnp.where(mask[None, None, :, None], s, -jnp.inf)

    m = jnp.max(s, axis=-1, keepdims=True)
    e = jnp.exp(s - m)
    den = jnp.sum(e, axis=-1, keepdims=True)
    p = e / den
    lse = (m + jnp.log(den))[..., 0]
    o = jnp.einsum('brnhqk,brnkhd->brnqhd', p.astype(vc.dtype), vc)
    o = o.reshape(B, dil, M, H, Dh).transpose(0, 2, 1, 3, 4).reshape(B, Sp, H, Dh)[:, :S]
    lse = lse.transpose(0, 1, 2, 4, 3).reshape(B, dil, M, H).transpose(0, 2, 1, 3).reshape(B, Sp, H)[:, :S]
    return o, lse


def mem_attention(q, mem, w_kv):
    B, S, H, Dh = q.shape
    M = mem.shape[1]
    kv = jnp.einsum('bmd,de->bme', mem, w_kv).reshape(B, M, 2, H, Dh)
    k, v = kv[:, :, 0], kv[:, :, 1]
    s = jnp.einsum('bshd,bmhd->bhsm', q, k, preferred_element_type=jnp.float32) * (Dh ** -0.5)
    p = jax.nn.softmax(s, axis=-1)
    return jnp.einsum('bhsm,bmhd->bshd', p.astype(v.dtype), v)


def clamped_swiglu(h):
    h_glu, h_lin = jnp.split(h, 2, axis=-1)
    h_glu = jnp.minimum(h_glu, SWIGLU_LIMIT)
    h_lin = jnp.clip(h_lin, -SWIGLU_LIMIT, SWIGLU_LIMIT)
    return h_glu * jax.nn.sigmoid(SWIGLU_ALPHA * h_glu) * (h_lin + 1.0)


def moe_ffn(xt, w_router, b_router, w1, b1, w2, b2):
    T, D = xt.shape
    A = T * TOP_K
    logits = jnp.einsum('td,de->te', xt, w_router, preferred_element_type=jnp.float32) + b_router.astype(jnp.float32)
    top_vals, top_idx = lax.top_k(logits, TOP_K)
    gates = jax.nn.softmax(top_vals, axis=-1)
    flat_e = top_idx.reshape(A)
    flat_tok = jnp.broadcast_to(jnp.arange(T, dtype=jnp.int32)[:, None], (T, TOP_K)).reshape(A)
    flat_g = gates.reshape(A)
    order = jnp.argsort(flat_e)
    sorted_e = flat_e[order]
    counts = jnp.bincount(flat_e, length=N_EXPERTS)
    starts = jnp.cumsum(counts) - counts
    padded = (counts + EBLK - 1) // EBLK * EBLK
    pad_ends = jnp.cumsum(padded)
    pad_starts = pad_ends - padded
    dest = pad_starts[sorted_e] + (jnp.arange(A) - starts[sorted_e])
    n_blocks = -(-(A + N_EXPERTS * EBLK) // EBLK)
    P = n_blocks * EBLK
    tok_buf = jnp.full((P,), T, dtype=jnp.int32).at[dest].set(flat_tok[order])
    gate_buf = jnp.zeros((P,), jnp.float32).at[dest].set(flat_g[order])
    blk_e = jnp.minimum(jnp.searchsorted(pad_ends, jnp.arange(n_blocks) * EBLK, side='right'), N_EXPERTS - 1)
    x_pad = jnp.concatenate([xt, jnp.zeros((1, D), xt.dtype)], axis=0)
    xb = x_pad[tok_buf].reshape(n_blocks, EBLK, D)

    def expert_block(args):
        xe, e = args
        h = xe @ w1[e] + b1[e]
        return clamped_swiglu(h) @ w2[e] + b2[e]

    yb = lax.map(expert_block, (xb, blk_e)).reshape(P, D)
    out = jnp.zeros((T + 1, D), jnp.float32).at[tok_buf].add(yb.astype(jnp.float32) * gate_buf[:, None])
    return out[:T].astype(xt.dtype)


def setup_inputs(seed: int = 0) -> dict:
    key = jax.random.key(seed)
    ks = jax.random.split(key, 32)

    def nrm(k, shape, scale):
        return jax.random.normal(k, shape, jnp.float32) * scale

    sd = D_MODEL ** -0.5
    beta = DEEPNORM_BETA
    x = nrm(ks[0], (BATCH, SEQ, D_MODEL), 1.0)
    mem = nrm(ks[1], (BATCH, MEM_LEN, D_MODEL), 1.0)
    w_in = jnp.concatenate([
        nrm(ks[2], (DEPTH, D_MODEL, 2 * FOX_W), sd),
        nrm(ks[3], (DEPTH, D_MODEL, FOX_W), sd * beta),
        nrm(ks[4], (DEPTH, D_MODEL, FOX_HEADS), 0.5 * sd),
        nrm(ks[5], (DEPTH, D_MODEL, 2 * DIL_W), sd),
        nrm(ks[6], (DEPTH, D_MODEL, DIL_W), sd * beta),
        nrm(ks[7], (DEPTH, D_MODEL, MEM_W), sd),
        nrm(ks[8], (DEPTH, D_MODEL, N_BRANCHES * D_MODEL), sd),
    ], axis=-1)
    b_fgate = jnp.linspace(1.0, 6.0, FOX_HEADS, dtype=jnp.float32)[None, :] + nrm(ks[9], (DEPTH, FOX_HEADS), 0.1)
    t5_bias = nrm(ks[10], (T5_BUCKETS, DIL_HEADS), 0.5)
    w_mem_kv = jnp.concatenate([
        nrm(ks[11], (DEPTH, D_MODEL, MEM_W), sd),
        nrm(ks[12], (DEPTH, D_MODEL, MEM_W), sd * beta),
    ], axis=-1)
    w_br_fox = nrm(ks[13], (DEPTH, FOX_W, D_MODEL), FOX_W ** -0.5 * beta)
    w_br_dil = nrm(ks[14], (DEPTH, DIL_W, D_MODEL), DIL_W ** -0.5 * beta)
    w_br_mem = nrm(ks[15], (DEPTH, MEM_W, D_MODEL), MEM_W ** -0.5 * beta)
    w_out = nrm(ks[16], (DEPTH, D_MODEL, D_MODEL), sd * beta)
    ln1_g = 1.0 + nrm(ks[17], (DEPTH, D_MODEL), 0.02)
    ln1_b = nrm(ks[18], (DEPTH, D_MODEL), 0.02)
    w_router = nrm(ks[19], (DEPTH, D_MODEL, N_EXPERTS), sd)
    b_router = nrm(ks[20], (DEPTH, N_EXPERTS), 0.01)
    w_exp_in = nrm(ks[21], (DEPTH, N_EXPERTS, D_MODEL, 2 * D_FF_EXPERT), sd * beta)
    b_exp_in = nrm(ks[22], (DEPTH, N_EXPERTS, 2 * D_FF_EXPERT), 0.01)
    w_exp_out = nrm(ks[23], (DEPTH, N_EXPERTS, D_FF_EXPERT, D_MODEL), D_FF_EXPERT ** -0.5 * beta)
    b_exp_out = nrm(ks[24], (DEPTH, N_EXPERTS, D_MODEL), 0.01)
    ln2_g = 1.0 + nrm(ks[25], (DEPTH, D_MODEL), 0.02)
    ln2_b = nrm(ks[26], (DEPTH, D_MODEL), 0.02)
    return {'x': x, 'mem': mem, 'w_in': w_in, 'b_fgate': b_fgate, 't5_bias': t5_bias,
            'w_mem_kv': w_mem_kv, 'w_br_fox': w_br_fox, 'w_br_dil': w_br_dil, 'w_br_mem': w_br_mem,
            'w_out': w_out, 'ln1_g': ln1_g, 'ln1_b': ln1_b, 'w_router': w_router, 'b_router': b_router,
            'w_exp_in': w_exp_in, 'b_exp_in': b_exp_in, 'w_exp_out': w_exp_out, 'b_exp_out': b_exp_out,
            'ln2_g': ln2_g, 'ln2_b': ln2_b}


def reference(x, mem, w_in, b_fgate, t5_bias, w_mem_kv, w_br_fox, w_br_dil, w_br_mem, w_out,
              ln1_g, ln1_b, w_router, b_router, w_exp_in, b_exp_in, w_exp_out, b_exp_out, ln2_g, ln2_b):
    B, S, D = x.shape
    h = x
    for l in range(DEPTH):
        proj = jnp.einsum('bsd,de->bse', h, w_in[l])
        fox_qkv = proj[..., OFF_FOX_QKV:OFF_FOX_F].reshape(B, S, 3, FOX_HEADS, HEAD_DIM)
        f_logit = proj[..., OFF_FOX_F:OFF_DIL_QKV] + b_fgate[l]
        log_f = jax.nn.log_sigmoid(f_logit.astype(jnp.float32))
        o_fox = fox_attention(fox_qkv[:, :, 0], fox_qkv[:, :, 1], fox_qkv[:, :, 2], log_f)
        o_fox = o_fox.reshape(B, S, FOX_W)

        dil_qkv = proj[..., OFF_DIL_QKV:OFF_MEM_Q].reshape(B, S, 3, DIL_HEADS, HEAD_DIM)
        outs = []
        lses = []
        for g, (window, dil) in enumerate(DIL_CONFIGS):
            hs = slice(g * DIL_HEADS_PER_GROUP, (g + 1) * DIL_HEADS_PER_GROUP)
            o_g, lse_g = dilated_group(dil_qkv[:, :, 0, hs], dil_qkv[:, :, 1, hs], dil_qkv[:, :, 2, hs],
                                       t5_bias[:, hs], window, dil)
            outs.append(o_g)
            lses.append(lse_g)
        o_stack = jnp.stack(outs, axis=2)
        w_den = jax.nn.softmax(jnp.stack(lses, axis=2), axis=2)
        o_dil = (o_stack * w_den[..., None].astype(o_stack.dtype)).reshape(B, S, DIL_W)

        mem_q = proj[..., OFF_MEM_Q:OFF_GATES].reshape(B, S, MEM_HEADS, HEAD_DIM)
        o_mem = mem_attention(mem_q, mem, w_mem_kv[l]).reshape(B, S, MEM_W)

        gates = jax.nn.sigmoid(proj[..., OFF_GATES:].reshape(B, S, N_BRANCHES, D))
        merged = (gates[:, :, 0] * jnp.einsum('bse,ed->bsd', o_fox, w_br_fox[l])
                  + gates[:, :, 1] * jnp.einsum('bse,ed->bsd', o_dil, w_br_dil[l])
                  + gates[:, :, 2] * jnp.einsum('bse,ed->bsd', o_mem, w_br_mem[l]))
        y = jnp.einsum('bsd,de->bse', merged, w_out[l])
        h = layer_norm(DEEPNORM_ALPHA * h + y, ln1_g[l], ln1_b[l])

        y_moe = moe_ffn(h.reshape(B * S, D), w_router[l], b_router[l], w_exp_in[l], b_exp_in[l],
                        w_exp_out[l], b_exp_out[l]).reshape(B, S, D)
        h = layer_norm(DEEPNORM_ALPHA * h + y_moe, ln2_g[l], ln2_b[l])
    return h
```

```cpp
#include <hip/hip_runtime.h>
#include <hip/hip_bf16.h>
#include <cstdio>
#include <cstdint>
#include <cmath>
namespace pg8 {
#define PG8_LAS __attribute__((address_space(3)))
typedef unsigned short bf16_t;
typedef short bf16x8 __attribute__((ext_vector_type(8)));
typedef float f32x4 __attribute__((ext_vector_type(4)));
typedef unsigned u32x4 __attribute__((ext_vector_type(4)));
constexpr int BM = 256, BK = 64, HALF = 128, HTB = HALF * BK * 2  , STAGE_BYTES = 8 * HTB, NXCD = 8, WGM = 8;

__host__ __device__ __forceinline__ int lds_byte(int r, int c) { const int st = (r >> 4) * 2 + (c >> 5), rr = r & 15, cc = c & 31, ob = rr * 64 + cc * 2; return st * 1024 + (ob ^ (((ob >> 9) & 1) << 5)); }
__host__ __device__ __forceinline__ void stage_rc(int b, int& R, int& C) { const int st = b / 1024, sb = b % 1024, swz = sb ^ (((sb >> 9) & 1) << 5); R = (st >> 1) * 16 + swz / 64; C = (st & 1) * 32 + (swz % 64) / 2; }
__host__ __device__ __forceinline__ int perm32(int rho) { const int n = rho >> 4, i = rho & 15; return 8 * (i >> 2) + 4 * n + (i & 3); }

struct Unit { int pm, pn, e; };
struct Gemm { const bf16_t* A; const bf16_t* Bt; int M, N, K; };

struct StaticOrder {
    int nM, nN, nwg, G, c;
    __host__ __device__ void init(int M, int N, int G_, int c_) { nM = M / BM; nN = N / BM; nwg = nM * nN; G = G_; c = c_; }
    __host__ __device__ bool next(int i, Unit& u) const {
        const long L = (long)i * G + c; if (L >= nwg) return false;
        int wgid = (int)L; { const int q = nwg / NXCD, r = nwg % NXCD, xcd = wgid % NXCD, off = wgid / NXCD; wgid = (xcd < r ? xcd * (q + 1) : r * (q + 1) + (xcd - r) * q) + off; }
        const int nig = WGM * nN, gid = wgid / nig, fm = gid * WGM, gsz = (nM - fm) < WGM ? (nM - fm) : WGM;
        u.pm = fm + ((wgid % nig) % gsz); u.pn = (wgid % nig) / gsz; u.e = 0; return true;
    }
    __device__ __forceinline__ void a_ready(const Unit&) const {}
    __device__ __forceinline__ void done(const Unit&) const {}
};

__device__ __forceinline__ unsigned cvt_pk_bf16(float lo, float hi) { unsigned r; asm volatile("v_cvt_pk_bf16_f32 %0, %1, %2" : "=v"(r) : "v"(lo), "v"(hi)); return r; }
__device__ __forceinline__ float bf_lo(unsigned w) { return __uint_as_float(w << 16); }
__device__ __forceinline__ float bf_hi(unsigned w) { return __uint_as_float(w & 0xffff0000u); }
__device__ __forceinline__ float sigmoid_f(float v) { return __builtin_amdgcn_rcpf(1.0f + __builtin_amdgcn_exp2f(-1.4426950408889634f * v)); }
typedef unsigned u32x2 __attribute__((ext_vector_type(2)));

struct EpiBf16Plain {
    static constexpr bool PERM = true, AFTER_DRAIN = false;
    bf16_t* O; int ldc;
    __device__ __forceinline__ void operator()(const f32x4 (&acc)[2][2][4][2], const Unit& u, int wr, int wc, int fr, int fq) const {
        const int row0 = u.pm * BM + wr * 64 + fr, col0 = u.pn * BM + wc * 32 + 8 * fq;
#pragma unroll
        for (int ai = 0; ai < 2; ++ai)
#pragma unroll
            for (int m = 0; m < 4; ++m) { bf16_t* rowp = O + (size_t)(row0 + ai * HALF + m * 16) * ldc + col0;
#pragma unroll
                for (int bj = 0; bj < 2; ++bj) { const f32x4 v0 = acc[ai][bj][m][0], v1 = acc[ai][bj][m][1];
                    u32x4 w; w.x = cvt_pk_bf16(v0[0], v0[1]); w.y = cvt_pk_bf16(v0[2], v0[3]); w.z = cvt_pk_bf16(v1[0], v1[1]); w.w = cvt_pk_bf16(v1[2], v1[3]);
                    *(u32x4*)(rowp + bj * HALF) = w; } }
    }
};
struct EpiProj {
    static constexpr bool PERM = true, AFTER_DRAIN = false;
    bf16_t* O; int ldc; int sig_from;
    __device__ __forceinline__ void operator()(const f32x4 (&acc)[2][2][4][2], const Unit& u, int wr, int wc, int fr, int fq) const {
        const int row0 = u.pm * BM + wr * 64 + fr, col0 = u.pn * BM + wc * 32 + 8 * fq; const bool sg = u.pn >= sig_from;
#pragma unroll
        for (int ai = 0; ai < 2; ++ai)
#pragma unroll
            for (int m = 0; m < 4; ++m) { bf16_t* rowp = O + (size_t)(row0 + ai * HALF + m * 16) * ldc + col0;
#pragma unroll
                for (int bj = 0; bj < 2; ++bj) { f32x4 v0 = acc[ai][bj][m][0], v1 = acc[ai][bj][m][1];
                    if (sg) {
#pragma unroll
                        for (int j = 0; j < 4; ++j) { v0[j] = sigmoid_f(v0[j]); v1[j] = sigmoid_f(v1[j]); } }
                    u32x4 w; w.x = cvt_pk_bf16(v0[0], v0[1]); w.y = cvt_pk_bf16(v0[2], v0[3]); w.z = cvt_pk_bf16(v1[0], v1[1]); w.w = cvt_pk_bf16(v1[2], v1[3]);
                    *(u32x4*)(rowp + bj * HALF) = w; } }
    }
};
template <int PASS> struct EpiMerge {
    static constexpr bool PERM = false, AFTER_DRAIN = false;
    const bf16_t* gate; int ldg; float* stash; bf16_t* outb; int ldc;
    __device__ __forceinline__ void operator()(const f32x4 (&acc)[2][2][4][2], const Unit& u, int wr, int wc, int fr, int fq) const {
        const int row0 = u.pm * BM + wr * 64 + fr, col0 = u.pn * BM + wc * 32 + 4 * fq;
#pragma unroll
        for (int ai = 0; ai < 2; ++ai)
#pragma unroll
            for (int m = 0; m < 4; ++m) { const size_t r = (size_t)(row0 + ai * HALF + m * 16);
#pragma unroll
                for (int bj = 0; bj < 2; ++bj)
#pragma unroll
                    for (int n = 0; n < 2; ++n) { const int c = col0 + bj * HALF + n * 16;
                        const u32x2 gv = *(const u32x2*)(gate + r * ldg + c);
                        f32x4 v = acc[ai][bj][m][n]; v[0] *= bf_lo(gv.x); v[1] *= bf_hi(gv.x); v[2] *= bf_lo(gv.y); v[3] *= bf_hi(gv.y);
                        if (PASS > 0) v += *(const f32x4*)(stash + r * ldc + c);
                        if (PASS < 2) *(f32x4*)(stash + r * ldc + c) = v;
                        else { u32x2 w; w.x = cvt_pk_bf16(v[0], v[1]); w.y = cvt_pk_bf16(v[2], v[3]); *(u32x2*)(outb + r * ldc + c) = w; } }
                asm volatile("" ::: "memory"); }
    }
};
struct EpiRes {
    static constexpr bool PERM = false, AFTER_DRAIN = false;
    const float* x; float* out; int ldc; float alpha;
    __device__ __forceinline__ void operator()(const f32x4 (&acc)[2][2][4][2], const Unit& u, int wr, int wc, int fr, int fq) const {
        const int row0 = u.pm * BM + wr * 64 + fr, col0 = u.pn * BM + wc * 32 + 4 * fq;
#pragma unroll
        for (int ai = 0; ai < 2; ++ai)
#pragma unroll
            for (int m = 0; m < 4; ++m) { const size_t off = (size_t)(row0 + ai * HALF + m * 16) * ldc + col0;
#pragma unroll
                for (int bj = 0; bj < 2; ++bj)
#pragma unroll
                    for (int n = 0; n < 2; ++n) { const f32x4 xv = *(const f32x4*)(x + off + bj * HALF + n * 16); *(f32x4*)(out + off + bj * HALF + n * 16) = xv * alpha + acc[ai][bj][m][n]; } }
    }
};
struct EpiSwiglu {
    static constexpr bool PERM = true, AFTER_DRAIN = false;
    bf16_t* O; const float* b1;
    __device__ __forceinline__ void operator()(const f32x4 (&acc)[2][2][4][2], const Unit& u, int wr, int wc, int fr, int fq) const {
        const int e = u.e, pnl = u.pn - e * 8; const int row0 = u.pm * BM + wr * 64 + fr, colo = pnl * 128 + wc * 32 + 8 * fq;
        f32x4 bg[2], bl[2];
#pragma unroll
        for (int n = 0; n < 2; ++n) { bg[n] = *(const f32x4*)(b1 + (size_t)e * 2048 + colo + 4 * n); bl[n] = *(const f32x4*)(b1 + (size_t)e * 2048 + 1024 + colo + 4 * n); }
#pragma unroll
        for (int ai = 0; ai < 2; ++ai)
#pragma unroll
            for (int m = 0; m < 4; ++m) { bf16_t* rowp = O + (size_t)(row0 + ai * HALF + m * 16) * 1024 + colo; f32x4 o[2];
#pragma unroll
                for (int n = 0; n < 2; ++n) { const f32x4 g = acc[ai][0][m][n] + bg[n], l = acc[ai][1][m][n] + bl[n];
#pragma unroll
                    for (int j = 0; j < 4; ++j) { const float gg = fminf(g[j], 7.0f), ll = fminf(fmaxf(l[j], -7.0f), 7.0f);
                        o[n][j] = gg * __builtin_amdgcn_rcpf(1.0f + __builtin_amdgcn_exp2f(-1.702f * 1.4426950408889634f * gg)) * (ll + 1.0f); } }
                u32x4 w; w.x = cvt_pk_bf16(o[0][0], o[0][1]); w.y = cvt_pk_bf16(o[0][2], o[0][3]); w.z = cvt_pk_bf16(o[1][0], o[1][1]); w.w = cvt_pk_bf16(o[1][2], o[1][3]);
                *(u32x4*)rowp = w; }
    }
};
struct EpiY {
    static constexpr bool PERM = true, AFTER_DRAIN = false;
    bf16_t* O; const float* b2;
    __device__ __forceinline__ void operator()(const f32x4 (&acc)[2][2][4][2], const Unit& u, int wr, int wc, int fr, int fq) const {
        const int e = u.e, pnl = u.pn - e * 4; const int row0 = u.pm * BM + wr * 64 + fr, col0 = pnl * BM + wc * 32 + 8 * fq;
        f32x4 bv[2][2];
#pragma unroll
        for (int bj = 0; bj < 2; ++bj)
#pragma unroll
            for (int n = 0; n < 2; ++n) bv[bj][n] = *(const f32x4*)(b2 + (size_t)e * 1024 + col0 + bj * HALF + 4 * n);
#pragma unroll
        for (int ai = 0; ai < 2; ++ai)
#pragma unroll
            for (int m = 0; m < 4; ++m) { bf16_t* rowp = O + (size_t)(row0 + ai * HALF + m * 16) * 1024 + col0;
#pragma unroll
                for (int bj = 0; bj < 2; ++bj) { const f32x4 v0 = acc[ai][bj][m][0] + bv[bj][0], v1 = acc[ai][bj][m][1] + bv[bj][1];
                    u32x4 w; w.x = cvt_pk_bf16(v0[0], v0[1]); w.y = cvt_pk_bf16(v0[2], v0[3]); w.z = cvt_pk_bf16(v1[0], v1[1]); w.w = cvt_pk_bf16(v1[2], v1[3]);
                    *(u32x4*)(rowp + bj * HALF) = w; } }
    }
};
struct MoeOrder {
    const PG8_LAS int* tstart; int nN, G, vcu;
    __device__ __forceinline__ int ts(int k) const { return __builtin_amdgcn_readfirstlane(tstart[k]); }
    __device__ __forceinline__ bool next(int i, Unit& u) const {
        const int L = i * G + vcu; const int T = ts(32); if (L >= T * nN) return false;
        int e = 0;
#pragma unroll
        for (int k = 1; k < 32; ++k) e += (L >= ts(k) * nN) ? 1 : 0;
        const int t0 = ts(e), R = ts(e + 1) - t0; const int rem = L - t0 * nN; const int ng = rem / (4 * R); const int r2 = rem - ng * 4 * R; const int pnl = r2 / R; const int pmi = r2 - pnl * R;
        u.pm = t0 + pmi; u.pn = e * nN + ng * 4 + pnl; u.e = e; return true;
    }
    __device__ __forceinline__ void a_ready(const Unit&) const {}
    __device__ __forceinline__ void done(const Unit&) const {}
};
template <class Epi, class Sched, bool ALIGN_EPI = false, bool SP2 = false>
__device__ __forceinline__ void gemm_phase(PG8_LAS unsigned char* lds, const Gemm g, const Sched& S, const Epi& E) {
    int tid_ = threadIdx.x; asm volatile("" : "+v"(tid_));
    const int tid = tid_, wid = __builtin_amdgcn_readfirstlane(tid >> 6), lane = tid & 63, wr = wid >> 2, wc = wid & 3, fr = lane & 15, fq = lane >> 4;
    const int K = g.K, nt = K / BK;
    unsigned voffA[2], voffB[2];
#pragma unroll
    for (int i = 0; i < 2; ++i) { int R, C; stage_rc(tid * 16 + i * 8192, R, C); const int Rb = Epi::PERM ? ((R & ~31) + perm32(R & 31)) : R;
        voffA[i] = (unsigned)(R * K + C) * 2u; voffB[i] = (unsigned)(Rb * K + C) * 2u; }
    const size_t kstep = (size_t)(BK * 2);
    const size_t hstep = (size_t)HALF * K * 2;
    const size_t tstep = 2 * hstep;
    const unsigned ldsw = (unsigned)wid * 1024u;
    const int aoff = lds_byte(wr * 64 + fr, fq * 8), boff = lds_byte(wc * 32 + fr, fq * 8);
#define PG8_SA(b, h) (((b) * 2 + (h)) * HTB)
#define PG8_SB(b, h) ((4 + (b) * 2 + (h)) * HTB)
#define PG8_STAGE(bufoff, gbase, voff) do { _Pragma("unroll") for (int _i = 0; _i < 2; ++_i) \
        __builtin_amdgcn_global_load_lds((const unsigned*)((const char*)(gbase) + (voff)[_i]), (PG8_LAS unsigned*)(lds + (bufoff) + ldsw + _i * 8192), 16, 0, 0); } while (0)
#define PG8_LDA(dst, b, h) do { _Pragma("unroll") for (int m = 0; m < 4; ++m) _Pragma("unroll") for (int k = 0; k < 2; ++k) dst[m][k] = *(const PG8_LAS bf16x8*)(lds + PG8_SA(b, h) + aoff + m * 2048 + k * 1024); } while (0)
#define PG8_LDB(dst, b, h) do { _Pragma("unroll") for (int n = 0; n < 2; ++n) _Pragma("unroll") for (int k = 0; k < 2; ++k) dst[n][k] = *(const PG8_LAS bf16x8*)(lds + PG8_SB(b, h) + boff + n * 2048 + k * 1024); } while (0)
#define PG8_MMA(ai, bj, At, Bt) do { __builtin_amdgcn_s_setprio(1); _Pragma("unroll") for (int m = 0; m < 4; ++m) _Pragma("unroll") for (int n = 0; n < 2; ++n) _Pragma("unroll") for (int k = 0; k < 2; ++k) \
        acc[ai][bj][m][n] = __builtin_amdgcn_mfma_f32_16x16x32_bf16(Bt[n][k], At[m][k], acc[ai][bj][m][n], 0, 0, 0); __builtin_amdgcn_s_setprio(0); } while (0)
#define PG8_WAIT_V(n) asm volatile("s_waitcnt vmcnt(" #n ")" ::: "memory")
#define PG8_WAIT_L(n) asm volatile("s_waitcnt lgkmcnt(" #n ")" ::: "memory")
#define PG8_BAR __builtin_amdgcn_s_barrier()
#define PG8_SCHED __builtin_amdgcn_sched_barrier(0)
    Unit cur, nxt; int ui = 0;
    if (!S.next(0, cur)) return;
    f32x4 acc[2][2][4][2];
#pragma unroll
    for (int a = 0; a < 2; ++a)
#pragma unroll
        for (int b = 0; b < 2; ++b)
#pragma unroll
            for (int m = 0; m < 4; ++m)
#pragma unroll
                for (int n = 0; n < 2; ++n) acc[a][b][m][n] = (f32x4){0.f, 0.f, 0.f, 0.f};
    bf16x8 At[4][2], B0[2][2], B1[2][2];
    const char* cA = (const char*)g.A + (size_t)cur.pm * tstep; const char* cB = (const char*)g.Bt + (size_t)cur.pn * tstep;
    S.a_ready(cur);
    if constexpr (SP2) {
        PG8_STAGE(PG8_SB(0, 0), cB, voffB); PG8_STAGE(PG8_SB(0, 1), cB + hstep, voffB); PG8_STAGE(PG8_SA(0, 0), cA, voffA); PG8_STAGE(PG8_SA(0, 1), cA + hstep, voffA);
        if (wr == 1) PG8_BAR;
        PG8_WAIT_V(2); PG8_BAR;
        PG8_STAGE(PG8_SB(1, 0), cB + kstep, voffB); PG8_STAGE(PG8_SA(1, 0), cA + kstep, voffA); PG8_STAGE(PG8_SB(1, 1), cB + hstep + kstep, voffB);
        PG8_WAIT_V(6); PG8_BAR;
    } else {
        PG8_STAGE(PG8_SB(0, 0), cB, voffB); PG8_STAGE(PG8_SA(0, 0), cA, voffA); PG8_STAGE(PG8_SB(0, 1), cB + hstep, voffB); PG8_STAGE(PG8_SA(0, 1), cA + hstep, voffA);
        if (wr == 1) PG8_BAR;
        PG8_WAIT_V(4); PG8_BAR;
        PG8_STAGE(PG8_SB(1, 0), cB + kstep, voffB); PG8_STAGE(PG8_SA(1, 0), cA + kstep, voffA); PG8_STAGE(PG8_SB(1, 1), cB + hstep + kstep, voffB);
        PG8_WAIT_V(6); PG8_BAR;
    }
    for (;;) {
        const bool has_next = S.next(ui + 1, nxt);
        const char* nA = has_next ? (const char*)g.A + (size_t)nxt.pm * tstep : cA; const char* nB = has_next ? (const char*)g.Bt + (size_t)nxt.pn * tstep : cB;
        for (int t = 0; t < nt; t += 2) {
            const bool last = (t == nt - 2);
            const char* a1 = cA + (size_t)(t + 1) * kstep;
            const char* a2 = last ? nA : cA + (size_t)(t + 2) * kstep; const char* b2 = last ? nB : cB + (size_t)(t + 2) * kstep;
            const char* a3 = a2 + kstep; const char* b3 = b2 + kstep;
            if (last && has_next) S.a_ready(nxt);
            if constexpr (SP2) {
            PG8_LDB(B0, 0, 0); PG8_LDB(B1, 0, 1); PG8_SCHED; PG8_LDA(At, 0, 0); PG8_STAGE(PG8_SA(1, 1), a1 + hstep, voffA);
            PG8_WAIT_V(8); PG8_WAIT_L(0); PG8_BAR; PG8_MMA(0, 0, At, B0); PG8_MMA(0, 1, At, B1); PG8_BAR; PG8_SCHED;
            PG8_LDA(At, 0, 1); PG8_STAGE(PG8_SB(0, 0), b2, voffB); PG8_STAGE(PG8_SB(0, 1), b2 + hstep, voffB); PG8_STAGE(PG8_SA(0, 0), a2, voffA);
            PG8_WAIT_V(8); PG8_WAIT_L(0); PG8_BAR; PG8_MMA(1, 0, At, B0); PG8_MMA(1, 1, At, B1); PG8_BAR; PG8_SCHED;
            PG8_LDB(B0, 1, 0); PG8_LDB(B1, 1, 1); PG8_SCHED; PG8_LDA(At, 1, 0); PG8_STAGE(PG8_SA(0, 1), a2 + hstep, voffA);
            PG8_WAIT_V(8); PG8_WAIT_L(0); PG8_BAR; PG8_MMA(0, 0, At, B0); PG8_MMA(0, 1, At, B1); PG8_BAR; PG8_SCHED;
            PG8_LDA(At, 1, 1); PG8_STAGE(PG8_SB(1, 0), b3, voffB); PG8_STAGE(PG8_SB(1, 1), b3 + hstep, voffB); PG8_STAGE(PG8_SA(1, 0), a3, voffA);
            PG8_WAIT_V(8); PG8_WAIT_L(0); PG8_BAR; PG8_MMA(1, 0, At, B0); PG8_MMA(1, 1, At, B1); PG8_BAR; PG8_SCHED;
            } else {
            PG8_LDB(B0, 0, 0); PG8_SCHED; PG8_LDA(At, 0, 0); PG8_STAGE(PG8_SA(1, 1), a1 + hstep, voffA);
            PG8_WAIT_L(8); PG8_BAR; PG8_WAIT_L(0); PG8_MMA(0, 0, At, B0); PG8_BAR; PG8_SCHED;
            PG8_LDB(B1, 0, 1); PG8_STAGE(PG8_SB(0, 0), b2, voffB);
            PG8_BAR; PG8_WAIT_L(0); PG8_MMA(0, 1, At, B1); PG8_BAR;
            PG8_LDA(At, 0, 1); PG8_STAGE(PG8_SA(0, 0), a2, voffA);
            PG8_BAR; PG8_WAIT_L(0); PG8_MMA(1, 0, At, B0); PG8_BAR; PG8_SCHED;
            PG8_STAGE(PG8_SB(0, 1), b2 + hstep, voffB);
            PG8_WAIT_V(6); PG8_BAR; PG8_MMA(1, 1, At, B1); PG8_BAR;
            PG8_LDB(B0, 1, 0); PG8_SCHED; PG8_LDA(At, 1, 0); PG8_STAGE(PG8_SA(0, 1), a2 + hstep, voffA);
            PG8_WAIT_L(8); PG8_BAR; PG8_WAIT_L(0); PG8_MMA(0, 0, At, B0); PG8_BAR; PG8_SCHED;
            PG8_LDB(B1, 1, 1); PG8_STAGE(PG8_SB(1, 0), b3, voffB);
            PG8_BAR; PG8_WAIT_L(0); PG8_MMA(0, 1, At, B1); PG8_BAR;
            PG8_LDA(At, 1, 1); PG8_STAGE(PG8_SA(1, 0), a3, voffA);
            PG8_BAR; PG8_WAIT_L(0); PG8_MMA(1, 0, At, B0); PG8_BAR; PG8_SCHED;
            PG8_STAGE(PG8_SB(1, 1), b3 + hstep, voffB);
            PG8_WAIT_V(6); PG8_BAR; PG8_MMA(1, 1, At, B1); PG8_BAR;
            }
        }
        if constexpr (ALIGN_EPI) { if (wr == 0) PG8_BAR; }
        if constexpr (!Epi::AFTER_DRAIN) { E(acc, cur, wr, wc, fr, fq); S.done(cur); }
        if (!has_next) break;
#pragma unroll
        for (int a = 0; a < 2; ++a)
#pragma unroll
            for (int b = 0; b < 2; ++b)
#pragma unroll
                for (int m = 0; m < 4; ++m)
#pragma unroll
                    for (int n = 0; n < 2; ++n) acc[a][b][m][n] = (f32x4){0.f, 0.f, 0.f, 0.f};
        cur = nxt; cA = nA; cB = nB; ++ui;
        if constexpr (ALIGN_EPI) { if (wr == 1) PG8_BAR; }
    }
    PG8_WAIT_V(0);
    if constexpr (!ALIGN_EPI) { if (wr == 0) PG8_BAR; }
    PG8_BAR;
    if constexpr (Epi::AFTER_DRAIN) { E.fused(acc, cur, wr, wc, fr, fq, lds, wid, lane); S.done(cur); }
#undef PG8_SA
#undef PG8_SB
#undef PG8_STAGE
#undef PG8_LDA
#undef PG8_LDB
#undef PG8_MMA
#undef PG8_WAIT_V
#undef PG8_WAIT_L
#undef PG8_BAR
#undef PG8_SCHED
}
}
namespace attn_body {
using bf16=__hip_bfloat16;
using bf16x8=__attribute__((ext_vector_type(8)))short;
using s16x4=__attribute__((ext_vector_type(4)))short;
using f32x16=__attribute__((ext_vector_type(16)))float;
using f32x4v=__attribute__((ext_vector_type(4)))float;
using u32x4=__attribute__((ext_vector_type(4)))unsigned;
constexpr int D=64;
constexpr int NW=8,QBLK=32,QB=QBLK*NW,KVBLK=64;
__device__ __forceinline__ int crow(int r,int hi){return (r&3)+8*(r>>2)+4*hi;}
#define SBAR() __builtin_amdgcn_sched_barrier(0)
__device__ __forceinline__ void cmask(f32x16&p0,f32x16&p1,int jb,int qrel,int hi){
  const float NEG=-INFINITY; int kb=64*jb+4*hi;
  #pragma unroll
  for(int r=0;r<16;++r){int kv=kb+(r&3)+8*(r>>2); if(kv>qrel)p0[r]=NEG; if(kv+32>qrel)p1[r]=NEG;}
}

constexpr int NSLOT=3, SLOTB=8192;
constexpr int LDS_K=0, LDS_V=NSLOT*SLOTB, LDS_WS=2*NSLOT*SLOTB, LDS_OST=LDS_WS+NW*64*4, LDS_BYTES=LDS_OST+NW*4096;
constexpr int LDS_CS=LDS_BYTES, CS_BYTES=65536, LDS_TOTAL=LDS_CS+CS_BYTES;
constexpr int TBL_N=640, TBL_ZERO=256;
__device__ __forceinline__ void glds16(const void*gsrc,unsigned lds_dst){unsigned keep;
  asm volatile("s_mov_b32 %0, m0\n\ts_mov_b32 m0, %2\n\ts_nop 0\n\tglobal_load_lds_dwordx4 %1, off\n\ts_mov_b32 m0, %0":"=&s"(keep):"v"(gsrc),"s"(lds_dst):"memory");}
__device__ __forceinline__ float max3f(float a,float b,float c){float r;asm("v_max3_f32 %0, %1, %2, %3":"=v"(r):"v"(a),"v"(b),"v"(c));return r;}
__device__ __forceinline__ float max2f(float a,float b){float r;asm("v_max_f32_e32 %0, %1, %2":"=v"(r):"v"(a),"v"(b));return r;}
__device__ __forceinline__ float fadd_s(float a,float b){float r;asm("v_add_f32_e32 %0, %1, %2":"=v"(r):"v"(a),"v"(b));return r;}
__device__ __forceinline__ float fsub_s(float a,float b){float r;asm("v_sub_f32_e32 %0, %1, %2":"=v"(r):"v"(a),"v"(b));return r;}
typedef float f32x2_t __attribute__((ext_vector_type(2))); typedef __bf16 bf16x2_t __attribute__((ext_vector_type(2)));
__device__ __forceinline__ unsigned cvtpk_s(float lo,float hi){f32x2_t v={lo,hi};bf16x2_t b=__builtin_convertvector(v,bf16x2_t);return __builtin_bit_cast(unsigned,b);}
#define WAIT_BAR(N) asm volatile("s_waitcnt vmcnt(" #N ") lgkmcnt(0)\n\ts_barrier":::"memory")

__device__ __forceinline__ void qkt(f32x16&p0,f32x16&p1,const char*Kslot,const bf16x8*qr,int r32,int hi){
  const char*kb=Kslot+hi*1024+r32*16;
  #pragma unroll
  for(int d0=0;d0<4;++d0){
    const bf16x8 b0=*reinterpret_cast<const bf16x8*>(kb+d0*2048);
    const bf16x8 b1=*reinterpret_cast<const bf16x8*>(kb+d0*2048+512);
    p0=__builtin_amdgcn_mfma_f32_32x32x16_bf16(b0,qr[d0],p0,0,0,0);p1=__builtin_amdgcn_mfma_f32_32x32x16_bf16(b1,qr[d0],p1,0,0,0);}
}
typedef __attribute__((address_space(3))) const char* lds_cptr;
typedef __attribute__((address_space(3))) char* lds_ptr;
typedef short v4i16_t __attribute__((ext_vector_type(4)));
__device__ __forceinline__ void kload8(bf16x8*kf,lds_cptr kp){
  kf[0]=*(const __attribute__((address_space(3))) bf16x8*)(kp);      kf[1]=*(const __attribute__((address_space(3))) bf16x8*)(kp+512);
  kf[2]=*(const __attribute__((address_space(3))) bf16x8*)(kp+2048); kf[3]=*(const __attribute__((address_space(3))) bf16x8*)(kp+2560);
  kf[4]=*(const __attribute__((address_space(3))) bf16x8*)(kp+4096); kf[5]=*(const __attribute__((address_space(3))) bf16x8*)(kp+4608);
  kf[6]=*(const __attribute__((address_space(3))) bf16x8*)(kp+6144); kf[7]=*(const __attribute__((address_space(3))) bf16x8*)(kp+6656);
}
__device__ __forceinline__ void kload2(bf16x8*kf,lds_cptr kp,int j){ kf[2*j]=*(const __attribute__((address_space(3))) bf16x8*)(kp+j*2048); kf[2*j+1]=*(const __attribute__((address_space(3))) bf16x8*)(kp+j*2048+512); }
__device__ __forceinline__ s16x4 vtr(lds_cptr p){ return __builtin_bit_cast(s16x4,__builtin_amdgcn_ds_read_tr16_b64_v4i16((__attribute__((address_space(3))) v4i16_t*)p)); }
__device__ __forceinline__ float rowmax(const f32x16&p0,const f32x16&p1){
  float a=max3f(p0[0],p0[1],p1[0]),b=max3f(p0[2],p0[3],p1[1]);a=max3f(a,p1[2],p1[3]);
  #pragma unroll
  for(int r=4;r<16;r+=4){a=max3f(a,p0[r],p0[r+1]);b=max3f(b,p0[r+2],p0[r+3]);a=max3f(a,p1[r],p1[r+1]);b=max3f(b,p1[r+2],p1[r+3]);}
  const float m=max2f(a,b);
  auto rr=__builtin_amdgcn_permlane32_swap(__float_as_uint(m),__float_as_uint(m),false,false);
  return max2f(__uint_as_float(rr[0]),__uint_as_float(rr[1]));
}
__device__ __forceinline__ void pv(f32x16*o,int vb,bf16x8 pa0,bf16x8 pa1,bf16x8 pa2,bf16x8 pa3){
  #pragma unroll
  for(int d0=0;d0<2;++d0){s16x4 lo[4],hi[4];
    #pragma unroll
    for(int ks=0;ks<4;++ks){
      asm volatile("ds_read_b64_tr_b16 %0,%1 offset:%c2":"=&v"(lo[ks]):"v"(vb),"i"(d0*4096+ks*1024):"memory");
      asm volatile("ds_read_b64_tr_b16 %0,%1 offset:%c2":"=&v"(hi[ks]):"v"(vb),"i"(d0*4096+ks*1024+512):"memory");}
    asm volatile("s_waitcnt lgkmcnt(0)":::"memory");SBAR();
    #define PK(k) (bf16x8){lo[k][0],lo[k][1],lo[k][2],lo[k][3],hi[k][0],hi[k][1],hi[k][2],hi[k][3]}
    o[d0]=__builtin_amdgcn_mfma_f32_32x32x16_bf16(pa0,PK(0),o[d0],0,0,0);
    o[d0]=__builtin_amdgcn_mfma_f32_32x32x16_bf16(pa1,PK(1),o[d0],0,0,0);
    o[d0]=__builtin_amdgcn_mfma_f32_32x32x16_bf16(pa2,PK(2),o[d0],0,0,0);
    o[d0]=__builtin_amdgcn_mfma_f32_32x32x16_bf16(pa3,PK(3),o[d0],0,0,0);
    #undef PK
  }
}

struct AttnArgs { const bf16* Q; const bf16* K; const bf16* V; bf16* O; long qp, kp, op; int q0, NT, kv0; const float* aux; float* lse; long lse_stride; };
#define ATTN_STORE16(p,v) (*(u32x4*)(p)=(v))
template<int MODE,int THRL> __device__ __forceinline__ void attn_unit(const AttnArgs&a,char*shm){
  int tid_=threadIdx.x; asm volatile("":"+v"(tid_));
  const int tid=tid_,lane=tid&63,r32=lane&31,hi=lane>>5; const int wid=__builtin_amdgcn_readfirstlane(tid>>6);
  const int q0=a.q0; const long KP=a.kp;
  const bf16*Qw=a.Q+(long)(q0+wid*QBLK)*a.qp;
  const bf16*Kh=a.K,*Vh=a.V;
  const unsigned lds0=(unsigned)(uintptr_t)shm;
  float*wsf=(float*)(shm+LDS_WS)+wid*64;
  const lds_cptr shm3=(lds_cptr)shm;
  const __attribute__((address_space(3))) float* cs3=(const __attribute__((address_space(3))) float*)(shm3+LDS_CS);
  float nb=0.f;
  if(MODE==0){ __attribute__((address_space(3))) f32x4v* dst=(__attribute__((address_space(3))) f32x4v*)((lds_ptr)shm+LDS_CS); const f32x4v* src=(const f32x4v*)a.aux; const int n4=(q0+QB)/4;
    for(int i=tid;i<n4;i+=NW*64)dst[i]=src[i];
    nb=a.aux[q0+wid*QBLK+r32]; }
  if(MODE==1){ __attribute__((address_space(3))) float* dst=(__attribute__((address_space(3))) float*)((lds_ptr)shm+LDS_CS);
    for(int i=tid;i<TBL_N;i+=NW*64)dst[i]=a.aux[i]; }
  const bf16*ksrc=Kh+(long)lane*KP+wid*8;
  const bf16*vsrc=Vh+(long)(16*(wid&3)+(lane>>2))*KP+(wid>>2)*32+(lane&3)*8;
  const unsigned kdst=lds0+LDS_K+wid*1024, vdst=lds0+LDS_V+wid*1024;
  #define DMA_K(t,slot) glds16(ksrc+(long)(t)*KVBLK*KP,(unsigned)__builtin_amdgcn_readfirstlane(kdst+(slot)))
  #define DMA_V(t,slot) glds16(vsrc+(long)(t)*KVBLK*KP,(unsigned)__builtin_amdgcn_readfirstlane(vdst+(slot)))
  const int vb0=(int)(lds0+LDS_V)+((lane>>4)&1)*32+(lane&3)*8+(4*hi+((lane&15)>>2))*64;
  const char*Kbase=shm+LDS_K; bf16x8 kf[8];
  const lds_cptr kp0=shm3+LDS_K+hi*1024+r32*16; const lds_cptr vp0=shm3+LDS_V+((lane>>4)&1)*32+(lane&3)*8+(4*hi+((lane&15)>>2))*64;
  const int NT=a.NT;
  DMA_K(0,0);DMA_V(0,0);DMA_K(1,SLOTB);
  bf16x8 qr[4];
  #pragma unroll
  for(int d0=0;d0<4;++d0)qr[d0]=*reinterpret_cast<const bf16x8*>(&Qw[(long)r32*a.qp+d0*16+hi*8]);
  float mhat=0.f,l_reg=0.f;f32x16 o[2];o[0]=f32x16{};o[1]=f32x16{};
  const int qrel=wid*QBLK+r32;
  const int tb0=q0+qrel-a.kv0-4*hi+TBL_ZERO-63;
  #define CINIT(C0,C1,t) do{ \
    if(MODE==0){ const __attribute__((address_space(3))) float* cp_=cs3+64*(t)+4*hi; \
      _Pragma("unroll") for(int g_=0;g_<4;++g_){ const f32x4v a_=*(const __attribute__((address_space(3))) f32x4v*)(cp_+8*g_); const f32x4v b_=*(const __attribute__((address_space(3))) f32x4v*)(cp_+32+8*g_); \
        C0[4*g_]=nb-a_[0];C0[4*g_+1]=nb-a_[1];C0[4*g_+2]=nb-a_[2];C0[4*g_+3]=nb-a_[3]; C1[4*g_]=nb-b_[0];C1[4*g_+1]=nb-b_[1];C1[4*g_+2]=nb-b_[2];C1[4*g_+3]=nb-b_[3]; } } \
    else if(MODE==1){ const __attribute__((address_space(3))) float* tp_=cs3+(tb0-64*(t)); \
      _Pragma("unroll") for(int g_=0;g_<4;++g_) _Pragma("unroll") for(int j_=0;j_<4;++j_){ C0[4*g_+j_]=nb+tp_[63-8*g_-j_]; C1[4*g_+j_]=nb+tp_[31-8*g_-j_]; } } \
    else { _Pragma("unroll") for(int r_=0;r_<16;++r_){C0[r_]=nb;C1[r_]=nb;} } }while(0)
  #define CMASK(P0,P1,t) do{ if(MODE==0){int jb_=(t)-(NT-4); if(jb_>=0)cmask(P0,P1,jb_,qrel,hi);} }while(0)
  bool resc=false;
  #define START(P0,P1) do{ const float rm=rowmax(P0,P1); resc=false; \
    { const float dl=(MODE==1)?max2f(rm,-256.0f):rm; mhat=fadd_s(mhat,dl); nb=fsub_s(nb,dl); \
      _Pragma("unroll") for(int r=0;r<16;++r){P0[r]=fsub_s(P0[r],dl);P1[r]=fsub_s(P1[r],dl);} } \
    _Pragma("unroll") for(int r=0;r<16;++r)P0[r]=__builtin_amdgcn_exp2f(P0[r]); }while(0)
  #define RESC() do{ if(resc){ asm volatile("s_waitcnt lgkmcnt(0)":::"memory"); \
      _Pragma("unroll") for(int d_=0;d_<2;++d_) _Pragma("unroll") for(int r=0;r<16;++r)o[d_][r]*=wsf[crow(r,hi)]; } }while(0)
  f32x16 pA0,pA1,pB0,pB1;
  int sl_prev=0,sl_cur=0,sl_next=SLOTB;
  #define ROT() do{sl_prev=sl_cur;sl_cur=sl_next;sl_next=(sl_next==(NSLOT-1)*SLOTB)?0:sl_next+SLOTB;}while(0)
  DMA_K(2,2*SLOTB);
  WAIT_BAR(3);
  CINIT(pA0,pA1,0);
  qkt(pA0,pA1,Kbase,qr,r32,hi);asm volatile("s_nop 15\n\ts_nop 7":"+v"(pA0),"+v"(pA1));CMASK(pA0,pA1,0);
  START(pA0,pA1);
  _Pragma("unroll") for(int r=0;r<16;++r)pA1[r]=__builtin_amdgcn_exp2f(pA1[r]);
  WAIT_BAR(0);
  DMA_K(3,0);DMA_V(1,SLOTB);
  ROT();
  kload8(kf,kp0+sl_cur);
  WAIT_BAR(2);
  s16x4 vlo[8],vhi[8]; u32x4 pw0,pw1,pw2,pw3;
  #define PKW(P,B) cvtpk_s(P[B],P[B+1])
  #define PAF(k) __builtin_bit_cast(bf16x8,pw##k)
  #define VFR(i) (bf16x8){vlo[i][0],vlo[i][1],vlo[i][2],vlo[i][3],vhi[i][0],vhi[i][1],vhi[i][2],vhi[i][3]}
  #define PIN(x) asm volatile("":"+v"(x))
  #define MX3(a,b,c) __builtin_fmaxf(__builtin_fmaxf((a),(b)),(c))
  #define GAPA(MF,A0,A1,A2,A3,W0,W1,PW) do{ MF; sacc+=A0; sacc+=A1; sacc+=A2; sacc+=A3; PIN(sacc); W0; W1; PIN(PW); SBAR(); }while(0)
  #define EX(v) __builtin_amdgcn_exp2f(v)
  #define GAPB(MF,X,B) do{ MF; X[B]=EX(X[B]); X[B+1]=EX(X[B+1]); X[B+2]=EX(X[B+2]); X[B+3]=EX(X[B+3]); PIN(X); SBAR(); }while(0)
  #define VRD(i) do{ vlo[i]=vtr(vp_+(((i)>>2)*4096+((i)&3)*1024)); vhi[i]=vtr(vp_+(((i)>>2)*4096+((i)&3)*1024+512)); }while(0)
  #define KRD(G,j) do{ if(G){ kload2(kf,kp0+sl_next,j); SBAR(); } }while(0)
  #define STEP(C0,C1,P0,P1,t,GK,GV,GL) do{ CINIT(C0,C1,t); SBAR(); \
    const lds_cptr vp_=vp0+sl_prev; \
    VRD(0); SBAR(); float sacc=(P0[0]+P0[1]); \
    GAPA(C0=__builtin_amdgcn_mfma_f32_32x32x16_bf16(kf[0],qr[0],C0,0,0,0), P0[2],P0[3],P0[4],P0[5],     pw0[0]=PKW(P0,0), pw0[1]=PKW(P0,2), pw0); \
    VRD(4); SBAR(); GAPA(C1=__builtin_amdgcn_mfma_f32_32x32x16_bf16(kf[1],qr[0],C1,0,0,0), P0[6],P0[7],P0[8],P0[9],     pw0[2]=PKW(P0,4), pw0[3]=PKW(P0,6), pw0); \
    VRD(1); SBAR(); GAPA(C0=__builtin_amdgcn_mfma_f32_32x32x16_bf16(kf[2],qr[1],C0,0,0,0),   P0[10],P0[11],P0[12],P0[13], pw1[0]=PKW(P0,8), pw1[1]=PKW(P0,10), pw1); \
    VRD(5); SBAR(); GAPA(C1=__builtin_amdgcn_mfma_f32_32x32x16_bf16(kf[3],qr[1],C1,0,0,0),   P0[14],P0[15],P1[0],P1[1],   pw1[2]=PKW(P0,12),pw1[3]=PKW(P0,14), pw1); \
    VRD(2); SBAR(); GAPA(C0=__builtin_amdgcn_mfma_f32_32x32x16_bf16(kf[4],qr[2],C0,0,0,0),   P1[2],P1[3],P1[4],P1[5],     pw2[0]=PKW(P1,0), pw2[1]=PKW(P1,2), pw2); \
    VRD(6); SBAR(); GAPA(C1=__builtin_amdgcn_mfma_f32_32x32x16_bf16(kf[5],qr[2],C1,0,0,0),   P1[6],P1[7],P1[8],P1[9],     pw2[2]=PKW(P1,4), pw2[3]=PKW(P1,6), pw2); \
    VRD(3); SBAR(); GAPA(C0=__builtin_amdgcn_mfma_f32_32x32x16_bf16(kf[6],qr[3],C0,0,0,0),   P1[10],P1[11],P1[12],P1[13], pw3[0]=PKW(P1,8), pw3[1]=PKW(P1,10), pw3); \
    VRD(7); SBAR(); GAPA(C1=__builtin_amdgcn_mfma_f32_32x32x16_bf16(kf[7],qr[3],C1,0,0,0),   P1[14],P1[15],0.f,0.f,       pw3[2]=PKW(P1,12),pw3[3]=PKW(P1,14), pw3); \
    l_reg+=sacc; \
    if(GK){DMA_K((t)+3,sl_cur);} if(GV){DMA_V((t)+1,sl_next);} \
    CMASK(C0,C1,t); \
    { float a=MX3(C0[0],C0[1],C1[0]),b=MX3(C0[2],C0[3],C1[1]); a=MX3(a,C1[2],C1[3]); \
      _Pragma("unroll") for(int r=4;r<16;r+=4){a=MX3(a,C0[r],C0[r+1]);b=MX3(b,C0[r+2],C0[r+3]);a=MX3(a,C1[r],C1[r+1]);b=MX3(b,C1[r+2],C1[r+3]);} \
      float rm=__builtin_fmaxf(a,b); { auto rr=__builtin_amdgcn_permlane32_swap(__float_as_uint(rm),__float_as_uint(rm),false,false); rm=__builtin_fmaxf(__uint_as_float(rr[0]),__uint_as_float(rr[1])); } \
      resc=false; \
      if(__builtin_expect(__any(rm>(float)THRL),0)){ const float dl=__builtin_fmaxf(rm,0.f); mhat+=dl; nb-=dl; \
        _Pragma("unroll") for(int r=0;r<16;++r){C0[r]-=dl;C1[r]-=dl;} \
        const float f=__builtin_amdgcn_exp2f(-dl); l_reg*=f; if(hi==0)wsf[r32]=f; resc=true; } } \
    SBAR(); \
    GAPB(o[0]=__builtin_amdgcn_mfma_f32_32x32x16_bf16(PAF(0),VFR(0),o[0],0,0,0), C0,0); \
    GAPB(o[1]=__builtin_amdgcn_mfma_f32_32x32x16_bf16(PAF(0),VFR(4),o[1],0,0,0), C0,4); \
    KRD(GL,0); GAPB(o[0]=__builtin_amdgcn_mfma_f32_32x32x16_bf16(PAF(1),VFR(1),o[0],0,0,0), C0,8); \
    KRD(GL,1); GAPB(o[1]=__builtin_amdgcn_mfma_f32_32x32x16_bf16(PAF(1),VFR(5),o[1],0,0,0), C0,12); \
    KRD(GL,2); GAPB(o[0]=__builtin_amdgcn_mfma_f32_32x32x16_bf16(PAF(2),VFR(2),o[0],0,0,0), C1,0); \
    KRD(GL,3); GAPB(o[1]=__builtin_amdgcn_mfma_f32_32x32x16_bf16(PAF(2),VFR(6),o[1],0,0,0), C1,4); \
    GAPB(o[0]=__builtin_amdgcn_mfma_f32_32x32x16_bf16(PAF(3),VFR(3),o[0],0,0,0), C1,8); \
    GAPB(o[1]=__builtin_amdgcn_mfma_f32_32x32x16_bf16(PAF(3),VFR(7),o[1],0,0,0), C1,12); \
    }while(0)
  int t=1;
  #undef CMASK
  #define CMASK(P0,P1,t) do{}while(0)
  for(;t+5<NT;t+=2){
    STEP(pB0,pB1,pA0,pA1,t,true,true,true);     WAIT_BAR(2); RESC(); ROT();
    STEP(pA0,pA1,pB0,pB1,t+1,true,true,true);   WAIT_BAR(2); RESC(); ROT();
  }
  #undef CMASK
  #define CMASK(P0,P1,t) do{ if(MODE==0){int jb_=(t)-(NT-4); if(jb_>=0)cmask(P0,P1,jb_,qrel,hi);} }while(0)
  #define ENDW(tt) do{ if((tt)+3<NT){WAIT_BAR(2);} else if((tt)+2<NT){WAIT_BAR(1);} else {WAIT_BAR(0);} }while(0)
  for(;t+1<NT;t+=2){
    STEP(pB0,pB1,pA0,pA1,t,(t+3<NT),(t+1<NT),(t+1<NT));       ENDW(t);   RESC(); ROT();
    STEP(pA0,pA1,pB0,pB1,t+1,(t+4<NT),(t+2<NT),(t+2<NT));     ENDW(t+1); RESC(); ROT();
  }
  STEP(pB0,pB1,pA0,pA1,NT-1,false,false,false); RESC();
  { float sacc=pB0[0]+pB0[1]; _Pragma("unroll") for(int r=2;r<16;++r)sacc+=pB0[r]; _Pragma("unroll") for(int r=0;r<16;++r)sacc+=pB1[r]; l_reg+=sacc;
    pw0=(u32x4){PKW(pB0,0),PKW(pB0,2),PKW(pB0,4),PKW(pB0,6)};pw1=(u32x4){PKW(pB0,8),PKW(pB0,10),PKW(pB0,12),PKW(pB0,14)};pw2=(u32x4){PKW(pB1,0),PKW(pB1,2),PKW(pB1,4),PKW(pB1,6)};pw3=(u32x4){PKW(pB1,8),PKW(pB1,10),PKW(pB1,12),PKW(pB1,14)};
    SBAR(); pv(o,vb0+sl_cur,PAF(0),PAF(1),PAF(2),PAF(3)); }
  #undef PKW
  #undef PAF
  #undef VFR
  #undef PIN
  #undef MX3
  #undef GAPA
  #undef GAPB
  #undef EX
  #undef VRD
  #undef KRD
  #undef STEP
  #undef ENDW
  {auto rr=__builtin_amdgcn_permlane32_swap(__float_as_uint(l_reg),__float_as_uint(l_reg),false,false);l_reg=__uint_as_float(rr[0])+__uint_as_float(rr[1]);}
  if(MODE==1){ if(hi==0) a.lse[(long)(q0+qrel)*a.lse_stride]=mhat+__builtin_amdgcn_logf(l_reg); }
  if(hi==0)wsf[32+r32]=l_reg;asm volatile("s_waitcnt lgkmcnt(0)":::"memory");
  float rli[16];
  #pragma unroll
  for(int r=0;r<16;++r)rli[r]=__builtin_amdgcn_rcpf(wsf[32+crow(r,hi)]);
  bf16*Ow=a.O+(long)(q0+wid*QBLK)*a.op;
  { bf16*stg=(bf16*)(shm+LDS_OST)+wid*2048;
    #pragma unroll
    for(int r=0;r<16;++r){const int orow=crow(r,hi);
      #pragma unroll
      for(int d0=0;d0<2;++d0)stg[orow*64+d0*32+r32]=__float2bfloat16(o[d0][r]*rli[r]);}
    asm volatile("s_waitcnt lgkmcnt(0)":::"memory");
    #pragma unroll
    for(int i=0;i<4;++i){const int row=i*8+(lane>>3),ch=lane&7; const u32x4 v=*(const u32x4*)(stg+row*64+ch*8); ATTN_STORE16(Ow+(long)row*a.op+ch*8,v);} }
  asm volatile("s_waitcnt lgkmcnt(0)\n\ts_barrier":::"memory");
  #undef DMA_K
  #undef DMA_V
  #undef CMASK
  #undef CINIT
  #undef START
  #undef RESC
  #undef ROT
}
constexpr int ATTN_LDS_BYTES=LDS_TOTAL;
#undef SBAR
#undef WAIT_BAR
}
#define GAS __attribute__((address_space(1)))
#define LAS __attribute__((address_space(3)))
typedef unsigned short bf16;
typedef unsigned v4u __attribute__((ext_vector_type(4)));
typedef float f32x4 __attribute__((ext_vector_type(4)));
typedef short bf16x8 __attribute__((ext_vector_type(8)));
typedef GAS unsigned gu32;
typedef GAS unsigned long long gu64;
#define RLX_AGENT __ATOMIC_RELAXED, __HIP_MEMORY_SCOPE_AGENT
#define LDS_WAIT() asm volatile("s_waitcnt lgkmcnt(0)" ::: "memory")
#define VM_WAIT() asm volatile("s_waitcnt vmcnt(0)" ::: "memory")
__device__ __forceinline__ unsigned long long rt() { return __builtin_amdgcn_s_memrealtime(); }
__device__ __forceinline__ unsigned f2bf(float f) { unsigned u = __builtin_bit_cast(unsigned, f); return (u + 0x7fffu + ((u >> 16) & 1u)) >> 16; }
__device__ __forceinline__ unsigned pk2(float lo, float hi) { return f2bf(lo) | (f2bf(hi) << 16); }

#define XB_TMO      128
#define XB_XCNT(j)  (256  + 64 * (j))
#define XB_XSUB(j)  (1280 + 64 * (j))
#define XB_XGEN(j)  (2304 + 64 * (j))
#define XB_TOP      3328
#define XB_TOPGEN   3392
#define XCD_BAR_WORDS 3456
#define XB_SPIN_CAP (1u << 18)

__device__ __forceinline__ unsigned xb_ld(unsigned* p)              { return __hip_atomic_load(p, __ATOMIC_RELAXED, __HIP_MEMORY_SCOPE_AGENT); }
__device__ __forceinline__ unsigned xb_add(unsigned* p, unsigned v) { return __hip_atomic_fetch_add(p, v, __ATOMIC_RELAXED, __HIP_MEMORY_SCOPE_AGENT); }
__device__ __forceinline__ unsigned xb_xcc_id() { return (unsigned)__builtin_amdgcn_s_getreg((3 << 11) | 20) & 0xFu; }
#define XB_SPIN(cond, bar) do { unsigned _sp = 0; while (cond) { __builtin_amdgcn_s_sleep(1); \
    if ((++_sp & 255u) == 0u) { if (xb_ld(&(bar)[XB_TMO])) break; if (_sp > XB_SPIN_CAP) { atomicAdd(&(bar)[XB_TMO], 1u); break; } } } } while (0)

struct XcdBarrier {
    unsigned* bar; unsigned x;
    volatile LAS unsigned* st;
};

__device__ __forceinline__ XcdBarrier xcd_barrier_post(unsigned* bar, volatile LAS unsigned* st) {
    XcdBarrier b; b.bar = bar; b.x = xb_xcc_id(); b.st = st;
    if (threadIdx.x == 0) (void)xb_add(&bar[XB_XCNT(b.x)], 1u);
    return b;
}
__device__ __forceinline__ void xcd_barrier_complete(unsigned* bar, unsigned x, unsigned& nloc, unsigned& nx) {
    const unsigned G = gridDim.x * gridDim.y * gridDim.z;
    unsigned sum, cnt, mine, sp = 0u;
    for (;;) {
        sum = 0u; cnt = 0u; mine = 0u;
#pragma unroll
        for (unsigned j = 0; j < 16; ++j) { const unsigned c = xb_ld(&bar[XB_XCNT(j)]); sum += c; cnt += (c > 0u) ? 1u : 0u; mine = (j == x) ? c : mine; }
        if (sum == G) break;
        __builtin_amdgcn_s_sleep(1);
        if ((++sp & 255u) == 0u) { if (xb_ld(&bar[XB_TMO])) break; if (sp > XB_SPIN_CAP) { atomicAdd(&bar[XB_TMO], 1u); break; } }
    }
    nloc = mine > 0u ? mine : 1u; nx = cnt > 0u ? cnt : 1u;
}

__device__ __forceinline__ void xcd_barrier(const XcdBarrier& b) {
    asm volatile("s_waitcnt vmcnt(0)" ::: "memory");
    __syncthreads();
    if (threadIdx.x == 0) {
        unsigned* bar = b.bar;
        __builtin_amdgcn_s_waitcnt(0);
        unsigned nloc = b.st[0], nx = b.st[1];
        if (nloc == 0u) { xcd_barrier_complete(bar, b.x, nloc, nx); b.st[0] = nloc; b.st[1] = nx; }
        const unsigned old = xb_add(&bar[XB_XSUB(b.x)], 1u);
        const unsigned gen = old / nloc;
        if (old + 1u == (gen + 1u) * nloc) {
            __builtin_amdgcn_fence(__ATOMIC_RELEASE, "agent");
            asm volatile("s_waitcnt vmcnt(0)" ::: "memory");
            const unsigned og = xb_add(&bar[XB_TOP], 1u);
            const unsigned tg = og / nx;
            if (og + 1u == (tg + 1u) * nx) xb_add(&bar[XB_TOPGEN], 1u);
            else XB_SPIN(xb_ld(&bar[XB_TOPGEN]) == tg, bar);
            __builtin_amdgcn_fence(__ATOMIC_ACQUIRE, "agent");
            xb_add(&bar[XB_XGEN(b.x)], 1u);
            asm volatile("s_waitcnt vmcnt(0)" ::: "memory");
        } else {
            XB_SPIN(xb_ld(&bar[XB_XGEN(b.x)]) == gen, bar);
            __builtin_amdgcn_fence(__ATOMIC_ACQUIRE, "agent");
            asm volatile("s_waitcnt vmcnt(0)" ::: "memory");
        }
    }
    __syncthreads();
}

constexpr int NWAVES = 8;
constexpr int S = 16384, DM = 1024, NPROJ = 5632, NE = 32, MEML = 256;
constexpr int PC_FQ = 0, PC_FK = 384, PC_FV = 768, PC_DQ = 1152, PC_DK = 1536, PC_DV = 1920, PC_MQ = 2304, PC_GT = 2560;
constexpr int W_IN_LD = 5638, W_IN_F = 1152;
constexpr float LN_EPS = 1e-5f, ALPHA = 1.189207115002721f;
constexpr float LOG2E = 1.4426950408889634f, C2F = 0.125f * 1.4426950408889634f;
constexpr int MAXROWS = 65536 + 32 * 256;
constexpr int NPHASE = 11;
#ifndef MK_N_LAUNCHES
#define MK_N_LAUNCHES 11
#endif
constexpr int N_LAUNCHES = MK_N_LAUNCHES;

constexpr size_t MiB = 1u << 20, KiB = 1u << 10;
constexpr size_t WS_CTL = 0, CTL_ZERO_BYTES = 64 * KiB;
constexpr size_t WS_WIN = 2 * MiB;
constexpr size_t WS_WBF = 13 * MiB, WS_WBD = WS_WBF + 768 * KiB, WS_WBM = WS_WBD + 768 * KiB, WS_WOUT = 15 * MiB, WS_WMKV = 17 * MiB;
constexpr size_t WS_LF2 = 18 * MiB, WS_C2 = WS_LF2 + 512 * KiB, WS_LSE = 19 * MiB, WS_TBL = WS_LSE + 512 * KiB, WS_MEMB = 20 * MiB, WS_MEMKV = WS_MEMB + 512 * KiB;
constexpr size_t WS_TOPI = 21 * MiB, WS_TOPG = WS_TOPI + 256 * KiB, WS_RANK = WS_TOPG + 256 * KiB, WS_DEST = WS_RANK + 256 * KiB, WS_BLKCNT = 22 * MiB, WS_TST = WS_BLKCNT + 64 * KiB;
constexpr size_t WS_XB = 24 * MiB;
constexpr size_t WS_PBUF = 56 * MiB;
constexpr size_t WS_Y = WS_PBUF;
constexpr size_t WS_OFOX = 232 * MiB, WS_ODIL = 244 * MiB, WS_OMEM = 256 * MiB;
constexpr size_t WS_W1 = 264 * MiB, WS_W2 = 392 * MiB;
constexpr size_t WS_STASH = 456 * MiB, WS_MERGED = 520 * MiB;
constexpr size_t WS_R1 = 552 * MiB, WS_H1 = 616 * MiB, WS_H1B = 680 * MiB;
constexpr size_t WS_XS = 712 * MiB, WS_ACT = 856 * MiB, WS_END = 1000 * MiB;
static_assert(WS_XS + (size_t)MAXROWS * 1024 * 2 <= WS_ACT && WS_ACT + (size_t)MAXROWS * 1024 * 2 <= WS_END && WS_Y + (size_t)MAXROWS * 1024 * 2 <= WS_OFOX, "ws map");
constexpr int CW_BAR = 4096;

constexpr int RING_OFF = 0;
constexpr int LDSCTL_OFF = attn_body::ATTN_LDS_BYTES, MISC_OFF = LDSCTL_OFF + 320, TBL_OFF = MISC_OFF + 128;
constexpr int LDS_BYTES = 150528;
static_assert(TBL_OFF + 256 <= LDS_BYTES && pg8::STAGE_BYTES <= LDSCTL_OFF, "LDS map");

struct Args { const float* in[20]; float* out; unsigned char* ws; int ph_lo, ph_hi; };
struct Frame {
    LAS unsigned char* lds;
    volatile LAS unsigned* MISC;
    gu32* ctl;
    int tid, lane, wave;
    int vcu, G;
    float* out; unsigned char* ws;
};
__device__ __forceinline__ float wave_sum(float v) {
#pragma unroll
    for (int o = 1; o < 64; o <<= 1) v += __shfl_xor(v, o);
    return v;
}
typedef float f4u __attribute__((ext_vector_type(4), aligned(4)));
typedef float f32x2 __attribute__((ext_vector_type(2)));
typedef unsigned v2u __attribute__((ext_vector_type(2)));
__device__ __forceinline__ void p0_tr_item(const float* W, int ldw, int k0, int src_n0, bf16* WT, int K, int dst_n0, float scale, LAS float* scr, int lane) {
    f4u v[16];
#pragma unroll
    for (int i = 0; i < 16; ++i) v[i] = *(const f4u*)(W + (size_t)(k0 + 4 * i + (lane >> 4)) * ldw + src_n0 + (lane & 15) * 4);
#pragma unroll
    for (int i = 0; i < 16; ++i) { LAS float* d = scr + (4 * i + (lane >> 4)) * 65 + (lane & 15) * 4; d[0] = v[i].x * scale; d[1] = v[i].y * scale; d[2] = v[i].z * scale; d[3] = v[i].w * scale; }
    LDS_WAIT(); asm volatile("" ::: "memory");
    const int c = lane & 7;
#pragma unroll
    for (int j = 0; j < 8; ++j) { const int n = (lane >> 3) + 8 * j; const LAS float* s = scr + (8 * c) * 65 + n;
        v4u o; o.x = pk2(s[0 * 65], s[1 * 65]); o.y = pk2(s[2 * 65], s[3 * 65]); o.z = pk2(s[4 * 65], s[5 * 65]); o.w = pk2(s[6 * 65], s[7 * 65]);
        *(GAS v4u*)(WT + (size_t)(dst_n0 + n) * K + k0 + 8 * c) = o; }
    LDS_WAIT(); asm volatile("" ::: "memory");
}
__device__ __forceinline__ void p0_prologue(Frame& F, const Args& A) {
    LAS float* scr = (LAS float*)(F.lds + RING_OFF + F.wave * 16640);
    const int gw = F.vcu * NWAVES + F.wave, NGW = F.G * NWAVES;
    bf16* const WIN = (bf16*)(F.ws + WS_WIN); bf16* const WBF = (bf16*)(F.ws + WS_WBF); bf16* const WBD = (bf16*)(F.ws + WS_WBD); bf16* const WBM = (bf16*)(F.ws + WS_WBM);
    bf16* const WOUT = (bf16*)(F.ws + WS_WOUT); bf16* const WMKV = (bf16*)(F.ws + WS_WMKV); bf16* const W1 = (bf16*)(F.ws + WS_W1); bf16* const W2 = (bf16*)(F.ws + WS_W2);
    constexpr int I_IN = 16 * 88, I_BF = 6 * 16, I_BD = 6 * 16, I_BM = 4 * 16, I_WO = 16 * 16, I_MKV = 16 * 8, I_E1 = 32 * 512, I_E2 = 32 * 256;
    constexpr int NITEMS = I_IN + I_BF + I_BD + I_BM + I_WO + I_MKV + I_E1 + I_E2;
    for (int it = gw; it < NITEMS; it += NGW) {
        int r = it;
        if (r < I_E1) { const int e = r >> 9, rr = r & 511, kb = rr >> 5, nb = rr & 31, dn = nb * 64; const int sn = ((dn >> 7) & 1) * 1024 + (dn >> 8) * 128 + (dn & 127);
            p0_tr_item(A.in[14] + (size_t)e * 1024 * 2048, 2048, kb * 64, sn, W1 + (size_t)e * 2048 * 1024, 1024, dn, 1.0f, scr, F.lane); continue; } r -= I_E1;
        if (r < I_E2) { const int e = r >> 8, rr = r & 255, kb = rr >> 4, nb = rr & 15;
            p0_tr_item(A.in[16] + (size_t)e * 1024 * 1024, 1024, kb * 64, nb * 64, W2 + (size_t)e * 1024 * 1024, 1024, nb * 64, 1.0f, scr, F.lane); continue; } r -= I_E2;
        if (r < I_IN) { const int kb = r / 88, nb = r % 88, dn = nb * 64; const int sn = dn + (dn >= W_IN_F ? 6 : 0);
            const float sc = (dn < PC_FK || (dn >= PC_DQ && dn < PC_DK) || (dn >= PC_MQ && dn < PC_GT)) ? C2F : 1.0f;
            p0_tr_item(A.in[2], W_IN_LD, kb * 64, sn, WIN, 1024, dn, sc, scr, F.lane); continue; } r -= I_IN;
        if (r < I_BF) { const int kb = r >> 4, nb = r & 15; p0_tr_item(A.in[6], 1024, kb * 64, nb * 64, WBF, 384, nb * 64, 1.0f, scr, F.lane); continue; } r -= I_BF;
        if (r < I_BD) { const int kb = r >> 4, nb = r & 15; p0_tr_item(A.in[7], 1024, kb * 64, nb * 64, WBD, 384, nb * 64, 1.0f, scr, F.lane); continue; } r -= I_BD;
        if (r < I_BM) { const int kb = r >> 4, nb = r & 15; p0_tr_item(A.in[8], 1024, kb * 64, nb * 64, WBM, 256, nb * 64, 1.0f, scr, F.lane); continue; } r -= I_BM;
        if (r < I_WO) { const int kb = r >> 4, nb = r & 15; p0_tr_item(A.in[9], 1024, kb * 64, nb * 64, WOUT, 1024, nb * 64, 1.0f, scr, F.lane); continue; } r -= I_WO;
        { const int kb = r >> 3, nb = r & 7; p0_tr_item(A.in[5], 512, kb * 64, nb * 64, WMKV, 1024, nb * 64, 1.0f, scr, F.lane); }
    }
    {
        float wf[4][4][6];
#pragma unroll
        for (int j = 0; j < 4; ++j)
#pragma unroll
            for (int i = 0; i < 4; ++i)
#pragma unroll
                for (int h = 0; h < 6; ++h) wf[j][i][h] = A.in[2][(size_t)(4 * F.lane + i + 256 * j) * W_IN_LD + W_IN_F + h];
        bf16* const XB = (bf16*)(F.ws + WS_XB); float* const LF2 = (float*)(F.ws + WS_LF2);
        for (int m = gw; m < S; m += NGW) {
            const GAS f32x4* xr = (const GAS f32x4*)(A.in[0] + (size_t)m * DM) + F.lane;
            f32x4 v[4]; float d[6] = {0.f, 0.f, 0.f, 0.f, 0.f, 0.f};
#pragma unroll
            for (int j = 0; j < 4; ++j) v[j] = xr[64 * j];
#pragma unroll
            for (int j = 0; j < 4; ++j)
#pragma unroll
                for (int h = 0; h < 6; ++h) d[h] += v[j].x * wf[j][0][h] + v[j].y * wf[j][1][h] + v[j].z * wf[j][2][h] + v[j].w * wf[j][3][h];
#pragma unroll
            for (int h = 0; h < 6; ++h) d[h] = wave_sum(d[h]);
            GAS unsigned long long* o8 = (GAS unsigned long long*)(XB + (size_t)m * DM) + F.lane;
#pragma unroll
            for (int j = 0; j < 4; ++j) o8[64 * j] = (unsigned long long)pk2(v[j].x, v[j].y) | ((unsigned long long)pk2(v[j].z, v[j].w) << 32);
            if (F.lane < 6) { const int h = F.lane; float f = h == 0 ? d[0] : h == 1 ? d[1] : h == 2 ? d[2] : h == 3 ? d[3] : h == 4 ? d[4] : d[5];
                f += A.in[3][h]; const float ls = fminf(f, 0.f) - log1pf(expf(-fabsf(f)));
                LF2[(size_t)h * S + m] = ls * LOG2E; }
        }
        bf16* const MEMB = (bf16*)(F.ws + WS_MEMB);
        for (int m = gw; m < MEML; m += NGW) {
            const GAS f32x4* xr = (const GAS f32x4*)(A.in[1] + (size_t)m * DM) + F.lane; GAS unsigned long long* o8 = (GAS unsigned long long*)(MEMB + (size_t)m * DM) + F.lane;
#pragma unroll
            for (int j = 0; j < 4; ++j) { const f32x4 v = xr[64 * j]; o8[64 * j] = (unsigned long long)pk2(v.x, v.y) | ((unsigned long long)pk2(v.z, v.w) << 32); }
        }
    }
    {
        float* const TBL = (float*)(F.ws + WS_TBL);
        for (int idx = F.vcu * (NWAVES * 64) + F.tid; idx < 6 * attn_body::TBL_N; idx += F.G * NWAVES * 64) {
            const int hd = idx / attn_body::TBL_N, i = idx - hd * attn_body::TBL_N, rel = i - attn_body::TBL_ZERO, g = hd >> 1, dil = g == 0 ? 1 : (g == 1 ? 4 : 16);
            float val = -INFINITY;
            if (rel >= 0 && rel <= 128) { const int dist = rel * dil; int bucket = dist;
                if (dist >= 16) { const float nf = (float)dist; bucket = 16 + (int)(logf(nf / 16.0f) / 4.852030263919617f * 16.0f); bucket = bucket > 31 ? 31 : bucket; }
                val = A.in[4][bucket * 6 + hd] * LOG2E; }
            TBL[idx] = val;
        }
    }
}

__device__ __forceinline__ void p1_cumsum(Frame& F, int h) {
    const float* src = (const float*)(F.ws + WS_LF2) + (size_t)h * S + F.tid * 32; float* dst = (float*)(F.ws + WS_C2) + (size_t)h * S + F.tid * 32;
    LAS double* part = (LAS double*)(F.lds + RING_OFF);
    f32x4 v[8]; double s = 0.0;
#pragma unroll
    for (int i = 0; i < 8; ++i) { v[i] = *(const f32x4*)(src + 4 * i); s += (double)v[i].x; s += (double)v[i].y; s += (double)v[i].z; s += (double)v[i].w; }
    part[F.tid] = s; __syncthreads();
    double run = 0.0;
    for (int j = 0; j < F.tid; ++j) run += part[j];
#pragma unroll
    for (int i = 0; i < 8; ++i) { f32x4 o; run += (double)v[i].x; o.x = (float)run; run += (double)v[i].y; o.y = (float)run; run += (double)v[i].z; o.z = (float)run; run += (double)v[i].w; o.w = (float)run; *(f32x4*)(dst + 4 * i) = o; }
    __syncthreads();
}

__device__ __forceinline__ bool p2_next(int G, int v, int i, int& kind, int& idx) {
    if (G == 256) {
        if (v < 128) { if (i > 0) return false; kind = 0; idx = v; return true; }
        const int f = v - 128;
        if (i == 0) { kind = 0; idx = v; return true; }
        if (i == 1) { kind = 0; idx = 511 - v; return true; }
        if (i < 5) { kind = 1; idx = f * 3 + (i - 2); return true; }
        if (i < 7) { kind = 2; idx = f * 2 + (i - 5); return true; }
        return false;
    }
    const int u = i * G + v; if (u >= 1024) return false;
    if (u < 384) { kind = 0; idx = u; } else if (u < 768) { kind = 1; idx = u - 384; } else { kind = 2; idx = u - 768; }
    return true;
}
__device__ __forceinline__ void p2_attention(Frame& F, char* lds) {
    typedef attn_body::bf16 abf;
    abf* const PB = (abf*)(F.ws + WS_PBUF);
    for (int i = 0;; ++i) {
        int kind, idx; if (!p2_next(F.G, F.vcu, i, kind, idx)) break;
        attn_body::AttnArgs a;
#ifndef ATT_MODES
#define ATT_MODES 7
#endif
        if (kind == 0 && (ATT_MODES & 1)) { const int h = idx % 6, qb = 63 - idx / 6;
            a.Q = PB + PC_FQ + h * 64; a.K = PB + PC_FK + h * 64; a.V = PB + PC_FV + h * 64; a.O = (abf*)(F.ws + WS_OFOX) + h * 64; a.qp = NPROJ; a.kp = NPROJ; a.op = 384;
            a.q0 = qb * 256; a.NT = 4 * qb + 4; a.kv0 = 0; a.aux = (const float*)(F.ws + WS_C2) + (size_t)h * S; a.lse = nullptr; a.lse_stride = 0;
            attn_body::attn_unit<0, 8>(a, lds);
        } else if (kind == 1 && (ATT_MODES & 2)) { const int g = idx >> 7, hs = (idx >> 6) & 1, w = idx & 63; const int dl = g == 0 ? 1 : (g == 1 ? 4 : 16); const int r = w % dl, qb = w / dl, hd = g * 2 + hs;
            const int t0 = 4 * qb - 2 > 0 ? 4 * qb - 2 : 0; const long pitch = (long)dl * NPROJ;
            a.Q = PB + PC_DQ + hd * 64 + (long)r * NPROJ; a.K = PB + PC_DK + hd * 64 + (long)r * NPROJ + (long)t0 * 64 * pitch; a.V = PB + PC_DV + hd * 64 + (long)r * NPROJ + (long)t0 * 64 * pitch;
            a.O = (abf*)(F.ws + WS_ODIL) + hd * 64 + (long)r * 384; a.qp = pitch; a.kp = pitch; a.op = (long)dl * 384;
            a.q0 = qb * 256; a.NT = 4 * qb + 4 - t0; a.kv0 = t0 * 64; a.aux = (const float*)(F.ws + WS_TBL) + hd * attn_body::TBL_N; a.lse = (float*)(F.ws + WS_LSE) + r * 6 + hd; a.lse_stride = (long)dl * 6;
            attn_body::attn_unit<1, 8>(a, lds);
        } else if (kind == 2 && (ATT_MODES & 4)) { const int h = idx >> 6, qb = idx & 63; abf* const MKV = (abf*)(F.ws + WS_MEMKV);
            a.Q = PB + PC_MQ + h * 64; a.K = MKV + h * 64; a.V = MKV + 256 + h * 64; a.O = (abf*)(F.ws + WS_OMEM) + h * 64; a.qp = NPROJ; a.kp = 512; a.op = 256;
            a.q0 = qb * 256; a.NT = 4; a.kv0 = 0; a.aux = nullptr; a.lse = nullptr; a.lse_stride = 0;
            attn_body::attn_unit<2, 8>(a, lds);
        }
    }
}
__device__ __forceinline__ void p3_dil_weights(Frame& F) {
    const float* LSE = (const float*)(F.ws + WS_LSE); bf16* const OD = (bf16*)(F.ws + WS_ODIL);
    for (int it = blockIdx.x * (NWAVES * 64) + F.tid; it < S * 48; it += F.G * NWAVES * 64) {
        const int tok = it / 48, rem = it - tok * 48, hd = rem >> 3, ch = rem & 7, hs = hd & 1, g = hd >> 1;
        const float l0 = LSE[tok * 6 + hs], l1 = LSE[tok * 6 + 2 + hs], l2 = LSE[tok * 6 + 4 + hs];
        const float mx = fmaxf(l0, fmaxf(l1, l2)); const float e0 = __builtin_amdgcn_exp2f(l0 - mx), e1 = __builtin_amdgcn_exp2f(l1 - mx), e2 = __builtin_amdgcn_exp2f(l2 - mx);
        const float w = (g == 0 ? e0 : (g == 1 ? e1 : e2)) / (e0 + e1 + e2);
        v4u* p = (v4u*)(OD + (size_t)tok * 384 + hd * 64 + ch * 8); v4u x = *p;
        x.x = pk2(__uint_as_float(x.x << 16) * w, __uint_as_float(x.x & 0xffff0000u) * w); x.y = pk2(__uint_as_float(x.y << 16) * w, __uint_as_float(x.y & 0xffff0000u) * w);
        x.z = pk2(__uint_as_float(x.z << 16) * w, __uint_as_float(x.z & 0xffff0000u) * w); x.w = pk2(__uint_as_float(x.w << 16) * w, __uint_as_float(x.w & 0xffff0000u) * w);
        *p = x;
    }
}
__device__ __forceinline__ void p6_ln_router(Frame& F, const Args& A) {
    LAS f32x4* wr4 = (LAS f32x4*)(F.lds + RING_OFF);
    LAS int* se = (LAS int*)(F.lds + 131072);
    { const f32x4* src = (const f32x4*)A.in[12];
      for (int i = F.tid; i < 1024 * 8; i += NWAVES * 64) { const int k = i >> 3, e4 = i & 7; wr4[e4 * 1024 + k] = src[i]; } }
    __syncthreads();
    const float* R1 = (const float*)(F.ws + WS_R1); float* const H1 = (float*)(F.ws + WS_H1); bf16* const H1B = (bf16*)(F.ws + WS_H1B);
    int* const TOPI = (int*)(F.ws + WS_TOPI); float* const TOPG = (float*)(F.ws + WS_TOPG); int* const RANK = (int*)(F.ws + WS_RANK); int* const BLKCNT = (int*)(F.ws + WS_BLKCNT);
    const float* lg1 = A.in[10]; const float* lb1 = A.in[11]; const float* br = A.in[13];
    for (int rb = blockIdx.x; rb < S / 64; rb += F.G) {
        for (int j = 0; j < 8; ++j) {
            const int lrow = F.wave * 8 + j; const size_t row = (size_t)rb * 64 + lrow;
            f32x2 v[8]; float s = 0.f;
#pragma unroll
            for (int m = 0; m < 8; ++m) { v[m] = *(const f32x2*)(R1 + row * DM + 2 * F.lane + 128 * m); s += v[m].x + v[m].y; }
            const float mean = wave_sum(s) * (1.f / DM); float s2 = 0.f;
#pragma unroll
            for (int m = 0; m < 8; ++m) { v[m].x -= mean; v[m].y -= mean; s2 += v[m].x * v[m].x + v[m].y * v[m].y; }
            const float rstd = 1.f / sqrtf(wave_sum(s2) * (1.f / DM) + LN_EPS);
            float lg[32];
#pragma unroll
            for (int e = 0; e < 32; ++e) lg[e] = 0.f;
#pragma unroll
            for (int m = 0; m < 8; ++m) { const int k = 2 * F.lane + 128 * m; const f32x2 gg = *(const f32x2*)(lg1 + k), bb = *(const f32x2*)(lb1 + k);
                f32x2 hv; hv.x = v[m].x * rstd * gg.x + bb.x; hv.y = v[m].y * rstd * gg.y + bb.y;
                *(f32x2*)(H1 + row * DM + k) = hv; *(unsigned*)(H1B + row * DM + k) = pk2(hv.x, hv.y);
#pragma unroll
                for (int e4 = 0; e4 < 8; ++e4) { const f32x4 w0 = wr4[e4 * 1024 + k], w1 = wr4[e4 * 1024 + k + 1];
                    lg[4 * e4 + 0] += hv.x * w0.x + hv.y * w1.x; lg[4 * e4 + 1] += hv.x * w0.y + hv.y * w1.y; lg[4 * e4 + 2] += hv.x * w0.z + hv.y * w1.z; lg[4 * e4 + 3] += hv.x * w0.w + hv.y * w1.w; }
                asm volatile("" ::: "memory"); }
#pragma unroll
            for (int e = 0; e < 32; ++e) lg[e] = wave_sum(lg[e]) + br[e];
            float bv[4]; int bi[4];
#pragma unroll
            for (int kk = 0; kk < 4; ++kk) { float best = -INFINITY; int be = 0;
#pragma unroll
                for (int e = 0; e < 32; ++e) { const bool take = lg[e] > best; best = take ? lg[e] : best; be = take ? e : be; }
                bv[kk] = best; bi[kk] = be;
#pragma unroll
                for (int e = 0; e < 32; ++e) lg[e] = (e == be) ? -INFINITY : lg[e]; }
            const float e1 = expf(bv[1] - bv[0]), e2 = expf(bv[2] - bv[0]), e3 = expf(bv[3] - bv[0]); const float inv = 1.f / (1.f + e1 + e2 + e3);
            if (F.lane == 0) { *(int4*)(TOPI + row * 4) = make_int4(bi[0], bi[1], bi[2], bi[3]); *(f32x4*)(TOPG + row * 4) = (f32x4){inv, e1 * inv, e2 * inv, e3 * inv};
                se[lrow * 4 + 0] = bi[0]; se[lrow * 4 + 1] = bi[1]; se[lrow * 4 + 2] = bi[2]; se[lrow * 4 + 3] = bi[3]; }
        }
        __syncthreads();
        if (F.tid < 256) { const int e = se[F.tid]; int rk = 0; for (int q = 0; q < F.tid; ++q) rk += (se[q] == e) ? 1 : 0; RANK[rb * 256 + F.tid] = rk; }
        else if (F.tid < 288) { const int e = F.tid - 256; int c = 0; for (int q = 0; q < 256; ++q) c += (se[q] == e) ? 1 : 0; BLKCNT[rb * 32 + e] = c; }
        __syncthreads();
    }
}
__device__ __forceinline__ void p7_scatter(Frame& F) {
    LAS int* ptot = (LAS int*)(F.lds + RING_OFF); LAS int* ppre = ptot + 512; LAS int* epre = ppre + 512; LAS int* tst = epre + 32; LAS int* dsts = tst + 64;
    const int* BLKCNT = (const int*)(F.ws + WS_BLKCNT); const int* TOPI = (const int*)(F.ws + WS_TOPI); const int* RANK = (const int*)(F.ws + WS_RANK);
    int* const DEST = (int*)(F.ws + WS_DEST); int* const TST = (int*)(F.ws + WS_TST); const bf16* H1B = (const bf16*)(F.ws + WS_H1B); bf16* const XS = (bf16*)(F.ws + WS_XS);
    for (int rb = blockIdx.x; rb < S / 64; rb += F.G) {
        { const int part = F.tid >> 5, e = F.tid & 31; int tot = 0, pre = 0;
          for (int b = part * 16; b < part * 16 + 16; ++b) { const int c = BLKCNT[b * 32 + e]; tot += c; pre += (b < rb) ? c : 0; }
          ptot[part * 32 + e] = tot; ppre[part * 32 + e] = pre; }
        __syncthreads();
        if (F.tid < 32) { int T = 0, P = 0; for (int p = 0; p < 16; ++p) { T += ptot[p * 32 + F.tid]; P += ppre[p * 32 + F.tid]; } ptot[F.tid] = T; epre[F.tid] = P; }
        __syncthreads();
        if (F.tid == 0) { int t = 0; for (int e = 0; e < 32; ++e) { tst[e] = t; t += (ptot[e] + 255) >> 8; } tst[32] = t;
            if (rb == 0) { for (int e = 0; e <= 32; ++e) TST[e] = tst[e]; } }
        __syncthreads();
        if (F.tid < 256) { const size_t a = (size_t)rb * 256 + F.tid; const int e = TOPI[a]; const int d = tst[e] * 256 + epre[e] + RANK[a]; DEST[a] = d; dsts[F.tid] = d; }
        __syncthreads();
        for (int q = 0; q < 32; ++q) { const int a = F.wave * 32 + q; const size_t srow = (size_t)rb * 64 + (a >> 2); const size_t drow = (size_t)dsts[a];
            const v4u* sp = (const v4u*)(H1B + srow * DM); v4u* dp = (v4u*)(XS + drow * DM); const v4u x0 = sp[F.lane], x1 = sp[F.lane + 64]; dp[F.lane] = x0; dp[F.lane + 64] = x1; }
        __syncthreads();
    }
}
__device__ __forceinline__ void p10_combine(Frame& F, const Args& A) {
    const int gw = F.vcu * NWAVES + F.wave, NGW = F.G * NWAVES;
    const float* H1 = (const float*)(F.ws + WS_H1); const bf16* Y = (const bf16*)(F.ws + WS_Y); const int* DEST = (const int*)(F.ws + WS_DEST); const float* TOPG = (const float*)(F.ws + WS_TOPG);
    const float* g2 = A.in[18]; const float* b2 = A.in[19];
    for (int m = gw; m < S; m += NGW) {
        const int4 dd = *(const int4*)(DEST + (size_t)m * 4); const f32x4 gg = *(const f32x4*)(TOPG + (size_t)m * 4);
        f32x4 v[4]; float s = 0.f;
#pragma unroll
        for (int j = 0; j < 4; ++j) { v[j] = *((const f32x4*)(H1 + (size_t)m * DM) + F.lane + 64 * j) * ALPHA; }
#pragma unroll
        for (int k = 0; k < 4; ++k) { const int d = k == 0 ? dd.x : (k == 1 ? dd.y : (k == 2 ? dd.z : dd.w)); const float g = k == 0 ? gg.x : (k == 1 ? gg.y : (k == 2 ? gg.z : gg.w));
#pragma unroll
            for (int j = 0; j < 4; ++j) { const v2u y = *((const v2u*)(Y + (size_t)d * DM) + F.lane + 64 * j);
                v[j].x += g * __uint_as_float(y.x << 16); v[j].y += g * __uint_as_float(y.x & 0xffff0000u); v[j].z += g * __uint_as_float(y.y << 16); v[j].w += g * __uint_as_float(y.y & 0xffff0000u); } }
#pragma unroll
        for (int j = 0; j < 4; ++j) s += (v[j].x + v[j].y) + (v[j].z + v[j].w);
        const float mean = wave_sum(s) * (1.f / DM); float s2 = 0.f;
#pragma unroll
        for (int j = 0; j < 4; ++j) { v[j] = v[j] - mean; s2 += (v[j].x * v[j].x + v[j].y * v[j].y) + (v[j].z * v[j].z + v[j].w * v[j].w); }
        const float rstd = 1.f / sqrtf(wave_sum(s2) * (1.f / DM) + LN_EPS);
#pragma unroll
        for (int j = 0; j < 4; ++j) { const f32x4 gv = *((const f32x4*)g2 + F.lane + 64 * j), bv = *((const f32x4*)b2 + F.lane + 64 * j);
            *((f32x4*)(F.out + (size_t)m * DM) + F.lane + 64 * j) = v[j] * rstd * gv + bv; }
    }
}

__global__ void __launch_bounds__(NWAVES * 64, 2) mk_fwd(Args args) {
    extern __shared__ __attribute__((aligned(16))) unsigned char lds[];
    Frame F;
    F.lds = (LAS unsigned char*)lds;
    F.MISC = (volatile LAS unsigned*)(F.lds + MISC_OFF);
    F.tid = threadIdx.x; F.lane = F.tid & 63; F.wave = __builtin_amdgcn_readfirstlane(F.tid >> 6);
    F.G = gridDim.x; { const int bx = blockIdx.x; F.vcu = (F.G % 8 == 0) ? (bx % 8) * (F.G / 8) + bx / 8 : bx; }
    F.ws = args.ws; F.out = args.out; F.ctl = (gu32*)(args.ws + WS_CTL);
    unsigned char* const ws = args.ws;
    for (int u = F.tid; u < (LDS_BYTES - LDSCTL_OFF) / 4; u += NWAVES * 64) ((LAS unsigned*)(F.lds + LDSCTL_OFF))[u] = 0u;
    __syncthreads();
    XcdBarrier bar; bar.bar = (unsigned*)(F.ctl + CW_BAR); bar.x = 0; bar.st = nullptr;
    if (N_LAUNCHES == 1) bar = xcd_barrier_post((unsigned*)(F.ctl + CW_BAR), F.MISC + 8);
#define GRID_BAR() do { if (N_LAUNCHES == 1) xcd_barrier(bar); } while (0)
    const int lo = args.ph_lo, hi = args.ph_hi;
#ifndef PHASE_MASK
#define PHASE_MASK 0x7ff
#endif
#define IN(k) (((PHASE_MASK >> (k)) & 1) && lo <= (k) && (k) < hi)
#define BOTH(k) (IN(k) && IN((k) + 1))
    typedef pg8::bf16_t pbf;
    pbf* const PBUF = (pbf*)(ws + WS_PBUF);

    if (IN(0)) { p0_prologue(F, args); if (BOTH(0)) GRID_BAR(); }

    if (IN(1)) {
        { pg8::Gemm g{(const pbf*)(ws + WS_XB), (const pbf*)(ws + WS_WIN), S, NPROJ, DM}; pg8::StaticOrder So; So.init(S, NPROJ, F.G, (int)blockIdx.x);
          pg8::EpiProj E{PBUF, NPROJ, PC_GT / 256};
          pg8::gemm_phase<pg8::EpiProj, pg8::StaticOrder, true, true>(F.lds + RING_OFF, g, So, E); }
        { pg8::Gemm g{(const pbf*)(ws + WS_MEMB), (const pbf*)(ws + WS_WMKV), MEML, 512, DM}; pg8::StaticOrder So; So.init(MEML, 512, F.G, (int)((blockIdx.x + F.G / 2) % F.G));
          pg8::EpiBf16Plain E{(pbf*)(ws + WS_MEMKV), 512};
          pg8::gemm_phase<pg8::EpiBf16Plain, pg8::StaticOrder, true, true>(F.lds + RING_OFF, g, So, E); }
        if ((int)blockIdx.x >= F.G - 6) p1_cumsum(F, F.G - 1 - (int)blockIdx.x);
        if (BOTH(1)) GRID_BAR();
    }

    if (IN(2)) { p2_attention(F, (char*)lds + RING_OFF); if (BOTH(2)) GRID_BAR(); }

    if (IN(3)) { p3_dil_weights(F); if (BOTH(3)) GRID_BAR(); }

    if (IN(4)) {
        float* const ST = (float*)(ws + WS_STASH); pbf* const MG = (pbf*)(ws + WS_MERGED);
#ifndef MERGE_MASK
#define MERGE_MASK 7
#endif
        if (MERGE_MASK & 1) { pg8::Gemm g{(const pbf*)(ws + WS_OFOX), (const pbf*)(ws + WS_WBF), S, DM, 384}; pg8::StaticOrder So; So.init(S, DM, F.G, (int)blockIdx.x);
          pg8::EpiMerge<0> E{PBUF + PC_GT, NPROJ, ST, MG, DM}; pg8::gemm_phase<pg8::EpiMerge<0>, pg8::StaticOrder, true, true>(F.lds + RING_OFF, g, So, E); }
        if (MERGE_MASK & 2) { pg8::Gemm g{(const pbf*)(ws + WS_ODIL), (const pbf*)(ws + WS_WBD), S, DM, 384}; pg8::StaticOrder So; So.init(S, DM, F.G, (int)blockIdx.x);
          pg8::EpiMerge<1> E{PBUF + PC_GT + 1024, NPROJ, ST, MG, DM}; pg8::gemm_phase<pg8::EpiMerge<1>, pg8::StaticOrder, true, true>(F.lds + RING_OFF, g, So, E); }
        if (MERGE_MASK & 4) { pg8::Gemm g{(const pbf*)(ws + WS_OMEM), (const pbf*)(ws + WS_WBM), S, DM, 256}; pg8::StaticOrder So; So.init(S, DM, F.G, (int)blockIdx.x);
          pg8::EpiMerge<2> E{PBUF + PC_GT + 2048, NPROJ, ST, MG, DM}; pg8::gemm_phase<pg8::EpiMerge<2>, pg8::StaticOrder, true, true>(F.lds + RING_OFF, g, So, E); }
        if (BOTH(4)) GRID_BAR();
    }

    if (IN(5)) {
        pg8::Gemm g{(const pbf*)(ws + WS_MERGED), (const pbf*)(ws + WS_WOUT), S, DM, DM}; pg8::StaticOrder So; So.init(S, DM, F.G, (int)blockIdx.x);
        pg8::EpiRes E{args.in[0], (float*)(ws + WS_R1), DM, ALPHA};
        pg8::gemm_phase<pg8::EpiRes, pg8::StaticOrder, true, true>(F.lds + RING_OFF, g, So, E);
        if (BOTH(5)) GRID_BAR();
    }

    if (IN(6)) { p6_ln_router(F, args); if (BOTH(6)) GRID_BAR(); }

    if (IN(7)) { p7_scatter(F); if (BOTH(7)) GRID_BAR(); }

    if (IN(8)) {
        LAS int* tbl = (LAS int*)(F.lds + TBL_OFF);
        if (F.tid < 33) tbl[F.tid] = ((const int*)(ws + WS_TST))[F.tid];
        __syncthreads();
        pg8::Gemm g{(const pbf*)(ws + WS_XS), (const pbf*)(ws + WS_W1), MAXROWS, 2048, DM}; pg8::MoeOrder So{tbl, 8, F.G, F.vcu};
        pg8::EpiSwiglu E{(pbf*)(ws + WS_ACT), args.in[15]};
        pg8::gemm_phase<pg8::EpiSwiglu, pg8::MoeOrder, true, true>(F.lds + RING_OFF, g, So, E);
        if (BOTH(8)) GRID_BAR();
    }

    if (IN(9)) {
        LAS int* tbl = (LAS int*)(F.lds + TBL_OFF);
        if (F.tid < 33) tbl[F.tid] = ((const int*)(ws + WS_TST))[F.tid];
        __syncthreads();
        pg8::Gemm g{(const pbf*)(ws + WS_ACT), (const pbf*)(ws + WS_W2), MAXROWS, 1024, DM}; pg8::MoeOrder So{tbl, 4, F.G, F.vcu};
        pg8::EpiY E{(pbf*)(ws + WS_Y), args.in[17]};
        pg8::gemm_phase<pg8::EpiY, pg8::MoeOrder, true, true>(F.lds + RING_OFF, g, So, E);
        if (BOTH(9)) GRID_BAR();
    }

    if (IN(10)) { p10_combine(F, args); }
#undef IN
#undef BOTH
#undef GRID_BAR
}

extern "C" void kernel_launch(void* const* d_in, const int* in_sizes, int n_in, void* d_out, int out_size, void* d_ws, size_t ws_size, hipStream_t stream) {
    static int grid = 0;
    if (grid == 0) {
        if (n_in != 20 || in_sizes[0] != S * DM || out_size != S * DM || ws_size < WS_END) { fprintf(stderr, "kernel_launch: built for 20 inputs, x/out of %d floats, >= %zu bytes of workspace; got n_in %d, in0 %d, out %d, ws %zu; nothing launched\n", S * DM, (size_t)WS_END, n_in, n_in > 0 ? in_sizes[0] : -1, out_size, ws_size); grid = -1; return; }
        int dev = 0, cus = 0, per_cu = 0;
        if (hipGetDevice(&dev) != hipSuccess || hipDeviceGetAttribute(&cus, hipDeviceAttributeMultiprocessorCount, dev) != hipSuccess) { fprintf(stderr, "kernel_launch: hipGetDevice / hipDeviceGetAttribute failed; nothing launched\n"); grid = -1; return; }
        if (hipFuncSetAttribute((const void*)mk_fwd, hipFuncAttributeMaxDynamicSharedMemorySize, LDS_BYTES) != hipSuccess) { fprintf(stderr, "kernel_launch: hipFuncSetAttribute failed (%d bytes of dynamic LDS); nothing launched\n", LDS_BYTES); grid = -1; return; }
        if (hipOccupancyMaxActiveBlocksPerMultiprocessor(&per_cu, (const void*)mk_fwd, NWAVES * 64, LDS_BYTES) != hipSuccess || per_cu < 1)
            fprintf(stderr, "kernel_launch: note: the occupancy query reports %d workgroups per CU\n", per_cu);
        (void)hipGetLastError();
        grid = cus;
    }
    if (grid < 0) return;
    if (hipMemsetAsync((char*)d_ws + WS_CTL, 0, CTL_ZERO_BYTES, stream) != hipSuccess) { fprintf(stderr, "kernel_launch: hipMemsetAsync of the control words failed; nothing launched\n"); return; }
    Args a{};
    for (int i = 0; i < 20; ++i) a.in[i] = (const float*)d_in[i];
    a.out = (float*)d_out; a.ws = (unsigned char*)d_ws;
    for (int li = 0; li < N_LAUNCHES; ++li) {
        a.ph_lo = (N_LAUNCHES == 1) ? 0 : li; a.ph_hi = (N_LAUNCHES == 1) ? NPHASE : li + 1;
        hipLaunchKernelGGL(mk_fwd, dim3(grid), dim3(NWAVES * 64), LDS_BYTES, stream, a);
        const hipError_t le = hipPeekAtLastError();
        if (le != hipSuccess) { fprintf(stderr, "kernel_launch: launch %d failed: %s\n", li, hipGetErrorName(le)); break; }
    }
}
```

```cpp
#include <hip/hip_runtime.h>
#include <hip/hip_bf16.h>
#include <cstdio>
#include <cstdint>
#include <cmath>
namespace pg8 {
#define PG8_LAS __attribute__((address_space(3)))
typedef unsigned short bf16_t;
typedef short bf16x8 __attribute__((ext_vector_type(8)));
typedef float f32x4 __attribute__((ext_vector_type(4)));
typedef unsigned u32x4 __attribute__((ext_vector_type(4)));
constexpr int BM = 256, BK = 64, HALF = 128, HTB = HALF * BK * 2  , STAGE_BYTES = 8 * HTB, NXCD = 8, WGM = 8;

__host__ __device__ __forceinline__ int lds_byte(int r, int c) { const int st = (r >> 4) * 2 + (c >> 5), rr = r & 15, cc = c & 31, ob = rr * 64 + cc * 2; return st * 1024 + (ob ^ (((ob >> 9) & 1) << 5)); }
__host__ __device__ __forceinline__ void stage_rc(int b, int& R, int& C) { const int st = b / 1024, sb = b % 1024, swz = sb ^ (((sb >> 9) & 1) << 5); R = (st >> 1) * 16 + swz / 64; C = (st & 1) * 32 + (swz % 64) / 2; }
__host__ __device__ __forceinline__ int perm32(int rho) { const int n = rho >> 4, i = rho & 15; return 8 * (i >> 2) + 4 * n + (i & 3); }

struct Unit { int pm, pn, e, slot, b; };
typedef int v8i_t_half __attribute__((ext_vector_type(4)));
typedef int v8i_t __attribute__((ext_vector_type(8)));
typedef short s16x16_t __attribute__((ext_vector_type(16)));
struct Gemm { const bf16_t* A; const bf16_t* Bt; int M, N, K; const int* rowmap; int scale_a, scale_b; size_t strideA = 0, strideB = 0; };

struct StaticOrder {
    int nM, nN, nwg, G, c;
    __host__ __device__ void init(int M, int N, int G_, int c_) { nM = M / BM; nN = N / BM; nwg = nM * nN; G = G_; c = c_; }
    __host__ __device__ bool next(int i, Unit& u) const {
        const long L = (long)i * G + c; if (L >= nwg) return false;
        int wgid = (int)L; { const int q = nwg / NXCD, r = nwg % NXCD, xcd = wgid % NXCD, off = wgid / NXCD; wgid = (xcd < r ? xcd * (q + 1) : r * (q + 1) + (xcd - r) * q) + off; }
        const int nig = WGM * nN, gid = wgid / nig, fm = gid * WGM, gsz = (nM - fm) < WGM ? (nM - fm) : WGM;
        u.pm = fm + ((wgid % nig) % gsz); u.pn = (wgid % nig) / gsz; u.e = 0; u.b = 0; return true;
    }
    __device__ __forceinline__ void a_ready(const Unit&) const {}
    __device__ __forceinline__ void done(const Unit&) const {}
};

__device__ __forceinline__ unsigned cvt_pk_bf16(float lo, float hi) { unsigned r; asm volatile("v_cvt_pk_bf16_f32 %0, %1, %2" : "=v"(r) : "v"(lo), "v"(hi)); return r; }
__device__ __forceinline__ float bf_lo(unsigned w) { return __uint_as_float(w << 16); }
__device__ __forceinline__ float bf_hi(unsigned w) { return __uint_as_float(w & 0xffff0000u); }
__device__ __forceinline__ float sigmoid_f(float v) { return __builtin_amdgcn_rcpf(1.0f + __builtin_amdgcn_exp2f(-1.4426950408889634f * v)); }
typedef unsigned u32x2 __attribute__((ext_vector_type(2)));

struct EpiBf16Plain {
    static constexpr bool PERM = true, AFTER_DRAIN = false; static constexpr bool CHAIN = false; static constexpr bool LDS_BIAS = false;
    bf16_t* O; int ldc;
    __device__ __forceinline__ void operator()(const f32x4 (&acc)[2][2][4][2], const Unit& u, int wr, int wc, int fr, int fq) const {
        const int row0 = u.pm * BM + wr * 64 + fr, col0 = u.pn * BM + wc * 32 + 8 * fq;
#pragma unroll
        for (int ai = 0; ai < 2; ++ai)
#pragma unroll
            for (int m = 0; m < 4; ++m) { bf16_t* rowp = O + (size_t)(row0 + ai * HALF + m * 16) * ldc + col0;
#pragma unroll
                for (int bj = 0; bj < 2; ++bj) { const f32x4 v0 = acc[ai][bj][m][0], v1 = acc[ai][bj][m][1];
                    u32x4 w; w.x = cvt_pk_bf16(v0[0], v0[1]); w.y = cvt_pk_bf16(v0[2], v0[3]); w.z = cvt_pk_bf16(v1[0], v1[1]); w.w = cvt_pk_bf16(v1[2], v1[3]);
                    *(u32x4*)(rowp + bj * HALF) = w; } }
    }
};
struct EpiProj {
    static constexpr bool PERM = true, AFTER_DRAIN = false; static constexpr bool CHAIN = false; static constexpr bool LDS_BIAS = false;
    bf16_t* O; int ldc; int sig_from; unsigned* nrm;
    __device__ __forceinline__ void operator()(const f32x4 (&acc)[2][2][4][2], const Unit& u, int wr, int wc, int fr, int fq) const {
        const int row0 = u.pm * BM + wr * 64 + fr, col0 = u.pn * BM + wc * 32 + 8 * fq; const bool sg = u.pn >= sig_from;
        if (u.pn < 3) {
#pragma unroll
            for (int bj = 0; bj < 2; ++bj) { float mx = 0.f;
#pragma unroll
                for (int ai = 0; ai < 2; ++ai)
#pragma unroll
                    for (int m = 0; m < 4; ++m) { const f32x4 a0 = acc[ai][bj][m][0], a1 = acc[ai][bj][m][1];
                        float ss = (a0[0] * a0[0] + a0[1] * a0[1]) + (a0[2] * a0[2] + a0[3] * a0[3]) + (a1[0] * a1[0] + a1[1] * a1[1]) + (a1[2] * a1[2] + a1[3] * a1[3]);
                        ss += __shfl_xor(ss, 16); ss += __shfl_xor(ss, 32); mx = fmaxf(mx, ss); }
                mx = fmaxf(mx, __shfl_xor(mx, 1)); mx = fmaxf(mx, __shfl_xor(mx, 2)); mx = fmaxf(mx, __shfl_xor(mx, 4)); mx = fmaxf(mx, __shfl_xor(mx, 8));
                if (fr == 0 && fq == 0) atomicMax(nrm + u.pn * 8 + bj * 4 + wc, __float_as_uint(mx)); }
        }
#pragma unroll
        for (int ai = 0; ai < 2; ++ai)
#pragma unroll
            for (int m = 0; m < 4; ++m) { bf16_t* rowp = O + (size_t)(row0 + ai * HALF + m * 16) * ldc + col0;
#pragma unroll
                for (int bj = 0; bj < 2; ++bj) { f32x4 v0 = acc[ai][bj][m][0], v1 = acc[ai][bj][m][1];
                    if (sg) {
#pragma unroll
                        for (int j = 0; j < 4; ++j) { v0[j] = sigmoid_f(v0[j]); v1[j] = sigmoid_f(v1[j]); } }
                    u32x4 w; w.x = cvt_pk_bf16(v0[0], v0[1]); w.y = cvt_pk_bf16(v0[2], v0[3]); w.z = cvt_pk_bf16(v1[0], v1[1]); w.w = cvt_pk_bf16(v1[2], v1[3]);
                    *(u32x4*)(rowp + bj * HALF) = w; } }
    }
};
struct EpiGate {
    static constexpr bool PERM = true, AFTER_DRAIN = false; static constexpr bool CHAIN = false; static constexpr bool LDS_BIAS = false;
    bf16_t* O; int ldc; int col_off; float ascale;
    __device__ __forceinline__ void operator()(const f32x4 (&acc)[2][2][4][2], const Unit& u, int wr, int wc, int fr, int fq) const {
        const int row0 = u.pm * BM + wr * 64 + fr, col0 = col_off + u.pn * BM + wc * 32 + 8 * fq;
#pragma unroll
        for (int ai = 0; ai < 2; ++ai)
#pragma unroll
            for (int m = 0; m < 4; ++m) { bf16_t* rowp = O + (size_t)(row0 + ai * HALF + m * 16) * ldc + col0;
#pragma unroll
                for (int bj = 0; bj < 2; ++bj) { f32x4 v0 = acc[ai][bj][m][0] * ascale, v1 = acc[ai][bj][m][1] * ascale;
#pragma unroll
                    for (int j = 0; j < 4; ++j) { v0[j] = sigmoid_f(v0[j]); v1[j] = sigmoid_f(v1[j]); }
                    u32x4 w; w.x = cvt_pk_bf16(v0[0], v0[1]); w.y = cvt_pk_bf16(v0[2], v0[3]); w.z = cvt_pk_bf16(v1[0], v1[1]); w.w = cvt_pk_bf16(v1[2], v1[3]);
                    *(u32x4*)(rowp + bj * HALF) = w; } }
    }
};
template <int PASS> struct EpiMerge {
    static constexpr bool PERM = false, AFTER_DRAIN = false; static constexpr bool CHAIN = false; static constexpr bool LDS_BIAS = false;
    const bf16_t* gate; int ldg; bf16_t* stash; bf16_t* outb; int ldc;
    __device__ __forceinline__ void operator()(const f32x4 (&acc)[2][2][4][2], const Unit& u, int wr, int wc, int fr, int fq) const {
        const int row0 = u.pm * BM + wr * 64 + fr, col0 = u.pn * BM + wc * 32 + 4 * fq;
#pragma unroll
        for (int ai = 0; ai < 2; ++ai)
#pragma unroll
            for (int m = 0; m < 4; ++m) { const size_t r = (size_t)(row0 + ai * HALF + m * 16);
#pragma unroll
                for (int bj = 0; bj < 2; ++bj)
#pragma unroll
                    for (int n = 0; n < 2; ++n) { const int c = col0 + bj * HALF + n * 16;
                        const u32x2 gv = *(const u32x2*)(gate + r * ldg + c);
                        f32x4 v = acc[ai][bj][m][n]; v[0] *= bf_lo(gv.x); v[1] *= bf_hi(gv.x); v[2] *= bf_lo(gv.y); v[3] *= bf_hi(gv.y);
                        if (PASS > 0) { const u32x2 sv = *(const u32x2*)(stash + r * ldc + c); v[0] += bf_lo(sv.x); v[1] += bf_hi(sv.x); v[2] += bf_lo(sv.y); v[3] += bf_hi(sv.y); }
                        u32x2 w; w.x = cvt_pk_bf16(v[0], v[1]); w.y = cvt_pk_bf16(v[2], v[3]);
                        if (PASS < 2) *(u32x2*)(stash + r * ldc + c) = w; else *(u32x2*)(outb + r * ldc + c) = w; }
                asm volatile("" ::: "memory"); }
    }
};
struct EpiRes {
    static constexpr bool PERM = false, AFTER_DRAIN = false; static constexpr bool CHAIN = false; static constexpr bool LDS_BIAS = false;
    const float* x; float* out; int ldc; float alpha;
    __device__ __forceinline__ void operator()(const f32x4 (&acc)[2][2][4][2], const Unit& u, int wr, int wc, int fr, int fq) const {
        const int row0 = u.pm * BM + wr * 64 + fr, col0 = u.pn * BM + wc * 32 + 4 * fq;
#pragma unroll
        for (int ai = 0; ai < 2; ++ai)
#pragma unroll
            for (int m = 0; m < 4; ++m) { const size_t off = (size_t)(row0 + ai * HALF + m * 16) * ldc + col0;
#pragma unroll
                for (int bj = 0; bj < 2; ++bj)
#pragma unroll
                    for (int n = 0; n < 2; ++n) { const f32x4 xv = *(const f32x4*)(x + off + bj * HALF + n * 16); *(f32x4*)(out + off + bj * HALF + n * 16) = xv * alpha + acc[ai][bj][m][n]; } }
    }
};
struct EpiMergeChain {
    static constexpr bool PERM = false, AFTER_DRAIN = false; static constexpr bool LDS_BIAS = false; static constexpr bool CHAIN = true;
    const bf16_t* gate; int ldg; bf16_t* outb; int ldc;
    __device__ __forceinline__ void operator()(f32x4 (&acc)[2][2][4][2], const Unit& u, int wr, int wc, int fr, int fq) const {
        const int row0 = u.pm * BM + wr * 64 + fr, col0 = u.pn * BM + wc * 32 + 4 * fq; const int b = u.b;
#pragma unroll
        for (int ai = 0; ai < 2; ++ai)
#pragma unroll
            for (int m = 0; m < 4; ++m) { const size_t r = (size_t)(row0 + ai * HALF + m * 16);
#pragma unroll
                for (int bj = 0; bj < 2; ++bj)
#pragma unroll
                    for (int n = 0; n < 2; ++n) { const int c = col0 + bj * HALF + n * 16;
                        const u32x2 gv = *(const u32x2*)(gate + r * ldg + b * 1024 + c);
                        f32x4 gb = {bf_lo(gv.x), bf_hi(gv.x), bf_lo(gv.y), bf_hi(gv.y)};
                        if (b > 0) { gb[0] = fmaxf(gb[0], 1e-6f); gb[1] = fmaxf(gb[1], 1e-6f); gb[2] = fmaxf(gb[2], 1e-6f); gb[3] = fmaxf(gb[3], 1e-6f); }
                        f32x4 v = acc[ai][bj][m][n] * gb;
                        if (b < 2) { const u32x2 gn = *(const u32x2*)(gate + r * ldg + (b + 1) * 1024 + c);
                            v[0] *= __builtin_amdgcn_rcpf(fmaxf(bf_lo(gn.x), 1e-6f)); v[1] *= __builtin_amdgcn_rcpf(fmaxf(bf_hi(gn.x), 1e-6f)); v[2] *= __builtin_amdgcn_rcpf(fmaxf(bf_lo(gn.y), 1e-6f)); v[3] *= __builtin_amdgcn_rcpf(fmaxf(bf_hi(gn.y), 1e-6f));
                            acc[ai][bj][m][n] = v; }
                        else { u32x2 w; w.x = cvt_pk_bf16(v[0], v[1]); w.y = cvt_pk_bf16(v[2], v[3]); *(u32x2*)(outb + r * ldc + c) = w; } }
                asm volatile("" ::: "memory"); }
    }
};
struct MergeOrder {
    StaticOrder so;
    __device__ __forceinline__ bool next(int i, Unit& u) const { if (!so.next(i / 3, u)) return false; u.b = i % 3; return true; }
    __device__ __forceinline__ void a_ready(const Unit&) const {}
    __device__ __forceinline__ void done(const Unit&) const {}
};
struct EpiSwiglu {
    static constexpr bool PERM = true, AFTER_DRAIN = false; static constexpr bool CHAIN = false;
    bf16_t* O; const float* b1; float ascale; const PG8_LAS float* lb;
    static constexpr bool LDS_BIAS = true;
    __device__ __forceinline__ const float* bias_src(const Unit& u, int lane) const { const int e = u.e, pnl = u.pn - e * 8; return b1 + (size_t)e * 2048 + (lane >> 5) * 1024 + pnl * 128 + (lane & 31) * 4; }
    __device__ __forceinline__ void operator()(const f32x4 (&acc)[2][2][4][2], const Unit& u, int wr, int wc, int fr, int fq) const {
        const int e = u.e, pnl = u.pn - e * 8; const int row0 = u.pm * BM + wr * 64 + fr;
        f32x4 bg[2], bl[2]; const PG8_LAS float* lbs = lb + u.slot * 256 + wc * 32 + 8 * fq;
#pragma unroll
        for (int n = 0; n < 2; ++n) { bg[n] = *(const PG8_LAS f32x4*)(lbs + 4 * n); bl[n] = *(const PG8_LAS f32x4*)(lbs + 128 + 4 * n); }
        unsigned char* const lanep = (unsigned char*)O + (size_t)(row0 + (fq & 1) * 16) * 1024 + pnl * 128 + wc * 32 + 8 * (fq & 2);
#pragma unroll
        for (int ai = 0; ai < 2; ++ai)
#pragma unroll
            for (int p = 0; p < 2; ++p) { u32x2 w[2];
#pragma unroll
                for (int q = 0; q < 2; ++q) { const int m = 2 * p + q; f32x4 o[2];
#pragma unroll
                    for (int n = 0; n < 2; ++n) { const f32x4 g = acc[ai][0][m][n] * ascale + bg[n], l = acc[ai][1][m][n] * ascale + bl[n];
#pragma unroll
                        for (int j = 0; j < 4; ++j) { const float gg = fminf(g[j], 7.0f), ll = fminf(fmaxf(l[j], -7.0f), 7.0f);
                            o[n][j] = gg * __builtin_amdgcn_rcpf(1.0f + __builtin_amdgcn_exp2f(-1.702f * 1.4426950408889634f * gg)) * (ll + 1.0f); } }
                    int t0 = __builtin_amdgcn_cvt_pk_fp8_f32(o[0][0], o[0][1], 0, false); t0 = __builtin_amdgcn_cvt_pk_fp8_f32(o[0][2], o[0][3], t0, true);
                    int t1 = __builtin_amdgcn_cvt_pk_fp8_f32(o[1][0], o[1][1], 0, false); t1 = __builtin_amdgcn_cvt_pk_fp8_f32(o[1][2], o[1][3], t1, true); w[q].x = (unsigned)t0; w[q].y = (unsigned)t1; }
                const auto r0 = __builtin_amdgcn_permlane16_swap(w[0].x, w[1].x, false, false), r1 = __builtin_amdgcn_permlane16_swap(w[0].y, w[1].y, false, false);
                u32x4 out; out.x = r0[0]; out.y = r1[0]; out.z = r0[1]; out.w = r1[1];
                *(u32x4*)(lanep + (size_t)(ai * HALF + p * 32) * 1024) = out; }
    }
};
struct EpiY {
    static constexpr bool PERM = true, PERM16 = true, AFTER_DRAIN = false; static constexpr bool CHAIN = false;
    bf16_t* O; const float* b2; float ascale; const PG8_LAS float* lb;
    static constexpr bool LDS_BIAS = true;
    __device__ __forceinline__ const float* bias_src(const Unit& u, int lane) const { const int e = u.e, pnl = u.pn - e * 4; return b2 + (size_t)e * 1024 + pnl * BM + lane * 4; }
    __device__ __forceinline__ void operator()(const f32x4 (&acc)[2][2][4][2], const Unit& u, int wr, int wc, int fr, int fq) const {
        const int e = u.e, pnl = u.pn - e * 4; const int row0 = u.pm * BM + wr * 64 + fr, col0 = pnl * BM + wc * 64 + 16 * fq;
        f32x4 bv[2][2]; const PG8_LAS float* lbs = lb + u.slot * 256 + wc * 64 + 16 * fq;
#pragma unroll
        for (int bj = 0; bj < 2; ++bj)
#pragma unroll
            for (int n = 0; n < 2; ++n) bv[bj][n] = *(const PG8_LAS f32x4*)(lbs + 8 * bj + 4 * n);
#pragma unroll
        for (int ai = 0; ai < 2; ++ai)
#pragma unroll
            for (int m = 0; m < 4; ++m) { unsigned char* rowp = (unsigned char*)O + (size_t)(row0 + ai * HALF + m * 16) * 1024 + col0;
                u32x4 w;
#pragma unroll
                for (int bj = 0; bj < 2; ++bj) { const f32x4 v0 = acc[ai][bj][m][0] * ascale + bv[bj][0], v1 = acc[ai][bj][m][1] * ascale + bv[bj][1];
                    int t0 = __builtin_amdgcn_cvt_pk_fp8_f32(v0[0], v0[1], 0, false); t0 = __builtin_amdgcn_cvt_pk_fp8_f32(v0[2], v0[3], t0, true);
                    int t1 = __builtin_amdgcn_cvt_pk_fp8_f32(v1[0], v1[1], 0, false); t1 = __builtin_amdgcn_cvt_pk_fp8_f32(v1[2], v1[3], t1, true);
                    if (bj == 0) { w.x = (unsigned)t0; w.y = (unsigned)t1; } else { w.z = (unsigned)t0; w.w = (unsigned)t1; } }
                *(u32x4*)rowp = w; }
    }
};
struct MoeOrder {
    const PG8_LAS int* tstart; int nN, G, vcu;
    __device__ __forceinline__ int ts(int k) const { return __builtin_amdgcn_readfirstlane(tstart[k]); }
    __device__ __forceinline__ bool next(int i, Unit& u) const {
        const int L = i * G + vcu; const int T = ts(32); if (L >= T * nN) return false;
        int e = 0;
#pragma unroll
        for (int k = 1; k < 32; ++k) e += (L >= ts(k) * nN) ? 1 : 0;
        const int t0 = ts(e), R = ts(e + 1) - t0; const int rem = L - t0 * nN; const int ng = rem / (4 * R); const int r2 = rem - ng * 4 * R; const int pnl = r2 / R; const int pmi = r2 - pnl * R;
        u.pm = t0 + pmi; u.pn = e * nN + ng * 4 + pnl; u.e = e; u.b = 0; return true;
    }
    __device__ __forceinline__ void a_ready(const Unit&) const {}
    __device__ __forceinline__ void done(const Unit&) const {}
};
template <class E, class = void> struct has_p16 { static constexpr bool v = false; };
template <class E> struct has_p16<E, decltype((void)E::PERM16)> { static constexpr bool v = E::PERM16; };
template <class Epi, class Sched, bool ALIGN_EPI = false, bool SP2 = false, bool GATHER = false, bool FP8 = false>
__device__ __forceinline__ void gemm_phase(PG8_LAS unsigned char* lds, const Gemm g, const Sched& S, const Epi& E) {
    static_assert(!GATHER || SP2, "GATHER is wired into the SP2 loop only");
    int tid_ = threadIdx.x; asm volatile("" : "+v"(tid_));
    const int tid = tid_, wid = __builtin_amdgcn_readfirstlane(tid >> 6), lane = tid & 63, wr = wid >> 2, wc = wid & 3, fr = lane & 15, fq = lane >> 4;
    int K_ = g.K; asm volatile("" : "+s"(K_));
    const int K = K_, nt = K / BK;
    constexpr bool P16 = has_p16<Epi>::v;
    unsigned voffA[2], voffB[2];
#pragma unroll
    for (int i = 0; i < 2; ++i) { int R, C; stage_rc(tid * 16 + i * 8192, R, C); const int Rb = P16 ? ((R >> 5) * 64 + 16 * ((R & 15) >> 2) + 4 * ((R >> 4) & 1) + (R & 3)) : Epi::PERM ? ((R & ~31) + perm32(R & 31)) : R;
        voffA[i] = (unsigned)(R * K + C) * 2u; voffB[i] = (unsigned)(Rb * K + C) * 2u; }
    unsigned vC[2][2] = {{0u, 0u}, {0u, 0u}};
    const PG8_LAS int* const rowlds = (const PG8_LAS int*)(lds + STAGE_BYTES + 4096);
#define PG8_ROWS(dst, pm_) do { if constexpr (GATHER) { _Pragma("unroll") for (int h_ = 0; h_ < 2; ++h_) _Pragma("unroll") for (int i_ = 0; i_ < 2; ++i_) { int R_, C_; stage_rc(tid * 16 + i_ * 8192, R_, C_); \
        const int ix_ = (pm_) * BM + h_ * HALF + R_; dst[h_][i_] = ((g.rowmap ? (unsigned)g.rowmap[ix_] : (unsigned)ix_) * (unsigned)K + (unsigned)C_) * 2u; } } } while (0)
#define PG8_ROWS_LDS(dst) do { _Pragma("unroll") for (int h_ = 0; h_ < 2; ++h_) _Pragma("unroll") for (int i_ = 0; i_ < 2; ++i_) { int R_, C_; stage_rc(tid * 16 + i_ * 8192, R_, C_); \
        dst[h_][i_] = ((unsigned)rowlds[h_ * HALF + R_] * (unsigned)K + (unsigned)C_) * 2u; } } while (0)
    const size_t kstep = (size_t)(BK * 2);
    const size_t hstep = (size_t)HALF * K * 2;
    const size_t b64step = (size_t)64 * K * 2;
    const size_t hB = P16 ? (size_t)8 * K * 2 : hstep, b64B = P16 ? 2 * b64step : b64step;
    const size_t hA = GATHER ? (size_t)0 : hstep;
    const size_t tstep = 2 * hstep;
    const unsigned ldsw = (unsigned)wid * 1024u;
    const int aoff = lds_byte(wr * 64 + fr, fq * 8), boff = lds_byte(wc * 32 + fr, fq * 8);
#define PG8_SA(b, h) (((b) * 2 + (h)) * HTB)
#define PG8_SB(b, h) ((4 + (b) * 2 + (h)) * HTB)
#define PG8_STAGE(bufoff, gbase, voff) do { if constexpr (true) { const bool isB_ = ((const void*)(voff) == (const void*)voffB), isA_ = ((const void*)(voff) == (const void*)voffA); _Pragma("unroll") for (int _i = 0; _i < 2; ++_i) \
        __builtin_amdgcn_global_load_lds((const unsigned*)((const char*)(gbase) + (isB_ ? (size_t)_i * b64B : isA_ ? (size_t)_i * b64step : (size_t)0) + (isB_ ? voffB[0] : (isA_ ? voffA[0] : (voff)[_i]))), (PG8_LAS unsigned*)(lds + (bufoff) + ldsw + _i * 8192), 16, 0, 0); } } while (0)
#define PG8_LD16(off) (*(const PG8_LAS v8i_t_half*)(lds + (off)))
#define PG8_LDA(dst, b, h) do { if constexpr (FP8) { _Pragma("unroll") for (int m = 0; m < 4; ++m) dst##8[m] = __builtin_shufflevector(__builtin_bit_cast(v8i_t_half, *(const PG8_LAS bf16x8*)(lds + PG8_SA(b, h) + aoff + m * 2048)), __builtin_bit_cast(v8i_t_half, *(const PG8_LAS bf16x8*)(lds + PG8_SA(b, h) + aoff + m * 2048 + 1024)), 0, 1, 2, 3, 4, 5, 6, 7); } \
        else { _Pragma("unroll") for (int m = 0; m < 4; ++m) _Pragma("unroll") for (int k = 0; k < 2; ++k) dst[m][k] = *(const PG8_LAS bf16x8*)(lds + PG8_SA(b, h) + aoff + m * 2048 + k * 1024); } } while (0)
#define PG8_LDB(dst, b, h) do { if constexpr (FP8) { _Pragma("unroll") for (int n = 0; n < 2; ++n) dst##8[n] = __builtin_shufflevector(__builtin_bit_cast(v8i_t_half, *(const PG8_LAS bf16x8*)(lds + PG8_SB(b, h) + boff + n * 2048)), __builtin_bit_cast(v8i_t_half, *(const PG8_LAS bf16x8*)(lds + PG8_SB(b, h) + boff + n * 2048 + 1024)), 0, 1, 2, 3, 4, 5, 6, 7); } \
        else { _Pragma("unroll") for (int n = 0; n < 2; ++n) _Pragma("unroll") for (int k = 0; k < 2; ++k) dst[n][k] = *(const PG8_LAS bf16x8*)(lds + PG8_SB(b, h) + boff + n * 2048 + k * 1024); } } while (0)
#define PG8_MMA(ai, bj, At, Bt) do { __builtin_amdgcn_s_setprio(1); _Pragma("unroll") for (int m = 0; m < 4; ++m) _Pragma("unroll") for (int n = 0; n < 2; ++n) { \
        if constexpr (FP8) acc[ai][bj][m][n] = __builtin_amdgcn_mfma_scale_f32_16x16x128_f8f6f4(Bt##8[n], At##8[m], acc[ai][bj][m][n], 0, 0, 0, g.scale_a, 0, g.scale_a); \
        else { _Pragma("unroll") for (int k = 0; k < 2; ++k) acc[ai][bj][m][n] = __builtin_amdgcn_mfma_f32_16x16x32_bf16(Bt[n][k], At[m][k], acc[ai][bj][m][n], 0, 0, 0); } } __builtin_amdgcn_s_setprio(0); } while (0)
#define PG8_WAIT_V(n) asm volatile("s_waitcnt vmcnt(" #n ")" ::: "memory")
#define PG8_WAIT_L(n) asm volatile("s_waitcnt lgkmcnt(" #n ")" ::: "memory")
#define PG8_BAR __builtin_amdgcn_s_barrier()
#define PG8_SCHED __builtin_amdgcn_sched_barrier(0)
    Unit cur, nxt; int ui = 0;
    if (!S.next(0, cur)) return;
    cur.slot = 0;
    f32x4 acc[2][2][4][2];
#pragma unroll
    for (int a = 0; a < 2; ++a)
#pragma unroll
        for (int b = 0; b < 2; ++b)
#pragma unroll
            for (int m = 0; m < 4; ++m)
#pragma unroll
                for (int n = 0; n < 2; ++n) acc[a][b][m][n] = (f32x4){0.f, 0.f, 0.f, 0.f};
    bf16x8 At[4][2], B0[2][2], B1[2][2]; v8i_t At8[4], B08[2], B18[2];
    const char* cA = (const char*)g.A + (GATHER ? (size_t)0 : (size_t)cur.pm * tstep + (size_t)cur.b * g.strideA); const char* cB = (const char*)g.Bt + (size_t)cur.pn * tstep + (size_t)cur.b * g.strideB;
    PG8_ROWS(vC, cur.pm);
    S.a_ready(cur);
    if constexpr (SP2) {
        PG8_STAGE(PG8_SB(0, 0), cB, voffB); PG8_STAGE(PG8_SB(0, 1), cB + hB, voffB); PG8_STAGE(PG8_SA(0, 0), cA, (GATHER ? vC[0] : voffA)); PG8_STAGE(PG8_SA(0, 1), cA + hA, (GATHER ? vC[1] : voffA));
        if (wr == 1) PG8_BAR;
        PG8_WAIT_V(2); PG8_BAR;
        PG8_STAGE(PG8_SB(1, 0), cB + kstep, voffB); PG8_STAGE(PG8_SA(1, 0), cA + kstep, (GATHER ? vC[0] : voffA)); PG8_STAGE(PG8_SB(1, 1), cB + hB + kstep, voffB);
        PG8_WAIT_V(6); PG8_BAR;
    } else {
        PG8_STAGE(PG8_SB(0, 0), cB, voffB); PG8_STAGE(PG8_SA(0, 0), cA, voffA); PG8_STAGE(PG8_SB(0, 1), cB + hB, voffB); PG8_STAGE(PG8_SA(0, 1), cA + hstep, voffA);
        if (wr == 1) PG8_BAR;
        PG8_WAIT_V(4); PG8_BAR;
        PG8_STAGE(PG8_SB(1, 0), cB + kstep, voffB); PG8_STAGE(PG8_SA(1, 0), cA + kstep, voffA); PG8_STAGE(PG8_SB(1, 1), cB + hB + kstep, voffB);
        PG8_WAIT_V(6); PG8_BAR;
    }
    for (;;) {
        const bool has_next = S.next(ui + 1, nxt); nxt.slot = (ui + 1) & 1;
        if constexpr (Epi::LDS_BIAS) { if (wid == 0) __builtin_amdgcn_global_load_lds((const unsigned*)E.bias_src(cur, lane), (PG8_LAS unsigned*)(lds + STAGE_BYTES + 5120 + cur.slot * 1024), 16, 0, 0); }
        const char* nA = (has_next && !GATHER) ? (const char*)g.A + (size_t)nxt.pm * tstep + (size_t)nxt.b * g.strideA : cA; const char* nB = has_next ? (const char*)g.Bt + (size_t)nxt.pn * tstep + (size_t)nxt.b * g.strideB : cB;
        if constexpr (GATHER) { if (g.rowmap && wid == 0) { const int np_ = has_next ? nxt.pm : cur.pm;
            __builtin_amdgcn_global_load_lds((const unsigned*)(g.rowmap + (size_t)np_ * BM + lane * 4), (PG8_LAS unsigned*)(lds + STAGE_BYTES + 4096), 16, 0, 0); } }
        for (int t = 0; t < nt; t += 2) {
            const bool last = (t == nt - 2);
            const char* a1 = cA + (size_t)(t + 1) * kstep;
            const char* a2 = last ? nA : cA + (size_t)(t + 2) * kstep; const char* b2 = last ? nB : cB + (size_t)(t + 2) * kstep;
            const char* a3 = a2 + kstep; const char* b3 = b2 + kstep;
            if (last && has_next) S.a_ready(nxt);
            if constexpr (SP2) {
            PG8_LDB(B0, 0, 0); PG8_LDB(B1, 0, 1); PG8_SCHED; PG8_LDA(At, 0, 0); PG8_STAGE(PG8_SA(1, 1), a1 + hA, (GATHER ? vC[1] : voffA));
            if constexpr (GATHER) { if (last) { if (g.rowmap) PG8_ROWS_LDS(vC); else { const int np_ = has_next ? nxt.pm : cur.pm; PG8_ROWS(vC, np_); } } }
            PG8_WAIT_V(8); PG8_WAIT_L(0); PG8_BAR; PG8_MMA(0, 0, At, B0); PG8_MMA(0, 1, At, B1); PG8_BAR; PG8_SCHED;
            PG8_LDA(At, 0, 1); PG8_STAGE(PG8_SB(0, 0), b2, voffB); PG8_STAGE(PG8_SB(0, 1), b2 + hB, voffB); PG8_STAGE(PG8_SA(0, 0), a2, (GATHER ? vC[0] : voffA));
            PG8_WAIT_V(8); PG8_WAIT_L(0); PG8_BAR; PG8_MMA(1, 0, At, B0); PG8_MMA(1, 1, At, B1); PG8_BAR; PG8_SCHED;
            PG8_LDB(B0, 1, 0); PG8_LDB(B1, 1, 1); PG8_SCHED; PG8_LDA(At, 1, 0); PG8_STAGE(PG8_SA(0, 1), a2 + hA, (GATHER ? vC[1] : voffA));
            PG8_WAIT_V(8); PG8_WAIT_L(0); PG8_BAR; PG8_MMA(0, 0, At, B0); PG8_MMA(0, 1, At, B1); PG8_BAR; PG8_SCHED;
            PG8_LDA(At, 1, 1); PG8_STAGE(PG8_SB(1, 0), b3, voffB); PG8_STAGE(PG8_SB(1, 1), b3 + hB, voffB); PG8_STAGE(PG8_SA(1, 0), a3, (GATHER ? vC[0] : voffA));
            PG8_WAIT_V(8); PG8_WAIT_L(0); PG8_BAR; PG8_MMA(1, 0, At, B0); PG8_MMA(1, 1, At, B1); PG8_BAR; PG8_SCHED;
            } else {
            PG8_LDB(B0, 0, 0); PG8_SCHED; PG8_LDA(At, 0, 0); PG8_STAGE(PG8_SA(1, 1), a1 + hstep, voffA);
            PG8_WAIT_L(8); PG8_BAR; PG8_WAIT_L(0); PG8_MMA(0, 0, At, B0); PG8_BAR; PG8_SCHED;
            PG8_LDB(B1, 0, 1); PG8_STAGE(PG8_SB(0, 0), b2, voffB);
            PG8_BAR; PG8_WAIT_L(0); PG8_MMA(0, 1, At, B1); PG8_BAR;
            PG8_LDA(At, 0, 1); PG8_STAGE(PG8_SA(0, 0), a2, voffA);
            PG8_BAR; PG8_WAIT_L(0); PG8_MMA(1, 0, At, B0); PG8_BAR; PG8_SCHED;
            PG8_STAGE(PG8_SB(0, 1), b2 + hB, voffB);
            PG8_WAIT_V(6); PG8_BAR; PG8_MMA(1, 1, At, B1); PG8_BAR;
            PG8_LDB(B0, 1, 0); PG8_SCHED; PG8_LDA(At, 1, 0); PG8_STAGE(PG8_SA(0, 1), a2 + hstep, voffA);
            PG8_WAIT_L(8); PG8_BAR; PG8_WAIT_L(0); PG8_MMA(0, 0, At, B0); PG8_BAR; PG8_SCHED;
            PG8_LDB(B1, 1, 1); PG8_STAGE(PG8_SB(1, 0), b3, voffB);
            PG8_BAR; PG8_WAIT_L(0); PG8_MMA(0, 1, At, B1); PG8_BAR;
            PG8_LDA(At, 1, 1); PG8_STAGE(PG8_SA(1, 0), a3, voffA);
            PG8_BAR; PG8_WAIT_L(0); PG8_MMA(1, 0, At, B0); PG8_BAR; PG8_SCHED;
            PG8_STAGE(PG8_SB(1, 1), b3 + hB, voffB);
            PG8_WAIT_V(6); PG8_BAR; PG8_MMA(1, 1, At, B1); PG8_BAR;
            }
        }
        if constexpr (ALIGN_EPI) { if (wr == 0) PG8_BAR; }
        if constexpr (!Epi::AFTER_DRAIN) { int t2_ = threadIdx.x; asm volatile("" : "+v"(t2_)); E(acc, cur, wr, wc, t2_ & 15, (t2_ & 63) >> 4); S.done(cur); }
        if (!has_next) break;
        if (!(Epi::CHAIN && cur.b < 2)) {
#pragma unroll
        for (int a = 0; a < 2; ++a)
#pragma unroll
            for (int b = 0; b < 2; ++b)
#pragma unroll
                for (int m = 0; m < 4; ++m)
#pragma unroll
                    for (int n = 0; n < 2; ++n) acc[a][b][m][n] = (f32x4){0.f, 0.f, 0.f, 0.f};
        }
        cur = nxt; cA = nA; cB = nB; ++ui;
        if constexpr (ALIGN_EPI) { if (wr == 1) PG8_BAR; }
    }
    PG8_WAIT_V(0);
    if constexpr (!ALIGN_EPI) { if (wr == 0) PG8_BAR; }
    PG8_BAR;
    if constexpr (Epi::AFTER_DRAIN) { E.fused(acc, cur, wr, wc, fr, fq, lds, wid, lane); S.done(cur); }
#undef PG8_ROWS
#undef PG8_ROWS_LDS
#undef PG8_SA
#undef PG8_SB
#undef PG8_STAGE
#undef PG8_LDA
#undef PG8_LDB
#undef PG8_MMA
#undef PG8_LD16
#undef PG8_WAIT_V
#undef PG8_WAIT_L
#undef PG8_BAR
#undef PG8_SCHED
}
}
namespace attn_body {
using bf16=__hip_bfloat16;
using bf16x8=__attribute__((ext_vector_type(8)))short;
using s16x4=__attribute__((ext_vector_type(4)))short;
using f32x16=__attribute__((ext_vector_type(16)))float;
using f32x4v=__attribute__((ext_vector_type(4)))float;
using u32x4=__attribute__((ext_vector_type(4)))unsigned;
constexpr int D=64;
constexpr int NW=8,QBLK=32,QB=QBLK*NW,KVBLK=64;
__device__ __forceinline__ int crow(int r,int hi){return (r&3)+8*(r>>2)+4*hi;}
#define SBAR() __builtin_amdgcn_sched_barrier(0)
__device__ __forceinline__ void cmask(f32x16&p0,f32x16&p1,int jb,int qrel,int hi){
  const float NEG=-INFINITY; int kb=64*jb+4*hi;
  #pragma unroll
  for(int r=0;r<16;++r){int kv=kb+(r&3)+8*(r>>2); if(kv>qrel)p0[r]=NEG; if(kv+32>qrel)p1[r]=NEG;}
}

constexpr int NSLOT=3, SLOTB=8192;
constexpr int LDS_K=0, LDS_V=NSLOT*SLOTB, LDS_WS=2*NSLOT*SLOTB, LDS_OST=LDS_WS+NW*64*4, LDS_BYTES=LDS_OST+NW*4096;
constexpr int LDS_CS=LDS_BYTES, CS_BYTES=65536, LDS_TOTAL=LDS_CS+CS_BYTES;
constexpr int TBL_N=640, TBL_ZERO=256;
__device__ __forceinline__ void glds16(const void*gsrc,unsigned lds_dst){unsigned keep;
  asm volatile("s_mov_b32 %0, m0\n\ts_mov_b32 m0, %2\n\ts_nop 0\n\tglobal_load_lds_dwordx4 %1, off\n\ts_mov_b32 m0, %0":"=&s"(keep):"v"(gsrc),"s"(lds_dst):"memory");}
__device__ __forceinline__ float max3f(float a,float b,float c){float r;asm("v_max3_f32 %0, %1, %2, %3":"=v"(r):"v"(a),"v"(b),"v"(c));return r;}
__device__ __forceinline__ float max2f(float a,float b){float r;asm("v_max_f32_e32 %0, %1, %2":"=v"(r):"v"(a),"v"(b));return r;}
__device__ __forceinline__ float fadd_s(float a,float b){float r;asm("v_add_f32_e32 %0, %1, %2":"=v"(r):"v"(a),"v"(b));return r;}
__device__ __forceinline__ float fsub_s(float a,float b){float r;asm("v_sub_f32_e32 %0, %1, %2":"=v"(r):"v"(a),"v"(b));return r;}
typedef float f32x2_t __attribute__((ext_vector_type(2))); typedef __bf16 bf16x2_t __attribute__((ext_vector_type(2)));
__device__ __forceinline__ unsigned cvtpk_s(float lo,float hi){f32x2_t v={lo,hi};bf16x2_t b=__builtin_convertvector(v,bf16x2_t);return __builtin_bit_cast(unsigned,b);}
#define WAIT_BAR(N) asm volatile("s_waitcnt vmcnt(" #N ") lgkmcnt(0)\n\ts_barrier":::"memory")

__device__ __forceinline__ void qkt(f32x16&p0,f32x16&p1,const char*Kslot,const bf16x8*qr,int r32,int hi){
  const char*kb=Kslot+hi*1024+r32*16;
  #pragma unroll
  for(int d0=0;d0<4;++d0){
    const bf16x8 b0=*reinterpret_cast<const bf16x8*>(kb+d0*2048);
    const bf16x8 b1=*reinterpret_cast<const bf16x8*>(kb+d0*2048+512);
    p0=__builtin_amdgcn_mfma_f32_32x32x16_bf16(b0,qr[d0],p0,0,0,0);p1=__builtin_amdgcn_mfma_f32_32x32x16_bf16(b1,qr[d0],p1,0,0,0);}
}
typedef __attribute__((address_space(3))) const char* lds_cptr;
typedef __attribute__((address_space(3))) char* lds_ptr;
typedef short v4i16_t __attribute__((ext_vector_type(4)));
__device__ __forceinline__ void kload8(bf16x8*kf,lds_cptr kp){
  kf[0]=*(const __attribute__((address_space(3))) bf16x8*)(kp);      kf[1]=*(const __attribute__((address_space(3))) bf16x8*)(kp+512);
  kf[2]=*(const __attribute__((address_space(3))) bf16x8*)(kp+2048); kf[3]=*(const __attribute__((address_space(3))) bf16x8*)(kp+2560);
  kf[4]=*(const __attribute__((address_space(3))) bf16x8*)(kp+4096); kf[5]=*(const __attribute__((address_space(3))) bf16x8*)(kp+4608);
  kf[6]=*(const __attribute__((address_space(3))) bf16x8*)(kp+6144); kf[7]=*(const __attribute__((address_space(3))) bf16x8*)(kp+6656);
}
__device__ __forceinline__ void kload2(bf16x8*kf,lds_cptr kp,int j){ kf[2*j]=*(const __attribute__((address_space(3))) bf16x8*)(kp+j*2048); kf[2*j+1]=*(const __attribute__((address_space(3))) bf16x8*)(kp+j*2048+512); }
__device__ __forceinline__ s16x4 vtr(lds_cptr p){ return __builtin_bit_cast(s16x4,__builtin_amdgcn_ds_read_tr16_b64_v4i16((__attribute__((address_space(3))) v4i16_t*)p)); }
__device__ __forceinline__ float rowmax(const f32x16&p0,const f32x16&p1){
  float a=max3f(p0[0],p0[1],p1[0]),b=max3f(p0[2],p0[3],p1[1]);a=max3f(a,p1[2],p1[3]);
  #pragma unroll
  for(int r=4;r<16;r+=4){a=max3f(a,p0[r],p0[r+1]);b=max3f(b,p0[r+2],p0[r+3]);a=max3f(a,p1[r],p1[r+1]);b=max3f(b,p1[r+2],p1[r+3]);}
  const float m=max2f(a,b);
  auto rr=__builtin_amdgcn_permlane32_swap(__float_as_uint(m),__float_as_uint(m),false,false);
  return max2f(__uint_as_float(rr[0]),__uint_as_float(rr[1]));
}
__device__ __forceinline__ void pv(f32x16*o,int vb,bf16x8 pa0,bf16x8 pa1,bf16x8 pa2,bf16x8 pa3){
  #pragma unroll
  for(int d0=0;d0<2;++d0){s16x4 lo[4],hi[4];
    #pragma unroll
    for(int ks=0;ks<4;++ks){
      asm volatile("ds_read_b64_tr_b16 %0,%1 offset:%c2":"=&v"(lo[ks]):"v"(vb),"i"(d0*4096+ks*1024):"memory");
      asm volatile("ds_read_b64_tr_b16 %0,%1 offset:%c2":"=&v"(hi[ks]):"v"(vb),"i"(d0*4096+ks*1024+512):"memory");}
    asm volatile("s_waitcnt lgkmcnt(0)":::"memory");SBAR();
    #define PK(k) (bf16x8){lo[k][0],lo[k][1],lo[k][2],lo[k][3],hi[k][0],hi[k][1],hi[k][2],hi[k][3]}
    o[d0]=__builtin_amdgcn_mfma_f32_32x32x16_bf16(pa0,PK(0),o[d0],0,0,0);
    o[d0]=__builtin_amdgcn_mfma_f32_32x32x16_bf16(pa1,PK(1),o[d0],0,0,0);
    o[d0]=__builtin_amdgcn_mfma_f32_32x32x16_bf16(pa2,PK(2),o[d0],0,0,0);
    o[d0]=__builtin_amdgcn_mfma_f32_32x32x16_bf16(pa3,PK(3),o[d0],0,0,0);
    #undef PK
  }
}

struct AttnArgs { const bf16* Q; const bf16* K; const bf16* V; bf16* O; long qp, kp, op; int q0, NT, kv0; const float* aux; float* lse; long lse_stride; int tlo, thi, band; float thr; };
#define ATTN_STORE16(p,v) (*(u32x4*)(p)=(v))
template<int MODE,int THRL> __device__ __forceinline__ void attn_unit(const AttnArgs&a,char*shm){
  int tid_=threadIdx.x; asm volatile("":"+v"(tid_));
  const int tid=tid_,lane=tid&63,r32=lane&31,hi=lane>>5; const int wid=__builtin_amdgcn_readfirstlane(tid>>6);
  const int q0=a.q0; const long KP=a.kp;
  const bf16*Qw=a.Q+(long)(q0+wid*QBLK)*a.qp;
  const bf16*Kh=a.K,*Vh=a.V;
  int NT=a.NT, lo=0;
  if(MODE==0){
    const int nt0=a.thi-a.tlo; const float cq=a.aux[q0];
    const float ck=(lane<nt0)?a.aux[64*(a.tlo+lane)+63]:0.f;
    const unsigned long long need=__ballot((lane<nt0)&&(cq-ck>=-a.thr));
    const int j0=need?(int)__builtin_ctzll(need):nt0;
    if(j0>=nt0){ if(a.lse&&tid<QB)a.lse[(long)(q0+tid)*a.lse_stride]=-INFINITY; return; }
    lo=a.tlo+j0; int n=a.thi-lo; if(n<4){lo=a.thi-4;n=4;} if(n&1){lo-=1;n+=1;} NT=n;
    Kh+=(long)lo*KVBLK*KP; Vh+=(long)lo*KVBLK*KP;
  }
  const unsigned lds0=(unsigned)(uintptr_t)shm;
  float*wsf=(float*)(shm+LDS_WS)+wid*64;
  const lds_cptr shm3=(lds_cptr)shm;
  const __attribute__((address_space(3))) float* cs3=(const __attribute__((address_space(3))) float*)(shm3+LDS_CS);
  float nb=0.f;
  if(MODE==0){ __attribute__((address_space(3))) f32x4v* dst=(__attribute__((address_space(3))) f32x4v*)((lds_ptr)shm+LDS_CS); const f32x4v* src=(const f32x4v*)a.aux+16*lo; const int n4=16*NT;
    for(int i=tid;i<n4;i+=NW*64)dst[i]=src[i];
    nb=a.aux[q0+wid*QBLK+r32]; }
  if(MODE==1){ __attribute__((address_space(3))) float* dst=(__attribute__((address_space(3))) float*)((lds_ptr)shm+LDS_CS);
    for(int i=tid;i<TBL_N;i+=NW*64)dst[i]=a.aux[i]; }
  const bf16*ksrc=Kh+(long)lane*KP+wid*8;
  const bf16*vsrc=Vh+(long)(16*(wid&3)+(lane>>2))*KP+(wid>>2)*32+(lane&3)*8;
  const unsigned kdst=lds0+LDS_K+wid*1024, vdst=lds0+LDS_V+wid*1024;
  #define DMA_K(t,slot) glds16(ksrc+(long)(t)*KVBLK*KP,(unsigned)__builtin_amdgcn_readfirstlane(kdst+(slot)))
  #define DMA_V(t,slot) glds16(vsrc+(long)(t)*KVBLK*KP,(unsigned)__builtin_amdgcn_readfirstlane(vdst+(slot)))
  const int vb0=(int)(lds0+LDS_V)+((lane>>4)&1)*32+(lane&3)*8+(4*hi+((lane&15)>>2))*64;
  const char*Kbase=shm+LDS_K; bf16x8 kf[8];
  const lds_cptr kp0=shm3+LDS_K+hi*1024+r32*16; const lds_cptr vp0=shm3+LDS_V+((lane>>4)&1)*32+(lane&3)*8+(4*hi+((lane&15)>>2))*64;
  DMA_K(0,0);DMA_V(0,0);DMA_K(1,SLOTB);
  bf16x8 qr[4];
  #pragma unroll
  for(int d0=0;d0<4;++d0)qr[d0]=*reinterpret_cast<const bf16x8*>(&Qw[(long)r32*a.qp+d0*16+hi*8]);
  float mhat=0.f,l_reg=0.f;f32x16 o[2];o[0]=f32x16{};o[1]=f32x16{};
  const int qrel=wid*QBLK+r32;
  const int tb0=q0+qrel-a.kv0-4*hi+TBL_ZERO-63;
  #define CINIT(C0,C1,t) do{ \
    if(MODE==0){ const __attribute__((address_space(3))) float* cp_=cs3+64*(t)+4*hi; \
      _Pragma("unroll") for(int g_=0;g_<4;++g_){ const f32x4v a_=*(const __attribute__((address_space(3))) f32x4v*)(cp_+8*g_); const f32x4v b_=*(const __attribute__((address_space(3))) f32x4v*)(cp_+32+8*g_); \
        C0[4*g_]=nb-a_[0];C0[4*g_+1]=nb-a_[1];C0[4*g_+2]=nb-a_[2];C0[4*g_+3]=nb-a_[3]; C1[4*g_]=nb-b_[0];C1[4*g_+1]=nb-b_[1];C1[4*g_+2]=nb-b_[2];C1[4*g_+3]=nb-b_[3]; } } \
    else if(MODE==1){ const __attribute__((address_space(3))) float* tp_=cs3+(tb0-64*(t)); \
      _Pragma("unroll") for(int g_=0;g_<4;++g_) _Pragma("unroll") for(int j_=0;j_<4;++j_){ C0[4*g_+j_]=nb+tp_[63-8*g_-j_]; C1[4*g_+j_]=nb+tp_[31-8*g_-j_]; } } \
    else { _Pragma("unroll") for(int r_=0;r_<16;++r_){C0[r_]=nb;C1[r_]=nb;} } }while(0)
  #define CMASK(P0,P1,t) do{ if(MODE==0&&a.band){int jb_=(t)-(NT-4); if(jb_>=0)cmask(P0,P1,jb_,qrel,hi);} }while(0)
  bool resc=false;
  #define START(P0,P1) do{ const float rm=rowmax(P0,P1); resc=false; \
    { const float dl=(MODE==1)?max2f(rm,-256.0f):rm; mhat=fadd_s(mhat,dl); nb=fsub_s(nb,dl); \
      _Pragma("unroll") for(int r=0;r<16;++r){P0[r]=fsub_s(P0[r],dl);P1[r]=fsub_s(P1[r],dl);} } \
    _Pragma("unroll") for(int r=0;r<16;++r)P0[r]=__builtin_amdgcn_exp2f(P0[r]); }while(0)
  #define RESC() do{ if(resc){ asm volatile("s_waitcnt lgkmcnt(0)":::"memory"); \
      _Pragma("unroll") for(int d_=0;d_<2;++d_) _Pragma("unroll") for(int r=0;r<16;++r)o[d_][r]*=wsf[crow(r,hi)]; } }while(0)
  f32x16 pA0,pA1,pB0,pB1;
  int sl_prev=0,sl_cur=0,sl_next=SLOTB;
  #define ROT() do{sl_prev=sl_cur;sl_cur=sl_next;sl_next=(sl_next==(NSLOT-1)*SLOTB)?0:sl_next+SLOTB;}while(0)
  DMA_K(2,2*SLOTB);
  WAIT_BAR(3);
  CINIT(pA0,pA1,0);
  qkt(pA0,pA1,Kbase,qr,r32,hi);asm volatile("s_nop 15\n\ts_nop 7":"+v"(pA0),"+v"(pA1));CMASK(pA0,pA1,0);
  START(pA0,pA1);
  _Pragma("unroll") for(int r=0;r<16;++r)pA1[r]=__builtin_amdgcn_exp2f(pA1[r]);
  WAIT_BAR(0);
  DMA_K(3,0);DMA_V(1,SLOTB);
  ROT();
  kload8(kf,kp0+sl_cur);
  WAIT_BAR(2);
  s16x4 vlo[8],vhi[8]; u32x4 pw0,pw1,pw2,pw3;
  #define PKW(P,B) cvtpk_s(P[B],P[B+1])
  #define PAF(k) __builtin_bit_cast(bf16x8,pw##k)
  #define VFR(i) (bf16x8){vlo[i][0],vlo[i][1],vlo[i][2],vlo[i][3],vhi[i][0],vhi[i][1],vhi[i][2],vhi[i][3]}
  #define PIN(x) asm volatile("":"+v"(x))
  #define MX3(a,b,c) __builtin_fmaxf(__builtin_fmaxf((a),(b)),(c))
  #define GAPA(MF,A0,A1,A2,A3,W0,W1,PW) do{ MF; sacc+=A0; sacc+=A1; sacc+=A2; sacc+=A3; PIN(sacc); W0; W1; PIN(PW); SBAR(); }while(0)
  #define EX(v) __builtin_amdgcn_exp2f(v)
  #define GAPB(MF,X,B) do{ MF; X[B]=EX(X[B]); X[B+1]=EX(X[B+1]); X[B+2]=EX(X[B+2]); X[B+3]=EX(X[B+3]); PIN(X); SBAR(); }while(0)
  #define VRD(i) do{ vlo[i]=vtr(vp_+(((i)>>2)*4096+((i)&3)*1024)); vhi[i]=vtr(vp_+(((i)>>2)*4096+((i)&3)*1024+512)); }while(0)
  #define KRD(G,j) do{ if(G){ kload2(kf,kp0+sl_next,j); SBAR(); } }while(0)
  #define STEP(C0,C1,P0,P1,t,GK,GV,GL) do{ CINIT(C0,C1,t); SBAR(); \
    const lds_cptr vp_=vp0+sl_prev; \
    VRD(0); SBAR(); float sacc=(P0[0]+P0[1]); \
    GAPA(C0=__builtin_amdgcn_mfma_f32_32x32x16_bf16(kf[0],qr[0],C0,0,0,0), P0[2],P0[3],P0[4],P0[5],     pw0[0]=PKW(P0,0), pw0[1]=PKW(P0,2), pw0); \
    VRD(4); SBAR(); GAPA(C1=__builtin_amdgcn_mfma_f32_32x32x16_bf16(kf[1],qr[0],C1,0,0,0), P0[6],P0[7],P0[8],P0[9],     pw0[2]=PKW(P0,4), pw0[3]=PKW(P0,6), pw0); \
    VRD(1); SBAR(); GAPA(C0=__builtin_amdgcn_mfma_f32_32x32x16_bf16(kf[2],qr[1],C0,0,0,0),   P0[10],P0[11],P0[12],P0[13], pw1[0]=PKW(P0,8), pw1[1]=PKW(P0,10), pw1); \
    VRD(5); SBAR(); GAPA(C1=__builtin_amdgcn_mfma_f32_32x32x16_bf16(kf[3],qr[1],C1,0,0,0),   P0[14],P0[15],P1[0],P1[1],   pw1[2]=PKW(P0,12),pw1[3]=PKW(P0,14), pw1); \
    VRD(2); SBAR(); GAPA(C0=__builtin_amdgcn_mfma_f32_32x32x16_bf16(kf[4],qr[2],C0,0,0,0),   P1[2],P1[3],P1[4],P1[5],     pw2[0]=PKW(P1,0), pw2[1]=PKW(P1,2), pw2); \
    VRD(6); SBAR(); GAPA(C1=__builtin_amdgcn_mfma_f32_32x32x16_bf16(kf[5],qr[2],C1,0,0,0),   P1[6],P1[7],P1[8],P1[9],     pw2[2]=PKW(P1,4), pw2[3]=PKW(P1,6), pw2); \
    VRD(3); SBAR(); GAPA(C0=__builtin_amdgcn_mfma_f32_32x32x16_bf16(kf[6],qr[3],C0,0,0,0),   P1[10],P1[11],P1[12],P1[13], pw3[0]=PKW(P1,8), pw3[1]=PKW(P1,10), pw3); \
    VRD(7); SBAR(); GAPA(C1=__builtin_amdgcn_mfma_f32_32x32x16_bf16(kf[7],qr[3],C1,0,0,0),   P1[14],P1[15],0.f,0.f,       pw3[2]=PKW(P1,12),pw3[3]=PKW(P1,14), pw3); \
    l_reg+=sacc; \
    if(GK){DMA_K((t)+3,sl_cur);} if(GV){DMA_V((t)+1,sl_next);} \
    CMASK(C0,C1,t); \
    { float a=MX3(C0[0],C0[1],C1[0]),b=MX3(C0[2],C0[3],C1[1]); a=MX3(a,C1[2],C1[3]); \
      _Pragma("unroll") for(int r=4;r<16;r+=4){a=MX3(a,C0[r],C0[r+1]);b=MX3(b,C0[r+2],C0[r+3]);a=MX3(a,C1[r],C1[r+1]);b=MX3(b,C1[r+2],C1[r+3]);} \
      float rm=__builtin_fmaxf(a,b); { auto rr=__builtin_amdgcn_permlane32_swap(__float_as_uint(rm),__float_as_uint(rm),false,false); rm=__builtin_fmaxf(__uint_as_float(rr[0]),__uint_as_float(rr[1])); } \
      resc=false; \
      if(__builtin_expect(__any(rm>(float)THRL),0)){ const float dl=__builtin_fmaxf(rm,0.f); mhat+=dl; nb-=dl; \
        _Pragma("unroll") for(int r=0;r<16;++r){C0[r]-=dl;C1[r]-=dl;} \
        const float f=__builtin_amdgcn_exp2f(-dl); l_reg*=f; if(hi==0)wsf[r32]=f; resc=true; } } \
    SBAR(); \
    GAPB(o[0]=__builtin_amdgcn_mfma_f32_32x32x16_bf16(PAF(0),VFR(0),o[0],0,0,0), C0,0); \
    GAPB(o[1]=__builtin_amdgcn_mfma_f32_32x32x16_bf16(PAF(0),VFR(4),o[1],0,0,0), C0,4); \
    KRD(GL,0); GAPB(o[0]=__builtin_amdgcn_mfma_f32_32x32x16_bf16(PAF(1),VFR(1),o[0],0,0,0), C0,8); \
    KRD(GL,1); GAPB(o[1]=__builtin_amdgcn_mfma_f32_32x32x16_bf16(PAF(1),VFR(5),o[1],0,0,0), C0,12); \
    KRD(GL,2); GAPB(o[0]=__builtin_amdgcn_mfma_f32_32x32x16_bf16(PAF(2),VFR(2),o[0],0,0,0), C1,0); \
    KRD(GL,3); GAPB(o[1]=__builtin_amdgcn_mfma_f32_32x32x16_bf16(PAF(2),VFR(6),o[1],0,0,0), C1,4); \
    GAPB(o[0]=__builtin_amdgcn_mfma_f32_32x32x16_bf16(PAF(3),VFR(3),o[0],0,0,0), C1,8); \
    GAPB(o[1]=__builtin_amdgcn_mfma_f32_32x32x16_bf16(PAF(3),VFR(7),o[1],0,0,0), C1,12); \
    }while(0)
  int t=1;
  #undef CMASK
  #define CMASK(P0,P1,t) do{}while(0)
  for(;t+5<NT;t+=2){
    STEP(pB0,pB1,pA0,pA1,t,true,true,true);     WAIT_BAR(2); RESC(); ROT();
    STEP(pA0,pA1,pB0,pB1,t+1,true,true,true);   WAIT_BAR(2); RESC(); ROT();
  }
  #undef CMASK
  #define CMASK(P0,P1,t) do{ if(MODE==0&&a.band){int jb_=(t)-(NT-4); if(jb_>=0)cmask(P0,P1,jb_,qrel,hi);} }while(0)
  #define ENDW(tt) do{ if((tt)+3<NT){WAIT_BAR(2);} else if((tt)+2<NT){WAIT_BAR(1);} else {WAIT_BAR(0);} }while(0)
  for(;t+1<NT;t+=2){
    STEP(pB0,pB1,pA0,pA1,t,(t+3<NT),(t+1<NT),(t+1<NT));       ENDW(t);   RESC(); ROT();
    STEP(pA0,pA1,pB0,pB1,t+1,(t+4<NT),(t+2<NT),(t+2<NT));     ENDW(t+1); RESC(); ROT();
  }
  STEP(pB0,pB1,pA0,pA1,NT-1,false,false,false); RESC();
  { float sacc=pB0[0]+pB0[1]; _Pragma("unroll") for(int r=2;r<16;++r)sacc+=pB0[r]; _Pragma("unroll") for(int r=0;r<16;++r)sacc+=pB1[r]; l_reg+=sacc;
    pw0=(u32x4){PKW(pB0,0),PKW(pB0,2),PKW(pB0,4),PKW(pB0,6)};pw1=(u32x4){PKW(pB0,8),PKW(pB0,10),PKW(pB0,12),PKW(pB0,14)};pw2=(u32x4){PKW(pB1,0),PKW(pB1,2),PKW(pB1,4),PKW(pB1,6)};pw3=(u32x4){PKW(pB1,8),PKW(pB1,10),PKW(pB1,12),PKW(pB1,14)};
    SBAR(); pv(o,vb0+sl_cur,PAF(0),PAF(1),PAF(2),PAF(3)); }
  #undef PKW
  #undef PAF
  #undef VFR
  #undef PIN
  #undef MX3
  #undef GAPA
  #undef GAPB
  #undef EX
  #undef VRD
  #undef KRD
  #undef STEP
  #undef ENDW
  {auto rr=__builtin_amdgcn_permlane32_swap(__float_as_uint(l_reg),__float_as_uint(l_reg),false,false);l_reg=__uint_as_float(rr[0])+__uint_as_float(rr[1]);}
  if(MODE==1||(MODE==0&&a.lse)){ if(hi==0) a.lse[(long)(q0+qrel)*a.lse_stride]=mhat+__builtin_amdgcn_logf(l_reg); }
  if(hi==0)wsf[32+r32]=l_reg;asm volatile("s_waitcnt lgkmcnt(0)":::"memory");
  float rli[16];
  #pragma unroll
  for(int r=0;r<16;++r)rli[r]=__builtin_amdgcn_rcpf(wsf[32+crow(r,hi)]);
  bf16*Ow=a.O+(long)(q0+wid*QBLK)*a.op;
  { bf16*stg=(bf16*)(shm+LDS_OST)+wid*2048;
    #pragma unroll
    for(int r=0;r<16;++r){const int orow=crow(r,hi);
      #pragma unroll
      for(int d0=0;d0<2;++d0)stg[orow*64+d0*32+r32]=__float2bfloat16(o[d0][r]*rli[r]);}
    asm volatile("s_waitcnt lgkmcnt(0)":::"memory");
    #pragma unroll
    for(int i=0;i<4;++i){const int row=i*8+(lane>>3),ch=lane&7; const u32x4 v=*(const u32x4*)(stg+row*64+ch*8); ATTN_STORE16(Ow+(long)row*a.op+ch*8,v);} }
  asm volatile("s_waitcnt lgkmcnt(0)\n\ts_barrier":::"memory");
  #undef DMA_K
  #undef DMA_V
  #undef CMASK
  #undef CINIT
  #undef START
  #undef RESC
  #undef ROT
}
constexpr int ATTN_LDS_BYTES=LDS_TOTAL;
#undef SBAR
#undef WAIT_BAR
}
#define GAS __attribute__((address_space(1)))
#define LAS __attribute__((address_space(3)))
typedef unsigned short bf16;
typedef unsigned v4u __attribute__((ext_vector_type(4)));
typedef float f32x4 __attribute__((ext_vector_type(4)));
typedef short bf16x8 __attribute__((ext_vector_type(8)));
typedef GAS unsigned gu32;
typedef GAS unsigned long long gu64;
#define RLX_AGENT __ATOMIC_RELAXED, __HIP_MEMORY_SCOPE_AGENT
#define LDS_WAIT() asm volatile("s_waitcnt lgkmcnt(0)" ::: "memory")
#define VM_WAIT() asm volatile("s_waitcnt vmcnt(0)" ::: "memory")
__device__ __forceinline__ unsigned long long rt() { return __builtin_amdgcn_s_memrealtime(); }
__device__ __forceinline__ unsigned f2bf(float f) { unsigned u = __builtin_bit_cast(unsigned, f); return (u + 0x7fffu + ((u >> 16) & 1u)) >> 16; }
__device__ __forceinline__ unsigned pk4_fp8(float a, float b, float c, float d) { int w = __builtin_amdgcn_cvt_pk_fp8_f32(a, b, 0, false); w = __builtin_amdgcn_cvt_pk_fp8_f32(c, d, w, true); return (unsigned)w; }
__device__ __forceinline__ unsigned pk2(float lo, float hi) { typedef float f2_t __attribute__((ext_vector_type(2))); typedef __bf16 b2_t __attribute__((ext_vector_type(2))); f2_t v = {lo, hi}; b2_t b = __builtin_convertvector(v, b2_t); return __builtin_bit_cast(unsigned, b); }

#define XB_TMO      128
#define XB_XCNT(j)  (256  + 64 * (j))
#define XB_XSUB(j)  (1280 + 64 * (j))
#define XB_XGEN(j)  (2304 + 64 * (j))
#define XB_TOP      3328
#define XB_TOPGEN   3392
#define XCD_BAR_WORDS 3456
#define XB_SPIN_CAP (1u << 18)

__device__ __forceinline__ unsigned xb_ld(unsigned* p)              { return __hip_atomic_load(p, __ATOMIC_RELAXED, __HIP_MEMORY_SCOPE_AGENT); }
__device__ __forceinline__ unsigned xb_add(unsigned* p, unsigned v) { return __hip_atomic_fetch_add(p, v, __ATOMIC_RELAXED, __HIP_MEMORY_SCOPE_AGENT); }
__device__ __forceinline__ unsigned xb_xcc_id() { return (unsigned)__builtin_amdgcn_s_getreg((3 << 11) | 20) & 0xFu; }
#define XB_SPIN(cond, bar) do { unsigned _sp = 0; while (cond) { __builtin_amdgcn_s_sleep(1); \
    if ((++_sp & 255u) == 0u) { if (xb_ld(&(bar)[XB_TMO])) break; if (_sp > XB_SPIN_CAP) { atomicAdd(&(bar)[XB_TMO], 1u); break; } } } } while (0)

struct XcdBarrier {
    unsigned* bar; unsigned x;
    volatile LAS unsigned* st;
};

__device__ __forceinline__ XcdBarrier xcd_barrier_post(unsigned* bar, volatile LAS unsigned* st) {
    XcdBarrier b; b.bar = bar; b.x = xb_xcc_id(); b.st = st;
    if (threadIdx.x == 0) (void)xb_add(&bar[XB_XCNT(b.x)], 1u);
    return b;
}
__device__ __forceinline__ void xcd_barrier_complete(unsigned* bar, unsigned x, unsigned& nloc, unsigned& nx) {
    const unsigned G = gridDim.x * gridDim.y * gridDim.z;
    unsigned sum, cnt, mine, sp = 0u;
    for (;;) {
        sum = 0u; cnt = 0u; mine = 0u;
#pragma unroll
        for (unsigned j = 0; j < 16; ++j) { const unsigned c = xb_ld(&bar[XB_XCNT(j)]); sum += c; cnt += (c > 0u) ? 1u : 0u; mine = (j == x) ? c : mine; }
        if (sum == G) break;
        __builtin_amdgcn_s_sleep(1);
        if ((++sp & 255u) == 0u) { if (xb_ld(&bar[XB_TMO])) break; if (sp > XB_SPIN_CAP) { atomicAdd(&bar[XB_TMO], 1u); break; } }
    }
    nloc = mine > 0u ? mine : 1u; nx = cnt > 0u ? cnt : 1u;
}

__device__ __forceinline__ void xcd_barrier(const XcdBarrier& b) {
    asm volatile("s_waitcnt vmcnt(0)" ::: "memory");
    __syncthreads();
    if (threadIdx.x == 0) {
        unsigned* bar = b.bar;
        __builtin_amdgcn_s_waitcnt(0);
        unsigned nloc = b.st[0], nx = b.st[1];
        if (nloc == 0u) { xcd_barrier_complete(bar, b.x, nloc, nx); b.st[0] = nloc; b.st[1] = nx; }
        const unsigned old = xb_add(&bar[XB_XSUB(b.x)], 1u);
        const unsigned gen = old / nloc;
        if (old + 1u == (gen + 1u) * nloc) {
            __builtin_amdgcn_fence(__ATOMIC_RELEASE, "agent");
            asm volatile("s_waitcnt vmcnt(0)" ::: "memory");
            const unsigned og = xb_add(&bar[XB_TOP], 1u);
            const unsigned tg = og / nx;
            if (og + 1u == (tg + 1u) * nx) xb_add(&bar[XB_TOPGEN], 1u);
            else XB_SPIN(xb_ld(&bar[XB_TOPGEN]) == tg, bar);
            __builtin_amdgcn_fence(__ATOMIC_ACQUIRE, "agent");
            xb_add(&bar[XB_XGEN(b.x)], 1u);
            asm volatile("s_waitcnt vmcnt(0)" ::: "memory");
        } else {
            XB_SPIN(xb_ld(&bar[XB_XGEN(b.x)]) == gen, bar);
            __builtin_amdgcn_fence(__ATOMIC_ACQUIRE, "agent");
            asm volatile("s_waitcnt vmcnt(0)" ::: "memory");
        }
    }
    __syncthreads();
}

constexpr int NWAVES = 8;
constexpr int S = 16384, DM = 1024, NPROJ = 5632, NE = 32, MEML = 256;
constexpr int PC_FQ = 0, PC_FK = 384, PC_FV = 768, PC_DQ = 1152, PC_DK = 1536, PC_DV = 1920, PC_MQ = 2304, PC_GT = 2560;
constexpr int W_IN_LD = 5638, W_IN_F = 1152;
constexpr float LN_EPS = 1e-5f, ALPHA = 1.189207115002721f;
constexpr float LOG2E = 1.4426950408889634f, C2F = 0.125f * 1.4426950408889634f;
constexpr int MAXROWS = 65536 + 32 * 256;
constexpr int NPHASE = 11;
#ifndef MK_N_LAUNCHES
#define MK_N_LAUNCHES 1
#endif
constexpr int N_LAUNCHES = MK_N_LAUNCHES;

constexpr size_t MiB = 1u << 20, KiB = 1u << 10;
constexpr size_t WS_CTL = 0, CTL_ZERO_BYTES = 256 * KiB;
constexpr size_t WS_WIN = 2 * MiB;
constexpr size_t WS_WBF = 748 * MiB, WS_WBD = WS_WBF + 768 * KiB, WS_WBM = WS_WBD + 768 * KiB, WS_WOUT = 15 * MiB, WS_WMKV = 17 * MiB;
constexpr size_t WS_LF2 = 18 * MiB, WS_C2 = WS_LF2 + 512 * KiB, WS_LSE = 19 * MiB, WS_TBL = WS_LSE + 512 * KiB, WS_MEMB = 20 * MiB, WS_MEMKV = WS_MEMB + 512 * KiB;
constexpr size_t WS_TOPI = 21 * MiB, WS_TOPG = WS_TOPI + 256 * KiB, WS_RANK = WS_TOPG + 256 * KiB, WS_DEST = WS_RANK + 256 * KiB, WS_BLKCNT = 22 * MiB, WS_TST = WS_BLKCNT + 64 * KiB;
constexpr size_t WS_TOKROW = 23 * MiB;
constexpr size_t WS_IDMAP = 23 * MiB + 512 * KiB;
constexpr size_t WS_XB = 24 * MiB;
constexpr size_t WS_PBUF = 56 * MiB;
constexpr size_t WS_Y = WS_PBUF;
constexpr size_t WS_OFOX = 712 * MiB, WS_ODIL = 724 * MiB, WS_OMEM = 736 * MiB;
constexpr size_t WS_W1 = 264 * MiB, WS_W2 = 392 * MiB;
constexpr size_t WS_STASH = 456 * MiB, WS_MERGED = 520 * MiB;
constexpr size_t WS_R1 = 552 * MiB, WS_H1F8 = 616 * MiB, WS_XF8 = 632 * MiB, WS_WGF8 = 648 * MiB, WS_H1B = 680 * MiB;
constexpr int W1_SHIFT = 5;
constexpr size_t WS_XS = 712 * MiB, WS_ACT = 856 * MiB, WS_END = 1000 * MiB;
static_assert(WS_XS + (size_t)MAXROWS * 1024 * 2 <= WS_ACT && WS_ACT + (size_t)MAXROWS * 1024 * 2 <= WS_END && WS_Y + (size_t)MAXROWS * 1024 * 2 <= 232 * MiB && WS_WBM + 768 * KiB <= WS_ACT, "ws map");
constexpr int CW_BAR = 4096;
constexpr int CW_NRM = 64, CW_QHEAD = 128;
constexpr size_t WS_OPART = WS_STASH, WS_LSEF = WS_STASH + 48 * MiB;

constexpr int RING_OFF = 0;
constexpr int LDSCTL_OFF = attn_body::ATTN_LDS_BYTES, MISC_OFF = LDSCTL_OFF + 320, TBL_OFF = MISC_OFF + 128;
constexpr int LDS_BYTES = 150528;
static_assert(TBL_OFF + 256 <= LDS_BYTES && pg8::STAGE_BYTES <= LDSCTL_OFF, "LDS map");

struct Args { const float* in[20]; float* out; unsigned char* ws; int ph_lo, ph_hi, li, pad; };
struct Frame {
    LAS unsigned char* lds;
    volatile LAS unsigned* MISC;
    gu32* ctl;
    int tid, lane, wave;
    int vcu, G;
    float* out; unsigned char* ws;
};
__device__ __forceinline__ float wave_sum(float v) {
#pragma unroll
    for (int o = 1; o < 64; o <<= 1) v += __shfl_xor(v, o);
    return v;
}
typedef float f4u __attribute__((ext_vector_type(4), aligned(4)));
typedef float f32x2 __attribute__((ext_vector_type(2)));
typedef unsigned v2u __attribute__((ext_vector_type(2)));
__device__ __forceinline__ void p0_tr_item(const float* W, int ldw, int k0, int src_n0, bf16* WT, int K, int dst_n0, float scale, LAS float* scr, int lane) {
    f4u v[16];
#pragma unroll
    for (int i = 0; i < 16; ++i) v[i] = *(const f4u*)(W + (size_t)(k0 + 4 * i + (lane >> 4)) * ldw + src_n0 + (lane & 15) * 4);
#pragma unroll
    for (int i = 0; i < 16; ++i) { LAS float* d = scr + (4 * i + (lane >> 4)) * 65 + (lane & 15) * 4; d[0] = v[i].x * scale; d[1] = v[i].y * scale; d[2] = v[i].z * scale; d[3] = v[i].w * scale; }
    LDS_WAIT(); asm volatile("" ::: "memory");
    const int c = lane & 7;
#pragma unroll
    for (int j = 0; j < 8; ++j) { const int n = (lane >> 3) + 8 * j; const LAS float* s = scr + (8 * c) * 65 + n;
        v4u o; o.x = pk2(s[0 * 65], s[1 * 65]); o.y = pk2(s[2 * 65], s[3 * 65]); o.z = pk2(s[4 * 65], s[5 * 65]); o.w = pk2(s[6 * 65], s[7 * 65]);
        *(GAS v4u*)(WT + (size_t)(dst_n0 + n) * K + k0 + 8 * c) = o; }
    LDS_WAIT(); asm volatile("" ::: "memory");
}
constexpr int CV_E1 = 32 * 512, CV_E2 = 32 * 256, CV_UNITS = (CV_E1 + CV_E2) / 64;
struct CvItem { const float* W; bf16* WT; int ldw, k0, sn, dn, f8; };
__device__ __forceinline__ CvItem cv_decode(const Args& A, unsigned char* ws, int r) {
    CvItem c;
    if (r < CV_E1) { const int e = r >> 9, rr = r & 511, kb = rr >> 5, nb = rr & 31, dn = nb * 64; c.sn = ((dn >> 7) & 1) * 1024 + (dn >> 8) * 128 + (dn & 127); c.dn = dn; c.k0 = kb * 64; c.ldw = 2048;
        c.W = A.in[14] + (size_t)e * 1024 * 2048; c.WT = (bf16*)(ws + WS_W1 + (size_t)e * 2048 * 1024); c.f8 = 1 + W1_SHIFT; }
    else { r -= CV_E1; const int e = r >> 8, rr = r & 255, kb = rr >> 4, nb = rr & 15; c.sn = nb * 64; c.dn = nb * 64; c.k0 = kb * 64; c.ldw = 1024;
        c.W = A.in[16] + (size_t)e * 1024 * 1024; c.WT = (bf16*)(ws + WS_W2 + (size_t)e * 1024 * 1024); c.f8 = 1 + W1_SHIFT; }
    return c;
}
__device__ __forceinline__ void cv_load(f4u (&v)[16], const CvItem& c, int lane) {
#pragma unroll
    for (int i = 0; i < 16; ++i) v[i] = *(const f4u*)(c.W + (size_t)(c.k0 + 4 * i + (lane >> 4)) * c.ldw + c.sn + (lane & 15) * 4);
}
__device__ __forceinline__ void cv_store(const f4u (&v)[16], const CvItem& c, LAS float* scr, int lane) {
#pragma unroll
    for (int i = 0; i < 16; ++i) { LAS float* d = scr + (4 * i + (lane >> 4)) * 65 + (lane & 15) * 4; d[0] = v[i].x; d[1] = v[i].y; d[2] = v[i].z; d[3] = v[i].w; }
    LDS_WAIT(); asm volatile("" ::: "memory");
    const int cc = lane & 7;
#pragma unroll
    for (int j = 0; j < 8; ++j) { const int n = (lane >> 3) + 8 * j; const LAS float* sp = scr + (8 * cc) * 65 + n;
        v4u o; o.x = pk2(sp[0 * 65], sp[1 * 65]); o.y = pk2(sp[2 * 65], sp[3 * 65]); o.z = pk2(sp[4 * 65], sp[5 * 65]); o.w = pk2(sp[6 * 65], sp[7 * 65]);
        *(GAS v4u*)(c.WT + (size_t)(c.dn + n) * 1024 + c.k0 + 8 * cc) = o; }
    LDS_WAIT(); asm volatile("" ::: "memory");
}
__device__ __forceinline__ void cv_store_f8(const f4u (&v)[16], const CvItem& c, LAS float* scr, int lane) {
    const float sc = (float)(1 << (c.f8 - 1));
#pragma unroll
    for (int i = 0; i < 16; ++i) { LAS float* d = scr + (4 * i + (lane >> 4)) * 65 + (lane & 15) * 4; d[0] = v[i].x * sc; d[1] = v[i].y * sc; d[2] = v[i].z * sc; d[3] = v[i].w * sc; }
    LDS_WAIT(); asm volatile("" ::: "memory");
    const int cc = lane & 7; unsigned char* const WT8 = (unsigned char*)c.WT;
#pragma unroll
    for (int j = 0; j < 8; ++j) { const int n = (lane >> 3) + 8 * j; const LAS float* sp = scr + (8 * cc) * 65 + n;
        v2u o; o.x = pk4_fp8(sp[0 * 65], sp[1 * 65], sp[2 * 65], sp[3 * 65]); o.y = pk4_fp8(sp[4 * 65], sp[5 * 65], sp[6 * 65], sp[7 * 65]);
        *(GAS v2u*)(WT8 + (size_t)(c.dn + n) * 1024 + c.k0 + 8 * cc) = o; }
    LDS_WAIT(); asm volatile("" ::: "memory");
}
__device__ __forceinline__ void conv_unit(Frame& F, const Args& A, int cu) {
    LAS float* scr = (LAS float*)(F.lds + RING_OFF + F.wave * 16640);
    const int r0 = cu * 64 + F.wave * 8;
    f4u va[16], vb[16];
    CvItem ca = cv_decode(A, F.ws, r0), cb; cv_load(va, ca, F.lane);
#pragma unroll 1
    for (int i = 0; i < 8; i += 2) {
        cb = cv_decode(A, F.ws, r0 + i + 1); cv_load(vb, cb, F.lane);
        if (ca.f8) cv_store_f8(va, ca, scr, F.lane); else cv_store(va, ca, scr, F.lane);
        if (i + 2 < 8) { ca = cv_decode(A, F.ws, r0 + i + 2); cv_load(va, ca, F.lane); }
        if (cb.f8) cv_store_f8(vb, cb, scr, F.lane); else cv_store(vb, cb, scr, F.lane);
    }
}
__device__ __forceinline__ void p0_prologue(Frame& F, const Args& A) {
    LAS float* scr = (LAS float*)(F.lds + RING_OFF + F.wave * 16640);
    const int gw = F.vcu * NWAVES + F.wave, NGW = F.G * NWAVES;
    bf16* const WIN = (bf16*)(F.ws + WS_WIN); bf16* const WBF = (bf16*)(F.ws + WS_WBF); bf16* const WBD = (bf16*)(F.ws + WS_WBD); bf16* const WBM = (bf16*)(F.ws + WS_WBM);
    bf16* const WOUT = (bf16*)(F.ws + WS_WOUT); bf16* const WMKV = (bf16*)(F.ws + WS_WMKV);
    constexpr int I_IN = 16 * 88, I_BF = 6 * 16, I_BD = 6 * 16, I_BM = 4 * 16, I_WO = 16 * 16, I_MKV = 16 * 8;
    constexpr int NITEMS = I_IN + I_BF + I_BD + I_BM + I_WO + I_MKV;
    for (int it = gw; it < NITEMS; it += NGW) {
        int r = it;
        if (r < I_IN) { const int kb = r / 88, nb = r % 88, dn = nb * 64; const int sn = dn + (dn >= W_IN_F ? 6 : 0);
            const float sc = (dn < PC_FK || (dn >= PC_DQ && dn < PC_DK) || (dn >= PC_MQ && dn < PC_GT)) ? C2F : 1.0f;
            { CvItem c; c.W = A.in[2]; c.WT = (bf16*)(F.ws + WS_WGF8); c.ldw = W_IN_LD; c.k0 = kb * 64; c.sn = sn; c.dn = dn; c.f8 = 1 + 6;
              f4u v[16]; cv_load(v, c, F.lane);
              if (sc != 1.0f) {
#pragma unroll
                  for (int i = 0; i < 16; ++i) { v[i].x *= sc; v[i].y *= sc; v[i].z *= sc; v[i].w *= sc; } }
              cv_store_f8(v, c, scr, F.lane); }
            continue; } r -= I_IN;
        if (r < I_BF) { const int kb = r >> 4, nb = r & 15; p0_tr_item(A.in[6], 1024, kb * 64, nb * 64, WBF, 384, nb * 64, 1.0f, scr, F.lane); continue; } r -= I_BF;
        if (r < I_BD) { const int kb = r >> 4, nb = r & 15; p0_tr_item(A.in[7], 1024, kb * 64, nb * 64, WBD, 384, nb * 64, 1.0f, scr, F.lane); continue; } r -= I_BD;
        if (r < I_BM) { const int kb = r >> 4, nb = r & 15; p0_tr_item(A.in[8], 1024, kb * 64, nb * 64, WBM, 384, nb * 64, 1.0f, scr, F.lane); continue; } r -= I_BM;
        if (r < I_WO) { const int kb = r >> 4, nb = r & 15; p0_tr_item(A.in[9], 1024, kb * 64, nb * 64, WOUT, 1024, nb * 64, 1.0f, scr, F.lane); continue; } r -= I_WO;
        { const int kb = r >> 3, nb = r & 7; p0_tr_item(A.in[5], 512, kb * 64, nb * 64, WMKV, 1024, nb * 64, 1.0f, scr, F.lane); }
    }
    {
        float wf[4][4][6];
#pragma unroll
        for (int j = 0; j < 4; ++j)
#pragma unroll
            for (int i = 0; i < 4; ++i)
#pragma unroll
                for (int h = 0; h < 6; ++h) wf[j][i][h] = A.in[2][(size_t)(4 * F.lane + i + 256 * j) * W_IN_LD + W_IN_F + h];
        float* const LF2 = (float*)(F.ws + WS_LF2);
        f32x4 vnx[4];
        if (gw < S) { const GAS f32x4* xr0 = (const GAS f32x4*)(A.in[0] + (size_t)gw * DM) + F.lane;
#pragma unroll
            for (int j = 0; j < 4; ++j) vnx[j] = xr0[64 * j]; }
        for (int m = gw; m < S; m += NGW) {
            f32x4 v[4]; float d[6] = {0.f, 0.f, 0.f, 0.f, 0.f, 0.f};
#pragma unroll
            for (int j = 0; j < 4; ++j) v[j] = vnx[j];
            if (m + NGW < S) { const GAS f32x4* xr1 = (const GAS f32x4*)(A.in[0] + (size_t)(m + NGW) * DM) + F.lane;
#pragma unroll
                for (int j = 0; j < 4; ++j) vnx[j] = xr1[64 * j]; }
#pragma unroll
            for (int j = 0; j < 4; ++j)
#pragma unroll
                for (int h = 0; h < 6; ++h) d[h] += v[j].x * wf[j][0][h] + v[j].y * wf[j][1][h] + v[j].z * wf[j][2][h] + v[j].w * wf[j][3][h];
#pragma unroll
            for (int h = 0; h < 6; ++h) d[h] = wave_sum(d[h]);
            { GAS unsigned* o4 = (GAS unsigned*)(F.ws + WS_XF8 + (size_t)m * DM) + F.lane;
#pragma unroll
              for (int j = 0; j < 4; ++j) o4[64 * j] = pk4_fp8(v[j].x, v[j].y, v[j].z, v[j].w); }
            if (F.lane < 6) { const int h = F.lane; float f = h == 0 ? d[0] : h == 1 ? d[1] : h == 2 ? d[2] : h == 3 ? d[3] : h == 4 ? d[4] : d[5];
                f += A.in[3][h]; const float ls = fminf(f, 0.f) - log1pf(expf(-fabsf(f)));
                LF2[(size_t)h * S + m] = ls * LOG2E; }
        }
        bf16* const MEMB = (bf16*)(F.ws + WS_MEMB);
        for (int m = gw; m < MEML; m += NGW) {
            const GAS f32x4* xr = (const GAS f32x4*)(A.in[1] + (size_t)m * DM) + F.lane; GAS unsigned long long* o8 = (GAS unsigned long long*)(MEMB + (size_t)m * DM) + F.lane;
#pragma unroll
            for (int j = 0; j < 4; ++j) { const f32x4 v = xr[64 * j]; o8[64 * j] = (unsigned long long)pk2(v.x, v.y) | ((unsigned long long)pk2(v.z, v.w) << 32); }
        }
    }
    { const int gt = F.vcu * (NWAVES * 64) + F.tid, GT = F.G * NWAVES * 64; const v4u z = {0u, 0u, 0u, 0u};
      for (int i = gt; i < 1024 * 16; i += GT) *(GAS v4u*)((bf16*)(F.ws + WS_WBM) + (size_t)(i >> 4) * 384 + 256 + (i & 15) * 8) = z;
      for (int i = gt; i < S * 16; i += GT) *(GAS v4u*)((bf16*)(F.ws + WS_OMEM) + (size_t)(i >> 4) * 384 + 256 + (i & 15) * 8) = z; }
    {
        float* const TBL = (float*)(F.ws + WS_TBL);
        for (int idx = F.vcu * (NWAVES * 64) + F.tid; idx < 6 * attn_body::TBL_N; idx += F.G * NWAVES * 64) {
            const int hd = idx / attn_body::TBL_N, i = idx - hd * attn_body::TBL_N, rel = i - attn_body::TBL_ZERO, g = hd >> 1, dil = g == 0 ? 1 : (g == 1 ? 4 : 16);
            float val = -INFINITY;
            if (rel >= 0 && rel <= 128) { const int dist = rel * dil; int bucket = dist;
                if (dist >= 16) { const float nf = (float)dist; bucket = 16 + (int)(logf(nf / 16.0f) / 4.852030263919617f * 16.0f); bucket = bucket > 31 ? 31 : bucket; }
                val = A.in[4][bucket * 6 + hd] * LOG2E; }
            TBL[idx] = val;
        }
    }
}

__device__ __forceinline__ void p1_cumsum(Frame& F, int h) {
    const float* src = (const float*)(F.ws + WS_LF2) + (size_t)h * S + F.tid * 32; float* dst = (float*)(F.ws + WS_C2) + (size_t)h * S + F.tid * 32;
    LAS double* part = (LAS double*)(F.lds + RING_OFF);
    f32x4 v[8]; double s = 0.0;
#pragma unroll
    for (int i = 0; i < 8; ++i) { v[i] = *(const f32x4*)(src + 4 * i); s += (double)v[i].x; s += (double)v[i].y; s += (double)v[i].z; s += (double)v[i].w; }
    part[F.tid] = s; __syncthreads();
    double run = 0.0;
    for (int j = 0; j < F.tid; ++j) run += part[j];
#pragma unroll
    for (int i = 0; i < 8; ++i) { f32x4 o; run += (double)v[i].x; o.x = (float)run; run += (double)v[i].y; o.y = (float)run; run += (double)v[i].z; o.z = (float)run; run += (double)v[i].w; o.w = (float)run; *(f32x4*)(dst + 4 * i) = o; }
    __syncthreads();
}

constexpr int P2_NA = 600, P2_NB = 360, P2_NC = 384, P2_ND = 256, P2_UNITS = P2_NA + P2_NB + P2_NC + P2_ND;
__device__ __forceinline__ void p2_attention(Frame& F, const Args& A, char* lds, int li) {
    typedef attn_body::bf16 abf;
    abf* const PB = (abf*)(F.ws + WS_PBUF);
    volatile LAS int* qslot = (volatile LAS int*)(F.lds + MISC_OFF + 64);
    for (;;) {
        if (F.tid == 0) qslot[0] = (int)__hip_atomic_fetch_add(F.ctl + CW_QHEAD + 64 * li, 1u, __ATOMIC_RELAXED, __HIP_MEMORY_SCOPE_AGENT);
        __syncthreads();
        const int pos = __builtin_amdgcn_readfirstlane(qslot[0]);
        __syncthreads();
        if (pos >= P2_UNITS + CV_UNITS) break;
        if (pos % 4 == 3 && pos / 4 < CV_UNITS) { conv_unit(F, A, pos / 4); __syncthreads(); continue; }
        const int idx = pos - (pos / 4 < CV_UNITS ? pos / 4 : CV_UNITS);
        attn_body::AttnArgs a; a.tlo = 0; a.thi = 0; a.band = 0; a.thr = 0.f;
        if (idx < P2_NA + P2_NB) {
            int h, qb, sgm;
            if (idx < P2_NA) { h = idx % 6; const int b = idx / 6; if (b < 49) { sgm = 0; qb = 15 + b; } else if (b < 82) { sgm = 1; qb = 31 + (b - 49); } else if (b < 99) { sgm = 2; qb = 47 + (b - 82); } else { sgm = 3; qb = 63; } }
            else { const int b2 = idx - P2_NA; h = b2 % 6; const int c = b2 / 6; const int L = 60 - 4 * (c >> 2); sgm = c & 3; qb = 16 * sgm + L / 4 - 1; }
            const int ntf = 4 * qb + 4, nseg = (ntf + 63) >> 6;
            const float q2 = __uint_as_float(__hip_atomic_load(F.ctl + CW_NRM + 2 * h, RLX_AGENT)) + __uint_as_float(__hip_atomic_load(F.ctl + CW_NRM + 2 * h + 1, RLX_AGENT)), k2 = __uint_as_float(__hip_atomic_load(F.ctl + CW_NRM + 12 + 2 * h, RLX_AGENT)) + __uint_as_float(__hip_atomic_load(F.ctl + CW_NRM + 13 + 2 * h, RLX_AGENT));
            const float qkmax = 1.02f * sqrtf(q2 * k2);
            a.Q = PB + PC_FQ + h * 64; a.K = PB + PC_FK + h * 64; a.V = PB + PC_FV + h * 64; a.qp = NPROJ; a.kp = NPROJ; a.op = 384;
            a.q0 = qb * 256; a.NT = 0; a.kv0 = 0; a.aux = (const float*)(F.ws + WS_C2) + (size_t)h * S;
            a.tlo = 64 * sgm; a.thi = (a.tlo + 64 < ntf) ? a.tlo + 64 : ntf; a.band = (sgm == nseg - 1) ? 1 : 0;
            a.thr = 160.0f + 2.0f * qkmax;
            if (nseg == 1) { a.O = (abf*)(F.ws + WS_OFOX) + h * 64; a.lse = nullptr; a.lse_stride = 0; }
            else { a.O = (abf*)(F.ws + WS_OPART) + (size_t)sgm * S * 384 + h * 64; a.lse = (float*)(F.ws + WS_LSEF) + (size_t)sgm * S * 6 + h; a.lse_stride = 6; }
            attn_body::attn_unit<0, 8>(a, lds);
        } else if (idx < P2_NA + P2_NB + P2_NC) { const int du = idx - (P2_NA + P2_NB); const int g = du >> 7, hs = (du >> 6) & 1, w = du & 63; const int dl = g == 0 ? 1 : (g == 1 ? 4 : 16); const int r = w % dl, qb = w / dl, hd = g * 2 + hs;
            const int t0 = 4 * qb - 2 > 0 ? 4 * qb - 2 : 0; const long pitch = (long)dl * NPROJ;
            a.Q = PB + PC_DQ + hd * 64 + (long)r * NPROJ; a.K = PB + PC_DK + hd * 64 + (long)r * NPROJ + (long)t0 * 64 * pitch; a.V = PB + PC_DV + hd * 64 + (long)r * NPROJ + (long)t0 * 64 * pitch;
            a.O = (abf*)(F.ws + WS_ODIL) + hd * 64 + (long)r * 384; a.qp = pitch; a.kp = pitch; a.op = (long)dl * 384;
            a.q0 = qb * 256; a.NT = 4 * qb + 4 - t0; a.kv0 = t0 * 64; a.aux = (const float*)(F.ws + WS_TBL) + hd * attn_body::TBL_N; a.lse = (float*)(F.ws + WS_LSE) + r * 6 + hd; a.lse_stride = (long)dl * 6;
            attn_body::attn_unit<1, 8>(a, lds);
        } else { const int mu = idx - (P2_NA + P2_NB + P2_NC); const int h = mu >> 6, qb = mu & 63; abf* const MKV = (abf*)(F.ws + WS_MEMKV);
            a.Q = PB + PC_MQ + h * 64; a.K = MKV + h * 64; a.V = MKV + 256 + h * 64; a.O = (abf*)(F.ws + WS_OMEM) + h * 64; a.qp = NPROJ; a.kp = 512; a.op = 384;
            a.q0 = qb * 256; a.NT = 4; a.kv0 = 0; a.aux = nullptr; a.lse = nullptr; a.lse_stride = 0;
            attn_body::attn_unit<2, 8>(a, lds);
        }
    }
}
__device__ __forceinline__ void p3_fox_combine(Frame& F) {
    const float* LSEF = (const float*)(F.ws + WS_LSEF); const bf16* OP = (const bf16*)(F.ws + WS_OPART); bf16* const OF = (bf16*)(F.ws + WS_OFOX);
    for (int it = blockIdx.x * (NWAVES * 64) + F.tid; it < (S - 4096) * 48; it += F.G * NWAVES * 64) {
        const int tok = 4096 + it / 48, rem = it % 48, h = rem >> 3, ch = rem & 7, nseg = (tok >> 12) + 1;
        float l[4]; float mx = -INFINITY;
#pragma unroll
        for (int sg = 0; sg < 4; ++sg) { l[sg] = (sg < nseg) ? LSEF[((size_t)sg * S + tok) * 6 + h] : -INFINITY; mx = fmaxf(mx, l[sg]); }
        float acc[8] = {0.f, 0.f, 0.f, 0.f, 0.f, 0.f, 0.f, 0.f}; float den = 0.f;
#pragma unroll
        for (int sg = 0; sg < 4; ++sg) { const float w = __builtin_amdgcn_exp2f(l[sg] - mx);
            if (w > 0.f) { const v4u x = *(const v4u*)(OP + ((size_t)sg * S + tok) * 384 + h * 64 + ch * 8); den += w;
                acc[0] += w * __uint_as_float(x.x << 16); acc[1] += w * __uint_as_float(x.x & 0xffff0000u); acc[2] += w * __uint_as_float(x.y << 16); acc[3] += w * __uint_as_float(x.y & 0xffff0000u);
                acc[4] += w * __uint_as_float(x.z << 16); acc[5] += w * __uint_as_float(x.z & 0xffff0000u); acc[6] += w * __uint_as_float(x.w << 16); acc[7] += w * __uint_as_float(x.w & 0xffff0000u); } }
        const float inv = 1.0f / den; v4u o; o.x = pk2(acc[0] * inv, acc[1] * inv); o.y = pk2(acc[2] * inv, acc[3] * inv); o.z = pk2(acc[4] * inv, acc[5] * inv); o.w = pk2(acc[6] * inv, acc[7] * inv);
        *(v4u*)(OF + (size_t)tok * 384 + h * 64 + ch * 8) = o;
    }
}
__device__ __forceinline__ void p3_dil_weights(Frame& F) {
    const float* LSE = (const float*)(F.ws + WS_LSE); bf16* const OD = (bf16*)(F.ws + WS_ODIL);
    for (int it = blockIdx.x * (NWAVES * 64) + F.tid; it < S * 48; it += F.G * NWAVES * 64) {
        const int tok = it / 48, rem = it - tok * 48, hd = rem >> 3, ch = rem & 7, hs = hd & 1, g = hd >> 1;
        const float l0 = LSE[tok * 6 + hs], l1 = LSE[tok * 6 + 2 + hs], l2 = LSE[tok * 6 + 4 + hs];
        const float mx = fmaxf(l0, fmaxf(l1, l2)); const float e0 = __builtin_amdgcn_exp2f(l0 - mx), e1 = __builtin_amdgcn_exp2f(l1 - mx), e2 = __builtin_amdgcn_exp2f(l2 - mx);
        const float w = (g == 0 ? e0 : (g == 1 ? e1 : e2)) / (e0 + e1 + e2);
        v4u* p = (v4u*)(OD + (size_t)tok * 384 + hd * 64 + ch * 8); v4u x = *p;
        x.x = pk2(__uint_as_float(x.x << 16) * w, __uint_as_float(x.x & 0xffff0000u) * w); x.y = pk2(__uint_as_float(x.y << 16) * w, __uint_as_float(x.y & 0xffff0000u) * w);
        x.z = pk2(__uint_as_float(x.z << 16) * w, __uint_as_float(x.z & 0xffff0000u) * w); x.w = pk2(__uint_as_float(x.w << 16) * w, __uint_as_float(x.w & 0xffff0000u) * w);
        *p = x;
    }
}
typedef float f32x16m __attribute__((ext_vector_type(16)));
__device__ __forceinline__ void p6_ln_router(Frame& F, const Args& A) {
    LAS float* hl = (LAS float*)(F.lds + RING_OFF);
    LAS float* part = hl;
    LAS float* lgt = (LAS float*)(F.lds + RING_OFF + 32768);
    LAS int* se = (LAS int*)(F.lds + RING_OFF + 131328);
    const float* R1 = (const float*)(F.ws + WS_R1); bf16* const H1B = (bf16*)(F.ws + WS_H1B); unsigned char* const H1F8 = F.ws + WS_H1F8;
    int* const TOPI = (int*)(F.ws + WS_TOPI); float* const TOPG = (float*)(F.ws + WS_TOPG); int* const RANK = (int*)(F.ws + WS_RANK); int* const BLKCNT = (int*)(F.ws + WS_BLKCNT);
    const float* lg1 = A.in[10]; const float* lb1 = A.in[11]; const float* wr = A.in[12]; const float* br = A.in[13];
    float wreg[64];
    { const float* bp = wr + (size_t)(128 * F.wave + (F.lane >> 5)) * 32 + (F.lane & 31);
#pragma unroll
      for (int st = 0; st < 64; ++st) wreg[st] = bp[64 * st]; }
    for (int rb = blockIdx.x; rb < S / 64; rb += F.G) {
        for (int half = 0; half < 2; ++half) {
            f32x4 vr[4][4];
#pragma unroll
            for (int j = 0; j < 4; ++j)
#pragma unroll
                for (int q = 0; q < 4; ++q) vr[j][q] = *((const f32x4*)(R1 + ((size_t)rb * 64 + half * 32 + F.wave * 4 + j) * DM) + F.lane + 64 * q);
#pragma unroll
            for (int j = 0; j < 4; ++j) {
                const int lr = F.wave * 4 + j; const size_t row = (size_t)rb * 64 + half * 32 + lr;
                f32x4 v[4]; float s = 0.f;
#pragma unroll
                for (int q = 0; q < 4; ++q) { v[q] = vr[j][q]; s += (v[q].x + v[q].y) + (v[q].z + v[q].w); }
                const float mean = wave_sum(s) * (1.f / DM); float s2 = 0.f;
#pragma unroll
                for (int q = 0; q < 4; ++q) { v[q] = v[q] - mean; s2 += (v[q].x * v[q].x + v[q].y * v[q].y) + (v[q].z * v[q].z + v[q].w * v[q].w); }
                const float rstd = 1.f / sqrtf(wave_sum(s2) * (1.f / DM) + LN_EPS);
#pragma unroll
                for (int q = 0; q < 4; ++q) { const f32x4 gv = *((const f32x4*)lg1 + F.lane + 64 * q), bv = *((const f32x4*)lb1 + F.lane + 64 * q); const f32x4 h = v[q] * rstd * gv + bv;
                    *((v2u*)(H1B + row * DM) + F.lane + 64 * q) = (v2u){pk2(h.x, h.y), pk2(h.z, h.w)};
                    *((unsigned*)(H1F8 + row * DM) + F.lane + 64 * q) = pk4_fp8(h.x, h.y, h.z, h.w);
                    LAS float* d = hl + lr * 1025 + 4 * F.lane + 256 * q; d[0] = h.x; d[1] = h.y; d[2] = h.z; d[3] = h.w; }
            }
            __syncthreads();
            f32x16m acc = {0.f, 0.f, 0.f, 0.f, 0.f, 0.f, 0.f, 0.f, 0.f, 0.f, 0.f, 0.f, 0.f, 0.f, 0.f, 0.f};
            { const int kk = F.lane >> 5; const LAS float* ap = hl + (F.lane & 31) * 1025 + 128 * F.wave + kk;
#pragma unroll
              for (int st = 0; st < 64; ++st) acc = __builtin_amdgcn_mfma_f32_32x32x2f32(ap[2 * st], wreg[st], acc, 0, 0, 0); }
            __syncthreads();
            { const int kk = F.lane >> 5;
#pragma unroll
              for (int r = 0; r < 16; ++r) part[(F.wave * 32 + ((r & 3) + 8 * (r >> 2) + 4 * kk)) * 32 + (F.lane & 31)] = acc[r]; }
            __syncthreads();
#pragma unroll
            for (int q = 0; q < 2; ++q) { const int p = F.tid + 512 * q, i = p >> 5, jx = p & 31; float sm = 0.f;
#pragma unroll
                for (int w = 0; w < 8; ++w) sm += part[(w * 32 + i) * 32 + jx];
                lgt[i * 33 + jx] = sm + br[jx]; }
            __syncthreads();
            if (F.tid < 32) { const int i = F.tid; const size_t row = (size_t)rb * 64 + half * 32 + i; float bv[4]; int bi[4];
                unsigned taken = 0u;
#pragma unroll
                for (int kx = 0; kx < 4; ++kx) { float best = -INFINITY; int be = 0;
                    for (int e = 0; e < 32; ++e) { const float x = lgt[i * 33 + e]; const bool take = (((taken >> e) & 1u) == 0u) && (x > best); best = take ? x : best; be = take ? e : be; }
                    bv[kx] = best; bi[kx] = be; taken |= 1u << be; }
                const float e1 = expf(bv[1] - bv[0]), e2 = expf(bv[2] - bv[0]), e3 = expf(bv[3] - bv[0]); const float inv = 1.f / (1.f + e1 + e2 + e3);
                *(int4*)(TOPI + row * 4) = make_int4(bi[0], bi[1], bi[2], bi[3]); *(f32x4*)(TOPG + row * 4) = (f32x4){inv, e1 * inv, e2 * inv, e3 * inv};
                const int lrow = half * 32 + i; se[lrow * 4 + 0] = bi[0]; se[lrow * 4 + 1] = bi[1]; se[lrow * 4 + 2] = bi[2]; se[lrow * 4 + 3] = bi[3]; }
            __syncthreads();
        }
        if (F.tid < 256) { const int e = se[F.tid]; int rk = 0; for (int q = 0; q < F.tid; ++q) rk += (se[q] == e) ? 1 : 0; RANK[rb * 256 + F.tid] = rk; }
        else if (F.tid < 288) { const int e = F.tid - 256; int c = 0; for (int q = 0; q < 256; ++q) c += (se[q] == e) ? 1 : 0; BLKCNT[rb * 32 + e] = c; }
        __syncthreads();
    }
}
__device__ __forceinline__ void p7_scatter(Frame& F) {
    LAS int* ptot = (LAS int*)(F.lds + RING_OFF); LAS int* ppre = ptot + 512; LAS int* epre = ppre + 512; LAS int* tst = epre + 32; LAS int* dsts = tst + 64;
    const int* BLKCNT = (const int*)(F.ws + WS_BLKCNT); const int* TOPI = (const int*)(F.ws + WS_TOPI); const int* RANK = (const int*)(F.ws + WS_RANK);
    int* const DEST = (int*)(F.ws + WS_DEST); int* const TST = (int*)(F.ws + WS_TST); int* const TOKROW = (int*)(F.ws + WS_TOKROW);
    { int* const IDM = (int*)(F.ws + WS_IDMAP); for (int i = blockIdx.x * (NWAVES * 64) + F.tid; i < MAXROWS; i += F.G * NWAVES * 64) IDM[i] = i; }
    for (int rb = blockIdx.x; rb < S / 64; rb += F.G) {
        { const int part = F.tid >> 5, e = F.tid & 31; int tot = 0, pre = 0;
          for (int b = part * 16; b < part * 16 + 16; ++b) { const int c = BLKCNT[b * 32 + e]; tot += c; pre += (b < rb) ? c : 0; }
          ptot[part * 32 + e] = tot; ppre[part * 32 + e] = pre; }
        __syncthreads();
        if (F.tid < 32) { int T = 0, P = 0; for (int p = 0; p < 16; ++p) { T += ptot[p * 32 + F.tid]; P += ppre[p * 32 + F.tid]; } ptot[F.tid] = T; epre[F.tid] = P; }
        __syncthreads();
        if (F.tid == 0) { int t = 0; for (int e = 0; e < 32; ++e) { tst[e] = t; t += (ptot[e] + 255) >> 8; } tst[32] = t;
            if (rb == 0) { for (int e = 0; e <= 32; ++e) TST[e] = tst[e]; } }
        __syncthreads();
        if (F.tid < 256) { const size_t a = (size_t)rb * 256 + F.tid; const int e = TOPI[a]; const int d = tst[e] * 256 + epre[e] + RANK[a]; DEST[a] = d; TOKROW[d] = (int)(a >> 2); }
        if (rb == 0) { for (int e = 0; e < 32; ++e) { const int c = ptot[e], base = tst[e] * 256, padn = (tst[e + 1] - tst[e]) * 256 - c; for (int p = F.tid; p < padn; p += NWAVES * 64) TOKROW[base + c + p] = 0; } }
        __syncthreads();
    }
}
__device__ __forceinline__ void p10_combine(Frame& F, const Args& A) {
    const int gw = F.vcu * NWAVES + F.wave, NGW = F.G * NWAVES;
    const bf16* H1B = (const bf16*)(F.ws + WS_H1B); const bf16* Y = (const bf16*)(F.ws + WS_Y); const int* DEST = (const int*)(F.ws + WS_DEST); const float* TOPG = (const float*)(F.ws + WS_TOPG);
    const float* g2 = A.in[18]; const float* b2 = A.in[19];
    int4 ddn; f32x4 ggn; v2u hbn[4]; unsigned yn[4][4];
#define P10_LOAD_IDX(m_) do { ddn = *(const int4*)(DEST + (size_t)(m_) * 4); ggn = *(const f32x4*)(TOPG + (size_t)(m_) * 4); } while (0)
#define P10_LOAD_ROWS(m_) do { _Pragma("unroll") for (int j = 0; j < 4; ++j) hbn[j] = *((const v2u*)(H1B + (size_t)(m_) * DM) + F.lane + 64 * j); \
        _Pragma("unroll") for (int k = 0; k < 4; ++k) { const int d_ = k == 0 ? ddn.x : (k == 1 ? ddn.y : (k == 2 ? ddn.z : ddn.w)); \
            _Pragma("unroll") for (int j = 0; j < 4; ++j) yn[k][j] = *((const unsigned*)((const unsigned char*)Y + (size_t)d_ * DM) + F.lane + 64 * j); } } while (0)
    int m = gw; if (m >= S) return;
    P10_LOAD_IDX(m); P10_LOAD_ROWS(m);
    for (; m < S; m += NGW) {
        const f32x4 gg = ggn; f32x4 v[4]; float s = 0.f;
#pragma unroll
        for (int j = 0; j < 4; ++j) v[j] = (f32x4){__uint_as_float(hbn[j].x << 16), __uint_as_float(hbn[j].x & 0xffff0000u), __uint_as_float(hbn[j].y << 16), __uint_as_float(hbn[j].y & 0xffff0000u)} * ALPHA;
#pragma unroll
        for (int k = 0; k < 4; ++k) { const float g = k == 0 ? gg.x : (k == 1 ? gg.y : (k == 2 ? gg.z : gg.w));
#pragma unroll
            for (int j = 0; j < 4; ++j) { const unsigned y = yn[k][j]; typedef float f2_ __attribute__((ext_vector_type(2)));
                const f2_ lo = __builtin_amdgcn_cvt_pk_f32_fp8((int)y, false), hi = __builtin_amdgcn_cvt_pk_f32_fp8((int)y, true);
                v[j].x += g * lo.x; v[j].y += g * lo.y; v[j].z += g * hi.x; v[j].w += g * hi.y; } }
        const int mn = m + NGW;
        if (mn < S) { P10_LOAD_IDX(mn); P10_LOAD_ROWS(mn); }
#pragma unroll
        for (int j = 0; j < 4; ++j) s += (v[j].x + v[j].y) + (v[j].z + v[j].w);
        const float mean = wave_sum(s) * (1.f / DM); float s2 = 0.f;
#pragma unroll
        for (int j = 0; j < 4; ++j) { v[j] = v[j] - mean; s2 += (v[j].x * v[j].x + v[j].y * v[j].y) + (v[j].z * v[j].z + v[j].w * v[j].w); }
        const float rstd = 1.f / sqrtf(wave_sum(s2) * (1.f / DM) + LN_EPS);
#pragma unroll
        for (int j = 0; j < 4; ++j) { const f32x4 gv = *((const f32x4*)g2 + F.lane + 64 * j), bv = *((const f32x4*)b2 + F.lane + 64 * j);
            *((f32x4*)(F.out + (size_t)m * DM) + F.lane + 64 * j) = v[j] * rstd * gv + bv; }
    }
#undef P10_LOAD_IDX
#undef P10_LOAD_ROWS
}

__global__ void __launch_bounds__(NWAVES * 64, 2) mk_fwd(Args args) {
    extern __shared__ __attribute__((aligned(16))) unsigned char lds[];
    Frame F;
    F.lds = (LAS unsigned char*)lds;
    F.MISC = (volatile LAS unsigned*)(F.lds + MISC_OFF);
    F.tid = threadIdx.x; F.lane = F.tid & 63; F.wave = __builtin_amdgcn_readfirstlane(F.tid >> 6);
    F.G = gridDim.x; { const int bx = blockIdx.x; F.vcu = (F.G % 8 == 0) ? (bx % 8) * (F.G / 8) + bx / 8 : bx; }
    F.ws = args.ws; F.out = args.out; F.ctl = (gu32*)(args.ws + WS_CTL);
    unsigned char* const ws = args.ws;
    for (int u = F.tid; u < (LDS_BYTES - LDSCTL_OFF) / 4; u += NWAVES * 64) ((LAS unsigned*)(F.lds + LDSCTL_OFF))[u] = 0u;
    __syncthreads();
    XcdBarrier bar = xcd_barrier_post((unsigned*)(F.ctl + CW_BAR) + args.li * XCD_BAR_WORDS, F.MISC + 8);
#define GRID_BAR() xcd_barrier(bar)
    const int lo = args.ph_lo, hi = args.ph_hi;
#ifndef PHASE_MASK
#define PHASE_MASK 0x7ff
#endif
#define IN(k) (((PHASE_MASK >> (k)) & 1) && lo <= (k) && (k) < hi)
#define BOTH(k) (IN(k) && IN((k) + 1))
    typedef pg8::bf16_t pbf;
    pbf* const PBUF = (pbf*)(ws + WS_PBUF);

    if (IN(0)) { p0_prologue(F, args); if (BOTH(0)) GRID_BAR(); }

    if (IN(1)) {
        { pg8::Gemm g{(const pbf*)(ws + WS_XF8), (const pbf*)(ws + WS_WGF8), S, NPROJ, DM / 2, nullptr, 0x7C7C7C7C, 0x7C7C7C7C}; pg8::StaticOrder So; So.init(S, NPROJ, F.G, (int)blockIdx.x);
          pg8::EpiProj E{PBUF, NPROJ, PC_GT / 256, (unsigned*)(F.ctl + CW_NRM)};
          pg8::gemm_phase<pg8::EpiProj, pg8::StaticOrder, true, true, true, true>(F.lds + RING_OFF, g, So, E); }
        { pg8::Gemm g{(const pbf*)(ws + WS_MEMB), (const pbf*)(ws + WS_WMKV), MEML, 512, DM, nullptr, 0, 0}; pg8::StaticOrder So; So.init(MEML, 512, F.G, (int)((blockIdx.x + F.G / 2) % F.G));
          pg8::EpiBf16Plain E{(pbf*)(ws + WS_MEMKV), 512};
          pg8::gemm_phase<pg8::EpiBf16Plain, pg8::StaticOrder, true, true>(F.lds + RING_OFF, g, So, E); }
        if ((int)blockIdx.x >= F.G - 6) p1_cumsum(F, F.G - 1 - (int)blockIdx.x);
        if (BOTH(1)) GRID_BAR();
    }

    if (IN(2)) { p2_attention(F, args, (char*)lds + RING_OFF, args.li); if (BOTH(2)) GRID_BAR(); }

    if (IN(3)) { p3_fox_combine(F); p3_dil_weights(F); if (BOTH(3)) GRID_BAR(); }

    if (IN(4)) {
        pg8::Gemm g{(const pbf*)(ws + WS_OFOX), (const pbf*)(ws + WS_WBF), S, DM, 384, nullptr, 0, 0, (size_t)S * 384 * 2, (size_t)DM * 384 * 2};
        pg8::MergeOrder So; So.so.init(S, DM, F.G, (int)blockIdx.x);
        pg8::EpiMergeChain E{PBUF + PC_GT, NPROJ, (pbf*)(ws + WS_MERGED), DM};
        pg8::gemm_phase<pg8::EpiMergeChain, pg8::MergeOrder, true, true>(F.lds + RING_OFF, g, So, E);
        if (BOTH(4)) GRID_BAR();
    }

    if (IN(5)) {
        pg8::Gemm g{(const pbf*)(ws + WS_MERGED), (const pbf*)(ws + WS_WOUT), S, DM, DM, nullptr, 0, 0}; pg8::StaticOrder So; So.init(S, DM, F.G, (int)blockIdx.x);
        pg8::EpiRes E{args.in[0], (float*)(ws + WS_R1), DM, ALPHA};
        pg8::gemm_phase<pg8::EpiRes, pg8::StaticOrder, true, true>(F.lds + RING_OFF, g, So, E);
        if (BOTH(5)) GRID_BAR();
    }

    if (IN(6)) { p6_ln_router(F, args); if (BOTH(6)) GRID_BAR(); }

    if (IN(7)) { p7_scatter(F); if (BOTH(7)) GRID_BAR(); }

    if (IN(8)) {
        LAS int* tbl = (LAS int*)(F.lds + TBL_OFF);
        if (F.tid < 33) tbl[F.tid] = ((const int*)(ws + WS_TST))[F.tid];
        __syncthreads();
        pg8::Gemm g{(const pbf*)(ws + WS_H1F8), (const pbf*)(ws + WS_W1), MAXROWS, 2048, DM / 2, (const int*)(ws + WS_TOKROW), 0x7F7F7F7F, 0x7F7F7F7F}; pg8::MoeOrder So{tbl, 8, F.G, F.vcu};
        pg8::EpiSwiglu E{(pbf*)(ws + WS_ACT), args.in[15], 1.0f / (float)(1 << W1_SHIFT), (const LAS float*)(F.lds + RING_OFF + pg8::STAGE_BYTES + 5120)};
        pg8::gemm_phase<pg8::EpiSwiglu, pg8::MoeOrder, true, true, true, true>(F.lds + RING_OFF, g, So, E);
        if (BOTH(8)) GRID_BAR();
    }

    if (IN(9)) {
        LAS int* tbl = (LAS int*)(F.lds + TBL_OFF);
        if (F.tid < 33) tbl[F.tid] = ((const int*)(ws + WS_TST))[F.tid];
        __syncthreads();
        pg8::Gemm g{(const pbf*)(ws + WS_ACT), (const pbf*)(ws + WS_W2), MAXROWS, 1024, DM / 2, nullptr, 0x7F7F7F7F, 0x7F7F7F7F}; pg8::MoeOrder So{tbl, 4, F.G, F.vcu};
        pg8::EpiY E{(pbf*)(ws + WS_Y), args.in[17], 1.0f / (float)(1 << W1_SHIFT), (const LAS float*)(F.lds + RING_OFF + pg8::STAGE_BYTES + 5120)};
        pg8::gemm_phase<pg8::EpiY, pg8::MoeOrder, true, true, true, true>(F.lds + RING_OFF, g, So, E);
        if (BOTH(9)) GRID_BAR();
    }

    if (IN(10)) { p10_combine(F, args); }
#undef IN
#undef BOTH
#undef GRID_BAR
}

extern "C" void kernel_launch(void* const* d_in, const int* in_sizes, int n_in, void* d_out, int out_size, void* d_ws, size_t ws_size, hipStream_t stream) {
    static int grid = 0;
    if (grid == 0) {
        if (n_in != 20 || in_sizes[0] != S * DM || out_size != S * DM || ws_size < WS_END) { fprintf(stderr, "kernel_launch: built for 20 inputs, x/out of %d floats, >= %zu bytes of workspace; got n_in %d, in0 %d, out %d, ws %zu; nothing launched\n", S * DM, (size_t)WS_END, n_in, n_in > 0 ? in_sizes[0] : -1, out_size, ws_size); grid = -1; return; }
        int dev = 0, cus = 0, per_cu = 0;
        if (hipGetDevice(&dev) != hipSuccess || hipDeviceGetAttribute(&cus, hipDeviceAttributeMultiprocessorCount, dev) != hipSuccess) { fprintf(stderr, "kernel_launch: hipGetDevice / hipDeviceGetAttribute failed; nothing launched\n"); grid = -1; return; }
        if (hipFuncSetAttribute((const void*)mk_fwd, hipFuncAttributeMaxDynamicSharedMemorySize, LDS_BYTES) != hipSuccess) { fprintf(stderr, "kernel_launch: hipFuncSetAttribute failed (%d bytes of dynamic LDS); nothing launched\n", LDS_BYTES); grid = -1; return; }
        if (hipOccupancyMaxActiveBlocksPerMultiprocessor(&per_cu, (const void*)mk_fwd, NWAVES * 64, LDS_BYTES) != hipSuccess || per_cu < 1)
            fprintf(stderr, "kernel_launch: note: the occupancy query reports %d workgroups per CU\n", per_cu);
        (void)hipGetLastError();
        grid = cus;
    }
    if (grid < 0) return;
    if (hipMemsetAsync((char*)d_ws + WS_CTL, 0, CTL_ZERO_BYTES, stream) != hipSuccess) { fprintf(stderr, "kernel_launch: hipMemsetAsync of the control words failed; nothing launched\n"); return; }
    Args a{};
    for (int i = 0; i < 20; ++i) a.in[i] = (const float*)d_in[i];
    a.out = (float*)d_out; a.ws = (unsigned char*)d_ws;
#ifdef PROBE_PHASE
    const int nl = (PROBE_PHASE + 1 < NPHASE) ? 3 : 2; const int cut_lo[3] = {0, PROBE_PHASE, PROBE_PHASE + 1}, cut_hi[3] = {PROBE_PHASE + 1, PROBE_PHASE + 1, NPHASE};
#else
    const int nl = N_LAUNCHES; int cut_lo[NPHASE], cut_hi[NPHASE]; for (int i = 0; i < NPHASE; ++i) { cut_lo[i] = (N_LAUNCHES == 1) ? 0 : i; cut_hi[i] = (N_LAUNCHES == 1) ? NPHASE : i + 1; }
#endif
    for (int li = 0; li < nl; ++li) {
        a.ph_lo = cut_lo[li]; a.ph_hi = cut_hi[li]; a.li = li;
        hipLaunchKernelGGL(mk_fwd, dim3(grid), dim3(NWAVES * 64), LDS_BYTES, stream, a);
        const hipError_t le = hipPeekAtLastError();
        if (le != hipSuccess) { fprintf(stderr, "kernel_launch: launch %d failed: %s\n", li, hipGetErrorName(le)); break; }
    }
}
```

```cpp
#include <hip/hip_runtime.h>
#include <hip/hip_bf16.h>
#include <cstdio>
#include <cstdint>
#include <cmath>
namespace pg8 {
#define PG8_LAS __attribute__((address_space(3)))
typedef unsigned short bf16_t;
typedef short bf16x8 __attribute__((ext_vector_type(8)));
typedef float f32x4 __attribute__((ext_vector_type(4)));
typedef unsigned u32x4 __attribute__((ext_vector_type(4)));
constexpr int BM = 256, BK = 64, HALF = 128, HTB = HALF * BK * 2  , STAGE_BYTES = 8 * HTB, NXCD = 8, WGM = 8;

__host__ __device__ __forceinline__ int lds_byte(int r, int c) { const int st = (r >> 4) * 2 + (c >> 5), rr = r & 15, cc = c & 31, ob = rr * 64 + cc * 2; return st * 1024 + (ob ^ (((ob >> 9) & 1) << 5)); }
__host__ __device__ __forceinline__ void stage_rc(int b, int& R, int& C) { const int st = b / 1024, sb = b % 1024, swz = sb ^ (((sb >> 9) & 1) << 5); R = (st >> 1) * 16 + swz / 64; C = (st & 1) * 32 + (swz % 64) / 2; }
__host__ __device__ __forceinline__ int perm32(int rho) { const int n = rho >> 4, i = rho & 15; return 8 * (i >> 2) + 4 * n + (i & 3); }

struct Unit { int pm, pn, e, slot, b; };
typedef int v8i_t_half __attribute__((ext_vector_type(4)));
typedef int v8i_t __attribute__((ext_vector_type(8)));
typedef short s16x16_t __attribute__((ext_vector_type(16)));
struct Gemm { const bf16_t* A; const bf16_t* Bt; int M, N, K; const int* rowmap; int scale_a, scale_b; size_t strideA = 0, strideB = 0; };

struct StaticOrder {
    int nM, nN, nwg, G, c;
    __host__ __device__ void init(int M, int N, int G_, int c_) { nM = M / BM; nN = N / BM; nwg = nM * nN; G = G_; c = c_; }
    __host__ __device__ bool next(int i, Unit& u) const {
        const long L = (long)i * G + c; if (L >= nwg) return false;
        int wgid = (int)L; { const int q = nwg / NXCD, r = nwg % NXCD, xcd = wgid % NXCD, off = wgid / NXCD; wgid = (xcd < r ? xcd * (q + 1) : r * (q + 1) + (xcd - r) * q) + off; }
        const int nig = WGM * nN, gid = wgid / nig, fm = gid * WGM, gsz = (nM - fm) < WGM ? (nM - fm) : WGM;
        u.pm = fm + ((wgid % nig) % gsz); u.pn = (wgid % nig) / gsz; u.e = 0; u.b = 0; return true;
    }
    __device__ __forceinline__ void a_ready(const Unit&) const {}
    __device__ __forceinline__ void done(const Unit&) const {}
};

__device__ __forceinline__ unsigned cvt_pk_bf16(float lo, float hi) { unsigned r; asm volatile("v_cvt_pk_bf16_f32 %0, %1, %2" : "=v"(r) : "v"(lo), "v"(hi)); return r; }
__device__ __forceinline__ float bf_lo(unsigned w) { return __uint_as_float(w << 16); }
__device__ __forceinline__ float bf_hi(unsigned w) { return __uint_as_float(w & 0xffff0000u); }
__device__ __forceinline__ float sigmoid_f(float v) { return __builtin_amdgcn_rcpf(1.0f + __builtin_amdgcn_exp2f(-1.4426950408889634f * v)); }
typedef unsigned u32x2 __attribute__((ext_vector_type(2)));

struct EpiBf16Plain {
    static constexpr bool PERM = true, AFTER_DRAIN = false; static constexpr bool CHAIN = false; static constexpr bool LDS_BIAS = false;
    bf16_t* O; int ldc;
    __device__ __forceinline__ void operator()(const f32x4 (&acc)[2][2][4][2], const Unit& u, int wr, int wc, int fr, int fq) const {
        const int row0 = u.pm * BM + wr * 64 + fr, col0 = u.pn * BM + wc * 32 + 8 * fq;
#pragma unroll
        for (int ai = 0; ai < 2; ++ai)
#pragma unroll
            for (int m = 0; m < 4; ++m) { bf16_t* rowp = O + (size_t)(row0 + ai * HALF + m * 16) * ldc + col0;
#pragma unroll
                for (int bj = 0; bj < 2; ++bj) { const f32x4 v0 = acc[ai][bj][m][0], v1 = acc[ai][bj][m][1];
                    u32x4 w; w.x = cvt_pk_bf16(v0[0], v0[1]); w.y = cvt_pk_bf16(v0[2], v0[3]); w.z = cvt_pk_bf16(v1[0], v1[1]); w.w = cvt_pk_bf16(v1[2], v1[3]);
                    *(u32x4*)(rowp + bj * HALF) = w; } }
    }
};
struct EpiProj {
    static constexpr bool PERM = true, AFTER_DRAIN = false; static constexpr bool CHAIN = false; static constexpr bool LDS_BIAS = false;
    bf16_t* O; int ldc; int sig_from; unsigned* nrm;
    __device__ __forceinline__ void operator()(const f32x4 (&acc)[2][2][4][2], const Unit& u, int wr, int wc, int fr, int fq) const {
        const int row0 = u.pm * BM + wr * 64 + fr, col0 = u.pn * BM + wc * 32 + 8 * fq; const bool sg = u.pn >= sig_from;
        if (u.pn < 3) {
#pragma unroll
            for (int bj = 0; bj < 2; ++bj) { float mx = 0.f;
#pragma unroll
                for (int ai = 0; ai < 2; ++ai)
#pragma unroll
                    for (int m = 0; m < 4; ++m) { const f32x4 a0 = acc[ai][bj][m][0], a1 = acc[ai][bj][m][1];
                        float ss = (a0[0] * a0[0] + a0[1] * a0[1]) + (a0[2] * a0[2] + a0[3] * a0[3]) + (a1[0] * a1[0] + a1[1] * a1[1]) + (a1[2] * a1[2] + a1[3] * a1[3]);
                        ss += __shfl_xor(ss, 16); ss += __shfl_xor(ss, 32); mx = fmaxf(mx, ss); }
                mx = fmaxf(mx, __shfl_xor(mx, 1)); mx = fmaxf(mx, __shfl_xor(mx, 2)); mx = fmaxf(mx, __shfl_xor(mx, 4)); mx = fmaxf(mx, __shfl_xor(mx, 8));
                if (fr == 0 && fq == 0) atomicMax(nrm + u.pn * 8 + bj * 4 + wc, __float_as_uint(mx)); }
        }
#pragma unroll
        for (int ai = 0; ai < 2; ++ai)
#pragma unroll
            for (int m = 0; m < 4; ++m) { bf16_t* rowp = O + (size_t)(row0 + ai * HALF + m * 16) * ldc + col0;
#pragma unroll
                for (int bj = 0; bj < 2; ++bj) { f32x4 v0 = acc[ai][bj][m][0], v1 = acc[ai][bj][m][1];
                    if (sg) {
#pragma unroll
                        for (int j = 0; j < 4; ++j) { v0[j] = sigmoid_f(v0[j]); v1[j] = sigmoid_f(v1[j]); } }
                    u32x4 w; w.x = cvt_pk_bf16(v0[0], v0[1]); w.y = cvt_pk_bf16(v0[2], v0[3]); w.z = cvt_pk_bf16(v1[0], v1[1]); w.w = cvt_pk_bf16(v1[2], v1[3]);
                    *(u32x4*)(rowp + bj * HALF) = w; } }
    }
};
struct EpiGate {
    static constexpr bool PERM = true, AFTER_DRAIN = false; static constexpr bool CHAIN = false; static constexpr bool LDS_BIAS = false;
    bf16_t* O; int ldc; int col_off; float ascale;
    __device__ __forceinline__ void operator()(const f32x4 (&acc)[2][2][4][2], const Unit& u, int wr, int wc, int fr, int fq) const {
        const int row0 = u.pm * BM + wr * 64 + fr, col0 = col_off + u.pn * BM + wc * 32 + 8 * fq;
#pragma unroll
        for (int ai = 0; ai < 2; ++ai)
#pragma unroll
            for (int m = 0; m < 4; ++m) { bf16_t* rowp = O + (size_t)(row0 + ai * HALF + m * 16) * ldc + col0;
#pragma unroll
                for (int bj = 0; bj < 2; ++bj) { f32x4 v0 = acc[ai][bj][m][0] * ascale, v1 = acc[ai][bj][m][1] * ascale;
#pragma unroll
                    for (int j = 0; j < 4; ++j) { v0[j] = sigmoid_f(v0[j]); v1[j] = sigmoid_f(v1[j]); }
                    u32x4 w; w.x = cvt_pk_bf16(v0[0], v0[1]); w.y = cvt_pk_bf16(v0[2], v0[3]); w.z = cvt_pk_bf16(v1[0], v1[1]); w.w = cvt_pk_bf16(v1[2], v1[3]);
                    *(u32x4*)(rowp + bj * HALF) = w; } }
    }
};
template <int PASS> struct EpiMerge {
    static constexpr bool PERM = false, AFTER_DRAIN = false; static constexpr bool CHAIN = false; static constexpr bool LDS_BIAS = false;
    const bf16_t* gate; int ldg; bf16_t* stash; bf16_t* outb; int ldc;
    __device__ __forceinline__ void operator()(const f32x4 (&acc)[2][2][4][2], const Unit& u, int wr, int wc, int fr, int fq) const {
        const int row0 = u.pm * BM + wr * 64 + fr, col0 = u.pn * BM + wc * 32 + 4 * fq;
#pragma unroll
        for (int ai = 0; ai < 2; ++ai)
#pragma unroll
            for (int m = 0; m < 4; ++m) { const size_t r = (size_t)(row0 + ai * HALF + m * 16);
#pragma unroll
                for (int bj = 0; bj < 2; ++bj)
#pragma unroll
                    for (int n = 0; n < 2; ++n) { const int c = col0 + bj * HALF + n * 16;
                        const u32x2 gv = *(const u32x2*)(gate + r * ldg + c);
                        f32x4 v = acc[ai][bj][m][n]; v[0] *= bf_lo(gv.x); v[1] *= bf_hi(gv.x); v[2] *= bf_lo(gv.y); v[3] *= bf_hi(gv.y);
                        if (PASS > 0) { const u32x2 sv = *(const u32x2*)(stash + r * ldc + c); v[0] += bf_lo(sv.x); v[1] += bf_hi(sv.x); v[2] += bf_lo(sv.y); v[3] += bf_hi(sv.y); }
                        u32x2 w; w.x = cvt_pk_bf16(v[0], v[1]); w.y = cvt_pk_bf16(v[2], v[3]);
                        if (PASS < 2) *(u32x2*)(stash + r * ldc + c) = w; else *(u32x2*)(outb + r * ldc + c) = w; }
                asm volatile("" ::: "memory"); }
    }
};
struct EpiRes {
    static constexpr bool PERM = false, AFTER_DRAIN = false; static constexpr bool CHAIN = false; static constexpr bool LDS_BIAS = false;
    const float* x; float* out; int ldc; float alpha;
    __device__ __forceinline__ void operator()(const f32x4 (&acc)[2][2][4][2], const Unit& u, int wr, int wc, int fr, int fq) const {
        const int row0 = u.pm * BM + wr * 64 + fr, col0 = u.pn * BM + wc * 32 + 4 * fq;
#pragma unroll
        for (int ai = 0; ai < 2; ++ai)
#pragma unroll
            for (int m = 0; m < 4; ++m) { const size_t off = (size_t)(row0 + ai * HALF + m * 16) * ldc + col0;
#pragma unroll
                for (int bj = 0; bj < 2; ++bj)
#pragma unroll
                    for (int n = 0; n < 2; ++n) { const f32x4 xv = *(const f32x4*)(x + off + bj * HALF + n * 16); *(f32x4*)(out + off + bj * HALF + n * 16) = xv * alpha + acc[ai][bj][m][n]; } }
    }
};
struct EpiMergeChain {
    static constexpr bool PERM = true, AFTER_DRAIN = false; static constexpr bool LDS_BIAS = false; static constexpr bool CHAIN = true;
    const bf16_t* gate; int ldg; bf16_t* outb; int ldc;
    __device__ __forceinline__ void operator()(f32x4 (&acc)[2][2][4][2], const Unit& u, int wr, int wc, int fr, int fq) const {
        const int row0 = u.pm * BM + wr * 64 + fr, col0 = u.pn * BM + wc * 32 + 8 * fq; const int b = u.b;
#pragma unroll
        for (int ai = 0; ai < 2; ++ai)
#pragma unroll
            for (int m = 0; m < 4; ++m) { const size_t r = (size_t)(row0 + ai * HALF + m * 16);
#pragma unroll
                for (int bj = 0; bj < 2; ++bj) { const int c = col0 + bj * HALF;
                    const u32x4 gv = *(const u32x4*)(gate + r * ldg + b * 1024 + c);
                    f32x4 g0, g1; g0[0] = bf_lo(gv.x); g0[1] = bf_hi(gv.x); g0[2] = bf_lo(gv.y); g0[3] = bf_hi(gv.y); g1[0] = bf_lo(gv.z); g1[1] = bf_hi(gv.z); g1[2] = bf_lo(gv.w); g1[3] = bf_hi(gv.w);
                    if (b > 0) {
#pragma unroll
                        for (int j = 0; j < 4; ++j) { g0[j] = fmaxf(g0[j], 1e-6f); g1[j] = fmaxf(g1[j], 1e-6f); } }
                    f32x4 v0 = acc[ai][bj][m][0] * g0, v1 = acc[ai][bj][m][1] * g1;
                    if (b < 2) { const u32x4 gn = *(const u32x4*)(gate + r * ldg + (b + 1) * 1024 + c);
                        v0[0] *= __builtin_amdgcn_rcpf(fmaxf(bf_lo(gn.x), 1e-6f)); v0[1] *= __builtin_amdgcn_rcpf(fmaxf(bf_hi(gn.x), 1e-6f)); v0[2] *= __builtin_amdgcn_rcpf(fmaxf(bf_lo(gn.y), 1e-6f)); v0[3] *= __builtin_amdgcn_rcpf(fmaxf(bf_hi(gn.y), 1e-6f));
                        v1[0] *= __builtin_amdgcn_rcpf(fmaxf(bf_lo(gn.z), 1e-6f)); v1[1] *= __builtin_amdgcn_rcpf(fmaxf(bf_hi(gn.z), 1e-6f)); v1[2] *= __builtin_amdgcn_rcpf(fmaxf(bf_lo(gn.w), 1e-6f)); v1[3] *= __builtin_amdgcn_rcpf(fmaxf(bf_hi(gn.w), 1e-6f));
                        acc[ai][bj][m][0] = v0; acc[ai][bj][m][1] = v1; }
                    else { u32x4 w; w.x = cvt_pk_bf16(v0[0], v0[1]); w.y = cvt_pk_bf16(v0[2], v0[3]); w.z = cvt_pk_bf16(v1[0], v1[1]); w.w = cvt_pk_bf16(v1[2], v1[3]); *(u32x4*)(outb + r * ldc + c) = w; } }
                asm volatile("" ::: "memory"); }
    }
};
struct MergeOrder {
    StaticOrder so;
    __device__ __forceinline__ bool next(int i, Unit& u) const { if (!so.next(i / 3, u)) return false; u.b = i % 3; return true; }
    __device__ __forceinline__ void a_ready(const Unit&) const {}
    __device__ __forceinline__ void done(const Unit&) const {}
};
struct EpiSwiglu {
    static constexpr bool PERM = true, AFTER_DRAIN = false; static constexpr bool CHAIN = false;
    bf16_t* O; const float* b1; float ascale; const PG8_LAS float* lb;
    static constexpr bool LDS_BIAS = true;
    __device__ __forceinline__ const float* bias_src(const Unit& u, int lane) const { const int e = u.e, pnl = u.pn - e * 8; return b1 + (size_t)e * 2048 + (lane >> 5) * 1024 + pnl * 128 + (lane & 31) * 4; }
    __device__ __forceinline__ void operator()(const f32x4 (&acc)[2][2][4][2], const Unit& u, int wr, int wc, int fr, int fq) const {
        const int e = u.e, pnl = u.pn - e * 8; const int row0 = u.pm * BM + wr * 64 + fr;
        f32x4 bg[2], bl[2]; const PG8_LAS float* lbs = lb + u.slot * 256 + wc * 32 + 8 * fq;
#pragma unroll
        for (int n = 0; n < 2; ++n) { bg[n] = *(const PG8_LAS f32x4*)(lbs + 4 * n); bl[n] = *(const PG8_LAS f32x4*)(lbs + 128 + 4 * n); }
        unsigned char* const lanep = (unsigned char*)O + (size_t)(row0 + (fq & 1) * 16) * 1024 + pnl * 128 + wc * 32 + 8 * (fq & 2);
#pragma unroll
        for (int ai = 0; ai < 2; ++ai)
#pragma unroll
            for (int p = 0; p < 2; ++p) { u32x2 w[2];
#pragma unroll
                for (int q = 0; q < 2; ++q) { const int m = 2 * p + q; f32x4 o[2];
#pragma unroll
                    for (int n = 0; n < 2; ++n) { const f32x4 g = acc[ai][0][m][n] * ascale + bg[n], l = acc[ai][1][m][n] * ascale + bl[n];
#pragma unroll
                        for (int j = 0; j < 4; ++j) { const float gg = fminf(g[j], 7.0f), ll = fminf(fmaxf(l[j], -7.0f), 7.0f);
                            o[n][j] = gg * __builtin_amdgcn_rcpf(1.0f + __builtin_amdgcn_exp2f(-1.702f * 1.4426950408889634f * gg)) * (ll + 1.0f); } }
                    int t0 = __builtin_amdgcn_cvt_pk_fp8_f32(o[0][0], o[0][1], 0, false); t0 = __builtin_amdgcn_cvt_pk_fp8_f32(o[0][2], o[0][3], t0, true);
                    int t1 = __builtin_amdgcn_cvt_pk_fp8_f32(o[1][0], o[1][1], 0, false); t1 = __builtin_amdgcn_cvt_pk_fp8_f32(o[1][2], o[1][3], t1, true); w[q].x = (unsigned)t0; w[q].y = (unsigned)t1; }
                const auto r0 = __builtin_amdgcn_permlane16_swap(w[0].x, w[1].x, false, false), r1 = __builtin_amdgcn_permlane16_swap(w[0].y, w[1].y, false, false);
                u32x4 out; out.x = r0[0]; out.y = r1[0]; out.z = r0[1]; out.w = r1[1];
                *(u32x4*)(lanep + (size_t)(ai * HALF + p * 32) * 1024) = out; }
    }
};
struct EpiY {
    static constexpr bool PERM = true, PERM16 = true, AFTER_DRAIN = false; static constexpr bool CHAIN = false;
    bf16_t* O; const float* b2; float ascale; const PG8_LAS float* lb;
    static constexpr bool LDS_BIAS = true;
    __device__ __forceinline__ const float* bias_src(const Unit& u, int lane) const { const int e = u.e, pnl = u.pn - e * 4; return b2 + (size_t)e * 1024 + pnl * BM + lane * 4; }
    __device__ __forceinline__ void operator()(const f32x4 (&acc)[2][2][4][2], const Unit& u, int wr, int wc, int fr, int fq) const {
        const int e = u.e, pnl = u.pn - e * 4; const int row0 = u.pm * BM + wr * 64 + fr, col0 = pnl * BM + wc * 64 + 16 * fq;
        f32x4 bv[2][2]; const PG8_LAS float* lbs = lb + u.slot * 256 + wc * 64 + 16 * fq;
#pragma unroll
        for (int bj = 0; bj < 2; ++bj)
#pragma unroll
            for (int n = 0; n < 2; ++n) bv[bj][n] = *(const PG8_LAS f32x4*)(lbs + 8 * bj + 4 * n);
#pragma unroll
        for (int ai = 0; ai < 2; ++ai)
#pragma unroll
            for (int m = 0; m < 4; ++m) { unsigned char* rowp = (unsigned char*)O + (size_t)(row0 + ai * HALF + m * 16) * 1024 + col0;
                u32x4 w;
#pragma unroll
                for (int bj = 0; bj < 2; ++bj) { const f32x4 v0 = acc[ai][bj][m][0] * ascale + bv[bj][0], v1 = acc[ai][bj][m][1] * ascale + bv[bj][1];
                    int t0 = __builtin_amdgcn_cvt_pk_fp8_f32(v0[0], v0[1], 0, false); t0 = __builtin_amdgcn_cvt_pk_fp8_f32(v0[2], v0[3], t0, true);
                    int t1 = __builtin_amdgcn_cvt_pk_fp8_f32(v1[0], v1[1], 0, false); t1 = __builtin_amdgcn_cvt_pk_fp8_f32(v1[2], v1[3], t1, true);
                    if (bj == 0) { w.x = (unsigned)t0; w.y = (unsigned)t1; } else { w.z = (unsigned)t0; w.w = (unsigned)t1; } }
                *(u32x4*)rowp = w; }
    }
};
struct MoeOrder {
    const PG8_LAS int* tstart; int nN, G, vcu;
    __device__ __forceinline__ int ts(int k) const { return __builtin_amdgcn_readfirstlane(tstart[k]); }
    __device__ __forceinline__ bool next(int i, Unit& u) const {
        const int L = i * G + vcu; const int T = ts(32); if (L >= T * nN) return false;
        int e = 0;
#pragma unroll
        for (int k = 1; k < 32; ++k) e += (L >= ts(k) * nN) ? 1 : 0;
        const int t0 = ts(e), R = ts(e + 1) - t0; const int rem = L - t0 * nN; const int ng = rem / (4 * R); const int r2 = rem - ng * 4 * R; const int pnl = r2 / R; const int pmi = r2 - pnl * R;
        u.pm = t0 + pmi; u.pn = e * nN + ng * 4 + pnl; u.e = e; u.b = 0; return true;
    }
    __device__ __forceinline__ void a_ready(const Unit&) const {}
    __device__ __forceinline__ void done(const Unit&) const {}
};
template <class E, class = void> struct has_p16 { static constexpr bool v = false; };
template <class E> struct has_p16<E, decltype((void)E::PERM16)> { static constexpr bool v = E::PERM16; };
template <class Epi, class Sched, bool ALIGN_EPI = false, bool SP2 = false, bool GATHER = false, bool FP8 = false>
__device__ __forceinline__ void gemm_phase(PG8_LAS unsigned char* lds, const Gemm g, const Sched& S, const Epi& E) {
    static_assert(!GATHER || SP2, "GATHER is wired into the SP2 loop only");
    int tid_ = threadIdx.x; asm volatile("" : "+v"(tid_));
    const int tid = tid_, wid = __builtin_amdgcn_readfirstlane(tid >> 6), lane = tid & 63, wr = wid >> 2, wc = wid & 3, fr = lane & 15, fq = lane >> 4;
    int K_ = g.K; asm volatile("" : "+s"(K_));
    const int K = K_, nt = K / BK;
    constexpr bool P16 = has_p16<Epi>::v;
    unsigned voffA[2], voffB[2];
#pragma unroll
    for (int i = 0; i < 2; ++i) { int R, C; stage_rc(tid * 16 + i * 8192, R, C); const int Rb = P16 ? ((R >> 5) * 64 + 16 * ((R & 15) >> 2) + 4 * ((R >> 4) & 1) + (R & 3)) : Epi::PERM ? ((R & ~31) + perm32(R & 31)) : R;
        voffA[i] = (unsigned)(R * K + C) * 2u; voffB[i] = (unsigned)(Rb * K + C) * 2u; }
    unsigned vC[2][2] = {{0u, 0u}, {0u, 0u}};
    const PG8_LAS int* const rowlds = (const PG8_LAS int*)(lds + STAGE_BYTES + 4096);
#define PG8_ROWS(dst, pm_) do { if constexpr (GATHER) { _Pragma("unroll") for (int h_ = 0; h_ < 2; ++h_) _Pragma("unroll") for (int i_ = 0; i_ < 2; ++i_) { int R_, C_; stage_rc(tid * 16 + i_ * 8192, R_, C_); \
        const int ix_ = (pm_) * BM + h_ * HALF + R_; dst[h_][i_] = ((g.rowmap ? (unsigned)g.rowmap[ix_] : (unsigned)ix_) * (unsigned)K + (unsigned)C_) * 2u; } } } while (0)
#define PG8_ROWS_LDS(dst) do { _Pragma("unroll") for (int h_ = 0; h_ < 2; ++h_) _Pragma("unroll") for (int i_ = 0; i_ < 2; ++i_) { int R_, C_; stage_rc(tid * 16 + i_ * 8192, R_, C_); \
        dst[h_][i_] = ((unsigned)rowlds[h_ * HALF + R_] * (unsigned)K + (unsigned)C_) * 2u; } } while (0)
    const size_t kstep = (size_t)(BK * 2);
    const size_t hstep = (size_t)HALF * K * 2;
    const size_t b64step = (size_t)64 * K * 2;
    const size_t hB = P16 ? (size_t)8 * K * 2 : hstep, b64B = P16 ? 2 * b64step : b64step;
    const size_t hA = GATHER ? (size_t)0 : hstep;
    const size_t tstep = 2 * hstep;
    const unsigned ldsw = (unsigned)wid * 1024u;
    const int aoff = lds_byte(wr * 64 + fr, fq * 8), boff = lds_byte(wc * 32 + fr, fq * 8);
#define PG8_SA(b, h) (((b) * 2 + (h)) * HTB)
#define PG8_SB(b, h) ((4 + (b) * 2 + (h)) * HTB)
#define PG8_STAGE(bufoff, gbase, voff) do { if constexpr (true) { const bool isB_ = ((const void*)(voff) == (const void*)voffB), isA_ = ((const void*)(voff) == (const void*)voffA); _Pragma("unroll") for (int _i = 0; _i < 2; ++_i) \
        __builtin_amdgcn_global_load_lds((const unsigned*)((const char*)(gbase) + (isB_ ? (size_t)_i * b64B : isA_ ? (size_t)_i * b64step : (size_t)0) + (isB_ ? voffB[0] : (isA_ ? voffA[0] : (voff)[_i]))), (PG8_LAS unsigned*)(lds + (bufoff) + ldsw + _i * 8192), 16, 0, 0); } } while (0)
#define PG8_LD16(off) (*(const PG8_LAS v8i_t_half*)(lds + (off)))
#define PG8_LDA(dst, b, h) do { if constexpr (FP8) { _Pragma("unroll") for (int m = 0; m < 4; ++m) dst##8[m] = __builtin_shufflevector(__builtin_bit_cast(v8i_t_half, *(const PG8_LAS bf16x8*)(lds + PG8_SA(b, h) + aoff + m * 2048)), __builtin_bit_cast(v8i_t_half, *(const PG8_LAS bf16x8*)(lds + PG8_SA(b, h) + aoff + m * 2048 + 1024)), 0, 1, 2, 3, 4, 5, 6, 7); } \
        else { _Pragma("unroll") for (int m = 0; m < 4; ++m) _Pragma("unroll") for (int k = 0; k < 2; ++k) dst[m][k] = *(const PG8_LAS bf16x8*)(lds + PG8_SA(b, h) + aoff + m * 2048 + k * 1024); } } while (0)
#define PG8_LDB(dst, b, h) do { if constexpr (FP8) { _Pragma("unroll") for (int n = 0; n < 2; ++n) dst##8[n] = __builtin_shufflevector(__builtin_bit_cast(v8i_t_half, *(const PG8_LAS bf16x8*)(lds + PG8_SB(b, h) + boff + n * 2048)), __builtin_bit_cast(v8i_t_half, *(const PG8_LAS bf16x8*)(lds + PG8_SB(b, h) + boff + n * 2048 + 1024)), 0, 1, 2, 3, 4, 5, 6, 7); } \
        else { _Pragma("unroll") for (int n = 0; n < 2; ++n) _Pragma("unroll") for (int k = 0; k < 2; ++k) dst[n][k] = *(const PG8_LAS bf16x8*)(lds + PG8_SB(b, h) + boff + n * 2048 + k * 1024); } } while (0)
#define PG8_MMA(ai, bj, At, Bt) do { __builtin_amdgcn_s_setprio(1); _Pragma("unroll") for (int m = 0; m < 4; ++m) _Pragma("unroll") for (int n = 0; n < 2; ++n) { \
        if constexpr (FP8) acc[ai][bj][m][n] = __builtin_amdgcn_mfma_scale_f32_16x16x128_f8f6f4(Bt##8[n], At##8[m], acc[ai][bj][m][n], 0, 0, 0, g.scale_a, 0, g.scale_a); \
        else { _Pragma("unroll") for (int k = 0; k < 2; ++k) acc[ai][bj][m][n] = __builtin_amdgcn_mfma_f32_16x16x32_bf16(Bt[n][k], At[m][k], acc[ai][bj][m][n], 0, 0, 0); } } __builtin_amdgcn_s_setprio(0); } while (0)
#define PG8_WAIT_V(n) asm volatile("s_waitcnt vmcnt(" #n ")" ::: "memory")
#define PG8_WAIT_L(n) asm volatile("s_waitcnt lgkmcnt(" #n ")" ::: "memory")
#define PG8_BAR __builtin_amdgcn_s_barrier()
#define PG8_SCHED __builtin_amdgcn_sched_barrier(0)
    Unit cur, nxt; int ui = 0;
    if (!S.next(0, cur)) return;
    cur.slot = 0;
    f32x4 acc[2][2][4][2];
#pragma unroll
    for (int a = 0; a < 2; ++a)
#pragma unroll
        for (int b = 0; b < 2; ++b)
#pragma unroll
            for (int m = 0; m < 4; ++m)
#pragma unroll
                for (int n = 0; n < 2; ++n) acc[a][b][m][n] = (f32x4){0.f, 0.f, 0.f, 0.f};
    bf16x8 At[4][2], B0[2][2], B1[2][2]; v8i_t At8[4], B08[2], B18[2];
    const char* cA = (const char*)g.A + (GATHER ? (size_t)0 : (size_t)cur.pm * tstep + (size_t)cur.b * g.strideA); const char* cB = (const char*)g.Bt + (size_t)cur.pn * tstep + (size_t)cur.b * g.strideB;
    PG8_ROWS(vC, cur.pm);
    S.a_ready(cur);
    if constexpr (SP2) {
        PG8_STAGE(PG8_SB(0, 0), cB, voffB); PG8_STAGE(PG8_SB(0, 1), cB + hB, voffB); PG8_STAGE(PG8_SA(0, 0), cA, (GATHER ? vC[0] : voffA)); PG8_STAGE(PG8_SA(0, 1), cA + hA, (GATHER ? vC[1] : voffA));
        if (wr == 1) PG8_BAR;
        PG8_WAIT_V(2); PG8_BAR;
        PG8_STAGE(PG8_SB(1, 0), cB + kstep, voffB); PG8_STAGE(PG8_SA(1, 0), cA + kstep, (GATHER ? vC[0] : voffA)); PG8_STAGE(PG8_SB(1, 1), cB + hB + kstep, voffB);
        PG8_WAIT_V(6); PG8_BAR;
    } else {
        PG8_STAGE(PG8_SB(0, 0), cB, voffB); PG8_STAGE(PG8_SA(0, 0), cA, voffA); PG8_STAGE(PG8_SB(0, 1), cB + hB, voffB); PG8_STAGE(PG8_SA(0, 1), cA + hstep, voffA);
        if (wr == 1) PG8_BAR;
        PG8_WAIT_V(4); PG8_BAR;
        PG8_STAGE(PG8_SB(1, 0), cB + kstep, voffB); PG8_STAGE(PG8_SA(1, 0), cA + kstep, voffA); PG8_STAGE(PG8_SB(1, 1), cB + hB + kstep, voffB);
        PG8_WAIT_V(6); PG8_BAR;
    }
    for (;;) {
        const bool has_next = S.next(ui + 1, nxt); nxt.slot = (ui + 1) & 1;
        if constexpr (Epi::LDS_BIAS) { if (wid == 0) __builtin_amdgcn_global_load_lds((const unsigned*)E.bias_src(cur, lane), (PG8_LAS unsigned*)(lds + STAGE_BYTES + 5120 + cur.slot * 1024), 16, 0, 0); }
        const char* nA = (has_next && !GATHER) ? (const char*)g.A + (size_t)nxt.pm * tstep + (size_t)nxt.b * g.strideA : cA; const char* nB = has_next ? (const char*)g.Bt + (size_t)nxt.pn * tstep + (size_t)nxt.b * g.strideB : cB;
        if constexpr (GATHER) { if (g.rowmap && wid == 0) { const int np_ = has_next ? nxt.pm : cur.pm;
            __builtin_amdgcn_global_load_lds((const unsigned*)(g.rowmap + (size_t)np_ * BM + lane * 4), (PG8_LAS unsigned*)(lds + STAGE_BYTES + 4096), 16, 0, 0); } }
        for (int t = 0; t < nt; t += 2) {
            const bool last = (t == nt - 2);
            const char* a1 = cA + (size_t)(t + 1) * kstep;
            const char* a2 = last ? nA : cA + (size_t)(t + 2) * kstep; const char* b2 = last ? nB : cB + (size_t)(t + 2) * kstep;
            const char* a3 = a2 + kstep; const char* b3 = b2 + kstep;
            if (last && has_next) S.a_ready(nxt);
            if constexpr (SP2) {
            PG8_LDB(B0, 0, 0); PG8_LDB(B1, 0, 1); PG8_SCHED; PG8_LDA(At, 0, 0); PG8_STAGE(PG8_SA(1, 1), a1 + hA, (GATHER ? vC[1] : voffA));
            if constexpr (GATHER) { if (last) { if (g.rowmap) PG8_ROWS_LDS(vC); else { const int np_ = has_next ? nxt.pm : cur.pm; PG8_ROWS(vC, np_); } } }
            PG8_WAIT_V(8); PG8_WAIT_L(0); PG8_BAR; PG8_MMA(0, 0, At, B0); PG8_MMA(0, 1, At, B1); PG8_BAR; PG8_SCHED;
            PG8_LDA(At, 0, 1); PG8_STAGE(PG8_SB(0, 0), b2, voffB); PG8_STAGE(PG8_SB(0, 1), b2 + hB, voffB); PG8_STAGE(PG8_SA(0, 0), a2, (GATHER ? vC[0] : voffA));
            PG8_WAIT_V(8); PG8_WAIT_L(0); PG8_BAR; PG8_MMA(1, 0, At, B0); PG8_MMA(1, 1, At, B1); PG8_BAR; PG8_SCHED;
            PG8_LDB(B0, 1, 0); PG8_LDB(B1, 1, 1); PG8_SCHED; PG8_LDA(At, 1, 0); PG8_STAGE(PG8_SA(0, 1), a2 + hA, (GATHER ? vC[1] : voffA));
            PG8_WAIT_V(8); PG8_WAIT_L(0); PG8_BAR; PG8_MMA(0, 0, At, B0); PG8_MMA(0, 1, At, B1); PG8_BAR; PG8_SCHED;
            PG8_LDA(At, 1, 1); PG8_STAGE(PG8_SB(1, 0), b3, voffB); PG8_STAGE(PG8_SB(1, 1), b3 + hB, voffB); PG8_STAGE(PG8_SA(1, 0), a3, (GATHER ? vC[0] : voffA));
            PG8_WAIT_V(8); PG8_WAIT_L(0); PG8_BAR; PG8_MMA(1, 0, At, B0); PG8_MMA(1, 1, At, B1); PG8_BAR; PG8_SCHED;
            } else {
            PG8_LDB(B0, 0, 0); PG8_SCHED; PG8_LDA(At, 0, 0); PG8_STAGE(PG8_SA(1, 1), a1 + hstep, voffA);
            PG8_WAIT_L(8); PG8_BAR; PG8_WAIT_L(0); PG8_MMA(0, 0, At, B0); PG8_BAR; PG8_SCHED;
            PG8_LDB(B1, 0, 1); PG8_STAGE(PG8_SB(0, 0), b2, voffB);
            PG8_BAR; PG8_WAIT_L(0); PG8_MMA(0, 1, At, B1); PG8_BAR;
            PG8_LDA(At, 0, 1); PG8_STAGE(PG8_SA(0, 0), a2, voffA);
            PG8_BAR; PG8_WAIT_L(0); PG8_MMA(1, 0, At, B0); PG8_BAR; PG8_SCHED;
            PG8_STAGE(PG8_SB(0, 1), b2 + hB, voffB);
            PG8_WAIT_V(6); PG8_BAR; PG8_MMA(1, 1, At, B1); PG8_BAR;
            PG8_LDB(B0, 1, 0); PG8_SCHED; PG8_LDA(At, 1, 0); PG8_STAGE(PG8_SA(0, 1), a2 + hstep, voffA);
            PG8_WAIT_L(8); PG8_BAR; PG8_WAIT_L(0); PG8_MMA(0, 0, At, B0); PG8_BAR; PG8_SCHED;
            PG8_LDB(B1, 1, 1); PG8_STAGE(PG8_SB(1, 0), b3, voffB);
            PG8_BAR; PG8_WAIT_L(0); PG8_MMA(0, 1, At, B1); PG8_BAR;
            PG8_LDA(At, 1, 1); PG8_STAGE(PG8_SA(1, 0), a3, voffA);
            PG8_BAR; PG8_WAIT_L(0); PG8_MMA(1, 0, At, B0); PG8_BAR; PG8_SCHED;
            PG8_STAGE(PG8_SB(1, 1), b3 + hB, voffB);
            PG8_WAIT_V(6); PG8_BAR; PG8_MMA(1, 1, At, B1); PG8_BAR;
            }
        }
        if constexpr (ALIGN_EPI) { if (wr == 0) PG8_BAR; }
        if constexpr (!Epi::AFTER_DRAIN) { int t2_ = threadIdx.x; asm volatile("" : "+v"(t2_)); E(acc, cur, wr, wc, t2_ & 15, (t2_ & 63) >> 4); S.done(cur); }
        if (!has_next) break;
        if (!(Epi::CHAIN && cur.b < 2)) {
#pragma unroll
        for (int a = 0; a < 2; ++a)
#pragma unroll
            for (int b = 0; b < 2; ++b)
#pragma unroll
                for (int m = 0; m < 4; ++m)
#pragma unroll
                    for (int n = 0; n < 2; ++n) acc[a][b][m][n] = (f32x4){0.f, 0.f, 0.f, 0.f};
        }
        cur = nxt; cA = nA; cB = nB; ++ui;
        if constexpr (ALIGN_EPI) { if (wr == 1) PG8_BAR; }
    }
    PG8_WAIT_V(0);
    if constexpr (!ALIGN_EPI) { if (wr == 0) PG8_BAR; }
    PG8_BAR;
    if constexpr (Epi::AFTER_DRAIN) { E.fused(acc, cur, wr, wc, fr, fq, lds, wid, lane); S.done(cur); }
#undef PG8_ROWS
#undef PG8_ROWS_LDS
#undef PG8_SA
#undef PG8_SB
#undef PG8_STAGE
#undef PG8_LDA
#undef PG8_LDB
#undef PG8_MMA
#undef PG8_LD16
#undef PG8_WAIT_V
#undef PG8_WAIT_L
#undef PG8_BAR
#undef PG8_SCHED
}
}
namespace attn_body {
using bf16=__hip_bfloat16;
using bf16x8=__attribute__((ext_vector_type(8)))short;
using s16x4=__attribute__((ext_vector_type(4)))short;
using f32x16=__attribute__((ext_vector_type(16)))float;
using f32x4v=__attribute__((ext_vector_type(4)))float;
using u32x4=__attribute__((ext_vector_type(4)))unsigned;
constexpr int D=64;
constexpr int NW=8,QBLK=32,QB=QBLK*NW,KVBLK=64;
__device__ __forceinline__ int crow(int r,int hi){return (r&3)+8*(r>>2)+4*hi;}
#define SBAR() __builtin_amdgcn_sched_barrier(0)
__device__ __forceinline__ void cmask(f32x16&p0,f32x16&p1,int jb,int qrel,int hi){
  const float NEG=-INFINITY; int kb=64*jb+4*hi;
  #pragma unroll
  for(int r=0;r<16;++r){int kv=kb+(r&3)+8*(r>>2); if(kv>qrel)p0[r]=NEG; if(kv+32>qrel)p1[r]=NEG;}
}

constexpr int NSLOT=3, SLOTB=8192;
constexpr int LDS_K=0, LDS_V=NSLOT*SLOTB, LDS_WS=2*NSLOT*SLOTB, LDS_OST=LDS_WS+NW*64*4, LDS_BYTES=LDS_OST+NW*4096;
constexpr int LDS_CS=LDS_BYTES, CS_BYTES=65536, LDS_TOTAL=LDS_CS+CS_BYTES;
constexpr int TBL_N=640, TBL_ZERO=256;
__device__ __forceinline__ void glds16(const void*gsrc,unsigned lds_dst){unsigned keep;
  asm volatile("s_mov_b32 %0, m0\n\ts_mov_b32 m0, %2\n\ts_nop 0\n\tglobal_load_lds_dwordx4 %1, off\n\ts_mov_b32 m0, %0":"=&s"(keep):"v"(gsrc),"s"(lds_dst):"memory");}
__device__ __forceinline__ float max3f(float a,float b,float c){float r;asm("v_max3_f32 %0, %1, %2, %3":"=v"(r):"v"(a),"v"(b),"v"(c));return r;}
__device__ __forceinline__ float max2f(float a,float b){float r;asm("v_max_f32_e32 %0, %1, %2":"=v"(r):"v"(a),"v"(b));return r;}
__device__ __forceinline__ float fadd_s(float a,float b){float r;asm("v_add_f32_e32 %0, %1, %2":"=v"(r):"v"(a),"v"(b));return r;}
__device__ __forceinline__ float fsub_s(float a,float b){float r;asm("v_sub_f32_e32 %0, %1, %2":"=v"(r):"v"(a),"v"(b));return r;}
typedef float f32x2_t __attribute__((ext_vector_type(2))); typedef __bf16 bf16x2_t __attribute__((ext_vector_type(2)));
__device__ __forceinline__ unsigned cvtpk_s(float lo,float hi){f32x2_t v={lo,hi};bf16x2_t b=__builtin_convertvector(v,bf16x2_t);return __builtin_bit_cast(unsigned,b);}
#define WAIT_BAR(N) asm volatile("s_waitcnt vmcnt(" #N ") lgkmcnt(0)\n\ts_barrier":::"memory")

__device__ __forceinline__ void qkt(f32x16&p0,f32x16&p1,const char*Kslot,const bf16x8*qr,int r32,int hi){
  const char*kb=Kslot+hi*1024+r32*16;
  #pragma unroll
  for(int d0=0;d0<4;++d0){
    const bf16x8 b0=*reinterpret_cast<const bf16x8*>(kb+d0*2048);
    const bf16x8 b1=*reinterpret_cast<const bf16x8*>(kb+d0*2048+512);
    p0=__builtin_amdgcn_mfma_f32_32x32x16_bf16(b0,qr[d0],p0,0,0,0);p1=__builtin_amdgcn_mfma_f32_32x32x16_bf16(b1,qr[d0],p1,0,0,0);}
}
typedef __attribute__((address_space(3))) const char* lds_cptr;
typedef __attribute__((address_space(3))) char* lds_ptr;
typedef short v4i16_t __attribute__((ext_vector_type(4)));
__device__ __forceinline__ void kload8(bf16x8*kf,lds_cptr kp){
  kf[0]=*(const __attribute__((address_space(3))) bf16x8*)(kp);      kf[1]=*(const __attribute__((address_space(3))) bf16x8*)(kp+512);
  kf[2]=*(const __attribute__((address_space(3))) bf16x8*)(kp+2048); kf[3]=*(const __attribute__((address_space(3))) bf16x8*)(kp+2560);
  kf[4]=*(const __attribute__((address_space(3))) bf16x8*)(kp+4096); kf[5]=*(const __attribute__((address_space(3))) bf16x8*)(kp+4608);
  kf[6]=*(const __attribute__((address_space(3))) bf16x8*)(kp+6144); kf[7]=*(const __attribute__((address_space(3))) bf16x8*)(kp+6656);
}
__device__ __forceinline__ void kload2(bf16x8*kf,lds_cptr kp,int j){ kf[2*j]=*(const __attribute__((address_space(3))) bf16x8*)(kp+j*2048); kf[2*j+1]=*(const __attribute__((address_space(3))) bf16x8*)(kp+j*2048+512); }
__device__ __forceinline__ s16x4 vtr(lds_cptr p){ return __builtin_bit_cast(s16x4,__builtin_amdgcn_ds_read_tr16_b64_v4i16((__attribute__((address_space(3))) v4i16_t*)p)); }
__device__ __forceinline__ float rowmax(const f32x16&p0,const f32x16&p1){
  float a=max3f(p0[0],p0[1],p1[0]),b=max3f(p0[2],p0[3],p1[1]);a=max3f(a,p1[2],p1[3]);
  #pragma unroll
  for(int r=4;r<16;r+=4){a=max3f(a,p0[r],p0[r+1]);b=max3f(b,p0[r+2],p0[r+3]);a=max3f(a,p1[r],p1[r+1]);b=max3f(b,p1[r+2],p1[r+3]);}
  const float m=max2f(a,b);
  auto rr=__builtin_amdgcn_permlane32_swap(__float_as_uint(m),__float_as_uint(m),false,false);
  return max2f(__uint_as_float(rr[0]),__uint_as_float(rr[1]));
}
__device__ __forceinline__ void pv(f32x16*o,int vb,bf16x8 pa0,bf16x8 pa1,bf16x8 pa2,bf16x8 pa3){
  #pragma unroll
  for(int d0=0;d0<2;++d0){s16x4 lo[4],hi[4];
    #pragma unroll
    for(int ks=0;ks<4;++ks){
      asm volatile("ds_read_b64_tr_b16 %0,%1 offset:%c2":"=&v"(lo[ks]):"v"(vb),"i"(d0*4096+ks*1024):"memory");
      asm volatile("ds_read_b64_tr_b16 %0,%1 offset:%c2":"=&v"(hi[ks]):"v"(vb),"i"(d0*4096+ks*1024+512):"memory");}
    asm volatile("s_waitcnt lgkmcnt(0)":::"memory");SBAR();
    #define PK(k) (bf16x8){lo[k][0],lo[k][1],lo[k][2],lo[k][3],hi[k][0],hi[k][1],hi[k][2],hi[k][3]}
    o[d0]=__builtin_amdgcn_mfma_f32_32x32x16_bf16(pa0,PK(0),o[d0],0,0,0);
    o[d0]=__builtin_amdgcn_mfma_f32_32x32x16_bf16(pa1,PK(1),o[d0],0,0,0);
    o[d0]=__builtin_amdgcn_mfma_f32_32x32x16_bf16(pa2,PK(2),o[d0],0,0,0);
    o[d0]=__builtin_amdgcn_mfma_f32_32x32x16_bf16(pa3,PK(3),o[d0],0,0,0);
    #undef PK
  }
}

struct AttnArgs { const bf16* Q; const bf16* K; const bf16* V; bf16* O; long qp, kp, op; int q0, NT, kv0; const float* aux; float* lse; long lse_stride; int tlo, thi, band; float thr; };
#define ATTN_STORE16(p,v) (*(u32x4*)(p)=(v))
template<int MODE,int THRL> __device__ __forceinline__ void attn_unit(const AttnArgs&a,char*shm){
  int tid_=threadIdx.x; asm volatile("":"+v"(tid_));
  const int tid=tid_,lane=tid&63,r32=lane&31,hi=lane>>5; const int wid=__builtin_amdgcn_readfirstlane(tid>>6);
  const int q0=a.q0; const long KP=a.kp;
  const bf16*Qw=a.Q+(long)(q0+wid*QBLK)*a.qp;
  const bf16*Kh=a.K,*Vh=a.V;
  int NT=a.NT, lo=0;
  if(MODE==0){
    const int nt0=a.thi-a.tlo; const float cq=a.aux[q0];
    const float ck=(lane<nt0)?a.aux[64*(a.tlo+lane)+63]:0.f;
    const unsigned long long need=__ballot((lane<nt0)&&(cq-ck>=-a.thr));
    const int j0=need?(int)__builtin_ctzll(need):nt0;
    if(j0>=nt0){ if(a.lse&&tid<QB)a.lse[(long)(q0+tid)*a.lse_stride]=-INFINITY; return; }
    lo=a.tlo+j0; int n=a.thi-lo; if(n<4){lo=a.thi-4;n=4;} if(n&1){lo-=1;n+=1;} NT=n;
    Kh+=(long)lo*KVBLK*KP; Vh+=(long)lo*KVBLK*KP;
  }
  const unsigned lds0=(unsigned)(uintptr_t)shm;
  float*wsf=(float*)(shm+LDS_WS)+wid*64;
  const lds_cptr shm3=(lds_cptr)shm;
  const __attribute__((address_space(3))) float* cs3=(const __attribute__((address_space(3))) float*)(shm3+LDS_CS);
  float nb=0.f;
  if(MODE==0){ __attribute__((address_space(3))) f32x4v* dst=(__attribute__((address_space(3))) f32x4v*)((lds_ptr)shm+LDS_CS); const f32x4v* src=(const f32x4v*)a.aux+16*lo; const int n4=16*NT;
    for(int i=tid;i<n4;i+=NW*64)dst[i]=src[i];
    nb=a.aux[q0+wid*QBLK+r32]; }
  if(MODE==1){ __attribute__((address_space(3))) float* dst=(__attribute__((address_space(3))) float*)((lds_ptr)shm+LDS_CS);
    for(int i=tid;i<TBL_N;i+=NW*64)dst[i]=a.aux[i]; }
  const bf16*ksrc=Kh+(long)lane*KP+wid*8;
  const bf16*vsrc=Vh+(long)(16*(wid&3)+(lane>>2))*KP+(wid>>2)*32+(lane&3)*8;
  const unsigned kdst=lds0+LDS_K+wid*1024, vdst=lds0+LDS_V+wid*1024;
  #define DMA_K(t,slot) glds16(ksrc+(long)(t)*KVBLK*KP,(unsigned)__builtin_amdgcn_readfirstlane(kdst+(slot)))
  #define DMA_V(t,slot) glds16(vsrc+(long)(t)*KVBLK*KP,(unsigned)__builtin_amdgcn_readfirstlane(vdst+(slot)))
  const int vb0=(int)(lds0+LDS_V)+((lane>>4)&1)*32+(lane&3)*8+(4*hi+((lane&15)>>2))*64;
  const char*Kbase=shm+LDS_K; bf16x8 kf[8];
  const lds_cptr kp0=shm3+LDS_K+hi*1024+r32*16; const lds_cptr vp0=shm3+LDS_V+((lane>>4)&1)*32+(lane&3)*8+(4*hi+((lane&15)>>2))*64;
  DMA_K(0,0);DMA_V(0,0);DMA_K(1,SLOTB);
  bf16x8 qr[4];
  #pragma unroll
  for(int d0=0;d0<4;++d0)qr[d0]=*reinterpret_cast<const bf16x8*>(&Qw[(long)r32*a.qp+d0*16+hi*8]);
  float mhat=0.f,l_reg=0.f;f32x16 o[2];o[0]=f32x16{};o[1]=f32x16{};
  const int qrel=wid*QBLK+r32;
  const int tb0=q0+qrel-a.kv0-4*hi+TBL_ZERO-63;
  #define CINIT(C0,C1,t) do{ \
    if(MODE==0){ const __attribute__((address_space(3))) float* cp_=cs3+64*(t)+4*hi; \
      _Pragma("unroll") for(int g_=0;g_<4;++g_){ const f32x4v a_=*(const __attribute__((address_space(3))) f32x4v*)(cp_+8*g_); const f32x4v b_=*(const __attribute__((address_space(3))) f32x4v*)(cp_+32+8*g_); \
        C0[4*g_]=nb-a_[0];C0[4*g_+1]=nb-a_[1];C0[4*g_+2]=nb-a_[2];C0[4*g_+3]=nb-a_[3]; C1[4*g_]=nb-b_[0];C1[4*g_+1]=nb-b_[1];C1[4*g_+2]=nb-b_[2];C1[4*g_+3]=nb-b_[3]; } } \
    else if(MODE==1){ const __attribute__((address_space(3))) float* tp_=cs3+(tb0-64*(t)); \
      _Pragma("unroll") for(int g_=0;g_<4;++g_) _Pragma("unroll") for(int j_=0;j_<4;++j_){ C0[4*g_+j_]=nb+tp_[63-8*g_-j_]; C1[4*g_+j_]=nb+tp_[31-8*g_-j_]; } } \
    else { _Pragma("unroll") for(int r_=0;r_<16;++r_){C0[r_]=nb;C1[r_]=nb;} } }while(0)
  #define CMASK(P0,P1,t) do{ if(MODE==0&&a.band){int jb_=(t)-(NT-4); if(jb_>=0)cmask(P0,P1,jb_,qrel,hi);} }while(0)
  bool resc=false;
  #define START(P0,P1) do{ const float rm=rowmax(P0,P1); resc=false; \
    { const float dl=(MODE==1)?max2f(rm,-256.0f):rm; mhat=fadd_s(mhat,dl); nb=fsub_s(nb,dl); \
      _Pragma("unroll") for(int r=0;r<16;++r){P0[r]=fsub_s(P0[r],dl);P1[r]=fsub_s(P1[r],dl);} } \
    _Pragma("unroll") for(int r=0;r<16;++r)P0[r]=__builtin_amdgcn_exp2f(P0[r]); }while(0)
  #define RESC() do{ if(resc){ asm volatile("s_waitcnt lgkmcnt(0)":::"memory"); \
      _Pragma("unroll") for(int d_=0;d_<2;++d_) _Pragma("unroll") for(int r=0;r<16;++r)o[d_][r]*=wsf[crow(r,hi)]; } }while(0)
  f32x16 pA0,pA1,pB0,pB1;
  int sl_prev=0,sl_cur=0,sl_next=SLOTB;
  #define ROT() do{sl_prev=sl_cur;sl_cur=sl_next;sl_next=(sl_next==(NSLOT-1)*SLOTB)?0:sl_next+SLOTB;}while(0)
  DMA_K(2,2*SLOTB);
  WAIT_BAR(3);
  CINIT(pA0,pA1,0);
  qkt(pA0,pA1,Kbase,qr,r32,hi);asm volatile("s_nop 15\n\ts_nop 7":"+v"(pA0),"+v"(pA1));CMASK(pA0,pA1,0);
  START(pA0,pA1);
  _Pragma("unroll") for(int r=0;r<16;++r)pA1[r]=__builtin_amdgcn_exp2f(pA1[r]);
  WAIT_BAR(0);
  DMA_K(3,0);DMA_V(1,SLOTB);
  ROT();
  kload8(kf,kp0+sl_cur);
  WAIT_BAR(2);
  s16x4 vlo[8],vhi[8]; u32x4 pw0,pw1,pw2,pw3;
  #define PKW(P,B) cvtpk_s(P[B],P[B+1])
  #define PAF(k) __builtin_bit_cast(bf16x8,pw##k)
  #define VFR(i) (bf16x8){vlo[i][0],vlo[i][1],vlo[i][2],vlo[i][3],vhi[i][0],vhi[i][1],vhi[i][2],vhi[i][3]}
  #define PIN(x) asm volatile("":"+v"(x))
  #define MX3(a,b,c) __builtin_fmaxf(__builtin_fmaxf((a),(b)),(c))
  #define GAPA(MF,A0,A1,A2,A3,W0,W1,PW) do{ MF; sacc+=A0; sacc+=A1; sacc+=A2; sacc+=A3; PIN(sacc); W0; W1; PIN(PW); SBAR(); }while(0)
  #define EX(v) __builtin_amdgcn_exp2f(v)
  #define GAPB(MF,X,B) do{ MF; X[B]=EX(X[B]); X[B+1]=EX(X[B+1]); X[B+2]=EX(X[B+2]); X[B+3]=EX(X[B+3]); PIN(X); SBAR(); }while(0)
  #define VRD(i) do{ vlo[i]=vtr(vp_+(((i)>>2)*4096+((i)&3)*1024)); vhi[i]=vtr(vp_+(((i)>>2)*4096+((i)&3)*1024+512)); }while(0)
  #define KRD(G,j) do{ if(G){ kload2(kf,kp0+sl_next,j); SBAR(); } }while(0)
  #define STEP(C0,C1,P0,P1,t,GK,GV,GL) do{ CINIT(C0,C1,t); SBAR(); \
    const lds_cptr vp_=vp0+sl_prev; \
    VRD(0); SBAR(); float sacc=(P0[0]+P0[1]); \
    GAPA(C0=__builtin_amdgcn_mfma_f32_32x32x16_bf16(kf[0],qr[0],C0,0,0,0), P0[2],P0[3],P0[4],P0[5],     pw0[0]=PKW(P0,0), pw0[1]=PKW(P0,2), pw0); \
    VRD(4); SBAR(); GAPA(C1=__builtin_amdgcn_mfma_f32_32x32x16_bf16(kf[1],qr[0],C1,0,0,0), P0[6],P0[7],P0[8],P0[9],     pw0[2]=PKW(P0,4), pw0[3]=PKW(P0,6), pw0); \
    VRD(1); SBAR(); GAPA(C0=__builtin_amdgcn_mfma_f32_32x32x16_bf16(kf[2],qr[1],C0,0,0,0),   P0[10],P0[11],P0[12],P0[13], pw1[0]=PKW(P0,8), pw1[1]=PKW(P0,10), pw1); \
    VRD(5); SBAR(); GAPA(C1=__builtin_amdgcn_mfma_f32_32x32x16_bf16(kf[3],qr[1],C1,0,0,0),   P0[14],P0[15],P1[0],P1[1],   pw1[2]=PKW(P0,12),pw1[3]=PKW(P0,14), pw1); \
    VRD(2); SBAR(); GAPA(C0=__builtin_amdgcn_mfma_f32_32x32x16_bf16(kf[4],qr[2],C0,0,0,0),   P1[2],P1[3],P1[4],P1[5],     pw2[0]=PKW(P1,0), pw2[1]=PKW(P1,2), pw2); \
    VRD(6); SBAR(); GAPA(C1=__builtin_amdgcn_mfma_f32_32x32x16_bf16(kf[5],qr[2],C1,0,0,0),   P1[6],P1[7],P1[8],P1[9],     pw2[2]=PKW(P1,4), pw2[3]=PKW(P1,6), pw2); \
    VRD(3); SBAR(); GAPA(C0=__builtin_amdgcn_mfma_f32_32x32x16_bf16(kf[6],qr[3],C0,0,0,0),   P1[10],P1[11],P1[12],P1[13], pw3[0]=PKW(P1,8), pw3[1]=PKW(P1,10), pw3); \
    VRD(7); SBAR(); GAPA(C1=__builtin_amdgcn_mfma_f32_32x32x16_bf16(kf[7],qr[3],C1,0,0,0),   P1[14],P1[15],0.f,0.f,       pw3[2]=PKW(P1,12),pw3[3]=PKW(P1,14), pw3); \
    l_reg+=sacc; \
    if(GK){DMA_K((t)+3,sl_cur);} if(GV){DMA_V((t)+1,sl_next);} \
    CMASK(C0,C1,t); \
    { float a=MX3(C0[0],C0[1],C1[0]),b=MX3(C0[2],C0[3],C1[1]); a=MX3(a,C1[2],C1[3]); \
      _Pragma("unroll") for(int r=4;r<16;r+=4){a=MX3(a,C0[r],C0[r+1]);b=MX3(b,C0[r+2],C0[r+3]);a=MX3(a,C1[r],C1[r+1]);b=MX3(b,C1[r+2],C1[r+3]);} \
      float rm=__builtin_fmaxf(a,b); { auto rr=__builtin_amdgcn_permlane32_swap(__float_as_uint(rm),__float_as_uint(rm),false,false); rm=__builtin_fmaxf(__uint_as_float(rr[0]),__uint_as_float(rr[1])); } \
      resc=false; \
      if(__builtin_expect(__any(rm>(float)THRL),0)){ const float dl=__builtin_fmaxf(rm,0.f); mhat+=dl; nb-=dl; \
        _Pragma("unroll") for(int r=0;r<16;++r){C0[r]-=dl;C1[r]-=dl;} \
        const float f=__builtin_amdgcn_exp2f(-dl); l_reg*=f; if(hi==0)wsf[r32]=f; resc=true; } } \
    SBAR(); \
    GAPB(o[0]=__builtin_amdgcn_mfma_f32_32x32x16_bf16(PAF(0),VFR(0),o[0],0,0,0), C0,0); \
    GAPB(o[1]=__builtin_amdgcn_mfma_f32_32x32x16_bf16(PAF(0),VFR(4),o[1],0,0,0), C0,4); \
    KRD(GL,0); GAPB(o[0]=__builtin_amdgcn_mfma_f32_32x32x16_bf16(PAF(1),VFR(1),o[0],0,0,0), C0,8); \
    KRD(GL,1); GAPB(o[1]=__builtin_amdgcn_mfma_f32_32x32x16_bf16(PAF(1),VFR(5),o[1],0,0,0), C0,12); \
    KRD(GL,2); GAPB(o[0]=__builtin_amdgcn_mfma_f32_32x32x16_bf16(PAF(2),VFR(2),o[0],0,0,0), C1,0); \
    KRD(GL,3); GAPB(o[1]=__builtin_amdgcn_mfma_f32_32x32x16_bf16(PAF(2),VFR(6),o[1],0,0,0), C1,4); \
    GAPB(o[0]=__builtin_amdgcn_mfma_f32_32x32x16_bf16(PAF(3),VFR(3),o[0],0,0,0), C1,8); \
    GAPB(o[1]=__builtin_amdgcn_mfma_f32_32x32x16_bf16(PAF(3),VFR(7),o[1],0,0,0), C1,12); \
    }while(0)
  int t=1;
  #undef CMASK
  #define CMASK(P0,P1,t) do{}while(0)
  for(;t+5<NT;t+=2){
    STEP(pB0,pB1,pA0,pA1,t,true,true,true);     WAIT_BAR(2); RESC(); ROT();
    STEP(pA0,pA1,pB0,pB1,t+1,true,true,true);   WAIT_BAR(2); RESC(); ROT();
  }
  #undef CMASK
  #define CMASK(P0,P1,t) do{ if(MODE==0&&a.band){int jb_=(t)-(NT-4); if(jb_>=0)cmask(P0,P1,jb_,qrel,hi);} }while(0)
  #define ENDW(tt) do{ if((tt)+3<NT){WAIT_BAR(2);} else if((tt)+2<NT){WAIT_BAR(1);} else {WAIT_BAR(0);} }while(0)
  for(;t+1<NT;t+=2){
    STEP(pB0,pB1,pA0,pA1,t,(t+3<NT),(t+1<NT),(t+1<NT));       ENDW(t);   RESC(); ROT();
    STEP(pA0,pA1,pB0,pB1,t+1,(t+4<NT),(t+2<NT),(t+2<NT));     ENDW(t+1); RESC(); ROT();
  }
  STEP(pB0,pB1,pA0,pA1,NT-1,false,false,false); RESC();
  { float sacc=pB0[0]+pB0[1]; _Pragma("unroll") for(int r=2;r<16;++r)sacc+=pB0[r]; _Pragma("unroll") for(int r=0;r<16;++r)sacc+=pB1[r]; l_reg+=sacc;
    pw0=(u32x4){PKW(pB0,0),PKW(pB0,2),PKW(pB0,4),PKW(pB0,6)};pw1=(u32x4){PKW(pB0,8),PKW(pB0,10),PKW(pB0,12),PKW(pB0,14)};pw2=(u32x4){PKW(pB1,0),PKW(pB1,2),PKW(pB1,4),PKW(pB1,6)};pw3=(u32x4){PKW(pB1,8),PKW(pB1,10),PKW(pB1,12),PKW(pB1,14)};
    SBAR(); pv(o,vb0+sl_cur,PAF(0),PAF(1),PAF(2),PAF(3)); }
  #undef PKW
  #undef PAF
  #undef VFR
  #undef PIN
  #undef MX3
  #undef GAPA
  #undef GAPB
  #undef EX
  #undef VRD
  #undef KRD
  #undef STEP
  #undef ENDW
  {auto rr=__builtin_amdgcn_permlane32_swap(__float_as_uint(l_reg),__float_as_uint(l_reg),false,false);l_reg=__uint_as_float(rr[0])+__uint_as_float(rr[1]);}
  if(MODE==1||(MODE==0&&a.lse)){ if(hi==0) a.lse[(long)(q0+qrel)*a.lse_stride]=mhat+__builtin_amdgcn_logf(l_reg); }
  if(hi==0)wsf[32+r32]=l_reg;asm volatile("s_waitcnt lgkmcnt(0)":::"memory");
  float rli[16];
  #pragma unroll
  for(int r=0;r<16;++r)rli[r]=__builtin_amdgcn_rcpf(wsf[32+crow(r,hi)]);
  bf16*Ow=a.O+(long)(q0+wid*QBLK)*a.op;
  { bf16*stg=(bf16*)(shm+LDS_OST)+wid*2048;
    #pragma unroll
    for(int r=0;r<16;++r){const int orow=crow(r,hi);
      #pragma unroll
      for(int d0=0;d0<2;++d0)stg[orow*64+d0*32+r32]=__float2bfloat16(o[d0][r]*rli[r]);}
    asm volatile("s_waitcnt lgkmcnt(0)":::"memory");
    #pragma unroll
    for(int i=0;i<4;++i){const int row=i*8+(lane>>3),ch=lane&7; const u32x4 v=*(const u32x4*)(stg+row*64+ch*8); ATTN_STORE16(Ow+(long)row*a.op+ch*8,v);} }
  asm volatile("s_waitcnt lgkmcnt(0)\n\ts_barrier":::"memory");
  #undef DMA_K
  #undef DMA_V
  #undef CMASK
  #undef CINIT
  #undef START
  #undef RESC
  #undef ROT
}
constexpr int ATTN_LDS_BYTES=LDS_TOTAL;
#undef SBAR
#undef WAIT_BAR
}
#define GAS __attribute__((address_space(1)))
#define LAS __attribute__((address_space(3)))
typedef unsigned short bf16;
typedef unsigned v4u __attribute__((ext_vector_type(4)));
typedef float f32x4 __attribute__((ext_vector_type(4)));
typedef short bf16x8 __attribute__((ext_vector_type(8)));
typedef GAS unsigned gu32;
typedef GAS unsigned long long gu64;
#define RLX_AGENT __ATOMIC_RELAXED, __HIP_MEMORY_SCOPE_AGENT
#define LDS_WAIT() asm volatile("s_waitcnt lgkmcnt(0)" ::: "memory")
#define VM_WAIT() asm volatile("s_waitcnt vmcnt(0)" ::: "memory")
__device__ __forceinline__ unsigned long long rt() { return __builtin_amdgcn_s_memrealtime(); }
__device__ __forceinline__ unsigned f2bf(float f) { unsigned u = __builtin_bit_cast(unsigned, f); return (u + 0x7fffu + ((u >> 16) & 1u)) >> 16; }
__device__ __forceinline__ unsigned pk4_fp8(float a, float b, float c, float d) { int w = __builtin_amdgcn_cvt_pk_fp8_f32(a, b, 0, false); w = __builtin_amdgcn_cvt_pk_fp8_f32(c, d, w, true); return (unsigned)w; }
__device__ __forceinline__ unsigned pk2(float lo, float hi) { typedef float f2_t __attribute__((ext_vector_type(2))); typedef __bf16 b2_t __attribute__((ext_vector_type(2))); f2_t v = {lo, hi}; b2_t b = __builtin_convertvector(v, b2_t); return __builtin_bit_cast(unsigned, b); }

#define XB_TMO      128
#define XB_XCNT(j)  (256  + 64 * (j))
#define XB_XSUB(j)  (1280 + 64 * (j))
#define XB_XGEN(j)  (2304 + 64 * (j))
#define XB_TOP      3328
#define XB_TOPGEN   3392
#define XCD_BAR_WORDS 3456
#define XB_SPIN_CAP (1u << 18)

__device__ __forceinline__ unsigned xb_ld(unsigned* p)              { return __hip_atomic_load(p, __ATOMIC_RELAXED, __HIP_MEMORY_SCOPE_AGENT); }
__device__ __forceinline__ unsigned xb_add(unsigned* p, unsigned v) { return __hip_atomic_fetch_add(p, v, __ATOMIC_RELAXED, __HIP_MEMORY_SCOPE_AGENT); }
__device__ __forceinline__ unsigned xb_xcc_id() { return (unsigned)__builtin_amdgcn_s_getreg((3 << 11) | 20) & 0xFu; }
#define XB_SPIN(cond, bar) do { unsigned _sp = 0; while (cond) { __builtin_amdgcn_s_sleep(1); \
    if ((++_sp & 255u) == 0u) { if (xb_ld(&(bar)[XB_TMO])) break; if (_sp > XB_SPIN_CAP) { atomicAdd(&(bar)[XB_TMO], 1u); break; } } } } while (0)

struct XcdBarrier {
    unsigned* bar; unsigned x;
    volatile LAS unsigned* st;
};

__device__ __forceinline__ XcdBarrier xcd_barrier_post(unsigned* bar, volatile LAS unsigned* st) {
    XcdBarrier b; b.bar = bar; b.x = xb_xcc_id(); b.st = st;
    if (threadIdx.x == 0) (void)xb_add(&bar[XB_XCNT(b.x)], 1u);
    return b;
}
__device__ __forceinline__ void xcd_barrier_complete(unsigned* bar, unsigned x, unsigned& nloc, unsigned& nx) {
    const unsigned G = gridDim.x * gridDim.y * gridDim.z;
    unsigned sum, cnt, mine, sp = 0u;
    for (;;) {
        sum = 0u; cnt = 0u; mine = 0u;
#pragma unroll
        for (unsigned j = 0; j < 16; ++j) { const unsigned c = xb_ld(&bar[XB_XCNT(j)]); sum += c; cnt += (c > 0u) ? 1u : 0u; mine = (j == x) ? c : mine; }
        if (sum == G) break;
        __builtin_amdgcn_s_sleep(1);
        if ((++sp & 255u) == 0u) { if (xb_ld(&bar[XB_TMO])) break; if (sp > XB_SPIN_CAP) { atomicAdd(&bar[XB_TMO], 1u); break; } }
    }
    nloc = mine > 0u ? mine : 1u; nx = cnt > 0u ? cnt : 1u;
}

__device__ __forceinline__ void xcd_barrier(const XcdBarrier& b) {
    asm volatile("s_waitcnt vmcnt(0)" ::: "memory");
    __syncthreads();
    if (threadIdx.x == 0) {
        unsigned* bar = b.bar;
        __builtin_amdgcn_s_waitcnt(0);
        unsigned nloc = b.st[0], nx = b.st[1];
        if (nloc == 0u) { xcd_barrier_complete(bar, b.x, nloc, nx); b.st[0] = nloc; b.st[1] = nx; }
        const unsigned old = xb_add(&bar[XB_XSUB(b.x)], 1u);
        const unsigned gen = old / nloc;
        if (old + 1u == (gen + 1u) * nloc) {
            __builtin_amdgcn_fence(__ATOMIC_RELEASE, "agent");
            asm volatile("s_waitcnt vmcnt(0)" ::: "memory");
            const unsigned og = xb_add(&bar[XB_TOP], 1u);
            const unsigned tg = og / nx;
            if (og + 1u == (tg + 1u) * nx) xb_add(&bar[XB_TOPGEN], 1u);
            else XB_SPIN(xb_ld(&bar[XB_TOPGEN]) == tg, bar);
            __builtin_amdgcn_fence(__ATOMIC_ACQUIRE, "agent");
            xb_add(&bar[XB_XGEN(b.x)], 1u);
            asm volatile("s_waitcnt vmcnt(0)" ::: "memory");
        } else {
            XB_SPIN(xb_ld(&bar[XB_XGEN(b.x)]) == gen, bar);
            __builtin_amdgcn_fence(__ATOMIC_ACQUIRE, "agent");
            asm volatile("s_waitcnt vmcnt(0)" ::: "memory");
        }
    }
    __syncthreads();
}

constexpr int NWAVES = 8;
constexpr int S = 16384, DM = 1024, NPROJ = 5632, NE = 32, MEML = 256;
constexpr int PC_FQ = 0, PC_FK = 384, PC_FV = 768, PC_DQ = 1152, PC_DK = 1536, PC_DV = 1920, PC_MQ = 2304, PC_GT = 2560;
constexpr int W_IN_LD = 5638, W_IN_F = 1152;
constexpr float LN_EPS = 1e-5f, ALPHA = 1.189207115002721f;
constexpr float LOG2E = 1.4426950408889634f, C2F = 0.125f * 1.4426950408889634f;
constexpr int MAXROWS = 65536 + 32 * 256;
constexpr int NPHASE = 11;
#ifndef MK_N_LAUNCHES
#define MK_N_LAUNCHES 1
#endif
constexpr int N_LAUNCHES = MK_N_LAUNCHES;

constexpr size_t MiB = 1u << 20, KiB = 1u << 10;
constexpr size_t WS_CTL = 0, CTL_ZERO_BYTES = 256 * KiB;
constexpr size_t WS_WIN = 2 * MiB;
constexpr size_t WS_WBF = 748 * MiB, WS_WBD = WS_WBF + 768 * KiB, WS_WBM = WS_WBD + 768 * KiB, WS_WOUT = 15 * MiB, WS_WMKV = 17 * MiB;
constexpr size_t WS_LF2 = 18 * MiB, WS_C2 = WS_LF2 + 512 * KiB, WS_LSE = 19 * MiB, WS_TBL = WS_LSE + 512 * KiB, WS_MEMB = 20 * MiB, WS_MEMKV = WS_MEMB + 512 * KiB;
constexpr size_t WS_TOPI = 21 * MiB, WS_TOPG = WS_TOPI + 256 * KiB, WS_RANK = WS_TOPG + 256 * KiB, WS_DEST = WS_RANK + 256 * KiB, WS_BLKCNT = 22 * MiB, WS_TST = WS_BLKCNT + 64 * KiB;
constexpr size_t WS_TOKROW = 23 * MiB;
constexpr size_t WS_IDMAP = 23 * MiB + 512 * KiB;
constexpr size_t WS_XB = 24 * MiB;
constexpr size_t WS_PBUF = 56 * MiB;
constexpr size_t WS_Y = WS_PBUF;
constexpr size_t WS_OFOX = 712 * MiB, WS_ODIL = 724 * MiB, WS_OMEM = 736 * MiB;
constexpr size_t WS_W1 = 264 * MiB, WS_W2 = 392 * MiB;
constexpr size_t WS_STASH = 456 * MiB, WS_MERGED = 520 * MiB;
constexpr size_t WS_R1 = 552 * MiB, WS_H1F8 = 616 * MiB, WS_XF8 = 632 * MiB, WS_WGF8 = 648 * MiB, WS_H1B = 680 * MiB;
constexpr int W1_SHIFT = 5;
constexpr size_t WS_XS = 712 * MiB, WS_ACT = 856 * MiB, WS_END = 1000 * MiB;
static_assert(WS_XS + (size_t)MAXROWS * 1024 * 2 <= WS_ACT && WS_ACT + (size_t)MAXROWS * 1024 * 2 <= WS_END && WS_Y + (size_t)MAXROWS * 1024 * 2 <= 232 * MiB && WS_WBM + 768 * KiB <= WS_ACT, "ws map");
constexpr int CW_BAR = 4096;
constexpr int CW_NRM = 64, CW_QHEAD = 128;
constexpr size_t WS_OPART = WS_STASH, WS_LSEF = WS_STASH + 48 * MiB;

constexpr int RING_OFF = 0;
constexpr int LDSCTL_OFF = attn_body::ATTN_LDS_BYTES, MISC_OFF = LDSCTL_OFF + 320, TBL_OFF = MISC_OFF + 128;
constexpr int LDS_BYTES = 150528;
static_assert(TBL_OFF + 256 <= LDS_BYTES && pg8::STAGE_BYTES <= LDSCTL_OFF, "LDS map");

struct Args { const float* in[20]; float* out; unsigned char* ws; int ph_lo, ph_hi, li, pad; };
struct Frame {
    LAS unsigned char* lds;
    volatile LAS unsigned* MISC;
    gu32* ctl;
    int tid, lane, wave;
    int vcu, G;
    float* out; unsigned char* ws;
};
__device__ __forceinline__ float wave_sum(float v) {
#pragma unroll
    for (int o = 1; o < 64; o <<= 1) v += __shfl_xor(v, o);
    return v;
}
typedef float f4u __attribute__((ext_vector_type(4), aligned(4)));
typedef float f32x2 __attribute__((ext_vector_type(2)));
typedef unsigned v2u __attribute__((ext_vector_type(2)));
__device__ __forceinline__ void p0_tr_item(const float* W, int ldw, int k0, int src_n0, bf16* WT, int K, int dst_n0, float scale, LAS float* scr, int lane) {
    f4u v[16];
#pragma unroll
    for (int i = 0; i < 16; ++i) v[i] = *(const f4u*)(W + (size_t)(k0 + 4 * i + (lane >> 4)) * ldw + src_n0 + (lane & 15) * 4);
#pragma unroll
    for (int i = 0; i < 16; ++i) { LAS float* d = scr + (4 * i + (lane >> 4)) * 65 + (lane & 15) * 4; d[0] = v[i].x * scale; d[1] = v[i].y * scale; d[2] = v[i].z * scale; d[3] = v[i].w * scale; }
    LDS_WAIT(); asm volatile("" ::: "memory");
    const int c = lane & 7;
#pragma unroll
    for (int j = 0; j < 8; ++j) { const int n = (lane >> 3) + 8 * j; const LAS float* s = scr + (8 * c) * 65 + n;
        v4u o; o.x = pk2(s[0 * 65], s[1 * 65]); o.y = pk2(s[2 * 65], s[3 * 65]); o.z = pk2(s[4 * 65], s[5 * 65]); o.w = pk2(s[6 * 65], s[7 * 65]);
        *(GAS v4u*)(WT + (size_t)(dst_n0 + n) * K + k0 + 8 * c) = o; }
    LDS_WAIT(); asm volatile("" ::: "memory");
}
constexpr int CV_E1 = 32 * 512, CV_E2 = 32 * 256, CV_UNITS = (CV_E1 + CV_E2) / 64;
struct CvItem { const float* W; bf16* WT; int ldw, k0, sn, dn, f8; };
__device__ __forceinline__ CvItem cv_decode(const Args& A, unsigned char* ws, int r) {
    CvItem c;
    if (r < CV_E1) { const int e = r >> 9, rr = r & 511, kb = rr >> 5, nb = rr & 31, dn = nb * 64; c.sn = ((dn >> 7) & 1) * 1024 + (dn >> 8) * 128 + (dn & 127); c.dn = dn; c.k0 = kb * 64; c.ldw = 2048;
        c.W = A.in[14] + (size_t)e * 1024 * 2048; c.WT = (bf16*)(ws + WS_W1 + (size_t)e * 2048 * 1024); c.f8 = 1 + W1_SHIFT; }
    else { r -= CV_E1; const int e = r >> 8, rr = r & 255, kb = rr >> 4, nb = rr & 15; c.sn = nb * 64; c.dn = nb * 64; c.k0 = kb * 64; c.ldw = 1024;
        c.W = A.in[16] + (size_t)e * 1024 * 1024; c.WT = (bf16*)(ws + WS_W2 + (size_t)e * 1024 * 1024); c.f8 = 1 + W1_SHIFT; }
    return c;
}
__device__ __forceinline__ void cv_load(f4u (&v)[16], const CvItem& c, int lane) {
#pragma unroll
    for (int i = 0; i < 16; ++i) v[i] = *(const f4u*)(c.W + (size_t)(c.k0 + 4 * i + (lane >> 4)) * c.ldw + c.sn + (lane & 15) * 4);
}
__device__ __forceinline__ void cv_store(const f4u (&v)[16], const CvItem& c, LAS float* scr, int lane) {
#pragma unroll
    for (int i = 0; i < 16; ++i) { LAS float* d = scr + (4 * i + (lane >> 4)) * 65 + (lane & 15) * 4; d[0] = v[i].x; d[1] = v[i].y; d[2] = v[i].z; d[3] = v[i].w; }
    LDS_WAIT(); asm volatile("" ::: "memory");
    const int cc = lane & 7;
#pragma unroll
    for (int j = 0; j < 8; ++j) { const int n = (lane >> 3) + 8 * j; const LAS float* sp = scr + (8 * cc) * 65 + n;
        v4u o; o.x = pk2(sp[0 * 65], sp[1 * 65]); o.y = pk2(sp[2 * 65], sp[3 * 65]); o.z = pk2(sp[4 * 65], sp[5 * 65]); o.w = pk2(sp[6 * 65], sp[7 * 65]);
        *(GAS v4u*)(c.WT + (size_t)(c.dn + n) * 1024 + c.k0 + 8 * cc) = o; }
    LDS_WAIT(); asm volatile("" ::: "memory");
}
__device__ __forceinline__ void cv_store_f8(const f4u (&v)[16], const CvItem& c, LAS float* scr, int lane) {
    const float sc = (float)(1 << (c.f8 - 1));
#pragma unroll
    for (int i = 0; i < 16; ++i) { LAS float* d = scr + (4 * i + (lane >> 4)) * 65 + (lane & 15) * 4; d[0] = v[i].x * sc; d[1] = v[i].y * sc; d[2] = v[i].z * sc; d[3] = v[i].w * sc; }
    LDS_WAIT(); asm volatile("" ::: "memory");
    const int cc = lane & 7; unsigned char* const WT8 = (unsigned char*)c.WT;
#pragma unroll
    for (int j = 0; j < 8; ++j) { const int n = (lane >> 3) + 8 * j; const LAS float* sp = scr + (8 * cc) * 65 + n;
        v2u o; o.x = pk4_fp8(sp[0 * 65], sp[1 * 65], sp[2 * 65], sp[3 * 65]); o.y = pk4_fp8(sp[4 * 65], sp[5 * 65], sp[6 * 65], sp[7 * 65]);
        *(GAS v2u*)(WT8 + (size_t)(c.dn + n) * 1024 + c.k0 + 8 * cc) = o; }
    LDS_WAIT(); asm volatile("" ::: "memory");
}
__device__ __forceinline__ void conv_unit(Frame& F, const Args& A, int cu) {
    LAS float* scr = (LAS float*)(F.lds + RING_OFF + F.wave * 16640);
    const int r0 = cu * 64 + F.wave * 8;
    f4u va[16], vb[16];
    CvItem ca = cv_decode(A, F.ws, r0), cb; cv_load(va, ca, F.lane);
#pragma unroll 1
    for (int i = 0; i < 8; i += 2) {
        cb = cv_decode(A, F.ws, r0 + i + 1); cv_load(vb, cb, F.lane);
        if (ca.f8) cv_store_f8(va, ca, scr, F.lane); else cv_store(va, ca, scr, F.lane);
        if (i + 2 < 8) { ca = cv_decode(A, F.ws, r0 + i + 2); cv_load(va, ca, F.lane); }
        if (cb.f8) cv_store_f8(vb, cb, scr, F.lane); else cv_store(vb, cb, scr, F.lane);
    }
}
__device__ __forceinline__ void p0_prologue(Frame& F, const Args& A) {
    LAS float* scr = (LAS float*)(F.lds + RING_OFF + F.wave * 16640);
    const int gw = F.vcu * NWAVES + F.wave, NGW = F.G * NWAVES;
    bf16* const WIN = (bf16*)(F.ws + WS_WIN); bf16* const WBF = (bf16*)(F.ws + WS_WBF); bf16* const WBD = (bf16*)(F.ws + WS_WBD); bf16* const WBM = (bf16*)(F.ws + WS_WBM);
    bf16* const WOUT = (bf16*)(F.ws + WS_WOUT); bf16* const WMKV = (bf16*)(F.ws + WS_WMKV);
    constexpr int I_IN = 16 * 88, I_BF = 6 * 16, I_BD = 6 * 16, I_BM = 4 * 16, I_WO = 16 * 16, I_MKV = 16 * 8;
    constexpr int NITEMS = I_IN + I_BF + I_BD + I_BM + I_WO + I_MKV;
    for (int it = gw; it < NITEMS; it += NGW) {
        int r = it;
        if (r < I_IN) { const int kb = r / 88, nb = r % 88, dn = nb * 64; const int sn = dn + (dn >= W_IN_F ? 6 : 0);
            const float sc = (dn < PC_FK || (dn >= PC_DQ && dn < PC_DK) || (dn >= PC_MQ && dn < PC_GT)) ? C2F : 1.0f;
            { CvItem c; c.W = A.in[2]; c.WT = (bf16*)(F.ws + WS_WGF8); c.ldw = W_IN_LD; c.k0 = kb * 64; c.sn = sn; c.dn = dn; c.f8 = 1 + 6;
              f4u v[16]; cv_load(v, c, F.lane);
              if (sc != 1.0f) {
#pragma unroll
                  for (int i = 0; i < 16; ++i) { v[i].x *= sc; v[i].y *= sc; v[i].z *= sc; v[i].w *= sc; } }
              cv_store_f8(v, c, scr, F.lane); }
            continue; } r -= I_IN;
        if (r < I_BF) { const int kb = r >> 4, nb = r & 15; p0_tr_item(A.in[6], 1024, kb * 64, nb * 64, WBF, 384, nb * 64, 1.0f, scr, F.lane); continue; } r -= I_BF;
        if (r < I_BD) { const int kb = r >> 4, nb = r & 15; p0_tr_item(A.in[7], 1024, kb * 64, nb * 64, WBD, 384, nb * 64, 1.0f, scr, F.lane); continue; } r -= I_BD;
        if (r < I_BM) { const int kb = r >> 4, nb = r & 15; p0_tr_item(A.in[8], 1024, kb * 64, nb * 64, WBM, 384, nb * 64, 1.0f, scr, F.lane); continue; } r -= I_BM;
        if (r < I_WO) { const int kb = r >> 4, nb = r & 15; p0_tr_item(A.in[9], 1024, kb * 64, nb * 64, WOUT, 1024, nb * 64, 1.0f, scr, F.lane); continue; } r -= I_WO;
        { const int kb = r >> 3, nb = r & 7; p0_tr_item(A.in[5], 512, kb * 64, nb * 64, WMKV, 1024, nb * 64, 1.0f, scr, F.lane); }
    }
    {
        float wf[4][4][6];
#pragma unroll
        for (int j = 0; j < 4; ++j)
#pragma unroll
            for (int i = 0; i < 4; ++i)
#pragma unroll
                for (int h = 0; h < 6; ++h) wf[j][i][h] = A.in[2][(size_t)(4 * F.lane + i + 256 * j) * W_IN_LD + W_IN_F + h];
        float* const LF2 = (float*)(F.ws + WS_LF2);
        f32x4 vnx[4];
        if (gw < S) { const GAS f32x4* xr0 = (const GAS f32x4*)(A.in[0] + (size_t)gw * DM) + F.lane;
#pragma unroll
            for (int j = 0; j < 4; ++j) vnx[j] = xr0[64 * j]; }
        for (int m = gw; m < S; m += NGW) {
            f32x4 v[4]; float d[6] = {0.f, 0.f, 0.f, 0.f, 0.f, 0.f};
#pragma unroll
            for (int j = 0; j < 4; ++j) v[j] = vnx[j];
            if (m + NGW < S) { const GAS f32x4* xr1 = (const GAS f32x4*)(A.in[0] + (size_t)(m + NGW) * DM) + F.lane;
#pragma unroll
                for (int j = 0; j < 4; ++j) vnx[j] = xr1[64 * j]; }
#pragma unroll
            for (int j = 0; j < 4; ++j)
#pragma unroll
                for (int h = 0; h < 6; ++h) d[h] += v[j].x * wf[j][0][h] + v[j].y * wf[j][1][h] + v[j].z * wf[j][2][h] + v[j].w * wf[j][3][h];
#pragma unroll
            for (int h = 0; h < 6; ++h) d[h] = wave_sum(d[h]);
            { GAS unsigned* o4 = (GAS unsigned*)(F.ws + WS_XF8 + (size_t)m * DM) + F.lane;
#pragma unroll
              for (int j = 0; j < 4; ++j) o4[64 * j] = pk4_fp8(v[j].x, v[j].y, v[j].z, v[j].w); }
            if (F.lane < 6) { const int h = F.lane; float f = h == 0 ? d[0] : h == 1 ? d[1] : h == 2 ? d[2] : h == 3 ? d[3] : h == 4 ? d[4] : d[5];
                f += A.in[3][h]; const float ls = fminf(f, 0.f) - log1pf(expf(-fabsf(f)));
                LF2[(size_t)h * S + m] = ls * LOG2E; }
        }
        bf16* const MEMB = (bf16*)(F.ws + WS_MEMB);
        for (int m = gw; m < MEML; m += NGW) {
            const GAS f32x4* xr = (const GAS f32x4*)(A.in[1] + (size_t)m * DM) + F.lane; GAS unsigned long long* o8 = (GAS unsigned long long*)(MEMB + (size_t)m * DM) + F.lane;
#pragma unroll
            for (int j = 0; j < 4; ++j) { const f32x4 v = xr[64 * j]; o8[64 * j] = (unsigned long long)pk2(v.x, v.y) | ((unsigned long long)pk2(v.z, v.w) << 32); }
        }
    }
    { const int gt = F.vcu * (NWAVES * 64) + F.tid, GT = F.G * NWAVES * 64; const v4u z = {0u, 0u, 0u, 0u};
      for (int i = gt; i < 1024 * 16; i += GT) *(GAS v4u*)((bf16*)(F.ws + WS_WBM) + (size_t)(i >> 4) * 384 + 256 + (i & 15) * 8) = z;
      for (int i = gt; i < S * 16; i += GT) *(GAS v4u*)((bf16*)(F.ws + WS_OMEM) + (size_t)(i >> 4) * 384 + 256 + (i & 15) * 8) = z; }
    {
        float* const TBL = (float*)(F.ws + WS_TBL);
        for (int idx = F.vcu * (NWAVES * 64) + F.tid; idx < 6 * attn_body::TBL_N; idx += F.G * NWAVES * 64) {
            const int hd = idx / attn_body::TBL_N, i = idx - hd * attn_body::TBL_N, rel = i - attn_body::TBL_ZERO, g = hd >> 1, dil = g == 0 ? 1 : (g == 1 ? 4 : 16);
            float val = -INFINITY;
            if (rel >= 0 && rel <= 128) { const int dist = rel * dil; int bucket = dist;
                if (dist >= 16) { const float nf = (float)dist; bucket = 16 + (int)(logf(nf / 16.0f) / 4.852030263919617f * 16.0f); bucket = bucket > 31 ? 31 : bucket; }
                val = A.in[4][bucket * 6 + hd] * LOG2E; }
            TBL[idx] = val;
        }
    }
}

__device__ __forceinline__ void p1_cumsum(Frame& F, int h) {
    const float* src = (const float*)(F.ws + WS_LF2) + (size_t)h * S + F.tid * 32; float* dst = (float*)(F.ws + WS_C2) + (size_t)h * S + F.tid * 32;
    LAS double* part = (LAS double*)(F.lds + RING_OFF);
    f32x4 v[8]; double s = 0.0;
#pragma unroll
    for (int i = 0; i < 8; ++i) { v[i] = *(const f32x4*)(src + 4 * i); s += (double)v[i].x; s += (double)v[i].y; s += (double)v[i].z; s += (double)v[i].w; }
    part[F.tid] = s; __syncthreads();
    double run = 0.0;
    for (int j = 0; j < F.tid; ++j) run += part[j];
#pragma unroll
    for (int i = 0; i < 8; ++i) { f32x4 o; run += (double)v[i].x; o.x = (float)run; run += (double)v[i].y; o.y = (float)run; run += (double)v[i].z; o.z = (float)run; run += (double)v[i].w; o.w = (float)run; *(f32x4*)(dst + 4 * i) = o; }
    __syncthreads();
}

constexpr int P2_NA = 600, P2_NB = 360, P2_NC = 384, P2_ND = 256, P2_UNITS = P2_NA + P2_NB + P2_NC + P2_ND;
__device__ __forceinline__ void p2_attention(Frame& F, const Args& A, char* lds, int li) {
    typedef attn_body::bf16 abf;
    abf* const PB = (abf*)(F.ws + WS_PBUF);
    volatile LAS int* qslot = (volatile LAS int*)(F.lds + MISC_OFF + 64);
    for (;;) {
        if (F.tid == 0) qslot[0] = (int)__hip_atomic_fetch_add(F.ctl + CW_QHEAD + 64 * li, 1u, __ATOMIC_RELAXED, __HIP_MEMORY_SCOPE_AGENT);
        __syncthreads();
        const int pos = __builtin_amdgcn_readfirstlane(qslot[0]);
        __syncthreads();
        if (pos >= P2_UNITS + CV_UNITS) break;
        if (pos % 4 == 3 && pos / 4 < CV_UNITS) { conv_unit(F, A, pos / 4); __syncthreads(); continue; }
        const int idx = pos - (pos / 4 < CV_UNITS ? pos / 4 : CV_UNITS);
        attn_body::AttnArgs a; a.tlo = 0; a.thi = 0; a.band = 0; a.thr = 0.f;
        if (idx < P2_NA + P2_NB) {
            int h, qb, sgm;
            if (idx < P2_NA) { h = idx % 6; const int b = idx / 6; if (b < 49) { sgm = 0; qb = 15 + b; } else if (b < 82) { sgm = 1; qb = 31 + (b - 49); } else if (b < 99) { sgm = 2; qb = 47 + (b - 82); } else { sgm = 3; qb = 63; } }
            else { const int b2 = idx - P2_NA; h = b2 % 6; const int c = b2 / 6; const int L = 60 - 4 * (c >> 2); sgm = c & 3; qb = 16 * sgm + L / 4 - 1; }
            const int ntf = 4 * qb + 4, nseg = (ntf + 63) >> 6;
            const float q2 = __uint_as_float(__hip_atomic_load(F.ctl + CW_NRM + 2 * h, RLX_AGENT)) + __uint_as_float(__hip_atomic_load(F.ctl + CW_NRM + 2 * h + 1, RLX_AGENT)), k2 = __uint_as_float(__hip_atomic_load(F.ctl + CW_NRM + 12 + 2 * h, RLX_AGENT)) + __uint_as_float(__hip_atomic_load(F.ctl + CW_NRM + 13 + 2 * h, RLX_AGENT));
            const float qkmax = 1.02f * sqrtf(q2 * k2);
            a.Q = PB + PC_FQ + h * 64; a.K = PB + PC_FK + h * 64; a.V = PB + PC_FV + h * 64; a.qp = NPROJ; a.kp = NPROJ; a.op = 384;
            a.q0 = qb * 256; a.NT = 0; a.kv0 = 0; a.aux = (const float*)(F.ws + WS_C2) + (size_t)h * S;
            a.tlo = 64 * sgm; a.thi = (a.tlo + 64 < ntf) ? a.tlo + 64 : ntf; a.band = (sgm == nseg - 1) ? 1 : 0;
            a.thr = 160.0f + 2.0f * qkmax;
            if (nseg == 1) { a.O = (abf*)(F.ws + WS_OFOX) + h * 64; a.lse = nullptr; a.lse_stride = 0; }
            else { a.O = (abf*)(F.ws + WS_OPART) + (size_t)sgm * S * 384 + h * 64; a.lse = (float*)(F.ws + WS_LSEF) + (size_t)sgm * S * 6 + h; a.lse_stride = 6; }
            attn_body::attn_unit<0, 8>(a, lds);
        } else if (idx < P2_NA + P2_NB + P2_NC) { const int du = idx - (P2_NA + P2_NB); const int g = du >> 7, hs = (du >> 6) & 1, w = du & 63; const int dl = g == 0 ? 1 : (g == 1 ? 4 : 16); const int r = w % dl, qb = w / dl, hd = g * 2 + hs;
            const int t0 = 4 * qb - 2 > 0 ? 4 * qb - 2 : 0; const long pitch = (long)dl * NPROJ;
            a.Q = PB + PC_DQ + hd * 64 + (long)r * NPROJ; a.K = PB + PC_DK + hd * 64 + (long)r * NPROJ + (long)t0 * 64 * pitch; a.V = PB + PC_DV + hd * 64 + (long)r * NPROJ + (long)t0 * 64 * pitch;
            a.O = (abf*)(F.ws + WS_ODIL) + hd * 64 + (long)r * 384; a.qp = pitch; a.kp = pitch; a.op = (long)dl * 384;
            a.q0 = qb * 256; a.NT = 4 * qb + 4 - t0; a.kv0 = t0 * 64; a.aux = (const float*)(F.ws + WS_TBL) + hd * attn_body::TBL_N; a.lse = (float*)(F.ws + WS_LSE) + r * 6 + hd; a.lse_stride = (long)dl * 6;
            attn_body::attn_unit<1, 8>(a, lds);
        } else { const int mu = idx - (P2_NA + P2_NB + P2_NC); const int h = mu >> 6, qb = mu & 63; abf* const MKV = (abf*)(F.ws + WS_MEMKV);
            a.Q = PB + PC_MQ + h * 64; a.K = MKV + h * 64; a.V = MKV + 256 + h * 64; a.O = (abf*)(F.ws + WS_OMEM) + h * 64; a.qp = NPROJ; a.kp = 512; a.op = 384;
            a.q0 = qb * 256; a.NT = 4; a.kv0 = 0; a.aux = nullptr; a.lse = nullptr; a.lse_stride = 0;
            attn_body::attn_unit<2, 8>(a, lds);
        }
    }
}
__device__ __forceinline__ void p3_fox_combine(Frame& F) {
    const float* LSEF = (const float*)(F.ws + WS_LSEF); const bf16* OP = (const bf16*)(F.ws + WS_OPART); bf16* const OF = (bf16*)(F.ws + WS_OFOX);
    for (int it = blockIdx.x * (NWAVES * 64) + F.tid; it < (S - 4096) * 48; it += F.G * NWAVES * 64) {
        const int tok = 4096 + it / 48, rem = it % 48, h = rem >> 3, ch = rem & 7, nseg = (tok >> 12) + 1;
        float l[4]; float mx = -INFINITY;
#pragma unroll
        for (int sg = 0; sg < 4; ++sg) { l[sg] = (sg < nseg) ? LSEF[((size_t)sg * S + tok) * 6 + h] : -INFINITY; mx = fmaxf(mx, l[sg]); }
        float acc[8] = {0.f, 0.f, 0.f, 0.f, 0.f, 0.f, 0.f, 0.f}; float den = 0.f;
#pragma unroll
        for (int sg = 0; sg < 4; ++sg) { const float w = __builtin_amdgcn_exp2f(l[sg] - mx);
            if (w > 0.f) { const v4u x = *(const v4u*)(OP + ((size_t)sg * S + tok) * 384 + h * 64 + ch * 8); den += w;
                acc[0] += w * __uint_as_float(x.x << 16); acc[1] += w * __uint_as_float(x.x & 0xffff0000u); acc[2] += w * __uint_as_float(x.y << 16); acc[3] += w * __uint_as_float(x.y & 0xffff0000u);
                acc[4] += w * __uint_as_float(x.z << 16); acc[5] += w * __uint_as_float(x.z & 0xffff0000u); acc[6] += w * __uint_as_float(x.w << 16); acc[7] += w * __uint_as_float(x.w & 0xffff0000u); } }
        const float inv = 1.0f / den; v4u o; o.x = pk2(acc[0] * inv, acc[1] * inv); o.y = pk2(acc[2] * inv, acc[3] * inv); o.z = pk2(acc[4] * inv, acc[5] * inv); o.w = pk2(acc[6] * inv, acc[7] * inv);
        *(v4u*)(OF + (size_t)tok * 384 + h * 64 + ch * 8) = o;
    }
}
__device__ __forceinline__ void p3_dil_weights(Frame& F) {
    const float* LSE = (const float*)(F.ws + WS_LSE); bf16* const OD = (bf16*)(F.ws + WS_ODIL);
    for (int it = blockIdx.x * (NWAVES * 64) + F.tid; it < S * 48; it += F.G * NWAVES * 64) {
        const int tok = it / 48, rem = it - tok * 48, hd = rem >> 3, ch = rem & 7, hs = hd & 1, g = hd >> 1;
        const float l0 = LSE[tok * 6 + hs], l1 = LSE[tok * 6 + 2 + hs], l2 = LSE[tok * 6 + 4 + hs];
        const float mx = fmaxf(l0, fmaxf(l1, l2)); const float e0 = __builtin_amdgcn_exp2f(l0 - mx), e1 = __builtin_amdgcn_exp2f(l1 - mx), e2 = __builtin_amdgcn_exp2f(l2 - mx);
        const float w = (g == 0 ? e0 : (g == 1 ? e1 : e2)) / (e0 + e1 + e2);
        v4u* p = (v4u*)(OD + (size_t)tok * 384 + hd * 64 + ch * 8); v4u x = *p;
        x.x = pk2(__uint_as_float(x.x << 16) * w, __uint_as_float(x.x & 0xffff0000u) * w); x.y = pk2(__uint_as_float(x.y << 16) * w, __uint_as_float(x.y & 0xffff0000u) * w);
        x.z = pk2(__uint_as_float(x.z << 16) * w, __uint_as_float(x.z & 0xffff0000u) * w); x.w = pk2(__uint_as_float(x.w << 16) * w, __uint_as_float(x.w & 0xffff0000u) * w);
        *p = x;
    }
}
typedef float f32x16m __attribute__((ext_vector_type(16)));
__device__ __forceinline__ void p6_ln_router(Frame& F, const Args& A) {
    LAS float* hl = (LAS float*)(F.lds + RING_OFF);
    LAS float* part = hl;
    LAS float* lgt = (LAS float*)(F.lds + RING_OFF + 32768);
    LAS int* se = (LAS int*)(F.lds + RING_OFF + 131328);
    const float* R1 = (const float*)(F.ws + WS_R1); bf16* const H1B = (bf16*)(F.ws + WS_H1B); unsigned char* const H1F8 = F.ws + WS_H1F8;
    int* const TOPI = (int*)(F.ws + WS_TOPI); float* const TOPG = (float*)(F.ws + WS_TOPG); int* const RANK = (int*)(F.ws + WS_RANK); int* const BLKCNT = (int*)(F.ws + WS_BLKCNT);
    const float* lg1 = A.in[10]; const float* lb1 = A.in[11]; const float* wr = A.in[12]; const float* br = A.in[13];
    float wreg[64];
    { const float* bp = wr + (size_t)(128 * F.wave + (F.lane >> 5)) * 32 + (F.lane & 31);
#pragma unroll
      for (int st = 0; st < 64; ++st) wreg[st] = bp[64 * st]; }
    for (int rb = blockIdx.x; rb < S / 64; rb += F.G) {
        for (int half = 0; half < 2; ++half) {
            f32x4 vr[4][4];
#pragma unroll
            for (int j = 0; j < 4; ++j)
#pragma unroll
                for (int q = 0; q < 4; ++q) vr[j][q] = *((const f32x4*)(R1 + ((size_t)rb * 64 + half * 32 + F.wave * 4 + j) * DM) + F.lane + 64 * q);
#pragma unroll
            for (int j = 0; j < 4; ++j) {
                const int lr = F.wave * 4 + j; const size_t row = (size_t)rb * 64 + half * 32 + lr;
                f32x4 v[4]; float s = 0.f;
#pragma unroll
                for (int q = 0; q < 4; ++q) { v[q] = vr[j][q]; s += (v[q].x + v[q].y) + (v[q].z + v[q].w); }
                const float mean = wave_sum(s) * (1.f / DM); float s2 = 0.f;
#pragma unroll
                for (int q = 0; q < 4; ++q) { v[q] = v[q] - mean; s2 += (v[q].x * v[q].x + v[q].y * v[q].y) + (v[q].z * v[q].z + v[q].w * v[q].w); }
                const float rstd = 1.f / sqrtf(wave_sum(s2) * (1.f / DM) + LN_EPS);
#pragma unroll
                for (int q = 0; q < 4; ++q) { const f32x4 gv = *((const f32x4*)lg1 + F.lane + 64 * q), bv = *((const f32x4*)lb1 + F.lane + 64 * q); const f32x4 h = v[q] * rstd * gv + bv;
                    *((v2u*)(H1B + row * DM) + F.lane + 64 * q) = (v2u){pk2(h.x, h.y), pk2(h.z, h.w)};
                    *((unsigned*)(H1F8 + row * DM) + F.lane + 64 * q) = pk4_fp8(h.x, h.y, h.z, h.w);
                    LAS float* d = hl + lr * 1025 + 4 * F.lane + 256 * q; d[0] = h.x; d[1] = h.y; d[2] = h.z; d[3] = h.w; }
            }
            __syncthreads();
            f32x16m acc = {0.f, 0.f, 0.f, 0.f, 0.f, 0.f, 0.f, 0.f, 0.f, 0.f, 0.f, 0.f, 0.f, 0.f, 0.f, 0.f};
            { const int kk = F.lane >> 5; const LAS float* ap = hl + (F.lane & 31) * 1025 + 128 * F.wave + kk;
#pragma unroll
              for (int st = 0; st < 64; ++st) acc = __builtin_amdgcn_mfma_f32_32x32x2f32(ap[2 * st], wreg[st], acc, 0, 0, 0); }
            __syncthreads();
            { const int kk = F.lane >> 5;
#pragma unroll
              for (int r = 0; r < 16; ++r) part[(F.wave * 32 + ((r & 3) + 8 * (r >> 2) + 4 * kk)) * 32 + (F.lane & 31)] = acc[r]; }
            __syncthreads();
#pragma unroll
            for (int q = 0; q < 2; ++q) { const int p = F.tid + 512 * q, i = p >> 5, jx = p & 31; float sm = 0.f;
#pragma unroll
                for (int w = 0; w < 8; ++w) sm += part[(w * 32 + i) * 32 + jx];
                lgt[i * 33 + jx] = sm + br[jx]; }
            __syncthreads();
            if (F.tid < 32) { const int i = F.tid; const size_t row = (size_t)rb * 64 + half * 32 + i; float bv[4]; int bi[4];
                unsigned taken = 0u;
#pragma unroll
                for (int kx = 0; kx < 4; ++kx) { float best = -INFINITY; int be = 0;
                    for (int e = 0; e < 32; ++e) { const float x = lgt[i * 33 + e]; const bool take = (((taken >> e) & 1u) == 0u) && (x > best); best = take ? x : best; be = take ? e : be; }
                    bv[kx] = best; bi[kx] = be; taken |= 1u << be; }
                const float e1 = expf(bv[1] - bv[0]), e2 = expf(bv[2] - bv[0]), e3 = expf(bv[3] - bv[0]); const float inv = 1.f / (1.f + e1 + e2 + e3);
                *(int4*)(TOPI + row * 4) = make_int4(bi[0], bi[1], bi[2], bi[3]); *(f32x4*)(TOPG + row * 4) = (f32x4){inv, e1 * inv, e2 * inv, e3 * inv};
                const int lrow = half * 32 + i; se[lrow * 4 + 0] = bi[0]; se[lrow * 4 + 1] = bi[1]; se[lrow * 4 + 2] = bi[2]; se[lrow * 4 + 3] = bi[3]; }
            __syncthreads();
        }
        if (F.tid < 256) { const int e = se[F.tid]; int rk = 0; for (int q = 0; q < F.tid; ++q) rk += (se[q] == e) ? 1 : 0; RANK[rb * 256 + F.tid] = rk; }
        else if (F.tid < 288) { const int e = F.tid - 256; int c = 0; for (int q = 0; q < 256; ++q) c += (se[q] == e) ? 1 : 0; BLKCNT[rb * 32 + e] = c; }
        __syncthreads();
    }
}
__device__ __forceinline__ void p7_scatter(Frame& F) {
    LAS int* ptot = (LAS int*)(F.lds + RING_OFF); LAS int* ppre = ptot + 512; LAS int* epre = ppre + 512; LAS int* tst = epre + 32; LAS int* dsts = tst + 64;
    const int* BLKCNT = (const int*)(F.ws + WS_BLKCNT); const int* TOPI = (const int*)(F.ws + WS_TOPI); const int* RANK = (const int*)(F.ws + WS_RANK);
    int* const DEST = (int*)(F.ws + WS_DEST); int* const TST = (int*)(F.ws + WS_TST); int* const TOKROW = (int*)(F.ws + WS_TOKROW);
    { int* const IDM = (int*)(F.ws + WS_IDMAP); for (int i = blockIdx.x * (NWAVES * 64) + F.tid; i < MAXROWS; i += F.G * NWAVES * 64) IDM[i] = i; }
    for (int rb = blockIdx.x; rb < S / 64; rb += F.G) {
        { const int part = F.tid >> 5, e = F.tid & 31; int tot = 0, pre = 0;
          for (int b = part * 16; b < part * 16 + 16; ++b) { const int c = BLKCNT[b * 32 + e]; tot += c; pre += (b < rb) ? c : 0; }
          ptot[part * 32 + e] = tot; ppre[part * 32 + e] = pre; }
        __syncthreads();
        if (F.tid < 32) { int T = 0, P = 0; for (int p = 0; p < 16; ++p) { T += ptot[p * 32 + F.tid]; P += ppre[p * 32 + F.tid]; } ptot[F.tid] = T; epre[F.tid] = P; }
        __syncthreads();
        if (F.tid == 0) { int t = 0; for (int e = 0; e < 32; ++e) { tst[e] = t; t += (ptot[e] + 255) >> 8; } tst[32] = t;
            if (rb == 0) { for (int e = 0; e <= 32; ++e) TST[e] = tst[e]; } }
        __syncthreads();
        if (F.tid < 256) { const size_t a = (size_t)rb * 256 + F.tid; const int e = TOPI[a]; const int d = tst[e] * 256 + epre[e] + RANK[a]; DEST[a] = d; TOKROW[d] = (int)(a >> 2); }
        if (rb == 0) { for (int e = 0; e < 32; ++e) { const int c = ptot[e], base = tst[e] * 256, padn = (tst[e + 1] - tst[e]) * 256 - c; for (int p = F.tid; p < padn; p += NWAVES * 64) TOKROW[base + c + p] = 0; } }
        __syncthreads();
    }
}
__device__ __forceinline__ void p10_combine(Frame& F, const Args& A) {
    const int gw = F.vcu * NWAVES + F.wave, NGW = F.G * NWAVES;
    const bf16* H1B = (const bf16*)(F.ws + WS_H1B); const bf16* Y = (const bf16*)(F.ws + WS_Y); const int* DEST = (const int*)(F.ws + WS_DEST); const float* TOPG = (const float*)(F.ws + WS_TOPG);
    const float* g2 = A.in[18]; const float* b2 = A.in[19];
    int4 ddn; f32x4 ggn; v2u hbn[4]; unsigned yn[4][4];
#define P10_LOAD_IDX(m_) do { ddn = *(const int4*)(DEST + (size_t)(m_) * 4); ggn = *(const f32x4*)(TOPG + (size_t)(m_) * 4); } while (0)
#define P10_LOAD_ROWS(m_) do { _Pragma("unroll") for (int j = 0; j < 4; ++j) hbn[j] = *((const v2u*)(H1B + (size_t)(m_) * DM) + F.lane + 64 * j); \
        _Pragma("unroll") for (int k = 0; k < 4; ++k) { const int d_ = k == 0 ? ddn.x : (k == 1 ? ddn.y : (k == 2 ? ddn.z : ddn.w)); \
            _Pragma("unroll") for (int j = 0; j < 4; ++j) yn[k][j] = *((const unsigned*)((const unsigned char*)Y + (size_t)d_ * DM) + F.lane + 64 * j); } } while (0)
    int m = gw; if (m >= S) return;
    P10_LOAD_IDX(m); P10_LOAD_ROWS(m);
    for (; m < S; m += NGW) {
        const f32x4 gg = ggn; f32x4 v[4]; float s = 0.f;
#pragma unroll
        for (int j = 0; j < 4; ++j) v[j] = (f32x4){__uint_as_float(hbn[j].x << 16), __uint_as_float(hbn[j].x & 0xffff0000u), __uint_as_float(hbn[j].y << 16), __uint_as_float(hbn[j].y & 0xffff0000u)} * ALPHA;
#pragma unroll
        for (int k = 0; k < 4; ++k) { const float g = k == 0 ? gg.x : (k == 1 ? gg.y : (k == 2 ? gg.z : gg.w));
#pragma unroll
            for (int j = 0; j < 4; ++j) { const unsigned y = yn[k][j]; typedef float f2_ __attribute__((ext_vector_type(2)));
                const f2_ lo = __builtin_amdgcn_cvt_pk_f32_fp8((int)y, false), hi = __builtin_amdgcn_cvt_pk_f32_fp8((int)y, true);
                v[j].x += g * lo.x; v[j].y += g * lo.y; v[j].z += g * hi.x; v[j].w += g * hi.y; } }
        const int mn = m + NGW;
        if (mn < S) { P10_LOAD_IDX(mn); P10_LOAD_ROWS(mn); }
#pragma unroll
        for (int j = 0; j < 4; ++j) s += (v[j].x + v[j].y) + (v[j].z + v[j].w);
        const float mean = wave_sum(s) * (1.f / DM); float s2 = 0.f;
#pragma unroll
        for (int j = 0; j < 4; ++j) { v[j] = v[j] - mean; s2 += (v[j].x * v[j].x + v[j].y * v[j].y) + (v[j].z * v[j].z + v[j].w * v[j].w); }
        const float rstd = 1.f / sqrtf(wave_sum(s2) * (1.f / DM) + LN_EPS);
#pragma unroll
        for (int j = 0; j < 4; ++j) { const f32x4 gv = *((const f32x4*)g2 + F.lane + 64 * j), bv = *((const f32x4*)b2 + F.lane + 64 * j);
            *((f32x4*)(F.out + (size_t)m * DM) + F.lane + 64 * j) = v[j] * rstd * gv + bv; }
    }
#undef P10_LOAD_IDX
#undef P10_LOAD_ROWS
}

__global__ void __launch_bounds__(NWAVES * 64, 2) mk_fwd(Args args) {
    extern __shared__ __attribute__((aligned(16))) unsigned char lds[];
    Frame F;
    F.lds = (LAS unsigned char*)lds;
    F.MISC = (volatile LAS unsigned*)(F.lds + MISC_OFF);
    F.tid = threadIdx.x; F.lane = F.tid & 63; F.wave = __builtin_amdgcn_readfirstlane(F.tid >> 6);
    F.G = gridDim.x; { const int bx = blockIdx.x; F.vcu = (F.G % 8 == 0) ? (bx % 8) * (F.G / 8) + bx / 8 : bx; }
    F.ws = args.ws; F.out = args.out; F.ctl = (gu32*)(args.ws + WS_CTL);
    unsigned char* const ws = args.ws;
    for (int u = F.tid; u < (LDS_BYTES - LDSCTL_OFF) / 4; u += NWAVES * 64) ((LAS unsigned*)(F.lds + LDSCTL_OFF))[u] = 0u;
    __syncthreads();
    XcdBarrier bar = xcd_barrier_post((unsigned*)(F.ctl + CW_BAR) + args.li * XCD_BAR_WORDS, F.MISC + 8);
#define GRID_BAR() xcd_barrier(bar)
    const int lo = args.ph_lo, hi = args.ph_hi;
#ifndef PHASE_MASK
#define PHASE_MASK 0x7ff
#endif
#define IN(k) (((PHASE_MASK >> (k)) & 1) && lo <= (k) && (k) < hi)
#define BOTH(k) (IN(k) && IN((k) + 1))
    typedef pg8::bf16_t pbf;
    pbf* const PBUF = (pbf*)(ws + WS_PBUF);

    if (IN(0)) { p0_prologue(F, args); if (BOTH(0)) GRID_BAR(); }

    if (IN(1)) {
        { pg8::Gemm g{(const pbf*)(ws + WS_XF8), (const pbf*)(ws + WS_WGF8), S, NPROJ, DM / 2, nullptr, 0x7C7C7C7C, 0x7C7C7C7C}; pg8::StaticOrder So; So.init(S, NPROJ, F.G, (int)blockIdx.x);
          pg8::EpiProj E{PBUF, NPROJ, PC_GT / 256, (unsigned*)(F.ctl + CW_NRM)};
          pg8::gemm_phase<pg8::EpiProj, pg8::StaticOrder, true, true, true, true>(F.lds + RING_OFF, g, So, E); }
        { pg8::Gemm g{(const pbf*)(ws + WS_MEMB), (const pbf*)(ws + WS_WMKV), MEML, 512, DM, nullptr, 0, 0}; pg8::StaticOrder So; So.init(MEML, 512, F.G, (int)((blockIdx.x + F.G / 2) % F.G));
          pg8::EpiBf16Plain E{(pbf*)(ws + WS_MEMKV), 512};
          pg8::gemm_phase<pg8::EpiBf16Plain, pg8::StaticOrder, true, true>(F.lds + RING_OFF, g, So, E); }
        if ((int)blockIdx.x >= F.G - 6) p1_cumsum(F, F.G - 1 - (int)blockIdx.x);
        if (BOTH(1)) GRID_BAR();
    }

    if (IN(2)) { p2_attention(F, args, (char*)lds + RING_OFF, args.li); if (BOTH(2)) GRID_BAR(); }

    if (IN(3)) { p3_fox_combine(F); p3_dil_weights(F); if (BOTH(3)) GRID_BAR(); }

    if (IN(4)) {
        pg8::Gemm g{(const pbf*)(ws + WS_OFOX), (const pbf*)(ws + WS_WBF), S, DM, 384, nullptr, 0, 0, (size_t)S * 384 * 2, (size_t)DM * 384 * 2};
        pg8::MergeOrder So; So.so.init(S, DM, F.G, (int)blockIdx.x);
        pg8::EpiMergeChain E{PBUF + PC_GT, NPROJ, (pbf*)(ws + WS_MERGED), DM};
        pg8::gemm_phase<pg8::EpiMergeChain, pg8::MergeOrder, true, true>(F.lds + RING_OFF, g, So, E);
        if (BOTH(4)) GRID_BAR();
    }

    if (IN(5)) {
        pg8::Gemm g{(const pbf*)(ws + WS_MERGED), (const pbf*)(ws + WS_WOUT), S, DM, DM, nullptr, 0, 0}; pg8::StaticOrder So; So.init(S, DM, F.G, (int)blockIdx.x);
        pg8::EpiRes E{args.in[0], (float*)(ws + WS_R1), DM, ALPHA};
        pg8::gemm_phase<pg8::EpiRes, pg8::StaticOrder, true, true>(F.lds + RING_OFF, g, So, E);
        if (BOTH(5)) GRID_BAR();
    }

    if (IN(6)) { p6_ln_router(F, args); if (BOTH(6)) GRID_BAR(); }

    if (IN(7)) { p7_scatter(F); if (BOTH(7)) GRID_BAR(); }

    if (IN(8)) {
        LAS int* tbl = (LAS int*)(F.lds + TBL_OFF);
        if (F.tid < 33) tbl[F.tid] = ((const int*)(ws + WS_TST))[F.tid];
        __syncthreads();
        pg8::Gemm g{(const pbf*)(ws + WS_H1F8), (const pbf*)(ws + WS_W1), MAXROWS, 2048, DM / 2, (const int*)(ws + WS_TOKROW), 0x7F7F7F7F, 0x7F7F7F7F}; pg8::MoeOrder So{tbl, 8, F.G, F.vcu};
        pg8::EpiSwiglu E{(pbf*)(ws + WS_ACT), args.in[15], 1.0f / (float)(1 << W1_SHIFT), (const LAS float*)(F.lds + RING_OFF + pg8::STAGE_BYTES + 5120)};
        pg8::gemm_phase<pg8::EpiSwiglu, pg8::MoeOrder, true, true, true, true>(F.lds + RING_OFF, g, So, E);
        if (BOTH(8)) GRID_BAR();
    }

    if (IN(9)) {
        LAS int* tbl = (LAS int*)(F.lds + TBL_OFF);
        if (F.tid < 33) tbl[F.tid] = ((const int*)(ws + WS_TST))[F.tid];
        __syncthreads();
        pg8::Gemm g{(const pbf*)(ws + WS_ACT), (const pbf*)(ws + WS_W2), MAXROWS, 1024, DM / 2, nullptr, 0x7F7F7F7F, 0x7F7F7F7F}; pg8::MoeOrder So{tbl, 4, F.G, F.vcu};
        pg8::EpiY E{(pbf*)(ws + WS_Y), args.in[17], 1.0f / (float)(1 << W1_SHIFT), (const LAS float*)(F.lds + RING_OFF + pg8::STAGE_BYTES + 5120)};
        pg8::gemm_phase<pg8::EpiY, pg8::MoeOrder, true, true, true, true>(F.lds + RING_OFF, g, So, E);
        if (BOTH(9)) GRID_BAR();
    }

    if (IN(10)) { p10_combine(F, args); }
#undef IN
#undef BOTH
#undef GRID_BAR
}

extern "C" void kernel_launch(void* const* d_in, const int* in_sizes, int n_in, void* d_out, int out_size, void* d_ws, size_t ws_size, hipStream_t stream) {
    static int grid = 0;
    if (grid == 0) {
        if (n_in != 20 || in_sizes[0] != S * DM || out_size != S * DM || ws_size < WS_END) { fprintf(stderr, "kernel_launch: built for 20 inputs, x/out of %d floats, >= %zu bytes of workspace; got n_in %d, in0 %d, out %d, ws %zu; nothing launched\n", S * DM, (size_t)WS_END, n_in, n_in > 0 ? in_sizes[0] : -1, out_size, ws_size); grid = -1; return; }
        int dev = 0, cus = 0, per_cu = 0;
        if (hipGetDevice(&dev) != hipSuccess || hipDeviceGetAttribute(&cus, hipDeviceAttributeMultiprocessorCount, dev) != hipSuccess) { fprintf(stderr, "kernel_launch: hipGetDevice / hipDeviceGetAttribute failed; nothing launched\n"); grid = -1; return; }
        if (hipFuncSetAttribute((const void*)mk_fwd, hipFuncAttributeMaxDynamicSharedMemorySize, LDS_BYTES) != hipSuccess) { fprintf(stderr, "kernel_launch: hipFuncSetAttribute failed (%d bytes of dynamic LDS); nothing launched\n", LDS_BYTES); grid = -1; return; }
        if (hipOccupancyMaxActiveBlocksPerMultiprocessor(&per_cu, (const void*)mk_fwd, NWAVES * 64, LDS_BYTES) != hipSuccess || per_cu < 1)
            fprintf(stderr, "kernel_launch: note: the occupancy query reports %d workgroups per CU\n", per_cu);
        (void)hipGetLastError();
        grid = cus;
    }
    if (grid < 0) return;
    if (hipMemsetAsync((char*)d_ws + WS_CTL, 0, CTL_ZERO_BYTES, stream) != hipSuccess) { fprintf(stderr, "kernel_launch: hipMemsetAsync of the control words failed; nothing launched\n"); return; }
    Args a{};
    for (int i = 0; i < 20; ++i) a.in[i] = (const float*)d_in[i];
    a.out = (float*)d_out; a.ws = (unsigned char*)d_ws;
#ifdef PROBE_PHASE
    const int nl = (PROBE_PHASE + 1 < NPHASE) ? 3 : 2; const int cut_lo[3] = {0, PROBE_PHASE, PROBE_PHASE + 1}, cut_hi[3] = {PROBE_PHASE + 1, PROBE_PHASE + 1, NPHASE};
#else
    const int nl = N_LAUNCHES; int cut_lo[NPHASE], cut_hi[NPHASE]; for (int i = 0; i < NPHASE; ++i) { cut_lo[i] = (N_LAUNCHES == 1) ? 0 : i; cut_hi[i] = (N_LAUNCHES == 1) ? NPHASE : i + 1; }
#endif
    for (int li = 0; li < nl; ++li) {
        a.ph_lo = cut_lo[li]; a.ph_hi = cut_hi[li]; a.li = li;
        hipLaunchKernelGGL(mk_fwd, dim3(grid), dim3(NWAVES * 64), LDS_BYTES, stream, a);
        const hipError_t le = hipPeekAtLastError();
        if (le != hipSuccess) { fprintf(stderr, "kernel_launch: launch %d failed: %s\n", li, hipGetErrorName(le)); break; }
    }
}
```

```cpp
#include <hip/hip_runtime.h>
#include <hip/hip_bf16.h>
#include <cstdio>
#include <cstdint>
#include <cmath>
namespace pg8 {
#define PG8_LAS __attribute__((address_space(3)))
typedef unsigned short bf16_t;
typedef short bf16x8 __attribute__((ext_vector_type(8)));
typedef float f32x4 __attribute__((ext_vector_type(4)));
typedef unsigned u32x4 __attribute__((ext_vector_type(4)));
constexpr int BM = 256, BK = 64, HALF = 128, HTB = HALF * BK * 2  , STAGE_BYTES = 8 * HTB, NXCD = 8, WGM = 8;

__host__ __device__ __forceinline__ int lds_byte(int r, int c) { const int st = (r >> 4) * 2 + (c >> 5), rr = r & 15, cc = c & 31, ob = rr * 64 + cc * 2; return st * 1024 + (ob ^ (((ob >> 9) & 1) << 5)); }
__host__ __device__ __forceinline__ void stage_rc(int b, int& R, int& C) { const int st = b / 1024, sb = b % 1024, swz = sb ^ (((sb >> 9) & 1) << 5); R = (st >> 1) * 16 + swz / 64; C = (st & 1) * 32 + (swz % 64) / 2; }
__host__ __device__ __forceinline__ int perm32(int rho) { const int n = rho >> 4, i = rho & 15; return 8 * (i >> 2) + 4 * n + (i & 3); }

struct Unit { int pm, pn, e, slot, b; };
typedef int v8i_t_half __attribute__((ext_vector_type(4)));
typedef int v8i_t __attribute__((ext_vector_type(8)));
typedef short s16x16_t __attribute__((ext_vector_type(16)));
struct Gemm { const bf16_t* A; const bf16_t* Bt; int M, N, K; const int* rowmap; int scale_a, scale_b; size_t strideA = 0, strideB = 0; };

struct StaticOrder {
    int nM, nN, nwg, G, c;
    __host__ __device__ void init(int M, int N, int G_, int c_) { nM = M / BM; nN = N / BM; nwg = nM * nN; G = G_; c = c_; }
    __host__ __device__ bool next(int i, Unit& u) const {
        const long L = (long)i * G + c; if (L >= nwg) return false;
        int wgid = (int)L; { const int q = nwg / NXCD, r = nwg % NXCD, xcd = wgid % NXCD, off = wgid / NXCD; wgid = (xcd < r ? xcd * (q + 1) : r * (q + 1) + (xcd - r) * q) + off; }
        const int nig = WGM * nN, gid = wgid / nig, fm = gid * WGM, gsz = (nM - fm) < WGM ? (nM - fm) : WGM;
        u.pm = fm + ((wgid % nig) % gsz); u.pn = (wgid % nig) / gsz; u.e = 0; u.b = 0; return true;
    }
    __device__ __forceinline__ void a_ready(const Unit&) const {}
    __device__ __forceinline__ void done(const Unit&) const {}
};

__device__ __forceinline__ unsigned cvt_pk_bf16(float lo, float hi) { unsigned r; asm volatile("v_cvt_pk_bf16_f32 %0, %1, %2" : "=v"(r) : "v"(lo), "v"(hi)); return r; }
__device__ __forceinline__ float bf_lo(unsigned w) { return __uint_as_float(w << 16); }
__device__ __forceinline__ float bf_hi(unsigned w) { return __uint_as_float(w & 0xffff0000u); }
__device__ __forceinline__ float sigmoid_f(float v) { return __builtin_amdgcn_rcpf(1.0f + __builtin_amdgcn_exp2f(-1.4426950408889634f * v)); }
typedef unsigned u32x2 __attribute__((ext_vector_type(2)));

struct EpiBf16Plain {
    static constexpr bool PERM = true, AFTER_DRAIN = false; static constexpr bool CHAIN = false; static constexpr bool LDS_BIAS = false;
    bf16_t* O; int ldc;
    __device__ __forceinline__ void operator()(const f32x4 (&acc)[2][2][4][2], const Unit& u, int wr, int wc, int fr, int fq) const {
        const int row0 = u.pm * BM + wr * 64 + fr, col0 = u.pn * BM + wc * 32 + 8 * fq;
#pragma unroll
        for (int ai = 0; ai < 2; ++ai)
#pragma unroll
            for (int m = 0; m < 4; ++m) { bf16_t* rowp = O + (size_t)(row0 + ai * HALF + m * 16) * ldc + col0;
#pragma unroll
                for (int bj = 0; bj < 2; ++bj) { const f32x4 v0 = acc[ai][bj][m][0], v1 = acc[ai][bj][m][1];
                    u32x4 w; w.x = cvt_pk_bf16(v0[0], v0[1]); w.y = cvt_pk_bf16(v0[2], v0[3]); w.z = cvt_pk_bf16(v1[0], v1[1]); w.w = cvt_pk_bf16(v1[2], v1[3]);
                    *(u32x4*)(rowp + bj * HALF) = w; } }
    }
};
struct EpiProj {
    static constexpr bool PERM = true, AFTER_DRAIN = false; static constexpr bool CHAIN = false; static constexpr bool LDS_BIAS = false;
    bf16_t* O; int ldc; int sig_from; unsigned* nrm;
    __device__ __forceinline__ void operator()(const f32x4 (&acc)[2][2][4][2], const Unit& u, int wr, int wc, int fr, int fq) const {
        const int row0 = u.pm * BM + wr * 64 + fr, col0 = u.pn * BM + wc * 32 + 8 * fq; const bool sg = u.pn >= sig_from;
        if (u.pn < 3) {
#pragma unroll
            for (int bj = 0; bj < 2; ++bj) { float mx = 0.f;
#pragma unroll
                for (int ai = 0; ai < 2; ++ai)
#pragma unroll
                    for (int m = 0; m < 4; ++m) { const f32x4 a0 = acc[ai][bj][m][0], a1 = acc[ai][bj][m][1];
                        float ss = (a0[0] * a0[0] + a0[1] * a0[1]) + (a0[2] * a0[2] + a0[3] * a0[3]) + (a1[0] * a1[0] + a1[1] * a1[1]) + (a1[2] * a1[2] + a1[3] * a1[3]);
                        ss += __shfl_xor(ss, 16); ss += __shfl_xor(ss, 32); mx = fmaxf(mx, ss); }
                mx = fmaxf(mx, __shfl_xor(mx, 1)); mx = fmaxf(mx, __shfl_xor(mx, 2)); mx = fmaxf(mx, __shfl_xor(mx, 4)); mx = fmaxf(mx, __shfl_xor(mx, 8));
                if (fr == 0 && fq == 0) atomicMax(nrm + u.pn * 8 + bj * 4 + wc, __float_as_uint(mx)); }
        }
#pragma unroll
        for (int ai = 0; ai < 2; ++ai)
#pragma unroll
            for (int m = 0; m < 4; ++m) { bf16_t* rowp = O + (size_t)(row0 + ai * HALF + m * 16) * ldc + col0;
#pragma unroll
                for (int bj = 0; bj < 2; ++bj) { f32x4 v0 = acc[ai][bj][m][0], v1 = acc[ai][bj][m][1];
                    if (sg) {
#pragma unroll
                        for (int j = 0; j < 4; ++j) { v0[j] = sigmoid_f(v0[j]); v1[j] = sigmoid_f(v1[j]); } }
                    u32x4 w; w.x = cvt_pk_bf16(v0[0], v0[1]); w.y = cvt_pk_bf16(v0[2], v0[3]); w.z = cvt_pk_bf16(v1[0], v1[1]); w.w = cvt_pk_bf16(v1[2], v1[3]);
                    *(u32x4*)(rowp + bj * HALF) = w; } }
    }
};
struct EpiGate {
    static constexpr bool PERM = true, AFTER_DRAIN = false; static constexpr bool CHAIN = false; static constexpr bool LDS_BIAS = false;
    bf16_t* O; int ldc; int col_off; float ascale;
    __device__ __forceinline__ void operator()(const f32x4 (&acc)[2][2][4][2], const Unit& u, int wr, int wc, int fr, int fq) const {
        const int row0 = u.pm * BM + wr * 64 + fr, col0 = col_off + u.pn * BM + wc * 32 + 8 * fq;
#pragma unroll
        for (int ai = 0; ai < 2; ++ai)
#pragma unroll
            for (int m = 0; m < 4; ++m) { bf16_t* rowp = O + (size_t)(row0 + ai * HALF + m * 16) * ldc + col0;
#pragma unroll
                for (int bj = 0; bj < 2; ++bj) { f32x4 v0 = acc[ai][bj][m][0] * ascale, v1 = acc[ai][bj][m][1] * ascale;
#pragma unroll
                    for (int j = 0; j < 4; ++j) { v0[j] = sigmoid_f(v0[j]); v1[j] = sigmoid_f(v1[j]); }
                    u32x4 w; w.x = cvt_pk_bf16(v0[0], v0[1]); w.y = cvt_pk_bf16(v0[2], v0[3]); w.z = cvt_pk_bf16(v1[0], v1[1]); w.w = cvt_pk_bf16(v1[2], v1[3]);
                    *(u32x4*)(rowp + bj * HALF) = w; } }
    }
};
template <int PASS> struct EpiMerge {
    static constexpr bool PERM = false, AFTER_DRAIN = false; static constexpr bool CHAIN = false; static constexpr bool LDS_BIAS = false;
    const bf16_t* gate; int ldg; bf16_t* stash; bf16_t* outb; int ldc;
    __device__ __forceinline__ void operator()(const f32x4 (&acc)[2][2][4][2], const Unit& u, int wr, int wc, int fr, int fq) const {
        const int row0 = u.pm * BM + wr * 64 + fr, col0 = u.pn * BM + wc * 32 + 4 * fq;
#pragma unroll
        for (int ai = 0; ai < 2; ++ai)
#pragma unroll
            for (int m = 0; m < 4; ++m) { const size_t r = (size_t)(row0 + ai * HALF + m * 16);
#pragma unroll
                for (int bj = 0; bj < 2; ++bj)
#pragma unroll
                    for (int n = 0; n < 2; ++n) { const int c = col0 + bj * HALF + n * 16;
                        const u32x2 gv = *(const u32x2*)(gate + r * ldg + c);
                        f32x4 v = acc[ai][bj][m][n]; v[0] *= bf_lo(gv.x); v[1] *= bf_hi(gv.x); v[2] *= bf_lo(gv.y); v[3] *= bf_hi(gv.y);
                        if (PASS > 0) { const u32x2 sv = *(const u32x2*)(stash + r * ldc + c); v[0] += bf_lo(sv.x); v[1] += bf_hi(sv.x); v[2] += bf_lo(sv.y); v[3] += bf_hi(sv.y); }
                        u32x2 w; w.x = cvt_pk_bf16(v[0], v[1]); w.y = cvt_pk_bf16(v[2], v[3]);
                        if (PASS < 2) *(u32x2*)(stash + r * ldc + c) = w; else *(u32x2*)(outb + r * ldc + c) = w; }
                asm volatile("" ::: "memory"); }
    }
};
struct EpiRes {
    static constexpr bool PERM = true, AFTER_DRAIN = false; static constexpr bool CHAIN = false; static constexpr bool LDS_BIAS = false;
    const float* x; bf16_t* out; int ldc; float alpha;
    __device__ __forceinline__ void operator()(const f32x4 (&acc)[2][2][4][2], const Unit& u, int wr, int wc, int fr, int fq) const {
        const int row0 = u.pm * BM + wr * 64 + fr, col0 = u.pn * BM + wc * 32 + 8 * fq;
#pragma unroll
        for (int ai = 0; ai < 2; ++ai)
#pragma unroll
            for (int m = 0; m < 4; ++m) { const size_t off = (size_t)(row0 + ai * HALF + m * 16) * ldc + col0;
#pragma unroll
                for (int bj = 0; bj < 2; ++bj) { const f32x4 x0 = *(const f32x4*)(x + off + bj * HALF), x1 = *(const f32x4*)(x + off + bj * HALF + 4);
                    const f32x4 v0 = x0 * alpha + acc[ai][bj][m][0], v1 = x1 * alpha + acc[ai][bj][m][1];
                    u32x4 w; w.x = cvt_pk_bf16(v0[0], v0[1]); w.y = cvt_pk_bf16(v0[2], v0[3]); w.z = cvt_pk_bf16(v1[0], v1[1]); w.w = cvt_pk_bf16(v1[2], v1[3]);
                    *(u32x4*)(out + off + bj * HALF) = w; } }
    }
};
struct EpiMergeChain {
    static constexpr bool PERM = true, AFTER_DRAIN = false; static constexpr bool LDS_BIAS = false; static constexpr bool CHAIN = true;
    const bf16_t* gate; int ldg; bf16_t* outb; int ldc;
    __device__ __forceinline__ void operator()(f32x4 (&acc)[2][2][4][2], const Unit& u, int wr, int wc, int fr, int fq) const {
        const int row0 = u.pm * BM + wr * 64 + fr, col0 = u.pn * BM + wc * 32 + 8 * fq; const int b = u.b;
#pragma unroll
        for (int ai = 0; ai < 2; ++ai)
#pragma unroll
            for (int m = 0; m < 4; ++m) { const size_t r = (size_t)(row0 + ai * HALF + m * 16);
#pragma unroll
                for (int bj = 0; bj < 2; ++bj) { const int c = col0 + bj * HALF;
                    const u32x4 gv = *(const u32x4*)(gate + r * ldg + b * 1024 + c);
                    f32x4 g0, g1; g0[0] = bf_lo(gv.x); g0[1] = bf_hi(gv.x); g0[2] = bf_lo(gv.y); g0[3] = bf_hi(gv.y); g1[0] = bf_lo(gv.z); g1[1] = bf_hi(gv.z); g1[2] = bf_lo(gv.w); g1[3] = bf_hi(gv.w);
                    if (b > 0) {
#pragma unroll
                        for (int j = 0; j < 4; ++j) { g0[j] = fmaxf(g0[j], 1e-6f); g1[j] = fmaxf(g1[j], 1e-6f); } }
                    f32x4 v0 = acc[ai][bj][m][0] * g0, v1 = acc[ai][bj][m][1] * g1;
                    if (b < 2) { const u32x4 gn = *(const u32x4*)(gate + r * ldg + (b + 1) * 1024 + c);
                        v0[0] *= __builtin_amdgcn_rcpf(fmaxf(bf_lo(gn.x), 1e-6f)); v0[1] *= __builtin_amdgcn_rcpf(fmaxf(bf_hi(gn.x), 1e-6f)); v0[2] *= __builtin_amdgcn_rcpf(fmaxf(bf_lo(gn.y), 1e-6f)); v0[3] *= __builtin_amdgcn_rcpf(fmaxf(bf_hi(gn.y), 1e-6f));
                        v1[0] *= __builtin_amdgcn_rcpf(fmaxf(bf_lo(gn.z), 1e-6f)); v1[1] *= __builtin_amdgcn_rcpf(fmaxf(bf_hi(gn.z), 1e-6f)); v1[2] *= __builtin_amdgcn_rcpf(fmaxf(bf_lo(gn.w), 1e-6f)); v1[3] *= __builtin_amdgcn_rcpf(fmaxf(bf_hi(gn.w), 1e-6f));
                        acc[ai][bj][m][0] = v0; acc[ai][bj][m][1] = v1; }
                    else { u32x4 w; w.x = cvt_pk_bf16(v0[0], v0[1]); w.y = cvt_pk_bf16(v0[2], v0[3]); w.z = cvt_pk_bf16(v1[0], v1[1]); w.w = cvt_pk_bf16(v1[2], v1[3]); *(u32x4*)(outb + r * ldc + c) = w; } }
                asm volatile("" ::: "memory"); }
    }
};
struct MergeOrder {
    StaticOrder so;
    __device__ __forceinline__ bool next(int i, Unit& u) const { if (!so.next(i / 3, u)) return false; u.b = i % 3; return true; }
    __device__ __forceinline__ void a_ready(const Unit&) const {}
    __device__ __forceinline__ void done(const Unit&) const {}
};
struct EpiSwiglu {
    static constexpr bool PERM = true, AFTER_DRAIN = false; static constexpr bool CHAIN = false;
    bf16_t* O; const float* b1; float ascale; const PG8_LAS float* lb;
    static constexpr bool LDS_BIAS = true;
    __device__ __forceinline__ const float* bias_src(const Unit& u, int lane) const { const int e = u.e, pnl = u.pn - e * 8; return b1 + (size_t)e * 2048 + (lane >> 5) * 1024 + pnl * 128 + (lane & 31) * 4; }
    __device__ __forceinline__ void operator()(const f32x4 (&acc)[2][2][4][2], const Unit& u, int wr, int wc, int fr, int fq) const {
        const int e = u.e, pnl = u.pn - e * 8; const int row0 = u.pm * BM + wr * 64 + fr;
        f32x4 bg[2], bl[2]; const PG8_LAS float* lbs = lb + u.slot * 256 + wc * 32 + 8 * fq;
#pragma unroll
        for (int n = 0; n < 2; ++n) { bg[n] = *(const PG8_LAS f32x4*)(lbs + 4 * n); bl[n] = *(const PG8_LAS f32x4*)(lbs + 128 + 4 * n); }
        unsigned char* const lanep = (unsigned char*)O + (size_t)(row0 + (fq & 1) * 16) * 1024 + pnl * 128 + wc * 32 + 8 * (fq & 2);
#pragma unroll
        for (int ai = 0; ai < 2; ++ai)
#pragma unroll
            for (int p = 0; p < 2; ++p) { u32x2 w[2];
#pragma unroll
                for (int q = 0; q < 2; ++q) { const int m = 2 * p + q; f32x4 o[2];
#pragma unroll
                    for (int n = 0; n < 2; ++n) { const f32x4 g = acc[ai][0][m][n] * ascale + bg[n], l = acc[ai][1][m][n] * ascale + bl[n];
#pragma unroll
                        for (int j = 0; j < 4; ++j) { const float gg = fminf(g[j], 7.0f), ll = fminf(fmaxf(l[j], -7.0f), 7.0f);
                            o[n][j] = gg * __builtin_amdgcn_rcpf(1.0f + __builtin_amdgcn_exp2f(-1.702f * 1.4426950408889634f * gg)) * (ll + 1.0f); } }
                    int t0 = __builtin_amdgcn_cvt_pk_fp8_f32(o[0][0], o[0][1], 0, false); t0 = __builtin_amdgcn_cvt_pk_fp8_f32(o[0][2], o[0][3], t0, true);
                    int t1 = __builtin_amdgcn_cvt_pk_fp8_f32(o[1][0], o[1][1], 0, false); t1 = __builtin_amdgcn_cvt_pk_fp8_f32(o[1][2], o[1][3], t1, true); w[q].x = (unsigned)t0; w[q].y = (unsigned)t1; }
                const auto r0 = __builtin_amdgcn_permlane16_swap(w[0].x, w[1].x, false, false), r1 = __builtin_amdgcn_permlane16_swap(w[0].y, w[1].y, false, false);
                u32x4 out; out.x = r0[0]; out.y = r1[0]; out.z = r0[1]; out.w = r1[1];
                *(u32x4*)(lanep + (size_t)(ai * HALF + p * 32) * 1024) = out; }
    }
};
struct EpiY {
    static constexpr bool PERM = true, PERM16 = true, AFTER_DRAIN = false; static constexpr bool CHAIN = false;
    bf16_t* O; const float* b2; float ascale; const PG8_LAS float* lb;
    static constexpr bool LDS_BIAS = true;
    __device__ __forceinline__ const float* bias_src(const Unit& u, int lane) const { const int e = u.e, pnl = u.pn - e * 4; return b2 + (size_t)e * 1024 + pnl * BM + lane * 4; }
    __device__ __forceinline__ void operator()(const f32x4 (&acc)[2][2][4][2], const Unit& u, int wr, int wc, int fr, int fq) const {
        const int e = u.e, pnl = u.pn - e * 4; const int row0 = u.pm * BM + wr * 64 + fr, col0 = pnl * BM + wc * 64 + 16 * fq;
        f32x4 bv[2][2]; const PG8_LAS float* lbs = lb + u.slot * 256 + wc * 64 + 16 * fq;
#pragma unroll
        for (int bj = 0; bj < 2; ++bj)
#pragma unroll
            for (int n = 0; n < 2; ++n) bv[bj][n] = *(const PG8_LAS f32x4*)(lbs + 8 * bj + 4 * n);
#pragma unroll
        for (int ai = 0; ai < 2; ++ai)
#pragma unroll
            for (int m = 0; m < 4; ++m) { unsigned char* rowp = (unsigned char*)O + (size_t)(row0 + ai * HALF + m * 16) * 1024 + col0;
                u32x4 w;
#pragma unroll
                for (int bj = 0; bj < 2; ++bj) { const f32x4 v0 = acc[ai][bj][m][0] * ascale + bv[bj][0], v1 = acc[ai][bj][m][1] * ascale + bv[bj][1];
                    int t0 = __builtin_amdgcn_cvt_pk_fp8_f32(v0[0], v0[1], 0, false); t0 = __builtin_amdgcn_cvt_pk_fp8_f32(v0[2], v0[3], t0, true);
                    int t1 = __builtin_amdgcn_cvt_pk_fp8_f32(v1[0], v1[1], 0, false); t1 = __builtin_amdgcn_cvt_pk_fp8_f32(v1[2], v1[3], t1, true);
                    if (bj == 0) { w.x = (unsigned)t0; w.y = (unsigned)t1; } else { w.z = (unsigned)t0; w.w = (unsigned)t1; } }
                *(u32x4*)rowp = w; }
    }
};
struct MoeOrder {
    const PG8_LAS int* tstart; int nN, G, vcu;
    __device__ __forceinline__ int ts(int k) const { return __builtin_amdgcn_readfirstlane(tstart[k]); }
    __device__ __forceinline__ bool next(int i, Unit& u) const {
        const int L = i * G + vcu; const int T = ts(32); if (L >= T * nN) return false;
        int e = 0;
#pragma unroll
        for (int k = 1; k < 32; ++k) e += (L >= ts(k) * nN) ? 1 : 0;
        const int t0 = ts(e), R = ts(e + 1) - t0; const int rem = L - t0 * nN; const int ng = rem / (4 * R); const int r2 = rem - ng * 4 * R; const int pnl = r2 / R; const int pmi = r2 - pnl * R;
        u.pm = t0 + pmi; u.pn = e * nN + ng * 4 + pnl; u.e = e; u.b = 0; return true;
    }
    __device__ __forceinline__ void a_ready(const Unit&) const {}
    __device__ __forceinline__ void done(const Unit&) const {}
};
template <class E, class = void> struct has_p16 { static constexpr bool v = false; };
template <class E> struct has_p16<E, decltype((void)E::PERM16)> { static constexpr bool v = E::PERM16; };
template <class Epi, class Sched, bool ALIGN_EPI = false, bool SP2 = false, bool GATHER = false, bool FP8 = false>
__device__ __forceinline__ void gemm_phase(PG8_LAS unsigned char* lds, const Gemm g, const Sched& S, const Epi& E) {
    static_assert(!GATHER || SP2, "GATHER is wired into the SP2 loop only");
    int tid_ = threadIdx.x; asm volatile("" : "+v"(tid_));
    const int tid = tid_, wid = __builtin_amdgcn_readfirstlane(tid >> 6), lane = tid & 63, wr = wid >> 2, wc = wid & 3, fr = lane & 15, fq = lane >> 4;
    int K_ = g.K; asm volatile("" : "+s"(K_));
    const int K = K_, nt = K / BK;
    constexpr bool P16 = has_p16<Epi>::v;
    unsigned voffA[2], voffB[2];
#pragma unroll
    for (int i = 0; i < 2; ++i) { int R, C; stage_rc(tid * 16 + i * 8192, R, C); const int Rb = P16 ? ((R >> 5) * 64 + 16 * ((R & 15) >> 2) + 4 * ((R >> 4) & 1) + (R & 3)) : Epi::PERM ? ((R & ~31) + perm32(R & 31)) : R;
        voffA[i] = (unsigned)(R * K + C) * 2u; voffB[i] = (unsigned)(Rb * K + C) * 2u; }
    unsigned vC[2][2] = {{0u, 0u}, {0u, 0u}};
    const PG8_LAS int* const rowlds = (const PG8_LAS int*)(lds + STAGE_BYTES + 4096);
#define PG8_ROWS(dst, pm_) do { if constexpr (GATHER) { _Pragma("unroll") for (int h_ = 0; h_ < 2; ++h_) _Pragma("unroll") for (int i_ = 0; i_ < 2; ++i_) { int R_, C_; stage_rc(tid * 16 + i_ * 8192, R_, C_); \
        const int ix_ = (pm_) * BM + h_ * HALF + R_; dst[h_][i_] = ((g.rowmap ? (unsigned)g.rowmap[ix_] : (unsigned)ix_) * (unsigned)K + (unsigned)C_) * 2u; } } } while (0)
#define PG8_ROWS_LDS(dst) do { _Pragma("unroll") for (int h_ = 0; h_ < 2; ++h_) _Pragma("unroll") for (int i_ = 0; i_ < 2; ++i_) { int R_, C_; stage_rc(tid * 16 + i_ * 8192, R_, C_); \
        dst[h_][i_] = ((unsigned)rowlds[h_ * HALF + R_] * (unsigned)K + (unsigned)C_) * 2u; } } while (0)
    const size_t kstep = (size_t)(BK * 2);
    const size_t hstep = (size_t)HALF * K * 2;
    const size_t b64step = (size_t)64 * K * 2;
    const size_t hB = P16 ? (size_t)8 * K * 2 : hstep, b64B = P16 ? 2 * b64step : b64step;
    const size_t hA = GATHER ? (size_t)0 : hstep;
    const size_t tstep = 2 * hstep;
    const unsigned ldsw = (unsigned)wid * 1024u;
    const int aoff = lds_byte(wr * 64 + fr, fq * 8), boff = lds_byte(wc * 32 + fr, fq * 8);
#define PG8_SA(b, h) (((b) * 2 + (h)) * HTB)
#define PG8_SB(b, h) ((4 + (b) * 2 + (h)) * HTB)
#define PG8_STAGE(bufoff, gbase, voff) do { if constexpr (true) { const bool isB_ = ((const void*)(voff) == (const void*)voffB), isA_ = ((const void*)(voff) == (const void*)voffA); _Pragma("unroll") for (int _i = 0; _i < 2; ++_i) \
        __builtin_amdgcn_global_load_lds((const unsigned*)((const char*)(gbase) + (isB_ ? (size_t)_i * b64B : isA_ ? (size_t)_i * b64step : (size_t)0) + (isB_ ? voffB[0] : (isA_ ? voffA[0] : (voff)[_i]))), (PG8_LAS unsigned*)(lds + (bufoff) + ldsw + _i * 8192), 16, 0, 0); } } while (0)
#define PG8_LD16(off) (*(const PG8_LAS v8i_t_half*)(lds + (off)))
#define PG8_LDA(dst, b, h) do { if constexpr (FP8) { _Pragma("unroll") for (int m = 0; m < 4; ++m) dst##8[m] = __builtin_shufflevector(__builtin_bit_cast(v8i_t_half, *(const PG8_LAS bf16x8*)(lds + PG8_SA(b, h) + aoff + m * 2048)), __builtin_bit_cast(v8i_t_half, *(const PG8_LAS bf16x8*)(lds + PG8_SA(b, h) + aoff + m * 2048 + 1024)), 0, 1, 2, 3, 4, 5, 6, 7); } \
        else { _Pragma("unroll") for (int m = 0; m < 4; ++m) _Pragma("unroll") for (int k = 0; k < 2; ++k) dst[m][k] = *(const PG8_LAS bf16x8*)(lds + PG8_SA(b, h) + aoff + m * 2048 + k * 1024); } } while (0)
#define PG8_LDB(dst, b, h) do { if constexpr (FP8) { _Pragma("unroll") for (int n = 0; n < 2; ++n) dst##8[n] = __builtin_shufflevector(__builtin_bit_cast(v8i_t_half, *(const PG8_LAS bf16x8*)(lds + PG8_SB(b, h) + boff + n * 2048)), __builtin_bit_cast(v8i_t_half, *(const PG8_LAS bf16x8*)(lds + PG8_SB(b, h) + boff + n * 2048 + 1024)), 0, 1, 2, 3, 4, 5, 6, 7); } \
        else { _Pragma("unroll") for (int n = 0; n < 2; ++n) _Pragma("unroll") for (int k = 0; k < 2; ++k) dst[n][k] = *(const PG8_LAS bf16x8*)(lds + PG8_SB(b, h) + boff + n * 2048 + k * 1024); } } while (0)
#define PG8_MMA(ai, bj, At, Bt) do { __builtin_amdgcn_s_setprio(1); _Pragma("unroll") for (int m = 0; m < 4; ++m) _Pragma("unroll") for (int n = 0; n < 2; ++n) { \
        if constexpr (FP8) acc[ai][bj][m][n] = __builtin_amdgcn_mfma_scale_f32_16x16x128_f8f6f4(Bt##8[n], At##8[m], acc[ai][bj][m][n], 0, 0, 0, g.scale_a, 0, g.scale_a); \
        else { _Pragma("unroll") for (int k = 0; k < 2; ++k) acc[ai][bj][m][n] = __builtin_amdgcn_mfma_f32_16x16x32_bf16(Bt[n][k], At[m][k], acc[ai][bj][m][n], 0, 0, 0); } } __builtin_amdgcn_s_setprio(0); } while (0)
#define PG8_WAIT_V(n) asm volatile("s_waitcnt vmcnt(" #n ")" ::: "memory")
#define PG8_WAIT_L(n) asm volatile("s_waitcnt lgkmcnt(" #n ")" ::: "memory")
#define PG8_BAR __builtin_amdgcn_s_barrier()
#define PG8_SCHED __builtin_amdgcn_sched_barrier(0)
    Unit cur, nxt; int ui = 0;
    if (!S.next(0, cur)) return;
    cur.slot = 0;
    f32x4 acc[2][2][4][2];
#pragma unroll
    for (int a = 0; a < 2; ++a)
#pragma unroll
        for (int b = 0; b < 2; ++b)
#pragma unroll
            for (int m = 0; m < 4; ++m)
#pragma unroll
                for (int n = 0; n < 2; ++n) acc[a][b][m][n] = (f32x4){0.f, 0.f, 0.f, 0.f};
    bf16x8 At[4][2], B0[2][2], B1[2][2]; v8i_t At8[4], B08[2], B18[2];
    const char* cA = (const char*)g.A + (GATHER ? (size_t)0 : (size_t)cur.pm * tstep + (size_t)cur.b * g.strideA); const char* cB = (const char*)g.Bt + (size_t)cur.pn * tstep + (size_t)cur.b * g.strideB;
    PG8_ROWS(vC, cur.pm);
    S.a_ready(cur);
    if constexpr (SP2) {
        PG8_STAGE(PG8_SB(0, 0), cB, voffB); PG8_STAGE(PG8_SB(0, 1), cB + hB, voffB); PG8_STAGE(PG8_SA(0, 0), cA, (GATHER ? vC[0] : voffA)); PG8_STAGE(PG8_SA(0, 1), cA + hA, (GATHER ? vC[1] : voffA));
        if (wr == 1) PG8_BAR;
        PG8_WAIT_V(2); PG8_BAR;
        PG8_STAGE(PG8_SB(1, 0), cB + kstep, voffB); PG8_STAGE(PG8_SA(1, 0), cA + kstep, (GATHER ? vC[0] : voffA)); PG8_STAGE(PG8_SB(1, 1), cB + hB + kstep, voffB);
        PG8_WAIT_V(6); PG8_BAR;
    } else {
        PG8_STAGE(PG8_SB(0, 0), cB, voffB); PG8_STAGE(PG8_SA(0, 0), cA, voffA); PG8_STAGE(PG8_SB(0, 1), cB + hB, voffB); PG8_STAGE(PG8_SA(0, 1), cA + hstep, voffA);
        if (wr == 1) PG8_BAR;
        PG8_WAIT_V(4); PG8_BAR;
        PG8_STAGE(PG8_SB(1, 0), cB + kstep, voffB); PG8_STAGE(PG8_SA(1, 0), cA + kstep, voffA); PG8_STAGE(PG8_SB(1, 1), cB + hB + kstep, voffB);
        PG8_WAIT_V(6); PG8_BAR;
    }
    for (;;) {
        const bool has_next = S.next(ui + 1, nxt); nxt.slot = (ui + 1) & 1;
        if constexpr (Epi::LDS_BIAS) { if (wid == 0) __builtin_amdgcn_global_load_lds((const unsigned*)E.bias_src(cur, lane), (PG8_LAS unsigned*)(lds + STAGE_BYTES + 5120 + cur.slot * 1024), 16, 0, 0); }
        const char* nA = (has_next && !GATHER) ? (const char*)g.A + (size_t)nxt.pm * tstep + (size_t)nxt.b * g.strideA : cA; const char* nB = has_next ? (const char*)g.Bt + (size_t)nxt.pn * tstep + (size_t)nxt.b * g.strideB : cB;
        if constexpr (GATHER) { if (g.rowmap && wid == 0) { const int np_ = has_next ? nxt.pm : cur.pm;
            __builtin_amdgcn_global_load_lds((const unsigned*)(g.rowmap + (size_t)np_ * BM + lane * 4), (PG8_LAS unsigned*)(lds + STAGE_BYTES + 4096), 16, 0, 0); } }
        for (int t = 0; t < nt; t += 2) {
            const bool last = (t == nt - 2);
            const char* a1 = cA + (size_t)(t + 1) * kstep;
            const char* a2 = last ? nA : cA + (size_t)(t + 2) * kstep; const char* b2 = last ? nB : cB + (size_t)(t + 2) * kstep;
            const char* a3 = a2 + kstep; const char* b3 = b2 + kstep;
            if (last && has_next) S.a_ready(nxt);
            if constexpr (SP2) {
            PG8_LDB(B0, 0, 0); PG8_LDB(B1, 0, 1); PG8_SCHED; PG8_LDA(At, 0, 0); PG8_STAGE(PG8_SA(1, 1), a1 + hA, (GATHER ? vC[1] : voffA));
            if constexpr (GATHER) { if (last) { if (g.rowmap) PG8_ROWS_LDS(vC); else { const int np_ = has_next ? nxt.pm : cur.pm; PG8_ROWS(vC, np_); } } }
            PG8_WAIT_V(8); PG8_WAIT_L(0); PG8_BAR; PG8_MMA(0, 0, At, B0); PG8_MMA(0, 1, At, B1); PG8_BAR; PG8_SCHED;
            PG8_LDA(At, 0, 1); PG8_STAGE(PG8_SB(0, 0), b2, voffB); PG8_STAGE(PG8_SB(0, 1), b2 + hB, voffB); PG8_STAGE(PG8_SA(0, 0), a2, (GATHER ? vC[0] : voffA));
            PG8_WAIT_V(8); PG8_WAIT_L(0); PG8_BAR; PG8_MMA(1, 0, At, B0); PG8_MMA(1, 1, At, B1); PG8_BAR; PG8_SCHED;
            PG8_LDB(B0, 1, 0); PG8_LDB(B1, 1, 1); PG8_SCHED; PG8_LDA(At, 1, 0); PG8_STAGE(PG8_SA(0, 1), a2 + hA, (GATHER ? vC[1] : voffA));
            PG8_WAIT_V(8); PG8_WAIT_L(0); PG8_BAR; PG8_MMA(0, 0, At, B0); PG8_MMA(0, 1, At, B1); PG8_BAR; PG8_SCHED;
            PG8_LDA(At, 1, 1); PG8_STAGE(PG8_SB(1, 0), b3, voffB); PG8_STAGE(PG8_SB(1, 1), b3 + hB, voffB); PG8_STAGE(PG8_SA(1, 0), a3, (GATHER ? vC[0] : voffA));
            PG8_WAIT_V(8); PG8_WAIT_L(0); PG8_BAR; PG8_MMA(1, 0, At, B0); PG8_MMA(1, 1, At, B1); PG8_BAR; PG8_SCHED;
            } else {
            PG8_LDB(B0, 0, 0); PG8_SCHED; PG8_LDA(At, 0, 0); PG8_STAGE(PG8_SA(1, 1), a1 + hstep, voffA);
            PG8_WAIT_L(8); PG8_BAR; PG8_WAIT_L(0); PG8_MMA(0, 0, At, B0); PG8_BAR; PG8_SCHED;
            PG8_LDB(B1, 0, 1); PG8_STAGE(PG8_SB(0, 0), b2, voffB);
            PG8_BAR; PG8_WAIT_L(0); PG8_MMA(0, 1, At, B1); PG8_BAR;
            PG8_LDA(At, 0, 1); PG8_STAGE(PG8_SA(0, 0), a2, voffA);
            PG8_BAR; PG8_WAIT_L(0); PG8_MMA(1, 0, At, B0); PG8_BAR; PG8_SCHED;
            PG8_STAGE(PG8_SB(0, 1), b2 + hB, voffB);
            PG8_WAIT_V(6); PG8_BAR; PG8_MMA(1, 1, At, B1); PG8_BAR;
            PG8_LDB(B0, 1, 0); PG8_SCHED; PG8_LDA(At, 1, 0); PG8_STAGE(PG8_SA(0, 1), a2 + hstep, voffA);
            PG8_WAIT_L(8); PG8_BAR; PG8_WAIT_L(0); PG8_MMA(0, 0, At, B0); PG8_BAR; PG8_SCHED;
            PG8_LDB(B1, 1, 1); PG8_STAGE(PG8_SB(1, 0), b3, voffB);
            PG8_BAR; PG8_WAIT_L(0); PG8_MMA(0, 1, At, B1); PG8_BAR;
            PG8_LDA(At, 1, 1); PG8_STAGE(PG8_SA(1, 0), a3, voffA);
            PG8_BAR; PG8_WAIT_L(0); PG8_MMA(1, 0, At, B0); PG8_BAR; PG8_SCHED;
            PG8_STAGE(PG8_SB(1, 1), b3 + hB, voffB);
            PG8_WAIT_V(6); PG8_BAR; PG8_MMA(1, 1, At, B1); PG8_BAR;
            }
        }
        if constexpr (ALIGN_EPI) { if (wr == 0) PG8_BAR; }
        if constexpr (!Epi::AFTER_DRAIN) { int t2_ = threadIdx.x; asm volatile("" : "+v"(t2_)); E(acc, cur, wr, wc, t2_ & 15, (t2_ & 63) >> 4); S.done(cur); }
        if (!has_next) break;
        if (!(Epi::CHAIN && cur.b < 2)) {
#pragma unroll
        for (int a = 0; a < 2; ++a)
#pragma unroll
            for (int b = 0; b < 2; ++b)
#pragma unroll
                for (int m = 0; m < 4; ++m)
#pragma unroll
                    for (int n = 0; n < 2; ++n) acc[a][b][m][n] = (f32x4){0.f, 0.f, 0.f, 0.f};
        }
        cur = nxt; cA = nA; cB = nB; ++ui;
        if constexpr (ALIGN_EPI) { if (wr == 1) PG8_BAR; }
    }
    PG8_WAIT_V(0);
    if constexpr (!ALIGN_EPI) { if (wr == 0) PG8_BAR; }
    PG8_BAR;
    if constexpr (Epi::AFTER_DRAIN) { E.fused(acc, cur, wr, wc, fr, fq, lds, wid, lane); S.done(cur); }
#undef PG8_ROWS
#undef PG8_ROWS_LDS
#undef PG8_SA
#undef PG8_SB
#undef PG8_STAGE
#undef PG8_LDA
#undef PG8_LDB
#undef PG8_MMA
#undef PG8_LD16
#undef PG8_WAIT_V
#undef PG8_WAIT_L
#undef PG8_BAR
#undef PG8_SCHED
}
}
namespace attn_body {
using bf16=__hip_bfloat16;
using bf16x8=__attribute__((ext_vector_type(8)))short;
using s16x4=__attribute__((ext_vector_type(4)))short;
using f32x16=__attribute__((ext_vector_type(16)))float;
using f32x4v=__attribute__((ext_vector_type(4)))float;
using u32x4=__attribute__((ext_vector_type(4)))unsigned;
constexpr int D=64;
constexpr int NW=8,QBLK=32,QB=QBLK*NW,KVBLK=64;
__device__ __forceinline__ int crow(int r,int hi){return (r&3)+8*(r>>2)+4*hi;}
#define SBAR() __builtin_amdgcn_sched_barrier(0)
__device__ __forceinline__ void cmask(f32x16&p0,f32x16&p1,int jb,int qrel,int hi){
  const float NEG=-INFINITY; int kb=64*jb+4*hi;
  #pragma unroll
  for(int r=0;r<16;++r){int kv=kb+(r&3)+8*(r>>2); if(kv>qrel)p0[r]=NEG; if(kv+32>qrel)p1[r]=NEG;}
}

constexpr int NSLOT=3, SLOTB=8192;
constexpr int LDS_K=0, LDS_V=NSLOT*SLOTB, LDS_WS=2*NSLOT*SLOTB, LDS_OST=LDS_WS+NW*64*4, LDS_BYTES=LDS_OST+NW*4096;
constexpr int LDS_CS=LDS_BYTES, CS_BYTES=65536, LDS_TOTAL=LDS_CS+CS_BYTES;
constexpr int TBL_N=640, TBL_ZERO=256;
__device__ __forceinline__ void glds16(const void*gsrc,unsigned lds_dst){unsigned keep;
  asm volatile("s_mov_b32 %0, m0\n\ts_mov_b32 m0, %2\n\ts_nop 0\n\tglobal_load_lds_dwordx4 %1, off\n\ts_mov_b32 m0, %0":"=&s"(keep):"v"(gsrc),"s"(lds_dst):"memory");}
__device__ __forceinline__ float max3f(float a,float b,float c){float r;asm("v_max3_f32 %0, %1, %2, %3":"=v"(r):"v"(a),"v"(b),"v"(c));return r;}
__device__ __forceinline__ float max2f(float a,float b){float r;asm("v_max_f32_e32 %0, %1, %2":"=v"(r):"v"(a),"v"(b));return r;}
__device__ __forceinline__ float fadd_s(float a,float b){float r;asm("v_add_f32_e32 %0, %1, %2":"=v"(r):"v"(a),"v"(b));return r;}
__device__ __forceinline__ float fsub_s(float a,float b){float r;asm("v_sub_f32_e32 %0, %1, %2":"=v"(r):"v"(a),"v"(b));return r;}
typedef float f32x2_t __attribute__((ext_vector_type(2))); typedef __bf16 bf16x2_t __attribute__((ext_vector_type(2)));
__device__ __forceinline__ unsigned cvtpk_s(float lo,float hi){f32x2_t v={lo,hi};bf16x2_t b=__builtin_convertvector(v,bf16x2_t);return __builtin_bit_cast(unsigned,b);}
#define WAIT_BAR(N) asm volatile("s_waitcnt vmcnt(" #N ") lgkmcnt(0)\n\ts_barrier":::"memory")

__device__ __forceinline__ void qkt(f32x16&p0,f32x16&p1,const char*Kslot,const bf16x8*qr,int r32,int hi){
  const char*kb=Kslot+hi*1024+r32*16;
  #pragma unroll
  for(int d0=0;d0<4;++d0){
    const bf16x8 b0=*reinterpret_cast<const bf16x8*>(kb+d0*2048);
    const bf16x8 b1=*reinterpret_cast<const bf16x8*>(kb+d0*2048+512);
    p0=__builtin_amdgcn_mfma_f32_32x32x16_bf16(b0,qr[d0],p0,0,0,0);p1=__builtin_amdgcn_mfma_f32_32x32x16_bf16(b1,qr[d0],p1,0,0,0);}
}
typedef __attribute__((address_space(3))) const char* lds_cptr;
typedef __attribute__((address_space(3))) char* lds_ptr;
typedef short v4i16_t __attribute__((ext_vector_type(4)));
__device__ __forceinline__ void kload8(bf16x8*kf,lds_cptr kp){
  kf[0]=*(const __attribute__((address_space(3))) bf16x8*)(kp);      kf[1]=*(const __attribute__((address_space(3))) bf16x8*)(kp+512);
  kf[2]=*(const __attribute__((address_space(3))) bf16x8*)(kp+2048); kf[3]=*(const __attribute__((address_space(3))) bf16x8*)(kp+2560);
  kf[4]=*(const __attribute__((address_space(3))) bf16x8*)(kp+4096); kf[5]=*(const __attribute__((address_space(3))) bf16x8*)(kp+4608);
  kf[6]=*(const __attribute__((address_space(3))) bf16x8*)(kp+6144); kf[7]=*(const __attribute__((address_space(3))) bf16x8*)(kp+6656);
}
__device__ __forceinline__ void kload2(bf16x8*kf,lds_cptr kp,int j){ kf[2*j]=*(const __attribute__((address_space(3))) bf16x8*)(kp+j*2048); kf[2*j+1]=*(const __attribute__((address_space(3))) bf16x8*)(kp+j*2048+512); }
__device__ __forceinline__ s16x4 vtr(lds_cptr p){ return __builtin_bit_cast(s16x4,__builtin_amdgcn_ds_read_tr16_b64_v4i16((__attribute__((address_space(3))) v4i16_t*)p)); }
__device__ __forceinline__ float rowmax(const f32x16&p0,const f32x16&p1){
  float a=max3f(p0[0],p0[1],p1[0]),b=max3f(p0[2],p0[3],p1[1]);a=max3f(a,p1[2],p1[3]);
  #pragma unroll
  for(int r=4;r<16;r+=4){a=max3f(a,p0[r],p0[r+1]);b=max3f(b,p0[r+2],p0[r+3]);a=max3f(a,p1[r],p1[r+1]);b=max3f(b,p1[r+2],p1[r+3]);}
  const float m=max2f(a,b);
  auto rr=__builtin_amdgcn_permlane32_swap(__float_as_uint(m),__float_as_uint(m),false,false);
  return max2f(__uint_as_float(rr[0]),__uint_as_float(rr[1]));
}
__device__ __forceinline__ void pv(f32x16*o,int vb,bf16x8 pa0,bf16x8 pa1,bf16x8 pa2,bf16x8 pa3){
  #pragma unroll
  for(int d0=0;d0<2;++d0){s16x4 lo[4],hi[4];
    #pragma unroll
    for(int ks=0;ks<4;++ks){
      asm volatile("ds_read_b64_tr_b16 %0,%1 offset:%c2":"=&v"(lo[ks]):"v"(vb),"i"(d0*4096+ks*1024):"memory");
      asm volatile("ds_read_b64_tr_b16 %0,%1 offset:%c2":"=&v"(hi[ks]):"v"(vb),"i"(d0*4096+ks*1024+512):"memory");}
    asm volatile("s_waitcnt lgkmcnt(0)":::"memory");SBAR();
    #define PK(k) (bf16x8){lo[k][0],lo[k][1],lo[k][2],lo[k][3],hi[k][0],hi[k][1],hi[k][2],hi[k][3]}
    o[d0]=__builtin_amdgcn_mfma_f32_32x32x16_bf16(pa0,PK(0),o[d0],0,0,0);
    o[d0]=__builtin_amdgcn_mfma_f32_32x32x16_bf16(pa1,PK(1),o[d0],0,0,0);
    o[d0]=__builtin_amdgcn_mfma_f32_32x32x16_bf16(pa2,PK(2),o[d0],0,0,0);
    o[d0]=__builtin_amdgcn_mfma_f32_32x32x16_bf16(pa3,PK(3),o[d0],0,0,0);
    #undef PK
  }
}

struct AttnArgs { const bf16* Q; const bf16* K; const bf16* V; bf16* O; long qp, kp, op; int q0, NT, kv0; const float* aux; float* lse; long lse_stride; int tlo, thi, band; float thr; };
#define ATTN_STORE16(p,v) (*(u32x4*)(p)=(v))
template<int MODE,int THRL> __device__ __forceinline__ void attn_unit(const AttnArgs&a,char*shm){
  int tid_=threadIdx.x; asm volatile("":"+v"(tid_));
  const int tid=tid_,lane=tid&63,r32=lane&31,hi=lane>>5; const int wid=__builtin_amdgcn_readfirstlane(tid>>6);
  const int q0=a.q0; const long KP=a.kp;
  const bf16*Qw=a.Q+(long)(q0+wid*QBLK)*a.qp;
  const bf16*Kh=a.K,*Vh=a.V;
  int NT=a.NT, lo=0;
  if(MODE==0){
    const int nt0=a.thi-a.tlo; const float cq=a.aux[q0];
    const float ck=(lane<nt0)?a.aux[64*(a.tlo+lane)+63]:0.f;
    const unsigned long long need=__ballot((lane<nt0)&&(cq-ck>=-a.thr));
    const int j0=need?(int)__builtin_ctzll(need):nt0;
    if(j0>=nt0){ if(a.lse&&tid<QB)a.lse[(long)(q0+tid)*a.lse_stride]=-INFINITY; return; }
    lo=a.tlo+j0; int n=a.thi-lo; if(n<4){lo=a.thi-4;n=4;} if(n&1){lo-=1;n+=1;} NT=n;
    Kh+=(long)lo*KVBLK*KP; Vh+=(long)lo*KVBLK*KP;
  }
  const unsigned lds0=(unsigned)(uintptr_t)shm;
  float*wsf=(float*)(shm+LDS_WS)+wid*64;
  const lds_cptr shm3=(lds_cptr)shm;
  const __attribute__((address_space(3))) float* cs3=(const __attribute__((address_space(3))) float*)(shm3+LDS_CS);
  float nb=0.f;
  if(MODE==0){ __attribute__((address_space(3))) f32x4v* dst=(__attribute__((address_space(3))) f32x4v*)((lds_ptr)shm+LDS_CS); const f32x4v* src=(const f32x4v*)a.aux+16*lo; const int n4=16*NT;
    for(int i=tid;i<n4;i+=NW*64)dst[i]=src[i];
    nb=a.aux[q0+wid*QBLK+r32]; }
  if(MODE==1){ __attribute__((address_space(3))) float* dst=(__attribute__((address_space(3))) float*)((lds_ptr)shm+LDS_CS);
    for(int i=tid;i<TBL_N;i+=NW*64)dst[i]=a.aux[i]; }
  const bf16*ksrc=Kh+(long)lane*KP+wid*8;
  const bf16*vsrc=Vh+(long)(16*(wid&3)+(lane>>2))*KP+(wid>>2)*32+(lane&3)*8;
  const unsigned kdst=lds0+LDS_K+wid*1024, vdst=lds0+LDS_V+wid*1024;
  #define DMA_K(t,slot) glds16(ksrc+(long)(t)*KVBLK*KP,(unsigned)__builtin_amdgcn_readfirstlane(kdst+(slot)))
  #define DMA_V(t,slot) glds16(vsrc+(long)(t)*KVBLK*KP,(unsigned)__builtin_amdgcn_readfirstlane(vdst+(slot)))
  const int vb0=(int)(lds0+LDS_V)+((lane>>4)&1)*32+(lane&3)*8+(4*hi+((lane&15)>>2))*64;
  const char*Kbase=shm+LDS_K; bf16x8 kf[8];
  const lds_cptr kp0=shm3+LDS_K+hi*1024+r32*16; const lds_cptr vp0=shm3+LDS_V+((lane>>4)&1)*32+(lane&3)*8+(4*hi+((lane&15)>>2))*64;
  DMA_K(0,0);DMA_V(0,0);DMA_K(1,SLOTB);
  bf16x8 qr[4];
  #pragma unroll
  for(int d0=0;d0<4;++d0)qr[d0]=*reinterpret_cast<const bf16x8*>(&Qw[(long)r32*a.qp+d0*16+hi*8]);
  float mhat=0.f,l_reg=0.f;f32x16 o[2];o[0]=f32x16{};o[1]=f32x16{};
  const int qrel=wid*QBLK+r32;
  const int tb0=q0+qrel-a.kv0-4*hi+TBL_ZERO-63;
  #define CINIT(C0,C1,t) do{ \
    if(MODE==0){ const __attribute__((address_space(3))) float* cp_=cs3+64*(t)+4*hi; \
      _Pragma("unroll") for(int g_=0;g_<4;++g_){ const f32x4v a_=*(const __attribute__((address_space(3))) f32x4v*)(cp_+8*g_); const f32x4v b_=*(const __attribute__((address_space(3))) f32x4v*)(cp_+32+8*g_); \
        C0[4*g_]=nb-a_[0];C0[4*g_+1]=nb-a_[1];C0[4*g_+2]=nb-a_[2];C0[4*g_+3]=nb-a_[3]; C1[4*g_]=nb-b_[0];C1[4*g_+1]=nb-b_[1];C1[4*g_+2]=nb-b_[2];C1[4*g_+3]=nb-b_[3]; } } \
    else if(MODE==1){ const __attribute__((address_space(3))) float* tp_=cs3+(tb0-64*(t)); \
      _Pragma("unroll") for(int g_=0;g_<4;++g_) _Pragma("unroll") for(int j_=0;j_<4;++j_){ C0[4*g_+j_]=nb+tp_[63-8*g_-j_]; C1[4*g_+j_]=nb+tp_[31-8*g_-j_]; } } \
    else { _Pragma("unroll") for(int r_=0;r_<16;++r_){C0[r_]=nb;C1[r_]=nb;} } }while(0)
  #define CMASK(P0,P1,t) do{ if(MODE==0&&a.band){int jb_=(t)-(NT-4); if(jb_>=0)cmask(P0,P1,jb_,qrel,hi);} }while(0)
  bool resc=false;
  #define START(P0,P1) do{ const float rm=rowmax(P0,P1); resc=false; \
    { const float dl=(MODE==1)?max2f(rm,-256.0f):rm; mhat=fadd_s(mhat,dl); nb=fsub_s(nb,dl); \
      _Pragma("unroll") for(int r=0;r<16;++r){P0[r]=fsub_s(P0[r],dl);P1[r]=fsub_s(P1[r],dl);} } \
    _Pragma("unroll") for(int r=0;r<16;++r)P0[r]=__builtin_amdgcn_exp2f(P0[r]); }while(0)
  #define RESC() do{ if(resc){ asm volatile("s_waitcnt lgkmcnt(0)":::"memory"); \
      _Pragma("unroll") for(int d_=0;d_<2;++d_) _Pragma("unroll") for(int r=0;r<16;++r)o[d_][r]*=wsf[crow(r,hi)]; } }while(0)
  f32x16 pA0,pA1,pB0,pB1;
  int sl_prev=0,sl_cur=0,sl_next=SLOTB;
  #define ROT() do{sl_prev=sl_cur;sl_cur=sl_next;sl_next=(sl_next==(NSLOT-1)*SLOTB)?0:sl_next+SLOTB;}while(0)
  DMA_K(2,2*SLOTB);
  WAIT_BAR(3);
  CINIT(pA0,pA1,0);
  qkt(pA0,pA1,Kbase,qr,r32,hi);asm volatile("s_nop 15\n\ts_nop 7":"+v"(pA0),"+v"(pA1));CMASK(pA0,pA1,0);
  START(pA0,pA1);
  _Pragma("unroll") for(int r=0;r<16;++r)pA1[r]=__builtin_amdgcn_exp2f(pA1[r]);
  WAIT_BAR(0);
  DMA_K(3,0);DMA_V(1,SLOTB);
  ROT();
  kload8(kf,kp0+sl_cur);
  WAIT_BAR(2);
  s16x4 vlo[8],vhi[8]; u32x4 pw0,pw1,pw2,pw3;
  #define PKW(P,B) cvtpk_s(P[B],P[B+1])
  #define PAF(k) __builtin_bit_cast(bf16x8,pw##k)
  #define VFR(i) (bf16x8){vlo[i][0],vlo[i][1],vlo[i][2],vlo[i][3],vhi[i][0],vhi[i][1],vhi[i][2],vhi[i][3]}
  #define PIN(x) asm volatile("":"+v"(x))
  #define MX3(a,b,c) __builtin_fmaxf(__builtin_fmaxf((a),(b)),(c))
  #define GAPA(MF,A0,A1,A2,A3,W0,W1,PW) do{ MF; sacc+=A0; sacc+=A1; sacc+=A2; sacc+=A3; PIN(sacc); W0; W1; PIN(PW); SBAR(); }while(0)
  #define EX(v) __builtin_amdgcn_exp2f(v)
  #define GAPB(MF,X,B) do{ MF; X[B]=EX(X[B]); X[B+1]=EX(X[B+1]); X[B+2]=EX(X[B+2]); X[B+3]=EX(X[B+3]); PIN(X); SBAR(); }while(0)
  #define VRD(i) do{ vlo[i]=vtr(vp_+(((i)>>2)*4096+((i)&3)*1024)); vhi[i]=vtr(vp_+(((i)>>2)*4096+((i)&3)*1024+512)); }while(0)
  #define KRD(G,j) do{ if(G){ kload2(kf,kp0+sl_next,j); SBAR(); } }while(0)
  #define STEP(C0,C1,P0,P1,t,GK,GV,GL) do{ CINIT(C0,C1,t); SBAR(); \
    const lds_cptr vp_=vp0+sl_prev; \
    VRD(0); SBAR(); float sacc=(P0[0]+P0[1]); \
    GAPA(C0=__builtin_amdgcn_mfma_f32_32x32x16_bf16(kf[0],qr[0],C0,0,0,0), P0[2],P0[3],P0[4],P0[5],     pw0[0]=PKW(P0,0), pw0[1]=PKW(P0,2), pw0); \
    VRD(4); SBAR(); GAPA(C1=__builtin_amdgcn_mfma_f32_32x32x16_bf16(kf[1],qr[0],C1,0,0,0), P0[6],P0[7],P0[8],P0[9],     pw0[2]=PKW(P0,4), pw0[3]=PKW(P0,6), pw0); \
    VRD(1); SBAR(); GAPA(C0=__builtin_amdgcn_mfma_f32_32x32x16_bf16(kf[2],qr[1],C0,0,0,0),   P0[10],P0[11],P0[12],P0[13], pw1[0]=PKW(P0,8), pw1[1]=PKW(P0,10), pw1); \
    VRD(5); SBAR(); GAPA(C1=__builtin_amdgcn_mfma_f32_32x32x16_bf16(kf[3],qr[1],C1,0,0,0),   P0[14],P0[15],P1[0],P1[1],   pw1[2]=PKW(P0,12),pw1[3]=PKW(P0,14), pw1); \
    VRD(2); SBAR(); GAPA(C0=__builtin_amdgcn_mfma_f32_32x32x16_bf16(kf[4],qr[2],C0,0,0,0),   P1[2],P1[3],P1[4],P1[5],     pw2[0]=PKW(P1,0), pw2[1]=PKW(P1,2), pw2); \
    VRD(6); SBAR(); GAPA(C1=__builtin_amdgcn_mfma_f32_32x32x16_bf16(kf[5],qr[2],C1,0,0,0),   P1[6],P1[7],P1[8],P1[9],     pw2[2]=PKW(P1,4), pw2[3]=PKW(P1,6), pw2); \
    VRD(3); SBAR(); GAPA(C0=__builtin_amdgcn_mfma_f32_32x32x16_bf16(kf[6],qr[3],C0,0,0,0),   P1[10],P1[11],P1[12],P1[13], pw3[0]=PKW(P1,8), pw3[1]=PKW(P1,10), pw3); \
    VRD(7); SBAR(); GAPA(C1=__builtin_amdgcn_mfma_f32_32x32x16_bf16(kf[7],qr[3],C1,0,0,0),   P1[14],P1[15],0.f,0.f,       pw3[2]=PKW(P1,12),pw3[3]=PKW(P1,14), pw3); \
    l_reg+=sacc; \
    if(GK){DMA_K((t)+3,sl_cur);} if(GV){DMA_V((t)+1,sl_next);} \
    CMASK(C0,C1,t); \
    { float a=MX3(C0[0],C0[1],C1[0]),b=MX3(C0[2],C0[3],C1[1]); a=MX3(a,C1[2],C1[3]); \
      _Pragma("unroll") for(int r=4;r<16;r+=4){a=MX3(a,C0[r],C0[r+1]);b=MX3(b,C0[r+2],C0[r+3]);a=MX3(a,C1[r],C1[r+1]);b=MX3(b,C1[r+2],C1[r+3]);} \
      float rm=__builtin_fmaxf(a,b); { auto rr=__builtin_amdgcn_permlane32_swap(__float_as_uint(rm),__float_as_uint(rm),false,false); rm=__builtin_fmaxf(__uint_as_float(rr[0]),__uint_as_float(rr[1])); } \
      resc=false; \
      if(__builtin_expect(__any(rm>(float)THRL),0)){ const float dl=__builtin_fmaxf(rm,0.f); mhat+=dl; nb-=dl; \
        _Pragma("unroll") for(int r=0;r<16;++r){C0[r]-=dl;C1[r]-=dl;} \
        const float f=__builtin_amdgcn_exp2f(-dl); l_reg*=f; if(hi==0)wsf[r32]=f; resc=true; } } \
    SBAR(); \
    GAPB(o[0]=__builtin_amdgcn_mfma_f32_32x32x16_bf16(PAF(0),VFR(0),o[0],0,0,0), C0,0); \
    GAPB(o[1]=__builtin_amdgcn_mfma_f32_32x32x16_bf16(PAF(0),VFR(4),o[1],0,0,0), C0,4); \
    KRD(GL,0); GAPB(o[0]=__builtin_amdgcn_mfma_f32_32x32x16_bf16(PAF(1),VFR(1),o[0],0,0,0), C0,8); \
    KRD(GL,1); GAPB(o[1]=__builtin_amdgcn_mfma_f32_32x32x16_bf16(PAF(1),VFR(5),o[1],0,0,0), C0,12); \
    KRD(GL,2); GAPB(o[0]=__builtin_amdgcn_mfma_f32_32x32x16_bf16(PAF(2),VFR(2),o[0],0,0,0), C1,0); \
    KRD(GL,3); GAPB(o[1]=__builtin_amdgcn_mfma_f32_32x32x16_bf16(PAF(2),VFR(6),o[1],0,0,0), C1,4); \
    GAPB(o[0]=__builtin_amdgcn_mfma_f32_32x32x16_bf16(PAF(3),VFR(3),o[0],0,0,0), C1,8); \
    GAPB(o[1]=__builtin_amdgcn_mfma_f32_32x32x16_bf16(PAF(3),VFR(7),o[1],0,0,0), C1,12); \
    }while(0)
  int t=1;
  #undef CMASK
  #define CMASK(P0,P1,t) do{}while(0)
  for(;t+5<NT;t+=2){
    STEP(pB0,pB1,pA0,pA1,t,true,true,true);     WAIT_BAR(2); RESC(); ROT();
    STEP(pA0,pA1,pB0,pB1,t+1,true,true,true);   WAIT_BAR(2); RESC(); ROT();
  }
  #undef CMASK
  #define CMASK(P0,P1,t) do{ if(MODE==0&&a.band){int jb_=(t)-(NT-4); if(jb_>=0)cmask(P0,P1,jb_,qrel,hi);} }while(0)
  #define ENDW(tt) do{ if((tt)+3<NT){WAIT_BAR(2);} else if((tt)+2<NT){WAIT_BAR(1);} else {WAIT_BAR(0);} }while(0)
  for(;t+1<NT;t+=2){
    STEP(pB0,pB1,pA0,pA1,t,(t+3<NT),(t+1<NT),(t+1<NT));       ENDW(t);   RESC(); ROT();
    STEP(pA0,pA1,pB0,pB1,t+1,(t+4<NT),(t+2<NT),(t+2<NT));     ENDW(t+1); RESC(); ROT();
  }
  STEP(pB0,pB1,pA0,pA1,NT-1,false,false,false); RESC();
  { float sacc=pB0[0]+pB0[1]; _Pragma("unroll") for(int r=2;r<16;++r)sacc+=pB0[r]; _Pragma("unroll") for(int r=0;r<16;++r)sacc+=pB1[r]; l_reg+=sacc;
    pw0=(u32x4){PKW(pB0,0),PKW(pB0,2),PKW(pB0,4),PKW(pB0,6)};pw1=(u32x4){PKW(pB0,8),PKW(pB0,10),PKW(pB0,12),PKW(pB0,14)};pw2=(u32x4){PKW(pB1,0),PKW(pB1,2),PKW(pB1,4),PKW(pB1,6)};pw3=(u32x4){PKW(pB1,8),PKW(pB1,10),PKW(pB1,12),PKW(pB1,14)};
    SBAR(); pv(o,vb0+sl_cur,PAF(0),PAF(1),PAF(2),PAF(3)); }
  #undef PKW
  #undef PAF
  #undef VFR
  #undef PIN
  #undef MX3
  #undef GAPA
  #undef GAPB
  #undef EX
  #undef VRD
  #undef KRD
  #undef STEP
  #undef ENDW
  {auto rr=__builtin_amdgcn_permlane32_swap(__float_as_uint(l_reg),__float_as_uint(l_reg),false,false);l_reg=__uint_as_float(rr[0])+__uint_as_float(rr[1]);}
  if(MODE==1||(MODE==0&&a.lse)){ if(hi==0) a.lse[(long)(q0+qrel)*a.lse_stride]=mhat+__builtin_amdgcn_logf(l_reg); }
  if(hi==0)wsf[32+r32]=l_reg;asm volatile("s_waitcnt lgkmcnt(0)":::"memory");
  float rli[16];
  #pragma unroll
  for(int r=0;r<16;++r)rli[r]=__builtin_amdgcn_rcpf(wsf[32+crow(r,hi)]);
  bf16*Ow=a.O+(long)(q0+wid*QBLK)*a.op;
  { bf16*stg=(bf16*)(shm+LDS_OST)+wid*2048;
    #pragma unroll
    for(int r=0;r<16;++r){const int orow=crow(r,hi);
      #pragma unroll
      for(int d0=0;d0<2;++d0)stg[orow*64+d0*32+r32]=__float2bfloat16(o[d0][r]*rli[r]);}
    asm volatile("s_waitcnt lgkmcnt(0)":::"memory");
    #pragma unroll
    for(int i=0;i<4;++i){const int row=i*8+(lane>>3),ch=lane&7; const u32x4 v=*(const u32x4*)(stg+row*64+ch*8); ATTN_STORE16(Ow+(long)row*a.op+ch*8,v);} }
  asm volatile("s_waitcnt lgkmcnt(0)\n\ts_barrier":::"memory");
  #undef DMA_K
  #undef DMA_V
  #undef CMASK
  #undef CINIT
  #undef START
  #undef RESC
  #undef ROT
}
constexpr int ATTN_LDS_BYTES=LDS_TOTAL;
#undef SBAR
#undef WAIT_BAR
}
#define GAS __attribute__((address_space(1)))
#define LAS __attribute__((address_space(3)))
typedef unsigned short bf16;
typedef unsigned v4u __attribute__((ext_vector_type(4)));
typedef float f32x4 __attribute__((ext_vector_type(4)));
typedef short bf16x8 __attribute__((ext_vector_type(8)));
typedef GAS unsigned gu32;
typedef GAS unsigned long long gu64;
#define RLX_AGENT __ATOMIC_RELAXED, __HIP_MEMORY_SCOPE_AGENT
#define LDS_WAIT() asm volatile("s_waitcnt lgkmcnt(0)" ::: "memory")
#define VM_WAIT() asm volatile("s_waitcnt vmcnt(0)" ::: "memory")
__device__ __forceinline__ unsigned long long rt() { return __builtin_amdgcn_s_memrealtime(); }
__device__ __forceinline__ unsigned f2bf(float f) { unsigned u = __builtin_bit_cast(unsigned, f); return (u + 0x7fffu + ((u >> 16) & 1u)) >> 16; }
__device__ __forceinline__ unsigned pk4_fp8(float a, float b, float c, float d) { int w = __builtin_amdgcn_cvt_pk_fp8_f32(a, b, 0, false); w = __builtin_amdgcn_cvt_pk_fp8_f32(c, d, w, true); return (unsigned)w; }
__device__ __forceinline__ unsigned pk2(float lo, float hi) { typedef float f2_t __attribute__((ext_vector_type(2))); typedef __bf16 b2_t __attribute__((ext_vector_type(2))); f2_t v = {lo, hi}; b2_t b = __builtin_convertvector(v, b2_t); return __builtin_bit_cast(unsigned, b); }

#define XB_TMO      128
#define XB_XCNT(j)  (256  + 64 * (j))
#define XB_XSUB(j)  (1280 + 64 * (j))
#define XB_XGEN(j)  (2304 + 64 * (j))
#define XB_TOP      3328
#define XB_TOPGEN   3392
#define XCD_BAR_WORDS 3456
#define XB_SPIN_CAP (1u << 18)

__device__ __forceinline__ unsigned xb_ld(unsigned* p)              { return __hip_atomic_load(p, __ATOMIC_RELAXED, __HIP_MEMORY_SCOPE_AGENT); }
__device__ __forceinline__ unsigned xb_add(unsigned* p, unsigned v) { return __hip_atomic_fetch_add(p, v, __ATOMIC_RELAXED, __HIP_MEMORY_SCOPE_AGENT); }
__device__ __forceinline__ unsigned xb_xcc_id() { return (unsigned)__builtin_amdgcn_s_getreg((3 << 11) | 20) & 0xFu; }
#define XB_SPIN(cond, bar) do { unsigned _sp = 0; while (cond) { __builtin_amdgcn_s_sleep(1); \
    if ((++_sp & 255u) == 0u) { if (xb_ld(&(bar)[XB_TMO])) break; if (_sp > XB_SPIN_CAP) { atomicAdd(&(bar)[XB_TMO], 1u); break; } } } } while (0)

struct XcdBarrier {
    unsigned* bar; unsigned x;
    volatile LAS unsigned* st;
};

__device__ __forceinline__ XcdBarrier xcd_barrier_post(unsigned* bar, volatile LAS unsigned* st) {
    XcdBarrier b; b.bar = bar; b.x = xb_xcc_id(); b.st = st;
    if (threadIdx.x == 0) (void)xb_add(&bar[XB_XCNT(b.x)], 1u);
    return b;
}
__device__ __forceinline__ void xcd_barrier_complete(unsigned* bar, unsigned x, unsigned& nloc, unsigned& nx) {
    const unsigned G = gridDim.x * gridDim.y * gridDim.z;
    unsigned sum, cnt, mine, sp = 0u;
    for (;;) {
        sum = 0u; cnt = 0u; mine = 0u;
#pragma unroll
        for (unsigned j = 0; j < 16; ++j) { const unsigned c = xb_ld(&bar[XB_XCNT(j)]); sum += c; cnt += (c > 0u) ? 1u : 0u; mine = (j == x) ? c : mine; }
        if (sum == G) break;
        __builtin_amdgcn_s_sleep(1);
        if ((++sp & 255u) == 0u) { if (xb_ld(&bar[XB_TMO])) break; if (sp > XB_SPIN_CAP) { atomicAdd(&bar[XB_TMO], 1u); break; } }
    }
    nloc = mine > 0u ? mine : 1u; nx = cnt > 0u ? cnt : 1u;
}

__device__ __forceinline__ void xcd_barrier(const XcdBarrier& b) {
    asm volatile("s_waitcnt vmcnt(0)" ::: "memory");
    __syncthreads();
    if (threadIdx.x == 0) {
        unsigned* bar = b.bar;
        __builtin_amdgcn_s_waitcnt(0);
        unsigned nloc = b.st[0], nx = b.st[1];
        if (nloc == 0u) { xcd_barrier_complete(bar, b.x, nloc, nx); b.st[0] = nloc; b.st[1] = nx; }
        const unsigned old = xb_add(&bar[XB_XSUB(b.x)], 1u);
        const unsigned gen = old / nloc;
        if (old + 1u == (gen + 1u) * nloc) {
            __builtin_amdgcn_fence(__ATOMIC_RELEASE, "agent");
            asm volatile("s_waitcnt vmcnt(0)" ::: "memory");
            const unsigned og = xb_add(&bar[XB_TOP], 1u);
            const unsigned tg = og / nx;
            if (og + 1u == (tg + 1u) * nx) xb_add(&bar[XB_TOPGEN], 1u);
            else XB_SPIN(xb_ld(&bar[XB_TOPGEN]) == tg, bar);
            __builtin_amdgcn_fence(__ATOMIC_ACQUIRE, "agent");
            xb_add(&bar[XB_XGEN(b.x)], 1u);
            asm volatile("s_waitcnt vmcnt(0)" ::: "memory");
        } else {
            XB_SPIN(xb_ld(&bar[XB_XGEN(b.x)]) == gen, bar);
            __builtin_amdgcn_fence(__ATOMIC_ACQUIRE, "agent");
            asm volatile("s_waitcnt vmcnt(0)" ::: "memory");
        }
    }
    __syncthreads();
}

constexpr int NWAVES = 8;
constexpr int S = 16384, DM = 1024, NPROJ = 5632, NE = 32, MEML = 256;
constexpr int PC_FQ = 0, PC_FK = 384, PC_FV = 768, PC_DQ = 1152, PC_DK = 1536, PC_DV = 1920, PC_MQ = 2304, PC_GT = 2560;
constexpr int W_IN_LD = 5638, W_IN_F = 1152;
constexpr float LN_EPS = 1e-5f, ALPHA = 1.189207115002721f;
constexpr float LOG2E = 1.4426950408889634f, C2F = 0.125f * 1.4426950408889634f;
constexpr int MAXROWS = 65536 + 32 * 256;
constexpr int NPHASE = 11;
#ifndef MK_N_LAUNCHES
#define MK_N_LAUNCHES 1
#endif
constexpr int N_LAUNCHES = MK_N_LAUNCHES;

constexpr size_t MiB = 1u << 20, KiB = 1u << 10;
constexpr size_t WS_CTL = 0, CTL_ZERO_BYTES = 256 * KiB;
constexpr size_t WS_WIN = 2 * MiB;
constexpr size_t WS_WBF = 748 * MiB, WS_WBD = WS_WBF + 768 * KiB, WS_WBM = WS_WBD + 768 * KiB, WS_WOUT = 15 * MiB, WS_WMKV = 17 * MiB;
constexpr size_t WS_LF2 = 18 * MiB, WS_C2 = WS_LF2 + 512 * KiB, WS_LSE = 19 * MiB, WS_TBL = WS_LSE + 512 * KiB, WS_MEMB = 20 * MiB, WS_MEMKV = WS_MEMB + 512 * KiB;
constexpr size_t WS_TOPI = 21 * MiB, WS_TOPG = WS_TOPI + 256 * KiB, WS_RANK = WS_TOPG + 256 * KiB, WS_DEST = WS_RANK + 256 * KiB, WS_BLKCNT = 22 * MiB, WS_TST = WS_BLKCNT + 64 * KiB;
constexpr size_t WS_TOKROW = 23 * MiB;
constexpr size_t WS_IDMAP = 23 * MiB + 512 * KiB;
constexpr size_t WS_XB = 24 * MiB;
constexpr size_t WS_PBUF = 56 * MiB;
constexpr size_t WS_Y = WS_PBUF;
constexpr size_t WS_OFOX = 712 * MiB, WS_ODIL = 724 * MiB, WS_OMEM = 736 * MiB;
constexpr size_t WS_W1 = 264 * MiB, WS_W2 = 392 * MiB;
constexpr size_t WS_STASH = 456 * MiB, WS_MERGED = 520 * MiB;
constexpr size_t WS_R1 = 552 * MiB, WS_H1F8 = 616 * MiB, WS_XF8 = 632 * MiB, WS_WGF8 = 648 * MiB, WS_H1B = 680 * MiB;
constexpr int W1_SHIFT = 5;
constexpr size_t WS_XS = 712 * MiB, WS_ACT = 856 * MiB, WS_END = 1000 * MiB;
static_assert(WS_XS + (size_t)MAXROWS * 1024 * 2 <= WS_ACT && WS_ACT + (size_t)MAXROWS * 1024 * 2 <= WS_END && WS_Y + (size_t)MAXROWS * 1024 * 2 <= 232 * MiB && WS_WBM + 768 * KiB <= WS_ACT, "ws map");
constexpr int CW_BAR = 4096;
constexpr int CW_NRM = 64, CW_QHEAD = 128;
constexpr size_t WS_OPART = WS_STASH, WS_LSEF = WS_STASH + 48 * MiB;

constexpr int RING_OFF = 0;
constexpr int LDSCTL_OFF = attn_body::ATTN_LDS_BYTES, MISC_OFF = LDSCTL_OFF + 320, TBL_OFF = MISC_OFF + 128;
constexpr int LDS_BYTES = 150528;
static_assert(TBL_OFF + 256 <= LDS_BYTES && pg8::STAGE_BYTES <= LDSCTL_OFF, "LDS map");

struct Args { const float* in[20]; float* out; unsigned char* ws; int ph_lo, ph_hi, li, pad; };
struct Frame {
    LAS unsigned char* lds;
    volatile LAS unsigned* MISC;
    gu32* ctl;
    int tid, lane, wave;
    int vcu, G;
    float* out; unsigned char* ws;
};
__device__ __forceinline__ float wave_sum(float v) {
#pragma unroll
    for (int o = 1; o < 64; o <<= 1) v += __shfl_xor(v, o);
    return v;
}
typedef float f4u __attribute__((ext_vector_type(4), aligned(4)));
typedef float f32x2 __attribute__((ext_vector_type(2)));
typedef unsigned v2u __attribute__((ext_vector_type(2)));
__device__ __forceinline__ void p0_tr_item(const float* W, int ldw, int k0, int src_n0, bf16* WT, int K, int dst_n0, float scale, LAS float* scr, int lane) {
    f4u v[16];
#pragma unroll
    for (int i = 0; i < 16; ++i) v[i] = *(const f4u*)(W + (size_t)(k0 + 4 * i + (lane >> 4)) * ldw + src_n0 + (lane & 15) * 4);
#pragma unroll
    for (int i = 0; i < 16; ++i) { LAS float* d = scr + (4 * i + (lane >> 4)) * 65 + (lane & 15) * 4; d[0] = v[i].x * scale; d[1] = v[i].y * scale; d[2] = v[i].z * scale; d[3] = v[i].w * scale; }
    LDS_WAIT(); asm volatile("" ::: "memory");
    const int c = lane & 7;
#pragma unroll
    for (int j = 0; j < 8; ++j) { const int n = (lane >> 3) + 8 * j; const LAS float* s = scr + (8 * c) * 65 + n;
        v4u o; o.x = pk2(s[0 * 65], s[1 * 65]); o.y = pk2(s[2 * 65], s[3 * 65]); o.z = pk2(s[4 * 65], s[5 * 65]); o.w = pk2(s[6 * 65], s[7 * 65]);
        *(GAS v4u*)(WT + (size_t)(dst_n0 + n) * K + k0 + 8 * c) = o; }
    LDS_WAIT(); asm volatile("" ::: "memory");
}
constexpr int CV_E1 = 32 * 512, CV_E2 = 32 * 256, CV_UNITS = (CV_E1 + CV_E2) / 64;
struct CvItem { const float* W; bf16* WT; int ldw, k0, sn, dn, f8; };
__device__ __forceinline__ CvItem cv_decode(const Args& A, unsigned char* ws, int r) {
    CvItem c;
    if (r < CV_E1) { const int e = r >> 9, rr = r & 511, kb = rr >> 5, nb = rr & 31, dn = nb * 64; c.sn = ((dn >> 7) & 1) * 1024 + (dn >> 8) * 128 + (dn & 127); c.dn = dn; c.k0 = kb * 64; c.ldw = 2048;
        c.W = A.in[14] + (size_t)e * 1024 * 2048; c.WT = (bf16*)(ws + WS_W1 + (size_t)e * 2048 * 1024); c.f8 = 1 + W1_SHIFT; }
    else { r -= CV_E1; const int e = r >> 8, rr = r & 255, kb = rr >> 4, nb = rr & 15; c.sn = nb * 64; c.dn = nb * 64; c.k0 = kb * 64; c.ldw = 1024;
        c.W = A.in[16] + (size_t)e * 1024 * 1024; c.WT = (bf16*)(ws + WS_W2 + (size_t)e * 1024 * 1024); c.f8 = 1 + W1_SHIFT; }
    return c;
}
__device__ __forceinline__ void cv_load(f4u (&v)[16], const CvItem& c, int lane) {
#pragma unroll
    for (int i = 0; i < 16; ++i) v[i] = *(const f4u*)(c.W + (size_t)(c.k0 + 4 * i + (lane >> 4)) * c.ldw + c.sn + (lane & 15) * 4);
}
__device__ __forceinline__ void cv_store(const f4u (&v)[16], const CvItem& c, LAS float* scr, int lane) {
#pragma unroll
    for (int i = 0; i < 16; ++i) { LAS float* d = scr + (4 * i + (lane >> 4)) * 65 + (lane & 15) * 4; d[0] = v[i].x; d[1] = v[i].y; d[2] = v[i].z; d[3] = v[i].w; }
    LDS_WAIT(); asm volatile("" ::: "memory");
    const int cc = lane & 7;
#pragma unroll
    for (int j = 0; j < 8; ++j) { const int n = (lane >> 3) + 8 * j; const LAS float* sp = scr + (8 * cc) * 65 + n;
        v4u o; o.x = pk2(sp[0 * 65], sp[1 * 65]); o.y = pk2(sp[2 * 65], sp[3 * 65]); o.z = pk2(sp[4 * 65], sp[5 * 65]); o.w = pk2(sp[6 * 65], sp[7 * 65]);
        *(GAS v4u*)(c.WT + (size_t)(c.dn + n) * 1024 + c.k0 + 8 * cc) = o; }
    LDS_WAIT(); asm volatile("" ::: "memory");
}
__device__ __forceinline__ void cv_store_f8(const f4u (&v)[16], const CvItem& c, LAS float* scr, int lane) {
    const float sc = (float)(1 << (c.f8 - 1));
#pragma unroll
    for (int i = 0; i < 16; ++i) { LAS float* d = scr + (4 * i + (lane >> 4)) * 65 + (lane & 15) * 4; d[0] = v[i].x * sc; d[1] = v[i].y * sc; d[2] = v[i].z * sc; d[3] = v[i].w * sc; }
    LDS_WAIT(); asm volatile("" ::: "memory");
    const int cc = lane & 7; unsigned char* const WT8 = (unsigned char*)c.WT;
#pragma unroll
    for (int j = 0; j < 8; ++j) { const int n = (lane >> 3) + 8 * j; const LAS float* sp = scr + (8 * cc) * 65 + n;
        v2u o; o.x = pk4_fp8(sp[0 * 65], sp[1 * 65], sp[2 * 65], sp[3 * 65]); o.y = pk4_fp8(sp[4 * 65], sp[5 * 65], sp[6 * 65], sp[7 * 65]);
        *(GAS v2u*)(WT8 + (size_t)(c.dn + n) * 1024 + c.k0 + 8 * cc) = o; }
    LDS_WAIT(); asm volatile("" ::: "memory");
}
__device__ __forceinline__ void conv_unit(Frame& F, const Args& A, int cu) {
    LAS float* scr = (LAS float*)(F.lds + RING_OFF + F.wave * 16640);
    const int r0 = cu * 64 + F.wave * 8;
    f4u va[16], vb[16];
    CvItem ca = cv_decode(A, F.ws, r0), cb; cv_load(va, ca, F.lane);
#pragma unroll 1
    for (int i = 0; i < 8; i += 2) {
        cb = cv_decode(A, F.ws, r0 + i + 1); cv_load(vb, cb, F.lane);
        if (ca.f8) cv_store_f8(va, ca, scr, F.lane); else cv_store(va, ca, scr, F.lane);
        if (i + 2 < 8) { ca = cv_decode(A, F.ws, r0 + i + 2); cv_load(va, ca, F.lane); }
        if (cb.f8) cv_store_f8(vb, cb, scr, F.lane); else cv_store(vb, cb, scr, F.lane);
    }
}
__device__ __forceinline__ void p0_prologue(Frame& F, const Args& A) {
    LAS float* scr = (LAS float*)(F.lds + RING_OFF + F.wave * 16640);
    const int gw = F.vcu * NWAVES + F.wave, NGW = F.G * NWAVES;
    bf16* const WIN = (bf16*)(F.ws + WS_WIN); bf16* const WBF = (bf16*)(F.ws + WS_WBF); bf16* const WBD = (bf16*)(F.ws + WS_WBD); bf16* const WBM = (bf16*)(F.ws + WS_WBM);
    bf16* const WOUT = (bf16*)(F.ws + WS_WOUT); bf16* const WMKV = (bf16*)(F.ws + WS_WMKV);
    constexpr int I_IN = 16 * 88, I_BF = 6 * 16, I_BD = 6 * 16, I_BM = 4 * 16, I_WO = 16 * 16, I_MKV = 16 * 8;
    constexpr int NITEMS = I_IN + I_BF + I_BD + I_BM + I_WO + I_MKV;
    for (int it = gw; it < NITEMS; it += NGW) {
        int r = it;
        if (r < I_IN) { const int kb = r / 88, nb = r % 88, dn = nb * 64; const int sn = dn + (dn >= W_IN_F ? 6 : 0);
            const float sc = (dn < PC_FK || (dn >= PC_DQ && dn < PC_DK) || (dn >= PC_MQ && dn < PC_GT)) ? C2F : 1.0f;
            { CvItem c; c.W = A.in[2]; c.WT = (bf16*)(F.ws + WS_WGF8); c.ldw = W_IN_LD; c.k0 = kb * 64; c.sn = sn; c.dn = dn; c.f8 = 1 + 6;
              f4u v[16]; cv_load(v, c, F.lane);
              if (sc != 1.0f) {
#pragma unroll
                  for (int i = 0; i < 16; ++i) { v[i].x *= sc; v[i].y *= sc; v[i].z *= sc; v[i].w *= sc; } }
              cv_store_f8(v, c, scr, F.lane); }
            continue; } r -= I_IN;
        if (r < I_BF) { const int kb = r >> 4, nb = r & 15; p0_tr_item(A.in[6], 1024, kb * 64, nb * 64, WBF, 384, nb * 64, 1.0f, scr, F.lane); continue; } r -= I_BF;
        if (r < I_BD) { const int kb = r >> 4, nb = r & 15; p0_tr_item(A.in[7], 1024, kb * 64, nb * 64, WBD, 384, nb * 64, 1.0f, scr, F.lane); continue; } r -= I_BD;
        if (r < I_BM) { const int kb = r >> 4, nb = r & 15; p0_tr_item(A.in[8], 1024, kb * 64, nb * 64, WBM, 384, nb * 64, 1.0f, scr, F.lane); continue; } r -= I_BM;
        if (r < I_WO) { const int kb = r >> 4, nb = r & 15; p0_tr_item(A.in[9], 1024, kb * 64, nb * 64, WOUT, 1024, nb * 64, 1.0f, scr, F.lane); continue; } r -= I_WO;
        { const int kb = r >> 3, nb = r & 7; p0_tr_item(A.in[5], 512, kb * 64, nb * 64, WMKV, 1024, nb * 64, 1.0f, scr, F.lane); }
    }
    {
        float wf[4][4][6];
#pragma unroll
        for (int j = 0; j < 4; ++j)
#pragma unroll
            for (int i = 0; i < 4; ++i)
#pragma unroll
                for (int h = 0; h < 6; ++h) wf[j][i][h] = A.in[2][(size_t)(4 * F.lane + i + 256 * j) * W_IN_LD + W_IN_F + h];
        float* const LF2 = (float*)(F.ws + WS_LF2);
        f32x4 vnx[4];
        if (gw < S) { const GAS f32x4* xr0 = (const GAS f32x4*)(A.in[0] + (size_t)gw * DM) + F.lane;
#pragma unroll
            for (int j = 0; j < 4; ++j) vnx[j] = xr0[64 * j]; }
        for (int m = gw; m < S; m += NGW) {
            f32x4 v[4]; float d[6] = {0.f, 0.f, 0.f, 0.f, 0.f, 0.f};
#pragma unroll
            for (int j = 0; j < 4; ++j) v[j] = vnx[j];
            if (m + NGW < S) { const GAS f32x4* xr1 = (const GAS f32x4*)(A.in[0] + (size_t)(m + NGW) * DM) + F.lane;
#pragma unroll
                for (int j = 0; j < 4; ++j) vnx[j] = xr1[64 * j]; }
#pragma unroll
            for (int j = 0; j < 4; ++j)
#pragma unroll
                for (int h = 0; h < 6; ++h) d[h] += v[j].x * wf[j][0][h] + v[j].y * wf[j][1][h] + v[j].z * wf[j][2][h] + v[j].w * wf[j][3][h];
#pragma unroll
            for (int h = 0; h < 6; ++h) d[h] = wave_sum(d[h]);
            { GAS unsigned* o4 = (GAS unsigned*)(F.ws + WS_XF8 + (size_t)m * DM) + F.lane;
#pragma unroll
              for (int j = 0; j < 4; ++j) o4[64 * j] = pk4_fp8(v[j].x, v[j].y, v[j].z, v[j].w); }
            if (F.lane < 6) { const int h = F.lane; float f = h == 0 ? d[0] : h == 1 ? d[1] : h == 2 ? d[2] : h == 3 ? d[3] : h == 4 ? d[4] : d[5];
                f += A.in[3][h]; const float ls = fminf(f, 0.f) - log1pf(expf(-fabsf(f)));
                LF2[(size_t)h * S + m] = ls * LOG2E; }
        }
        bf16* const MEMB = (bf16*)(F.ws + WS_MEMB);
        for (int m = gw; m < MEML; m += NGW) {
            const GAS f32x4* xr = (const GAS f32x4*)(A.in[1] + (size_t)m * DM) + F.lane; GAS unsigned long long* o8 = (GAS unsigned long long*)(MEMB + (size_t)m * DM) + F.lane;
#pragma unroll
            for (int j = 0; j < 4; ++j) { const f32x4 v = xr[64 * j]; o8[64 * j] = (unsigned long long)pk2(v.x, v.y) | ((unsigned long long)pk2(v.z, v.w) << 32); }
        }
    }
    { const int gt = F.vcu * (NWAVES * 64) + F.tid, GT = F.G * NWAVES * 64; const v4u z = {0u, 0u, 0u, 0u};
      for (int i = gt; i < 1024 * 16; i += GT) *(GAS v4u*)((bf16*)(F.ws + WS_WBM) + (size_t)(i >> 4) * 384 + 256 + (i & 15) * 8) = z;
      for (int i = gt; i < S * 16; i += GT) *(GAS v4u*)((bf16*)(F.ws + WS_OMEM) + (size_t)(i >> 4) * 384 + 256 + (i & 15) * 8) = z; }
    {
        float* const TBL = (float*)(F.ws + WS_TBL);
        for (int idx = F.vcu * (NWAVES * 64) + F.tid; idx < 6 * attn_body::TBL_N; idx += F.G * NWAVES * 64) {
            const int hd = idx / attn_body::TBL_N, i = idx - hd * attn_body::TBL_N, rel = i - attn_body::TBL_ZERO, g = hd >> 1, dil = g == 0 ? 1 : (g == 1 ? 4 : 16);
            float val = -INFINITY;
            if (rel >= 0 && rel <= 128) { const int dist = rel * dil; int bucket = dist;
                if (dist >= 16) { const float nf = (float)dist; bucket = 16 + (int)(logf(nf / 16.0f) / 4.852030263919617f * 16.0f); bucket = bucket > 31 ? 31 : bucket; }
                val = A.in[4][bucket * 6 + hd] * LOG2E; }
            TBL[idx] = val;
        }
    }
}

__device__ __forceinline__ void p1_cumsum(Frame& F, int h) {
    const float* src = (const float*)(F.ws + WS_LF2) + (size_t)h * S + F.tid * 32; float* dst = (float*)(F.ws + WS_C2) + (size_t)h * S + F.tid * 32;
    LAS double* part = (LAS double*)(F.lds + RING_OFF);
    f32x4 v[8]; double s = 0.0;
#pragma unroll
    for (int i = 0; i < 8; ++i) { v[i] = *(const f32x4*)(src + 4 * i); s += (double)v[i].x; s += (double)v[i].y; s += (double)v[i].z; s += (double)v[i].w; }
    part[F.tid] = s; __syncthreads();
    double run = 0.0;
    for (int j = 0; j < F.tid; ++j) run += part[j];
#pragma unroll
    for (int i = 0; i < 8; ++i) { f32x4 o; run += (double)v[i].x; o.x = (float)run; run += (double)v[i].y; o.y = (float)run; run += (double)v[i].z; o.z = (float)run; run += (double)v[i].w; o.w = (float)run; *(f32x4*)(dst + 4 * i) = o; }
    __syncthreads();
}

constexpr int P2_NA = 600, P2_NB = 360, P2_NC = 384, P2_ND = 256, P2_UNITS = P2_NA + P2_NB + P2_NC + P2_ND;
__device__ __forceinline__ void p2_attention(Frame& F, const Args& A, char* lds, int li) {
    typedef attn_body::bf16 abf;
    abf* const PB = (abf*)(F.ws + WS_PBUF);
    volatile LAS int* qslot = (volatile LAS int*)(F.lds + MISC_OFF + 64);
    for (;;) {
        if (F.tid == 0) qslot[0] = (int)__hip_atomic_fetch_add(F.ctl + CW_QHEAD + 64 * li, 1u, __ATOMIC_RELAXED, __HIP_MEMORY_SCOPE_AGENT);
        __syncthreads();
        const int pos = __builtin_amdgcn_readfirstlane(qslot[0]);
        __syncthreads();
        if (pos >= P2_UNITS + CV_UNITS) break;
        if (pos % 4 == 3 && pos / 4 < CV_UNITS) { conv_unit(F, A, pos / 4); __syncthreads(); continue; }
        const int idx = pos - (pos / 4 < CV_UNITS ? pos / 4 : CV_UNITS);
        attn_body::AttnArgs a; a.tlo = 0; a.thi = 0; a.band = 0; a.thr = 0.f;
        if (idx < P2_NA + P2_NB) {
            int h, qb, sgm;
            if (idx < P2_NA) { h = idx % 6; const int b = idx / 6; if (b < 49) { sgm = 0; qb = 15 + b; } else if (b < 82) { sgm = 1; qb = 31 + (b - 49); } else if (b < 99) { sgm = 2; qb = 47 + (b - 82); } else { sgm = 3; qb = 63; } }
            else { const int b2 = idx - P2_NA; h = b2 % 6; const int c = b2 / 6; const int L = 60 - 4 * (c >> 2); sgm = c & 3; qb = 16 * sgm + L / 4 - 1; }
            const int ntf = 4 * qb + 4, nseg = (ntf + 63) >> 6;
            const float q2 = __uint_as_float(__hip_atomic_load(F.ctl + CW_NRM + 2 * h, RLX_AGENT)) + __uint_as_float(__hip_atomic_load(F.ctl + CW_NRM + 2 * h + 1, RLX_AGENT)), k2 = __uint_as_float(__hip_atomic_load(F.ctl + CW_NRM + 12 + 2 * h, RLX_AGENT)) + __uint_as_float(__hip_atomic_load(F.ctl + CW_NRM + 13 + 2 * h, RLX_AGENT));
            const float qkmax = 1.02f * sqrtf(q2 * k2);
            a.Q = PB + PC_FQ + h * 64; a.K = PB + PC_FK + h * 64; a.V = PB + PC_FV + h * 64; a.qp = NPROJ; a.kp = NPROJ; a.op = 384;
            a.q0 = qb * 256; a.NT = 0; a.kv0 = 0; a.aux = (const float*)(F.ws + WS_C2) + (size_t)h * S;
            a.tlo = 64 * sgm; a.thi = (a.tlo + 64 < ntf) ? a.tlo + 64 : ntf; a.band = (sgm == nseg - 1) ? 1 : 0;
            a.thr = 160.0f + 2.0f * qkmax;
            if (nseg == 1) { a.O = (abf*)(F.ws + WS_OFOX) + h * 64; a.lse = nullptr; a.lse_stride = 0; }
            else { a.O = (abf*)(F.ws + WS_OPART) + (size_t)sgm * S * 384 + h * 64; a.lse = (float*)(F.ws + WS_LSEF) + (size_t)sgm * S * 6 + h; a.lse_stride = 6; }
            attn_body::attn_unit<0, 8>(a, lds);
        } else if (idx < P2_NA + P2_NB + P2_NC) { const int du = idx - (P2_NA + P2_NB); const int g = du >> 7, hs = (du >> 6) & 1, w = du & 63; const int dl = g == 0 ? 1 : (g == 1 ? 4 : 16); const int r = w % dl, qb = w / dl, hd = g * 2 + hs;
            const int t0 = 4 * qb - 2 > 0 ? 4 * qb - 2 : 0; const long pitch = (long)dl * NPROJ;
            a.Q = PB + PC_DQ + hd * 64 + (long)r * NPROJ; a.K = PB + PC_DK + hd * 64 + (long)r * NPROJ + (long)t0 * 64 * pitch; a.V = PB + PC_DV + hd * 64 + (long)r * NPROJ + (long)t0 * 64 * pitch;
            a.O = (abf*)(F.ws + WS_ODIL) + hd * 64 + (long)r * 384; a.qp = pitch; a.kp = pitch; a.op = (long)dl * 384;
            a.q0 = qb * 256; a.NT = 4 * qb + 4 - t0; a.kv0 = t0 * 64; a.aux = (const float*)(F.ws + WS_TBL) + hd * attn_body::TBL_N; a.lse = (float*)(F.ws + WS_LSE) + r * 6 + hd; a.lse_stride = (long)dl * 6;
            attn_body::attn_unit<1, 8>(a, lds);
        } else { const int mu = idx - (P2_NA + P2_NB + P2_NC); const int h = mu >> 6, qb = mu & 63; abf* const MKV = (abf*)(F.ws + WS_MEMKV);
            a.Q = PB + PC_MQ + h * 64; a.K = MKV + h * 64; a.V = MKV + 256 + h * 64; a.O = (abf*)(F.ws + WS_OMEM) + h * 64; a.qp = NPROJ; a.kp = 512; a.op = 384;
            a.q0 = qb * 256; a.NT = 4; a.kv0 = 0; a.aux = nullptr; a.lse = nullptr; a.lse_stride = 0;
            attn_body::attn_unit<2, 8>(a, lds);
        }
    }
}
__device__ __forceinline__ void p3_fox_combine(Frame& F) {
    const float* LSEF = (const float*)(F.ws + WS_LSEF); const bf16* OP = (const bf16*)(F.ws + WS_OPART); bf16* const OF = (bf16*)(F.ws + WS_OFOX);
    for (int it = blockIdx.x * (NWAVES * 64) + F.tid; it < (S - 4096) * 48; it += F.G * NWAVES * 64) {
        const int tok = 4096 + it / 48, rem = it % 48, h = rem >> 3, ch = rem & 7, nseg = (tok >> 12) + 1;
        float l[4]; float mx = -INFINITY;
#pragma unroll
        for (int sg = 0; sg < 4; ++sg) { l[sg] = (sg < nseg) ? LSEF[((size_t)sg * S + tok) * 6 + h] : -INFINITY; mx = fmaxf(mx, l[sg]); }
        float acc[8] = {0.f, 0.f, 0.f, 0.f, 0.f, 0.f, 0.f, 0.f}; float den = 0.f;
#pragma unroll
        for (int sg = 0; sg < 4; ++sg) { const float w = __builtin_amdgcn_exp2f(l[sg] - mx);
            if (w > 0.f) { const v4u x = *(const v4u*)(OP + ((size_t)sg * S + tok) * 384 + h * 64 + ch * 8); den += w;
                acc[0] += w * __uint_as_float(x.x << 16); acc[1] += w * __uint_as_float(x.x & 0xffff0000u); acc[2] += w * __uint_as_float(x.y << 16); acc[3] += w * __uint_as_float(x.y & 0xffff0000u);
                acc[4] += w * __uint_as_float(x.z << 16); acc[5] += w * __uint_as_float(x.z & 0xffff0000u); acc[6] += w * __uint_as_float(x.w << 16); acc[7] += w * __uint_as_float(x.w & 0xffff0000u); } }
        const float inv = 1.0f / den; v4u o; o.x = pk2(acc[0] * inv, acc[1] * inv); o.y = pk2(acc[2] * inv, acc[3] * inv); o.z = pk2(acc[4] * inv, acc[5] * inv); o.w = pk2(acc[6] * inv, acc[7] * inv);
        *(v4u*)(OF + (size_t)tok * 384 + h * 64 + ch * 8) = o;
    }
}
__device__ __forceinline__ void p3_dil_weights(Frame& F) {
    const float* LSE = (const float*)(F.ws + WS_LSE); bf16* const OD = (bf16*)(F.ws + WS_ODIL);
    for (int it = blockIdx.x * (NWAVES * 64) + F.tid; it < S * 48; it += F.G * NWAVES * 64) {
        const int tok = it / 48, rem = it - tok * 48, hd = rem >> 3, ch = rem & 7, hs = hd & 1, g = hd >> 1;
        const float l0 = LSE[tok * 6 + hs], l1 = LSE[tok * 6 + 2 + hs], l2 = LSE[tok * 6 + 4 + hs];
        const float mx = fmaxf(l0, fmaxf(l1, l2)); const float e0 = __builtin_amdgcn_exp2f(l0 - mx), e1 = __builtin_amdgcn_exp2f(l1 - mx), e2 = __builtin_amdgcn_exp2f(l2 - mx);
        const float w = (g == 0 ? e0 : (g == 1 ? e1 : e2)) / (e0 + e1 + e2);
        v4u* p = (v4u*)(OD + (size_t)tok * 384 + hd * 64 + ch * 8); v4u x = *p;
        x.x = pk2(__uint_as_float(x.x << 16) * w, __uint_as_float(x.x & 0xffff0000u) * w); x.y = pk2(__uint_as_float(x.y << 16) * w, __uint_as_float(x.y & 0xffff0000u) * w);
        x.z = pk2(__uint_as_float(x.z << 16) * w, __uint_as_float(x.z & 0xffff0000u) * w); x.w = pk2(__uint_as_float(x.w << 16) * w, __uint_as_float(x.w & 0xffff0000u) * w);
        *p = x;
    }
}
typedef float f32x16m __attribute__((ext_vector_type(16)));
__device__ __forceinline__ void p6_ln_router(Frame& F, const Args& A) {
    LAS float* hl = (LAS float*)(F.lds + RING_OFF);
    LAS float* part = hl;
    LAS float* lgt = (LAS float*)(F.lds + RING_OFF + 32768);
    LAS int* se = (LAS int*)(F.lds + RING_OFF + 131328);
    const bf16* R1 = (const bf16*)(F.ws + WS_R1); bf16* const H1B = (bf16*)(F.ws + WS_H1B); unsigned char* const H1F8 = F.ws + WS_H1F8;
    int* const TOPI = (int*)(F.ws + WS_TOPI); float* const TOPG = (float*)(F.ws + WS_TOPG); int* const RANK = (int*)(F.ws + WS_RANK); int* const BLKCNT = (int*)(F.ws + WS_BLKCNT);
    const float* lg1 = A.in[10]; const float* lb1 = A.in[11]; const float* wr = A.in[12]; const float* br = A.in[13];
    float wreg[64];
    { const float* bp = wr + (size_t)(128 * F.wave + (F.lane >> 5)) * 32 + (F.lane & 31);
#pragma unroll
      for (int st = 0; st < 64; ++st) wreg[st] = bp[64 * st]; }
    for (int rb = blockIdx.x; rb < S / 64; rb += F.G) {
        for (int half = 0; half < 2; ++half) {
            f32x4 vr[4][4];
#pragma unroll
            for (int j = 0; j < 4; ++j)
#pragma unroll
                for (int q = 0; q < 4; ++q) { const v2u t = *((const v2u*)(R1 + ((size_t)rb * 64 + half * 32 + F.wave * 4 + j) * DM) + F.lane + 64 * q);
                    vr[j][q] = (f32x4){__builtin_bit_cast(float, t.x << 16), __builtin_bit_cast(float, t.x & 0xffff0000u), __builtin_bit_cast(float, t.y << 16), __builtin_bit_cast(float, t.y & 0xffff0000u)}; }
#pragma unroll
            for (int j = 0; j < 4; ++j) {
                const int lr = F.wave * 4 + j; const size_t row = (size_t)rb * 64 + half * 32 + lr;
                f32x4 v[4]; float s = 0.f;
#pragma unroll
                for (int q = 0; q < 4; ++q) { v[q] = vr[j][q]; s += (v[q].x + v[q].y) + (v[q].z + v[q].w); }
                const float mean = wave_sum(s) * (1.f / DM); float s2 = 0.f;
#pragma unroll
                for (int q = 0; q < 4; ++q) { v[q] = v[q] - mean; s2 += (v[q].x * v[q].x + v[q].y * v[q].y) + (v[q].z * v[q].z + v[q].w * v[q].w); }
                const float rstd = 1.f / sqrtf(wave_sum(s2) * (1.f / DM) + LN_EPS);
#pragma unroll
                for (int q = 0; q < 4; ++q) { const f32x4 gv = *((const f32x4*)lg1 + F.lane + 64 * q), bv = *((const f32x4*)lb1 + F.lane + 64 * q); const f32x4 h = v[q] * rstd * gv + bv;
                    *((v2u*)(H1B + row * DM) + F.lane + 64 * q) = (v2u){pk2(h.x, h.y), pk2(h.z, h.w)};
                    *((unsigned*)(H1F8 + row * DM) + F.lane + 64 * q) = pk4_fp8(h.x, h.y, h.z, h.w);
                    LAS float* d = hl + lr * 1025 + 4 * F.lane + 256 * q; d[0] = h.x; d[1] = h.y; d[2] = h.z; d[3] = h.w; }
            }
            __syncthreads();
            f32x16m acc = {0.f, 0.f, 0.f, 0.f, 0.f, 0.f, 0.f, 0.f, 0.f, 0.f, 0.f, 0.f, 0.f, 0.f, 0.f, 0.f};
            { const int kk = F.lane >> 5; const LAS float* ap = hl + (F.lane & 31) * 1025 + 128 * F.wave + kk;
#pragma unroll
              for (int st = 0; st < 64; ++st) acc = __builtin_amdgcn_mfma_f32_32x32x2f32(ap[2 * st], wreg[st], acc, 0, 0, 0); }
            __syncthreads();
            { const int kk = F.lane >> 5;
#pragma unroll
              for (int r = 0; r < 16; ++r) part[(F.wave * 32 + ((r & 3) + 8 * (r >> 2) + 4 * kk)) * 32 + (F.lane & 31)] = acc[r]; }
            __syncthreads();
#pragma unroll
            for (int q = 0; q < 2; ++q) { const int p = F.tid + 512 * q, i = p >> 5, jx = p & 31; float sm = 0.f;
#pragma unroll
                for (int w = 0; w < 8; ++w) sm += part[(w * 32 + i) * 32 + jx];
                lgt[i * 33 + jx] = sm + br[jx]; }
            __syncthreads();
            if (F.tid < 32) { const int i = F.tid; const size_t row = (size_t)rb * 64 + half * 32 + i; float bv[4]; int bi[4];
                unsigned taken = 0u;
#pragma unroll
                for (int kx = 0; kx < 4; ++kx) { float best = -INFINITY; int be = 0;
                    for (int e = 0; e < 32; ++e) { const float x = lgt[i * 33 + e]; const bool take = (((taken >> e) & 1u) == 0u) && (x > best); best = take ? x : best; be = take ? e : be; }
                    bv[kx] = best; bi[kx] = be; taken |= 1u << be; }
                const float e1 = expf(bv[1] - bv[0]), e2 = expf(bv[2] - bv[0]), e3 = expf(bv[3] - bv[0]); const float inv = 1.f / (1.f + e1 + e2 + e3);
                *(int4*)(TOPI + row * 4) = make_int4(bi[0], bi[1], bi[2], bi[3]); *(f32x4*)(TOPG + row * 4) = (f32x4){inv, e1 * inv, e2 * inv, e3 * inv};
                const int lrow = half * 32 + i; se[lrow * 4 + 0] = bi[0]; se[lrow * 4 + 1] = bi[1]; se[lrow * 4 + 2] = bi[2]; se[lrow * 4 + 3] = bi[3]; }
            __syncthreads();
        }
        if (F.tid < 256) { const int e = se[F.tid]; int rk = 0; for (int q = 0; q < F.tid; ++q) rk += (se[q] == e) ? 1 : 0; RANK[rb * 256 + F.tid] = rk; }
        else if (F.tid < 288) { const int e = F.tid - 256; int c = 0; for (int q = 0; q < 256; ++q) c += (se[q] == e) ? 1 : 0; BLKCNT[rb * 32 + e] = c; }
        __syncthreads();
    }
}
__device__ __forceinline__ void p7_scatter(Frame& F) {
    LAS int* ptot = (LAS int*)(F.lds + RING_OFF); LAS int* ppre = ptot + 512; LAS int* epre = ppre + 512; LAS int* tst = epre + 32; LAS int* dsts = tst + 64;
    const int* BLKCNT = (const int*)(F.ws + WS_BLKCNT); const int* TOPI = (const int*)(F.ws + WS_TOPI); const int* RANK = (const int*)(F.ws + WS_RANK);
    int* const DEST = (int*)(F.ws + WS_DEST); int* const TST = (int*)(F.ws + WS_TST); int* const TOKROW = (int*)(F.ws + WS_TOKROW);
    { int* const IDM = (int*)(F.ws + WS_IDMAP); for (int i = blockIdx.x * (NWAVES * 64) + F.tid; i < MAXROWS; i += F.G * NWAVES * 64) IDM[i] = i; }
    for (int rb = blockIdx.x; rb < S / 64; rb += F.G) {
        { const int part = F.tid >> 5, e = F.tid & 31; int tot = 0, pre = 0;
          for (int b = part * 16; b < part * 16 + 16; ++b) { const int c = BLKCNT[b * 32 + e]; tot += c; pre += (b < rb) ? c : 0; }
          ptot[part * 32 + e] = tot; ppre[part * 32 + e] = pre; }
        __syncthreads();
        if (F.tid < 32) { int T = 0, P = 0; for (int p = 0; p < 16; ++p) { T += ptot[p * 32 + F.tid]; P += ppre[p * 32 + F.tid]; } ptot[F.tid] = T; epre[F.tid] = P; }
        __syncthreads();
        if (F.tid == 0) { int t = 0; for (int e = 0; e < 32; ++e) { tst[e] = t; t += (ptot[e] + 255) >> 8; } tst[32] = t;
            if (rb == 0) { for (int e = 0; e <= 32; ++e) TST[e] = tst[e]; } }
        __syncthreads();
        if (F.tid < 256) { const size_t a = (size_t)rb * 256 + F.tid; const int e = TOPI[a]; const int d = tst[e] * 256 + epre[e] + RANK[a]; DEST[a] = d; TOKROW[d] = (int)(a >> 2); }
        if (rb == 0) { for (int e = 0; e < 32; ++e) { const int c = ptot[e], base = tst[e] * 256, padn = (tst[e + 1] - tst[e]) * 256 - c; for (int p = F.tid; p < padn; p += NWAVES * 64) TOKROW[base + c + p] = 0; } }
        __syncthreads();
    }
}
__device__ __forceinline__ void p10_combine(Frame& F, const Args& A) {
    const int gw = F.vcu * NWAVES + F.wave, NGW = F.G * NWAVES;
    const bf16* H1B = (const bf16*)(F.ws + WS_H1B); const bf16* Y = (const bf16*)(F.ws + WS_Y); const int* DEST = (const int*)(F.ws + WS_DEST); const float* TOPG = (const float*)(F.ws + WS_TOPG);
    const float* g2 = A.in[18]; const float* b2 = A.in[19];
    int4 ddn; f32x4 ggn; v2u hbn[4]; unsigned yn[4][4];
#define P10_LOAD_IDX(m_) do { ddn = *(const int4*)(DEST + (size_t)(m_) * 4); ggn = *(const f32x4*)(TOPG + (size_t)(m_) * 4); } while (0)
#define P10_LOAD_ROWS(m_) do { _Pragma("unroll") for (int j = 0; j < 4; ++j) hbn[j] = *((const v2u*)(H1B + (size_t)(m_) * DM) + F.lane + 64 * j); \
        _Pragma("unroll") for (int k = 0; k < 4; ++k) { const int d_ = k == 0 ? ddn.x : (k == 1 ? ddn.y : (k == 2 ? ddn.z : ddn.w)); \
            _Pragma("unroll") for (int j = 0; j < 4; ++j) yn[k][j] = *((const unsigned*)((const unsigned char*)Y + (size_t)d_ * DM) + F.lane + 64 * j); } } while (0)
    int m = gw; if (m >= S) return;
    P10_LOAD_IDX(m); P10_LOAD_ROWS(m);
    for (; m < S; m += NGW) {
        const f32x4 gg = ggn; f32x4 v[4]; float s = 0.f;
#pragma unroll
        for (int j = 0; j < 4; ++j) v[j] = (f32x4){__uint_as_float(hbn[j].x << 16), __uint_as_float(hbn[j].x & 0xffff0000u), __uint_as_float(hbn[j].y << 16), __uint_as_float(hbn[j].y & 0xffff0000u)} * ALPHA;
#pragma unroll
        for (int k = 0; k < 4; ++k) { const float g = k == 0 ? gg.x : (k == 1 ? gg.y : (k == 2 ? gg.z : gg.w));
#pragma unroll
            for (int j = 0; j < 4; ++j) { const unsigned y = yn[k][j]; typedef float f2_ __attribute__((ext_vector_type(2)));
                const f2_ lo = __builtin_amdgcn_cvt_pk_f32_fp8((int)y, false), hi = __builtin_amdgcn_cvt_pk_f32_fp8((int)y, true);
                v[j].x += g * lo.x; v[j].y += g * lo.y; v[j].z += g * hi.x; v[j].w += g * hi.y; } }
        const int mn = m + NGW;
        if (mn < S) { P10_LOAD_IDX(mn); P10_LOAD_ROWS(mn); }
#pragma unroll
        for (int j = 0; j < 4; ++j) s += (v[j].x + v[j].y) + (v[j].z + v[j].w);
        const float mean = wave_sum(s) * (1.f / DM); float s2 = 0.f;
#pragma unroll
        for (int j = 0; j < 4; ++j) { v[j] = v[j] - mean; s2 += (v[j].x * v[j].x + v[j].y * v[j].y) + (v[j].z * v[j].z + v[j].w * v[j].w); }
        const float rstd = 1.f / sqrtf(wave_sum(s2) * (1.f / DM) + LN_EPS);
#pragma unroll
        for (int j = 0; j < 4; ++j) { const f32x4 gv = *((const f32x4*)g2 + F.lane + 64 * j), bv = *((const f32x4*)b2 + F.lane + 64 * j);
            *((f32x4*)(F.out + (size_t)m * DM) + F.lane + 64 * j) = v[j] * rstd * gv + bv; }
    }
#undef P10_LOAD_IDX
#undef P10_LOAD_ROWS
}

__global__ void __launch_bounds__(NWAVES * 64, 2) mk_fwd(Args args) {
    extern __shared__ __attribute__((aligned(16))) unsigned char lds[];
    Frame F;
    F.lds = (LAS unsigned char*)lds;
    F.MISC = (volatile LAS unsigned*)(F.lds + MISC_OFF);
    F.tid = threadIdx.x; F.lane = F.tid & 63; F.wave = __builtin_amdgcn_readfirstlane(F.tid >> 6);
    F.G = gridDim.x; { const int bx = blockIdx.x; F.vcu = (F.G % 8 == 0) ? (bx % 8) * (F.G / 8) + bx / 8 : bx; }
    F.ws = args.ws; F.out = args.out; F.ctl = (gu32*)(args.ws + WS_CTL);
    unsigned char* const ws = args.ws;
    for (int u = F.tid; u < (LDS_BYTES - LDSCTL_OFF) / 4; u += NWAVES * 64) ((LAS unsigned*)(F.lds + LDSCTL_OFF))[u] = 0u;
    __syncthreads();
    XcdBarrier bar = xcd_barrier_post((unsigned*)(F.ctl + CW_BAR) + args.li * XCD_BAR_WORDS, F.MISC + 8);
#define GRID_BAR() xcd_barrier(bar)
    const int lo = args.ph_lo, hi = args.ph_hi;
#ifndef PHASE_MASK
#define PHASE_MASK 0x7ff
#endif
#define IN(k) (((PHASE_MASK >> (k)) & 1) && lo <= (k) && (k) < hi)
#define BOTH(k) (IN(k) && IN((k) + 1))
    typedef pg8::bf16_t pbf;
    pbf* const PBUF = (pbf*)(ws + WS_PBUF);

    if (IN(0)) { p0_prologue(F, args); if (BOTH(0)) GRID_BAR(); }

    if (IN(1)) {
        { pg8::Gemm g{(const pbf*)(ws + WS_XF8), (const pbf*)(ws + WS_WGF8), S, NPROJ, DM / 2, nullptr, 0x7C7C7C7C, 0x7C7C7C7C}; pg8::StaticOrder So; So.init(S, NPROJ, F.G, (int)blockIdx.x);
          pg8::EpiProj E{PBUF, NPROJ, PC_GT / 256, (unsigned*)(F.ctl + CW_NRM)};
          pg8::gemm_phase<pg8::EpiProj, pg8::StaticOrder, true, true, true, true>(F.lds + RING_OFF, g, So, E); }
        { pg8::Gemm g{(const pbf*)(ws + WS_MEMB), (const pbf*)(ws + WS_WMKV), MEML, 512, DM, nullptr, 0, 0}; pg8::StaticOrder So; So.init(MEML, 512, F.G, (int)((blockIdx.x + F.G / 2) % F.G));
          pg8::EpiBf16Plain E{(pbf*)(ws + WS_MEMKV), 512};
          pg8::gemm_phase<pg8::EpiBf16Plain, pg8::StaticOrder, true, true>(F.lds + RING_OFF, g, So, E); }
        if ((int)blockIdx.x >= F.G - 6) p1_cumsum(F, F.G - 1 - (int)blockIdx.x);
        if (BOTH(1)) GRID_BAR();
    }

    if (IN(2)) { p2_attention(F, args, (char*)lds + RING_OFF, args.li); if (BOTH(2)) GRID_BAR(); }

    if (IN(3)) { p3_fox_combine(F); p3_dil_weights(F); if (BOTH(3)) GRID_BAR(); }

    if (IN(4)) {
        pg8::Gemm g{(const pbf*)(ws + WS_OFOX), (const pbf*)(ws + WS_WBF), S, DM, 384, nullptr, 0, 0, (size_t)S * 384 * 2, (size_t)DM * 384 * 2};
        pg8::MergeOrder So; So.so.init(S, DM, F.G, (int)blockIdx.x);
        pg8::EpiMergeChain E{PBUF + PC_GT, NPROJ, (pbf*)(ws + WS_MERGED), DM};
        pg8::gemm_phase<pg8::EpiMergeChain, pg8::MergeOrder, true, true>(F.lds + RING_OFF, g, So, E);
        if (BOTH(4)) GRID_BAR();
    }

    if (IN(5)) {
        pg8::Gemm g{(const pbf*)(ws + WS_MERGED), (const pbf*)(ws + WS_WOUT), S, DM, DM, nullptr, 0, 0}; pg8::StaticOrder So; So.init(S, DM, F.G, (int)blockIdx.x);
        pg8::EpiRes E{args.in[0], (pbf*)(ws + WS_R1), DM, ALPHA};
        pg8::gemm_phase<pg8::EpiRes, pg8::StaticOrder, true, true>(F.lds + RING_OFF, g, So, E);
        if (BOTH(5)) GRID_BAR();
    }

    if (IN(6)) { p6_ln_router(F, args); if (BOTH(6)) GRID_BAR(); }

    if (IN(7)) { p7_scatter(F); if (BOTH(7)) GRID_BAR(); }

    if (IN(8)) {
        LAS int* tbl = (LAS int*)(F.lds + TBL_OFF);
        if (F.tid < 33) tbl[F.tid] = ((const int*)(ws + WS_TST))[F.tid];
        __syncthreads();
        pg8::Gemm g{(const pbf*)(ws + WS_H1F8), (const pbf*)(ws + WS_W1), MAXROWS, 2048, DM / 2, (const int*)(ws + WS_TOKROW), 0x7F7F7F7F, 0x7F7F7F7F}; pg8::MoeOrder So{tbl, 8, F.G, F.vcu};
        pg8::EpiSwiglu E{(pbf*)(ws + WS_ACT), args.in[15], 1.0f / (float)(1 << W1_SHIFT), (const LAS float*)(F.lds + RING_OFF + pg8::STAGE_BYTES + 5120)};
        pg8::gemm_phase<pg8::EpiSwiglu, pg8::MoeOrder, true, true, true, true>(F.lds + RING_OFF, g, So, E);
        if (BOTH(8)) GRID_BAR();
    }

    if (IN(9)) {
        LAS int* tbl = (LAS int*)(F.lds + TBL_OFF);
        if (F.tid < 33) tbl[F.tid] = ((const int*)(ws + WS_TST))[F.tid];
        __syncthreads();
        pg8::Gemm g{(const pbf*)(ws + WS_ACT), (const pbf*)(ws + WS_W2), MAXROWS, 1024, DM / 2, nullptr, 0x7F7F7F7F, 0x7F7F7F7F}; pg8::MoeOrder So{tbl, 4, F.G, F.vcu};
        pg8::EpiY E{(pbf*)(ws + WS_Y), args.in[17], 1.0f / (float)(1 << W1_SHIFT), (const LAS float*)(F.lds + RING_OFF + pg8::STAGE_BYTES + 5120)};
        pg8::gemm_phase<pg8::EpiY, pg8::MoeOrder, true, true, true, true>(F.lds + RING_OFF, g, So, E);
        if (BOTH(9)) GRID_BAR();
    }

    if (IN(10)) { p10_combine(F, args); }
#undef IN
#undef BOTH
#undef GRID_BAR
}

extern "C" void kernel_launch(void* const* d_in, const int* in_sizes, int n_in, void* d_out, int out_size, void* d_ws, size_t ws_size, hipStream_t stream) {
    static int grid = 0;
    if (grid == 0) {
        if (n_in != 20 || in_sizes[0] != S * DM || out_size != S * DM || ws_size < WS_END) { fprintf(stderr, "kernel_launch: built for 20 inputs, x/out of %d floats, >= %zu bytes of workspace; got n_in %d, in0 %d, out %d, ws %zu; nothing launched\n", S * DM, (size_t)WS_END, n_in, n_in > 0 ? in_sizes[0] : -1, out_size, ws_size); grid = -1; return; }
        int dev = 0, cus = 0, per_cu = 0;
        if (hipGetDevice(&dev) != hipSuccess || hipDeviceGetAttribute(&cus, hipDeviceAttributeMultiprocessorCount, dev) != hipSuccess) { fprintf(stderr, "kernel_launch: hipGetDevice / hipDeviceGetAttribute failed; nothing launched\n"); grid = -1; return; }
        if (hipFuncSetAttribute((const void*)mk_fwd, hipFuncAttributeMaxDynamicSharedMemorySize, LDS_BYTES) != hipSuccess) { fprintf(stderr, "kernel_launch: hipFuncSetAttribute failed (%d bytes of dynamic LDS); nothing launched\n", LDS_BYTES); grid = -1; return; }
        if (hipOccupancyMaxActiveBlocksPerMultiprocessor(&per_cu, (const void*)mk_fwd, NWAVES * 64, LDS_BYTES) != hipSuccess || per_cu < 1)
            fprintf(stderr, "kernel_launch: note: the occupancy query reports %d workgroups per CU\n", per_cu);
        (void)hipGetLastError();
        grid = cus;
    }
    if (grid < 0) return;
    if (hipMemsetAsync((char*)d_ws + WS_CTL, 0, CTL_ZERO_BYTES, stream) != hipSuccess) { fprintf(stderr, "kernel_launch: hipMemsetAsync of the control words failed; nothing launched\n"); return; }
    Args a{};
    for (int i = 0; i < 20; ++i) a.in[i] = (const float*)d_in[i];
    a.out = (float*)d_out; a.ws = (unsigned char*)d_ws;
#ifdef PROBE_PHASE
    const int nl = (PROBE_PHASE + 1 < NPHASE) ? 3 : 2; const int cut_lo[3] = {0, PROBE_PHASE, PROBE_PHASE + 1}, cut_hi[3] = {PROBE_PHASE + 1, PROBE_PHASE + 1, NPHASE};
#else
    const int nl = N_LAUNCHES; int cut_lo[NPHASE], cut_hi[NPHASE]; for (int i = 0; i < NPHASE; ++i) { cut_lo[i] = (N_LAUNCHES == 1) ? 0 : i; cut_hi[i] = (N_LAUNCHES == 1) ? NPHASE : i + 1; }
#endif
    for (int li = 0; li < nl; ++li) {
        a.ph_lo = cut_lo[li]; a.ph_hi = cut_hi[li]; a.li = li;
        hipLaunchKernelGGL(mk_fwd, dim3(grid), dim3(NWAVES * 64), LDS_BYTES, stream, a);
        const hipError_t le = hipPeekAtLastError();
        if (le != hipSuccess) { fprintf(stderr, "kernel_launch: launch %d failed: %s\n", li, hipGetErrorName(le)); break; }
    }
}
```

```cpp
#include <hip/hip_runtime.h>
#include <hip/hip_bf16.h>
#include <cstdio>
#include <cstdint>
#include <cmath>
namespace pg8 {
#define PG8_LAS __attribute__((address_space(3)))
typedef unsigned short bf16_t;
typedef short bf16x8 __attribute__((ext_vector_type(8)));
typedef float f32x4 __attribute__((ext_vector_type(4)));
typedef unsigned u32x4 __attribute__((ext_vector_type(4)));
constexpr int BM = 256, BK = 64, HALF = 128, HTB = HALF * BK * 2  , STAGE_BYTES = 8 * HTB, NXCD = 8, WGM = 8;

__host__ __device__ __forceinline__ int lds_byte(int r, int c) { const int st = (r >> 4) * 2 + (c >> 5), rr = r & 15, cc = c & 31, ob = rr * 64 + cc * 2; return st * 1024 + (ob ^ (((ob >> 9) & 1) << 5)); }
__host__ __device__ __forceinline__ void stage_rc(int b, int& R, int& C) { const int st = b / 1024, sb = b % 1024, swz = sb ^ (((sb >> 9) & 1) << 5); R = (st >> 1) * 16 + swz / 64; C = (st & 1) * 32 + (swz % 64) / 2; }
__host__ __device__ __forceinline__ int perm32(int rho) { const int n = rho >> 4, i = rho & 15; return 8 * (i >> 2) + 4 * n + (i & 3); }

struct Unit { int pm, pn, e, slot, b; };
typedef int v8i_t_half __attribute__((ext_vector_type(4)));
typedef int v8i_t __attribute__((ext_vector_type(8)));
typedef short s16x16_t __attribute__((ext_vector_type(16)));
struct Gemm { const bf16_t* A; const bf16_t* Bt; int M, N, K; const int* rowmap; int scale_a, scale_b; size_t strideA = 0, strideB = 0; };

struct StaticOrder {
    int nM, nN, nwg, G, c;
    __host__ __device__ void init(int M, int N, int G_, int c_) { nM = M / BM; nN = N / BM; nwg = nM * nN; G = G_; c = c_; }
    __host__ __device__ bool next(int i, Unit& u) const {
        const long L = (long)i * G + c; if (L >= nwg) return false;
        int wgid = (int)L; { const int q = nwg / NXCD, r = nwg % NXCD, xcd = wgid % NXCD, off = wgid / NXCD; wgid = (xcd < r ? xcd * (q + 1) : r * (q + 1) + (xcd - r) * q) + off; }
        const int nig = WGM * nN, gid = wgid / nig, fm = gid * WGM, gsz = (nM - fm) < WGM ? (nM - fm) : WGM;
        u.pm = fm + ((wgid % nig) % gsz); u.pn = (wgid % nig) / gsz; u.e = 0; u.b = 0; return true;
    }
    __device__ __forceinline__ void a_ready(const Unit&) const {}
    __device__ __forceinline__ void done(const Unit&) const {}
};

__device__ __forceinline__ unsigned cvt_pk_bf16(float lo, float hi) { unsigned r; asm volatile("v_cvt_pk_bf16_f32 %0, %1, %2" : "=v"(r) : "v"(lo), "v"(hi)); return r; }
__device__ __forceinline__ float bf_lo(unsigned w) { return __uint_as_float(w << 16); }
__device__ __forceinline__ float bf_hi(unsigned w) { return __uint_as_float(w & 0xffff0000u); }
__device__ __forceinline__ float sigmoid_f(float v) { return __builtin_amdgcn_rcpf(1.0f + __builtin_amdgcn_exp2f(-1.4426950408889634f * v)); }
typedef unsigned u32x2 __attribute__((ext_vector_type(2)));
__device__ __forceinline__ unsigned ror8(unsigned v) { return (unsigned)__builtin_amdgcn_update_dpp(0, (int)v, 0x128, 0xf, 0xf, false); }
__device__ __forceinline__ u32x4 sel4(bool c, const u32x4& a, const u32x4& b) { u32x4 r; r.x = c ? a.x : b.x; r.y = c ? a.y : b.y; r.z = c ? a.z : b.z; r.w = c ? a.w : b.w; return r; }
__device__ __forceinline__ u32x4 ror8x4(const u32x4& a) { u32x4 r; r.x = ror8(a.x); r.y = ror8(a.y); r.z = ror8(a.z); r.w = ror8(a.w); return r; }
__device__ __forceinline__ void fl_store(unsigned char* lanep, size_t pitch8, const u32x4& p0, const u32x4& p1, bool lo) {
    const u32x4 y = ror8x4(sel4(lo, p1, p0)); *(u32x4*)lanep = sel4(lo, p0, y); *(u32x4*)(lanep + pitch8) = sel4(lo, y, p1); }
__device__ __forceinline__ void fl_load(const unsigned char* lanep, size_t pitch8, u32x4& p0, u32x4& p1, bool lo) {
    const u32x4 a = *(const u32x4*)lanep, b = *(const u32x4*)(lanep + pitch8); const u32x4 y = ror8x4(sel4(lo, b, a)); p0 = sel4(lo, a, y); p1 = sel4(lo, y, b); }

struct EpiBf16Plain {
    static constexpr bool PERM = true, AFTER_DRAIN = false; static constexpr bool CHAIN = false; static constexpr bool LDS_BIAS = false;
    bf16_t* O; int ldc;
    __device__ __forceinline__ void operator()(const f32x4 (&acc)[2][2][4][2], const Unit& u, int wr, int wc, int fr, int fq) const {
        const int row0 = u.pm * BM + wr * 64 + fr, col0 = u.pn * BM + wc * 32 + 8 * fq;
#pragma unroll
        for (int ai = 0; ai < 2; ++ai)
#pragma unroll
            for (int m = 0; m < 4; ++m) { bf16_t* rowp = O + (size_t)(row0 + ai * HALF + m * 16) * ldc + col0;
#pragma unroll
                for (int bj = 0; bj < 2; ++bj) { const f32x4 v0 = acc[ai][bj][m][0], v1 = acc[ai][bj][m][1];
                    u32x4 w; w.x = cvt_pk_bf16(v0[0], v0[1]); w.y = cvt_pk_bf16(v0[2], v0[3]); w.z = cvt_pk_bf16(v1[0], v1[1]); w.w = cvt_pk_bf16(v1[2], v1[3]);
                    *(u32x4*)(rowp + bj * HALF) = w; } }
    }
};
struct EpiProj {
    static constexpr bool PERM = true, PERM16 = true, AFTER_DRAIN = false; static constexpr bool CHAIN = false; static constexpr bool LDS_BIAS = false;
    bf16_t* O; int ldc; int sig_from; unsigned* nrm;
    __device__ __forceinline__ void operator()(const f32x4 (&acc)[2][2][4][2], const Unit& u, int wr, int wc, int fr, int fq) const {
        const bool sg = u.pn >= sig_from, lo = fr < 8;
        if (u.pn < 3) {
            float mx = 0.f;
#pragma unroll
            for (int ai = 0; ai < 2; ++ai)
#pragma unroll
                for (int m = 0; m < 4; ++m) { float ss = 0.f;
#pragma unroll
                    for (int bj = 0; bj < 2; ++bj) { const f32x4 a0 = acc[ai][bj][m][0], a1 = acc[ai][bj][m][1];
                        ss += (a0[0] * a0[0] + a0[1] * a0[1]) + (a0[2] * a0[2] + a0[3] * a0[3]) + (a1[0] * a1[0] + a1[1] * a1[1]) + (a1[2] * a1[2] + a1[3] * a1[3]); }
                    ss += __shfl_xor(ss, 16); ss += __shfl_xor(ss, 32); mx = fmaxf(mx, ss); }
            mx = fmaxf(mx, __shfl_xor(mx, 1)); mx = fmaxf(mx, __shfl_xor(mx, 2)); mx = fmaxf(mx, __shfl_xor(mx, 4)); mx = fmaxf(mx, __shfl_xor(mx, 8));
            if (fr == 0 && fq == 0) atomicMax(nrm + 2 * (u.pn * 4 + wc), __float_as_uint(mx));
        }
        unsigned char* const lanep = (unsigned char*)(O + (size_t)(u.pm * BM + wr * 64 + (fr & 7)) * ldc + u.pn * BM + wc * 64) + (2 * fq + (fr >> 3)) * 16; const size_t pitch = (size_t)ldc * 2;
#pragma unroll
        for (int ai = 0; ai < 2; ++ai)
#pragma unroll
            for (int m = 0; m < 4; ++m) { u32x4 p[2];
#pragma unroll
                for (int bj = 0; bj < 2; ++bj) { f32x4 v0 = acc[ai][bj][m][0], v1 = acc[ai][bj][m][1];
                    if (sg) {
#pragma unroll
                        for (int j = 0; j < 4; ++j) { v0[j] = sigmoid_f(v0[j]); v1[j] = sigmoid_f(v1[j]); } }
                    p[bj].x = cvt_pk_bf16(v0[0], v0[1]); p[bj].y = cvt_pk_bf16(v0[2], v0[3]); p[bj].z = cvt_pk_bf16(v1[0], v1[1]); p[bj].w = cvt_pk_bf16(v1[2], v1[3]); }
                fl_store(lanep + (size_t)(ai * HALF + m * 16) * pitch, 8 * pitch, p[0], p[1], lo); }
    }
};
struct EpiGate {
    static constexpr bool PERM = true, AFTER_DRAIN = false; static constexpr bool CHAIN = false; static constexpr bool LDS_BIAS = false;
    bf16_t* O; int ldc; int col_off; float ascale;
    __device__ __forceinline__ void operator()(const f32x4 (&acc)[2][2][4][2], const Unit& u, int wr, int wc, int fr, int fq) const {
        const int row0 = u.pm * BM + wr * 64 + fr, col0 = col_off + u.pn * BM + wc * 32 + 8 * fq;
#pragma unroll
        for (int ai = 0; ai < 2; ++ai)
#pragma unroll
            for (int m = 0; m < 4; ++m) { bf16_t* rowp = O + (size_t)(row0 + ai * HALF + m * 16) * ldc + col0;
#pragma unroll
                for (int bj = 0; bj < 2; ++bj) { f32x4 v0 = acc[ai][bj][m][0] * ascale, v1 = acc[ai][bj][m][1] * ascale;
#pragma unroll
                    for (int j = 0; j < 4; ++j) { v0[j] = sigmoid_f(v0[j]); v1[j] = sigmoid_f(v1[j]); }
                    u32x4 w; w.x = cvt_pk_bf16(v0[0], v0[1]); w.y = cvt_pk_bf16(v0[2], v0[3]); w.z = cvt_pk_bf16(v1[0], v1[1]); w.w = cvt_pk_bf16(v1[2], v1[3]);
                    *(u32x4*)(rowp + bj * HALF) = w; } }
    }
};
template <int PASS> struct EpiMerge {
    static constexpr bool PERM = false, AFTER_DRAIN = false; static constexpr bool CHAIN = false; static constexpr bool LDS_BIAS = false;
    const bf16_t* gate; int ldg; bf16_t* stash; bf16_t* outb; int ldc;
    __device__ __forceinline__ void operator()(const f32x4 (&acc)[2][2][4][2], const Unit& u, int wr, int wc, int fr, int fq) const {
        const int row0 = u.pm * BM + wr * 64 + fr, col0 = u.pn * BM + wc * 32 + 4 * fq;
#pragma unroll
        for (int ai = 0; ai < 2; ++ai)
#pragma unroll
            for (int m = 0; m < 4; ++m) { const size_t r = (size_t)(row0 + ai * HALF + m * 16);
#pragma unroll
                for (int bj = 0; bj < 2; ++bj)
#pragma unroll
                    for (int n = 0; n < 2; ++n) { const int c = col0 + bj * HALF + n * 16;
                        const u32x2 gv = *(const u32x2*)(gate + r * ldg + c);
                        f32x4 v = acc[ai][bj][m][n]; v[0] *= bf_lo(gv.x); v[1] *= bf_hi(gv.x); v[2] *= bf_lo(gv.y); v[3] *= bf_hi(gv.y);
                        if (PASS > 0) { const u32x2 sv = *(const u32x2*)(stash + r * ldc + c); v[0] += bf_lo(sv.x); v[1] += bf_hi(sv.x); v[2] += bf_lo(sv.y); v[3] += bf_hi(sv.y); }
                        u32x2 w; w.x = cvt_pk_bf16(v[0], v[1]); w.y = cvt_pk_bf16(v[2], v[3]);
                        if (PASS < 2) *(u32x2*)(stash + r * ldc + c) = w; else *(u32x2*)(outb + r * ldc + c) = w; }
                asm volatile("" ::: "memory"); }
    }
};
struct EpiRes {
    static constexpr bool PERM = true, AFTER_DRAIN = false; static constexpr bool CHAIN = false; static constexpr bool LDS_BIAS = false;
    const float* x; bf16_t* out; int ldc; float alpha;
    __device__ __forceinline__ void operator()(const f32x4 (&acc)[2][2][4][2], const Unit& u, int wr, int wc, int fr, int fq) const {
        const int row0 = u.pm * BM + wr * 64 + fr, col0 = u.pn * BM + wc * 32 + 8 * fq;
#pragma unroll
        for (int ai = 0; ai < 2; ++ai)
#pragma unroll
            for (int m = 0; m < 4; ++m) { const size_t off = (size_t)(row0 + ai * HALF + m * 16) * ldc + col0;
#pragma unroll
                for (int bj = 0; bj < 2; ++bj) { const f32x4 x0 = *(const f32x4*)(x + off + bj * HALF), x1 = *(const f32x4*)(x + off + bj * HALF + 4);
                    const f32x4 v0 = x0 * alpha + acc[ai][bj][m][0], v1 = x1 * alpha + acc[ai][bj][m][1];
                    u32x4 w; w.x = cvt_pk_bf16(v0[0], v0[1]); w.y = cvt_pk_bf16(v0[2], v0[3]); w.z = cvt_pk_bf16(v1[0], v1[1]); w.w = cvt_pk_bf16(v1[2], v1[3]);
                    *(u32x4*)(out + off + bj * HALF) = w; } }
    }
};
struct EpiMergeChain {
    static constexpr bool PERM = true, AFTER_DRAIN = false; static constexpr bool LDS_BIAS = false; static constexpr bool CHAIN = true;
    const bf16_t* gate; int ldg; bf16_t* outb; int ldc;
    __device__ __forceinline__ void operator()(f32x4 (&acc)[2][2][4][2], const Unit& u, int wr, int wc, int fr, int fq) const {
        const int row0 = u.pm * BM + wr * 64 + fr, col0 = u.pn * BM + wc * 32 + 8 * fq; const int b = u.b;
#pragma unroll
        for (int ai = 0; ai < 2; ++ai)
#pragma unroll
            for (int m = 0; m < 4; ++m) { const size_t r = (size_t)(row0 + ai * HALF + m * 16);
#pragma unroll
                for (int bj = 0; bj < 2; ++bj) { const int c = col0 + bj * HALF;
                    const u32x4 gv = *(const u32x4*)(gate + r * ldg + b * 1024 + c);
                    f32x4 g0, g1; g0[0] = bf_lo(gv.x); g0[1] = bf_hi(gv.x); g0[2] = bf_lo(gv.y); g0[3] = bf_hi(gv.y); g1[0] = bf_lo(gv.z); g1[1] = bf_hi(gv.z); g1[2] = bf_lo(gv.w); g1[3] = bf_hi(gv.w);
                    if (b > 0) {
#pragma unroll
                        for (int j = 0; j < 4; ++j) { g0[j] = fmaxf(g0[j], 1e-6f); g1[j] = fmaxf(g1[j], 1e-6f); } }
                    f32x4 v0 = acc[ai][bj][m][0] * g0, v1 = acc[ai][bj][m][1] * g1;
                    if (b < 2) { const u32x4 gn = *(const u32x4*)(gate + r * ldg + (b + 1) * 1024 + c);
                        v0[0] *= __builtin_amdgcn_rcpf(fmaxf(bf_lo(gn.x), 1e-6f)); v0[1] *= __builtin_amdgcn_rcpf(fmaxf(bf_hi(gn.x), 1e-6f)); v0[2] *= __builtin_amdgcn_rcpf(fmaxf(bf_lo(gn.y), 1e-6f)); v0[3] *= __builtin_amdgcn_rcpf(fmaxf(bf_hi(gn.y), 1e-6f));
                        v1[0] *= __builtin_amdgcn_rcpf(fmaxf(bf_lo(gn.z), 1e-6f)); v1[1] *= __builtin_amdgcn_rcpf(fmaxf(bf_hi(gn.z), 1e-6f)); v1[2] *= __builtin_amdgcn_rcpf(fmaxf(bf_lo(gn.w), 1e-6f)); v1[3] *= __builtin_amdgcn_rcpf(fmaxf(bf_hi(gn.w), 1e-6f));
                        acc[ai][bj][m][0] = v0; acc[ai][bj][m][1] = v1; }
                    else { u32x4 w; w.x = cvt_pk_bf16(v0[0], v0[1]); w.y = cvt_pk_bf16(v0[2], v0[3]); w.z = cvt_pk_bf16(v1[0], v1[1]); w.w = cvt_pk_bf16(v1[2], v1[3]); *(u32x4*)(outb + r * ldc + c) = w; } }
                asm volatile("" ::: "memory"); }
    }
};
struct MergeOrder {
    StaticOrder so;
    __device__ __forceinline__ bool next(int i, Unit& u) const { if (!so.next(i / 3, u)) return false; u.b = i % 3; return true; }
    __device__ __forceinline__ void a_ready(const Unit&) const {}
    __device__ __forceinline__ void done(const Unit&) const {}
};
struct EpiSwiglu {
    static constexpr bool PERM = true, AFTER_DRAIN = false; static constexpr bool CHAIN = false;
    bf16_t* O; const float* b1; float ascale; const PG8_LAS float* lb;
    static constexpr bool LDS_BIAS = true;
    __device__ __forceinline__ const float* bias_src(const Unit& u, int lane) const { const int e = u.e, pnl = u.pn - e * 8; return b1 + (size_t)e * 2048 + (lane >> 5) * 1024 + pnl * 128 + (lane & 31) * 4; }
    __device__ __forceinline__ void operator()(const f32x4 (&acc)[2][2][4][2], const Unit& u, int wr, int wc, int fr, int fq) const {
        const int e = u.e, pnl = u.pn - e * 8; const int row0 = u.pm * BM + wr * 64 + fr;
        f32x4 bg[2], bl[2]; const PG8_LAS float* lbs = lb + u.slot * 256 + wc * 32 + 8 * fq;
#pragma unroll
        for (int n = 0; n < 2; ++n) { bg[n] = *(const PG8_LAS f32x4*)(lbs + 4 * n); bl[n] = *(const PG8_LAS f32x4*)(lbs + 128 + 4 * n); }
        unsigned char* const lanep = (unsigned char*)O + (size_t)(row0 + (fq & 1) * 16) * 1024 + pnl * 128 + wc * 32 + 8 * (fq & 2);
#pragma unroll
        for (int ai = 0; ai < 2; ++ai)
#pragma unroll
            for (int p = 0; p < 2; ++p) { u32x2 w[2];
#pragma unroll
                for (int q = 0; q < 2; ++q) { const int m = 2 * p + q; f32x4 o[2];
#pragma unroll
                    for (int n = 0; n < 2; ++n) { const f32x4 g = acc[ai][0][m][n] * ascale + bg[n], l = acc[ai][1][m][n] * ascale + bl[n];
#pragma unroll
                        for (int j = 0; j < 4; ++j) { const float gg = fminf(g[j], 7.0f), ll = fminf(fmaxf(l[j], -7.0f), 7.0f);
                            o[n][j] = gg * __builtin_amdgcn_rcpf(1.0f + __builtin_amdgcn_exp2f(-1.702f * 1.4426950408889634f * gg)) * (ll + 1.0f); } }
                    int t0 = __builtin_amdgcn_cvt_pk_fp8_f32(o[0][0], o[0][1], 0, false); t0 = __builtin_amdgcn_cvt_pk_fp8_f32(o[0][2], o[0][3], t0, true);
                    int t1 = __builtin_amdgcn_cvt_pk_fp8_f32(o[1][0], o[1][1], 0, false); t1 = __builtin_amdgcn_cvt_pk_fp8_f32(o[1][2], o[1][3], t1, true); w[q].x = (unsigned)t0; w[q].y = (unsigned)t1; }
                const auto r0 = __builtin_amdgcn_permlane16_swap(w[0].x, w[1].x, false, false), r1 = __builtin_amdgcn_permlane16_swap(w[0].y, w[1].y, false, false);
                u32x4 out; out.x = r0[0]; out.y = r1[0]; out.z = r0[1]; out.w = r1[1];
                *(u32x4*)(lanep + (size_t)(ai * HALF + p * 32) * 1024) = out; }
    }
};
struct EpiY {
    static constexpr bool PERM = true, PERM16 = true, AFTER_DRAIN = false; static constexpr bool CHAIN = false;
    bf16_t* O; const float* b2; float ascale; const PG8_LAS float* lb;
    static constexpr bool LDS_BIAS = true;
    __device__ __forceinline__ const float* bias_src(const Unit& u, int lane) const { const int e = u.e, pnl = u.pn - e * 4; return b2 + (size_t)e * 1024 + pnl * BM + lane * 4; }
    __device__ __forceinline__ void operator()(const f32x4 (&acc)[2][2][4][2], const Unit& u, int wr, int wc, int fr, int fq) const {
        const int e = u.e, pnl = u.pn - e * 4; const int row0 = u.pm * BM + wr * 64 + fr, col0 = pnl * BM + wc * 64 + 16 * fq;
        f32x4 bv[2][2]; const PG8_LAS float* lbs = lb + u.slot * 256 + wc * 64 + 16 * fq;
#pragma unroll
        for (int bj = 0; bj < 2; ++bj)
#pragma unroll
            for (int n = 0; n < 2; ++n) bv[bj][n] = *(const PG8_LAS f32x4*)(lbs + 8 * bj + 4 * n);
#pragma unroll
        for (int ai = 0; ai < 2; ++ai)
#pragma unroll
            for (int m = 0; m < 4; ++m) { unsigned char* rowp = (unsigned char*)O + (size_t)(row0 + ai * HALF + m * 16) * 1024 + col0;
                u32x4 w;
#pragma unroll
                for (int bj = 0; bj < 2; ++bj) { const f32x4 v0 = acc[ai][bj][m][0] * ascale + bv[bj][0], v1 = acc[ai][bj][m][1] * ascale + bv[bj][1];
                    int t0 = __builtin_amdgcn_cvt_pk_fp8_f32(v0[0], v0[1], 0, false); t0 = __builtin_amdgcn_cvt_pk_fp8_f32(v0[2], v0[3], t0, true);
                    int t1 = __builtin_amdgcn_cvt_pk_fp8_f32(v1[0], v1[1], 0, false); t1 = __builtin_amdgcn_cvt_pk_fp8_f32(v1[2], v1[3], t1, true);
                    if (bj == 0) { w.x = (unsigned)t0; w.y = (unsigned)t1; } else { w.z = (unsigned)t0; w.w = (unsigned)t1; } }
                *(u32x4*)rowp = w; }
    }
};
struct MoeOrder {
    const PG8_LAS int* tstart; int nN, G, vcu;
    __device__ __forceinline__ int ts(int k) const { return __builtin_amdgcn_readfirstlane(tstart[k]); }
    __device__ __forceinline__ bool next(int i, Unit& u) const {
        const int L = i * G + vcu; const int T = ts(32); if (L >= T * nN) return false;
        int e = 0;
#pragma unroll
        for (int k = 1; k < 32; ++k) e += (L >= ts(k) * nN) ? 1 : 0;
        const int t0 = ts(e), R = ts(e + 1) - t0; const int rem = L - t0 * nN; const int ng = rem / (4 * R); const int r2 = rem - ng * 4 * R; const int pnl = r2 / R; const int pmi = r2 - pnl * R;
        u.pm = t0 + pmi; u.pn = e * nN + ng * 4 + pnl; u.e = e; u.b = 0; return true;
    }
    __device__ __forceinline__ void a_ready(const Unit&) const {}
    __device__ __forceinline__ void done(const Unit&) const {}
};
template <class E, class = void> struct has_p16 { static constexpr bool v = false; };
template <class E> struct has_p16<E, decltype((void)E::PERM16)> { static constexpr bool v = E::PERM16; };
template <class Epi, class Sched, bool ALIGN_EPI = false, bool SP2 = false, bool GATHER = false, bool FP8 = false>
__device__ __forceinline__ void gemm_phase(PG8_LAS unsigned char* lds, const Gemm g, const Sched& S, const Epi& E) {
    static_assert(!GATHER || SP2, "GATHER is wired into the SP2 loop only");
    int tid_ = threadIdx.x; asm volatile("" : "+v"(tid_));
    const int tid = tid_, wid = __builtin_amdgcn_readfirstlane(tid >> 6), lane = tid & 63, wr = wid >> 2, wc = wid & 3, fr = lane & 15, fq = lane >> 4;
    int K_ = g.K; asm volatile("" : "+s"(K_));
    const int K = K_, nt = K / BK;
    constexpr bool P16 = has_p16<Epi>::v;
    unsigned voffA[2], voffB[2];
#pragma unroll
    for (int i = 0; i < 2; ++i) { int R, C; stage_rc(tid * 16 + i * 8192, R, C); const int Rb = P16 ? ((R >> 5) * 64 + 16 * ((R & 15) >> 2) + 4 * ((R >> 4) & 1) + (R & 3)) : Epi::PERM ? ((R & ~31) + perm32(R & 31)) : R;
        voffA[i] = (unsigned)(R * K + C) * 2u; voffB[i] = (unsigned)(Rb * K + C) * 2u; }
    unsigned vC[2][2] = {{0u, 0u}, {0u, 0u}};
    const PG8_LAS int* const rowlds = (const PG8_LAS int*)(lds + STAGE_BYTES + 4096);
#define PG8_ROWS(dst, pm_) do { if constexpr (GATHER) { _Pragma("unroll") for (int h_ = 0; h_ < 2; ++h_) _Pragma("unroll") for (int i_ = 0; i_ < 2; ++i_) { int R_, C_; stage_rc(tid * 16 + i_ * 8192, R_, C_); \
        const int ix_ = (pm_) * BM + h_ * HALF + R_; dst[h_][i_] = ((g.rowmap ? (unsigned)g.rowmap[ix_] : (unsigned)ix_) * (unsigned)K + (unsigned)C_) * 2u; } } } while (0)
#define PG8_ROWS_LDS(dst) do { _Pragma("unroll") for (int h_ = 0; h_ < 2; ++h_) _Pragma("unroll") for (int i_ = 0; i_ < 2; ++i_) { int R_, C_; stage_rc(tid * 16 + i_ * 8192, R_, C_); \
        dst[h_][i_] = ((unsigned)rowlds[h_ * HALF + R_] * (unsigned)K + (unsigned)C_) * 2u; } } while (0)
    const size_t kstep = (size_t)(BK * 2);
    const size_t hstep = (size_t)HALF * K * 2;
    const size_t b64step = (size_t)64 * K * 2;
    const size_t hB = P16 ? (size_t)8 * K * 2 : hstep, b64B = P16 ? 2 * b64step : b64step;
    const size_t hA = GATHER ? (size_t)0 : hstep;
    const size_t tstep = 2 * hstep;
    const unsigned ldsw = (unsigned)wid * 1024u;
    const int aoff = lds_byte(wr * 64 + fr, fq * 8), boff = lds_byte(wc * 32 + fr, fq * 8);
#define PG8_SA(b, h) (((b) * 2 + (h)) * HTB)
#define PG8_SB(b, h) ((4 + (b) * 2 + (h)) * HTB)
#define PG8_STAGE(bufoff, gbase, voff) do { if constexpr (true) { const bool isB_ = ((const void*)(voff) == (const void*)voffB), isA_ = ((const void*)(voff) == (const void*)voffA); _Pragma("unroll") for (int _i = 0; _i < 2; ++_i) \
        __builtin_amdgcn_global_load_lds((const unsigned*)((const char*)(gbase) + (isB_ ? (size_t)_i * b64B : isA_ ? (size_t)_i * b64step : (size_t)0) + (isB_ ? voffB[0] : (isA_ ? voffA[0] : (voff)[_i]))), (PG8_LAS unsigned*)(lds + (bufoff) + ldsw + _i * 8192), 16, 0, 0); } } while (0)
#define PG8_LD16(off) (*(const PG8_LAS v8i_t_half*)(lds + (off)))
#define PG8_LDA(dst, b, h) do { if constexpr (FP8) { _Pragma("unroll") for (int m = 0; m < 4; ++m) dst##8[m] = __builtin_shufflevector(__builtin_bit_cast(v8i_t_half, *(const PG8_LAS bf16x8*)(lds + PG8_SA(b, h) + aoff + m * 2048)), __builtin_bit_cast(v8i_t_half, *(const PG8_LAS bf16x8*)(lds + PG8_SA(b, h) + aoff + m * 2048 + 1024)), 0, 1, 2, 3, 4, 5, 6, 7); } \
        else { _Pragma("unroll") for (int m = 0; m < 4; ++m) _Pragma("unroll") for (int k = 0; k < 2; ++k) dst[m][k] = *(const PG8_LAS bf16x8*)(lds + PG8_SA(b, h) + aoff + m * 2048 + k * 1024); } } while (0)
#define PG8_LDB(dst, b, h) do { if constexpr (FP8) { _Pragma("unroll") for (int n = 0; n < 2; ++n) dst##8[n] = __builtin_shufflevector(__builtin_bit_cast(v8i_t_half, *(const PG8_LAS bf16x8*)(lds + PG8_SB(b, h) + boff + n * 2048)), __builtin_bit_cast(v8i_t_half, *(const PG8_LAS bf16x8*)(lds + PG8_SB(b, h) + boff + n * 2048 + 1024)), 0, 1, 2, 3, 4, 5, 6, 7); } \
        else { _Pragma("unroll") for (int n = 0; n < 2; ++n) _Pragma("unroll") for (int k = 0; k < 2; ++k) dst[n][k] = *(const PG8_LAS bf16x8*)(lds + PG8_SB(b, h) + boff + n * 2048 + k * 1024); } } while (0)
#define PG8_MMA(ai, bj, At, Bt) do { __builtin_amdgcn_s_setprio(1); _Pragma("unroll") for (int m = 0; m < 4; ++m) _Pragma("unroll") for (int n = 0; n < 2; ++n) { \
        if constexpr (FP8) acc[ai][bj][m][n] = __builtin_amdgcn_mfma_scale_f32_16x16x128_f8f6f4(Bt##8[n], At##8[m], acc[ai][bj][m][n], 0, 0, 0, g.scale_a, 0, g.scale_a); \
        else { _Pragma("unroll") for (int k = 0; k < 2; ++k) acc[ai][bj][m][n] = __builtin_amdgcn_mfma_f32_16x16x32_bf16(Bt[n][k], At[m][k], acc[ai][bj][m][n], 0, 0, 0); } } __builtin_amdgcn_s_setprio(0); } while (0)
#define PG8_WAIT_V(n) asm volatile("s_waitcnt vmcnt(" #n ")" ::: "memory")
#define PG8_WAIT_L(n) asm volatile("s_waitcnt lgkmcnt(" #n ")" ::: "memory")
#define PG8_BAR __builtin_amdgcn_s_barrier()
#define PG8_SCHED __builtin_amdgcn_sched_barrier(0)
    Unit cur, nxt; int ui = 0;
    if (!S.next(0, cur)) return;
    cur.slot = 0;
    f32x4 acc[2][2][4][2];
#pragma unroll
    for (int a = 0; a < 2; ++a)
#pragma unroll
        for (int b = 0; b < 2; ++b)
#pragma unroll
            for (int m = 0; m < 4; ++m)
#pragma unroll
                for (int n = 0; n < 2; ++n) acc[a][b][m][n] = (f32x4){0.f, 0.f, 0.f, 0.f};
    bf16x8 At[4][2], B0[2][2], B1[2][2]; v8i_t At8[4], B08[2], B18[2];
    const char* cA = (const char*)g.A + (GATHER ? (size_t)0 : (size_t)cur.pm * tstep + (size_t)cur.b * g.strideA); const char* cB = (const char*)g.Bt + (size_t)cur.pn * tstep + (size_t)cur.b * g.strideB;
    PG8_ROWS(vC, cur.pm);
    S.a_ready(cur);
    if constexpr (SP2) {
        PG8_STAGE(PG8_SB(0, 0), cB, voffB); PG8_STAGE(PG8_SB(0, 1), cB + hB, voffB); PG8_STAGE(PG8_SA(0, 0), cA, (GATHER ? vC[0] : voffA)); PG8_STAGE(PG8_SA(0, 1), cA + hA, (GATHER ? vC[1] : voffA));
        if (wr == 1) PG8_BAR;
        PG8_WAIT_V(2); PG8_BAR;
        PG8_STAGE(PG8_SB(1, 0), cB + kstep, voffB); PG8_STAGE(PG8_SA(1, 0), cA + kstep, (GATHER ? vC[0] : voffA)); PG8_STAGE(PG8_SB(1, 1), cB + hB + kstep, voffB);
        PG8_WAIT_V(6); PG8_BAR;
    } else {
        PG8_STAGE(PG8_SB(0, 0), cB, voffB); PG8_STAGE(PG8_SA(0, 0), cA, voffA); PG8_STAGE(PG8_SB(0, 1), cB + hB, voffB); PG8_STAGE(PG8_SA(0, 1), cA + hstep, voffA);
        if (wr == 1) PG8_BAR;
        PG8_WAIT_V(4); PG8_BAR;
        PG8_STAGE(PG8_SB(1, 0), cB + kstep, voffB); PG8_STAGE(PG8_SA(1, 0), cA + kstep, voffA); PG8_STAGE(PG8_SB(1, 1), cB + hB + kstep, voffB);
        PG8_WAIT_V(6); PG8_BAR;
    }
    for (;;) {
        const bool has_next = S.next(ui + 1, nxt); nxt.slot = (ui + 1) & 1;
        if constexpr (Epi::LDS_BIAS) { if (wid == 0) __builtin_amdgcn_global_load_lds((const unsigned*)E.bias_src(cur, lane), (PG8_LAS unsigned*)(lds + STAGE_BYTES + 5120 + cur.slot * 1024), 16, 0, 0); }
        const char* nA = (has_next && !GATHER) ? (const char*)g.A + (size_t)nxt.pm * tstep + (size_t)nxt.b * g.strideA : cA; const char* nB = has_next ? (const char*)g.Bt + (size_t)nxt.pn * tstep + (size_t)nxt.b * g.strideB : cB;
        if constexpr (GATHER) { if (g.rowmap && wid == 0) { const int np_ = has_next ? nxt.pm : cur.pm;
            __builtin_amdgcn_global_load_lds((const unsigned*)(g.rowmap + (size_t)np_ * BM + lane * 4), (PG8_LAS unsigned*)(lds + STAGE_BYTES + 4096), 16, 0, 0); } }
        for (int t = 0; t < nt; t += 2) {
            const bool last = (t == nt - 2);
            const char* a1 = cA + (size_t)(t + 1) * kstep;
            const char* a2 = last ? nA : cA + (size_t)(t + 2) * kstep; const char* b2 = last ? nB : cB + (size_t)(t + 2) * kstep;
            const char* a3 = a2 + kstep; const char* b3 = b2 + kstep;
            if (last && has_next) S.a_ready(nxt);
            if constexpr (SP2) {
            PG8_LDB(B0, 0, 0); PG8_LDB(B1, 0, 1); PG8_SCHED; PG8_LDA(At, 0, 0); PG8_STAGE(PG8_SA(1, 1), a1 + hA, (GATHER ? vC[1] : voffA));
            if constexpr (GATHER) { if (last) { if (g.rowmap) PG8_ROWS_LDS(vC); else { const int np_ = has_next ? nxt.pm : cur.pm; PG8_ROWS(vC, np_); } } }
            PG8_WAIT_V(8); PG8_WAIT_L(0); PG8_BAR; PG8_MMA(0, 0, At, B0); PG8_MMA(0, 1, At, B1); PG8_BAR; PG8_SCHED;
            PG8_LDA(At, 0, 1); PG8_STAGE(PG8_SB(0, 0), b2, voffB); PG8_STAGE(PG8_SB(0, 1), b2 + hB, voffB); PG8_STAGE(PG8_SA(0, 0), a2, (GATHER ? vC[0] : voffA));
            PG8_WAIT_V(8); PG8_WAIT_L(0); PG8_BAR; PG8_MMA(1, 0, At, B0); PG8_MMA(1, 1, At, B1); PG8_BAR; PG8_SCHED;
            PG8_LDB(B0, 1, 0); PG8_LDB(B1, 1, 1); PG8_SCHED; PG8_LDA(At, 1, 0); PG8_STAGE(PG8_SA(0, 1), a2 + hA, (GATHER ? vC[1] : voffA));
            PG8_WAIT_V(8); PG8_WAIT_L(0); PG8_BAR; PG8_MMA(0, 0, At, B0); PG8_MMA(0, 1, At, B1); PG8_BAR; PG8_SCHED;
            PG8_LDA(At, 1, 1); PG8_STAGE(PG8_SB(1, 0), b3, voffB); PG8_STAGE(PG8_SB(1, 1), b3 + hB, voffB); PG8_STAGE(PG8_SA(1, 0), a3, (GATHER ? vC[0] : voffA));
            PG8_WAIT_V(8); PG8_WAIT_L(0); PG8_BAR; PG8_MMA(1, 0, At, B0); PG8_MMA(1, 1, At, B1); PG8_BAR; PG8_SCHED;
            } else {
            PG8_LDB(B0, 0, 0); PG8_SCHED; PG8_LDA(At, 0, 0); PG8_STAGE(PG8_SA(1, 1), a1 + hstep, voffA);
            PG8_WAIT_L(8); PG8_BAR; PG8_WAIT_L(0); PG8_MMA(0, 0, At, B0); PG8_BAR; PG8_SCHED;
            PG8_LDB(B1, 0, 1); PG8_STAGE(PG8_SB(0, 0), b2, voffB);
            PG8_BAR; PG8_WAIT_L(0); PG8_MMA(0, 1, At, B1); PG8_BAR;
            PG8_LDA(At, 0, 1); PG8_STAGE(PG8_SA(0, 0), a2, voffA);
            PG8_BAR; PG8_WAIT_L(0); PG8_MMA(1, 0, At, B0); PG8_BAR; PG8_SCHED;
            PG8_STAGE(PG8_SB(0, 1), b2 + hB, voffB);
            PG8_WAIT_V(6); PG8_BAR; PG8_MMA(1, 1, At, B1); PG8_BAR;
            PG8_LDB(B0, 1, 0); PG8_SCHED; PG8_LDA(At, 1, 0); PG8_STAGE(PG8_SA(0, 1), a2 + hstep, voffA);
            PG8_WAIT_L(8); PG8_BAR; PG8_WAIT_L(0); PG8_MMA(0, 0, At, B0); PG8_BAR; PG8_SCHED;
            PG8_LDB(B1, 1, 1); PG8_STAGE(PG8_SB(1, 0), b3, voffB);
            PG8_BAR; PG8_WAIT_L(0); PG8_MMA(0, 1, At, B1); PG8_BAR;
            PG8_LDA(At, 1, 1); PG8_STAGE(PG8_SA(1, 0), a3, voffA);
            PG8_BAR; PG8_WAIT_L(0); PG8_MMA(1, 0, At, B0); PG8_BAR; PG8_SCHED;
            PG8_STAGE(PG8_SB(1, 1), b3 + hB, voffB);
            PG8_WAIT_V(6); PG8_BAR; PG8_MMA(1, 1, At, B1); PG8_BAR;
            }
        }
        if constexpr (ALIGN_EPI) { if (wr == 0) PG8_BAR; }
        if constexpr (!Epi::AFTER_DRAIN) { int t2_ = threadIdx.x; asm volatile("" : "+v"(t2_)); E(acc, cur, wr, wc, t2_ & 15, (t2_ & 63) >> 4); S.done(cur); }
        if (!has_next) break;
        if (!(Epi::CHAIN && cur.b < 2)) {
#pragma unroll
        for (int a = 0; a < 2; ++a)
#pragma unroll
            for (int b = 0; b < 2; ++b)
#pragma unroll
                for (int m = 0; m < 4; ++m)
#pragma unroll
                    for (int n = 0; n < 2; ++n) acc[a][b][m][n] = (f32x4){0.f, 0.f, 0.f, 0.f};
        }
        cur = nxt; cA = nA; cB = nB; ++ui;
        if constexpr (ALIGN_EPI) { if (wr == 1) PG8_BAR; }
    }
    PG8_WAIT_V(0);
    if constexpr (!ALIGN_EPI) { if (wr == 0) PG8_BAR; }
    PG8_BAR;
    if constexpr (Epi::AFTER_DRAIN) { E.fused(acc, cur, wr, wc, fr, fq, lds, wid, lane); S.done(cur); }
#undef PG8_ROWS
#undef PG8_ROWS_LDS
#undef PG8_SA
#undef PG8_SB
#undef PG8_STAGE
#undef PG8_LDA
#undef PG8_LDB
#undef PG8_MMA
#undef PG8_LD16
#undef PG8_WAIT_V
#undef PG8_WAIT_L
#undef PG8_BAR
#undef PG8_SCHED
}
}
namespace attn_body {
using bf16=__hip_bfloat16;
using bf16x8=__attribute__((ext_vector_type(8)))short;
using s16x4=__attribute__((ext_vector_type(4)))short;
using f32x16=__attribute__((ext_vector_type(16)))float;
using f32x4v=__attribute__((ext_vector_type(4)))float;
using u32x4=__attribute__((ext_vector_type(4)))unsigned;
constexpr int D=64;
constexpr int NW=8,QBLK=32,QB=QBLK*NW,KVBLK=64;
__device__ __forceinline__ int crow(int r,int hi){return (r&3)+8*(r>>2)+4*hi;}
#define SBAR() __builtin_amdgcn_sched_barrier(0)
__device__ __forceinline__ void cmask(f32x16&p0,f32x16&p1,int jb,int qrel,int hi){
  const float NEG=-INFINITY; int kb=64*jb+4*hi;
  #pragma unroll
  for(int r=0;r<16;++r){int kv=kb+(r&3)+8*(r>>2); if(kv>qrel)p0[r]=NEG; if(kv+32>qrel)p1[r]=NEG;}
}

constexpr int NSLOT=3, SLOTB=8192;
constexpr int LDS_K=0, LDS_V=NSLOT*SLOTB, LDS_WS=2*NSLOT*SLOTB, LDS_OST=LDS_WS+NW*64*4, LDS_BYTES=LDS_OST+NW*4096;
constexpr int LDS_CS=LDS_BYTES, CS_BYTES=65536, LDS_TOTAL=LDS_CS+CS_BYTES;
constexpr int TBL_N=640, TBL_ZERO=256;
__device__ __forceinline__ void glds16(const void*gsrc,unsigned lds_dst){unsigned keep;
  asm volatile("s_mov_b32 %0, m0\n\ts_mov_b32 m0, %2\n\ts_nop 0\n\tglobal_load_lds_dwordx4 %1, off\n\ts_mov_b32 m0, %0":"=&s"(keep):"v"(gsrc),"s"(lds_dst):"memory");}
__device__ __forceinline__ float max3f(float a,float b,float c){float r;asm("v_max3_f32 %0, %1, %2, %3":"=v"(r):"v"(a),"v"(b),"v"(c));return r;}
__device__ __forceinline__ float max2f(float a,float b){float r;asm("v_max_f32_e32 %0, %1, %2":"=v"(r):"v"(a),"v"(b));return r;}
__device__ __forceinline__ float fadd_s(float a,float b){float r;asm("v_add_f32_e32 %0, %1, %2":"=v"(r):"v"(a),"v"(b));return r;}
__device__ __forceinline__ float fsub_s(float a,float b){float r;asm("v_sub_f32_e32 %0, %1, %2":"=v"(r):"v"(a),"v"(b));return r;}
typedef float f32x2_t __attribute__((ext_vector_type(2))); typedef __bf16 bf16x2_t __attribute__((ext_vector_type(2)));
__device__ __forceinline__ unsigned cvtpk_s(float lo,float hi){f32x2_t v={lo,hi};bf16x2_t b=__builtin_convertvector(v,bf16x2_t);return __builtin_bit_cast(unsigned,b);}
#define WAIT_BAR(N) asm volatile("s_waitcnt vmcnt(" #N ") lgkmcnt(0)\n\ts_barrier":::"memory")

__device__ __forceinline__ void qkt(f32x16&p0,f32x16&p1,const char*Kslot,const bf16x8*qr,int r32,int hi){
  const char*kb=Kslot+hi*1024+r32*16;
  #pragma unroll
  for(int d0=0;d0<4;++d0){
    const bf16x8 b0=*reinterpret_cast<const bf16x8*>(kb+d0*2048);
    const bf16x8 b1=*reinterpret_cast<const bf16x8*>(kb+d0*2048+512);
    p0=__builtin_amdgcn_mfma_f32_32x32x16_bf16(b0,qr[d0],p0,0,0,0);p1=__builtin_amdgcn_mfma_f32_32x32x16_bf16(b1,qr[d0],p1,0,0,0);}
}
typedef __attribute__((address_space(3))) const char* lds_cptr;
typedef __attribute__((address_space(3))) char* lds_ptr;
typedef short v4i16_t __attribute__((ext_vector_type(4)));
__device__ __forceinline__ void kload8(bf16x8*kf,lds_cptr kp){
  kf[0]=*(const __attribute__((address_space(3))) bf16x8*)(kp);      kf[1]=*(const __attribute__((address_space(3))) bf16x8*)(kp+512);
  kf[2]=*(const __attribute__((address_space(3))) bf16x8*)(kp+2048); kf[3]=*(const __attribute__((address_space(3))) bf16x8*)(kp+2560);
  kf[4]=*(const __attribute__((address_space(3))) bf16x8*)(kp+4096); kf[5]=*(const __attribute__((address_space(3))) bf16x8*)(kp+4608);
  kf[6]=*(const __attribute__((address_space(3))) bf16x8*)(kp+6144); kf[7]=*(const __attribute__((address_space(3))) bf16x8*)(kp+6656);
}
__device__ __forceinline__ void kload2(bf16x8*kf,lds_cptr kp,int j){ kf[2*j]=*(const __attribute__((address_space(3))) bf16x8*)(kp+j*2048); kf[2*j+1]=*(const __attribute__((address_space(3))) bf16x8*)(kp+j*2048+512); }
__device__ __forceinline__ s16x4 vtr(lds_cptr p){ return __builtin_bit_cast(s16x4,__builtin_amdgcn_ds_read_tr16_b64_v4i16((__attribute__((address_space(3))) v4i16_t*)p)); }
__device__ __forceinline__ float rowmax(const f32x16&p0,const f32x16&p1){
  float a=max3f(p0[0],p0[1],p1[0]),b=max3f(p0[2],p0[3],p1[1]);a=max3f(a,p1[2],p1[3]);
  #pragma unroll
  for(int r=4;r<16;r+=4){a=max3f(a,p0[r],p0[r+1]);b=max3f(b,p0[r+2],p0[r+3]);a=max3f(a,p1[r],p1[r+1]);b=max3f(b,p1[r+2],p1[r+3]);}
  const float m=max2f(a,b);
  auto rr=__builtin_amdgcn_permlane32_swap(__float_as_uint(m),__float_as_uint(m),false,false);
  return max2f(__uint_as_float(rr[0]),__uint_as_float(rr[1]));
}
__device__ __forceinline__ void pv(f32x16*o,int vb,bf16x8 pa0,bf16x8 pa1,bf16x8 pa2,bf16x8 pa3){
  #pragma unroll
  for(int d0=0;d0<2;++d0){s16x4 lo[4],hi[4];
    #pragma unroll
    for(int ks=0;ks<4;++ks){
      asm volatile("ds_read_b64_tr_b16 %0,%1 offset:%c2":"=&v"(lo[ks]):"v"(vb),"i"(d0*4096+ks*1024):"memory");
      asm volatile("ds_read_b64_tr_b16 %0,%1 offset:%c2":"=&v"(hi[ks]):"v"(vb),"i"(d0*4096+ks*1024+512):"memory");}
    asm volatile("s_waitcnt lgkmcnt(0)":::"memory");SBAR();
    #define PK(k) (bf16x8){lo[k][0],lo[k][1],lo[k][2],lo[k][3],hi[k][0],hi[k][1],hi[k][2],hi[k][3]}
    o[d0]=__builtin_amdgcn_mfma_f32_32x32x16_bf16(pa0,PK(0),o[d0],0,0,0);
    o[d0]=__builtin_amdgcn_mfma_f32_32x32x16_bf16(pa1,PK(1),o[d0],0,0,0);
    o[d0]=__builtin_amdgcn_mfma_f32_32x32x16_bf16(pa2,PK(2),o[d0],0,0,0);
    o[d0]=__builtin_amdgcn_mfma_f32_32x32x16_bf16(pa3,PK(3),o[d0],0,0,0);
    #undef PK
  }
}

struct AttnArgs { const bf16* Q; const bf16* K; const bf16* V; bf16* O; long qp, kp, op; int q0, NT, kv0; const float* aux; float* lse; long lse_stride; int tlo, thi, band; float thr; };
#define ATTN_STORE16(p,v) (*(u32x4*)(p)=(v))
template<int MODE,int THRL> __device__ __forceinline__ void attn_unit(const AttnArgs&a,char*shm){
  int tid_=threadIdx.x; asm volatile("":"+v"(tid_));
  const int tid=tid_,lane=tid&63,r32=lane&31,hi=lane>>5; const int wid=__builtin_amdgcn_readfirstlane(tid>>6);
  const int q0=a.q0; const long KP=a.kp;
  const bf16*Qw=a.Q+(long)(q0+wid*QBLK)*a.qp;
  const bf16*Kh=a.K,*Vh=a.V;
  int NT=a.NT, lo=0;
  if(MODE==0){
    const int nt0=a.thi-a.tlo; const float cq=a.aux[q0];
    const float ck=(lane<nt0)?a.aux[64*(a.tlo+lane)+63]:0.f;
    const unsigned long long need=__ballot((lane<nt0)&&(cq-ck>=-a.thr));
    const int j0=need?(int)__builtin_ctzll(need):nt0;
    if(j0>=nt0){ if(a.lse&&tid<QB)a.lse[(long)(q0+tid)*a.lse_stride]=-INFINITY; return; }
    lo=a.tlo+j0; int n=a.thi-lo; if(n<4){lo=a.thi-4;n=4;} if(n&1){lo-=1;n+=1;} NT=n;
    Kh+=(long)lo*KVBLK*KP; Vh+=(long)lo*KVBLK*KP;
  }
  const unsigned lds0=(unsigned)(uintptr_t)shm;
  float*wsf=(float*)(shm+LDS_WS)+wid*64;
  const lds_cptr shm3=(lds_cptr)shm;
  const __attribute__((address_space(3))) float* cs3=(const __attribute__((address_space(3))) float*)(shm3+LDS_CS);
  float nb=0.f;
  if(MODE==0){ __attribute__((address_space(3))) f32x4v* dst=(__attribute__((address_space(3))) f32x4v*)((lds_ptr)shm+LDS_CS); const f32x4v* src=(const f32x4v*)a.aux+16*lo; const int n4=16*NT;
    for(int i=tid;i<n4;i+=NW*64)dst[i]=src[i];
    nb=a.aux[q0+wid*QBLK+r32]; }
  if(MODE==1){ __attribute__((address_space(3))) float* dst=(__attribute__((address_space(3))) float*)((lds_ptr)shm+LDS_CS);
    for(int i=tid;i<TBL_N;i+=NW*64)dst[i]=a.aux[i]; }
  const bf16*ksrc=Kh+(long)lane*KP+wid*8;
  const bf16*vsrc=Vh+(long)(16*(wid&3)+(lane>>2))*KP+(wid>>2)*32+(lane&3)*8;
  const unsigned kdst=lds0+LDS_K+wid*1024, vdst=lds0+LDS_V+wid*1024;
  #define DMA_K(t,slot) glds16(ksrc+(long)(t)*KVBLK*KP,(unsigned)__builtin_amdgcn_readfirstlane(kdst+(slot)))
  #define DMA_V(t,slot) glds16(vsrc+(long)(t)*KVBLK*KP,(unsigned)__builtin_amdgcn_readfirstlane(vdst+(slot)))
  const int vb0=(int)(lds0+LDS_V)+((lane>>4)&1)*32+(lane&3)*8+(4*hi+((lane&15)>>2))*64;
  const char*Kbase=shm+LDS_K; bf16x8 kf[8];
  const lds_cptr kp0=shm3+LDS_K+hi*1024+r32*16; const lds_cptr vp0=shm3+LDS_V+((lane>>4)&1)*32+(lane&3)*8+(4*hi+((lane&15)>>2))*64;
  DMA_K(0,0);DMA_V(0,0);DMA_K(1,SLOTB);
  bf16x8 qr[4];
  #pragma unroll
  for(int d0=0;d0<4;++d0)qr[d0]=*reinterpret_cast<const bf16x8*>(&Qw[(long)r32*a.qp+d0*16+hi*8]);
  float mhat=0.f,l_reg=0.f;f32x16 o[2];o[0]=f32x16{};o[1]=f32x16{};
  const int qrel=wid*QBLK+r32;
  const int tb0=q0+qrel-a.kv0-4*hi+TBL_ZERO-63;
  #define CINIT(C0,C1,t) do{ \
    if(MODE==0){ const __attribute__((address_space(3))) float* cp_=cs3+64*(t)+4*hi; \
      _Pragma("unroll") for(int g_=0;g_<4;++g_){ const f32x4v a_=*(const __attribute__((address_space(3))) f32x4v*)(cp_+8*g_); const f32x4v b_=*(const __attribute__((address_space(3))) f32x4v*)(cp_+32+8*g_); \
        C0[4*g_]=nb-a_[0];C0[4*g_+1]=nb-a_[1];C0[4*g_+2]=nb-a_[2];C0[4*g_+3]=nb-a_[3]; C1[4*g_]=nb-b_[0];C1[4*g_+1]=nb-b_[1];C1[4*g_+2]=nb-b_[2];C1[4*g_+3]=nb-b_[3]; } } \
    else if(MODE==1){ const __attribute__((address_space(3))) float* tp_=cs3+(tb0-64*(t)); \
      _Pragma("unroll") for(int g_=0;g_<4;++g_) _Pragma("unroll") for(int j_=0;j_<4;++j_){ C0[4*g_+j_]=nb+tp_[63-8*g_-j_]; C1[4*g_+j_]=nb+tp_[31-8*g_-j_]; } } \
    else { _Pragma("unroll") for(int r_=0;r_<16;++r_){C0[r_]=nb;C1[r_]=nb;} } }while(0)
  #define CMASK(P0,P1,t) do{ if(MODE==0&&a.band){int jb_=(t)-(NT-4); if(jb_>=0)cmask(P0,P1,jb_,qrel,hi);} }while(0)
  bool resc=false;
  #define START(P0,P1) do{ const float rm=rowmax(P0,P1); resc=false; \
    { const float dl=(MODE==1)?max2f(rm,-256.0f):rm; mhat=fadd_s(mhat,dl); nb=fsub_s(nb,dl); \
      _Pragma("unroll") for(int r=0;r<16;++r){P0[r]=fsub_s(P0[r],dl);P1[r]=fsub_s(P1[r],dl);} } \
    _Pragma("unroll") for(int r=0;r<16;++r)P0[r]=__builtin_amdgcn_exp2f(P0[r]); }while(0)
  #define RESC() do{ if(resc){ asm volatile("s_waitcnt lgkmcnt(0)":::"memory"); \
      _Pragma("unroll") for(int d_=0;d_<2;++d_) _Pragma("unroll") for(int r=0;r<16;++r)o[d_][r]*=wsf[crow(r,hi)]; } }while(0)
  f32x16 pA0,pA1,pB0,pB1;
  int sl_prev=0,sl_cur=0,sl_next=SLOTB;
  #define ROT() do{sl_prev=sl_cur;sl_cur=sl_next;sl_next=(sl_next==(NSLOT-1)*SLOTB)?0:sl_next+SLOTB;}while(0)
  DMA_K(2,2*SLOTB);
  WAIT_BAR(3);
  CINIT(pA0,pA1,0);
  qkt(pA0,pA1,Kbase,qr,r32,hi);asm volatile("s_nop 15\n\ts_nop 7":"+v"(pA0),"+v"(pA1));CMASK(pA0,pA1,0);
  START(pA0,pA1);
  _Pragma("unroll") for(int r=0;r<16;++r)pA1[r]=__builtin_amdgcn_exp2f(pA1[r]);
  WAIT_BAR(0);
  DMA_K(3,0);DMA_V(1,SLOTB);
  ROT();
  kload8(kf,kp0+sl_cur);
  WAIT_BAR(2);
  s16x4 vlo[8],vhi[8]; u32x4 pw0,pw1,pw2,pw3;
  #define PKW(P,B) cvtpk_s(P[B],P[B+1])
  #define PAF(k) __builtin_bit_cast(bf16x8,pw##k)
  #define VFR(i) (bf16x8){vlo[i][0],vlo[i][1],vlo[i][2],vlo[i][3],vhi[i][0],vhi[i][1],vhi[i][2],vhi[i][3]}
  #define PIN(x) asm volatile("":"+v"(x))
  #define MX3(a,b,c) __builtin_fmaxf(__builtin_fmaxf((a),(b)),(c))
  #define GAPA(MF,A0,A1,A2,A3,W0,W1,PW) do{ MF; sacc+=A0; sacc+=A1; sacc+=A2; sacc+=A3; PIN(sacc); W0; W1; PIN(PW); SBAR(); }while(0)
  #define EX(v) __builtin_amdgcn_exp2f(v)
  #define GAPB(MF,X,B) do{ MF; X[B]=EX(X[B]); X[B+1]=EX(X[B+1]); X[B+2]=EX(X[B+2]); X[B+3]=EX(X[B+3]); PIN(X); SBAR(); }while(0)
  #define VRD(i) do{ vlo[i]=vtr(vp_+(((i)>>2)*4096+((i)&3)*1024)); vhi[i]=vtr(vp_+(((i)>>2)*4096+((i)&3)*1024+512)); }while(0)
  #define KRD(G,j) do{ if(G){ kload2(kf,kp0+sl_next,j); SBAR(); } }while(0)
  #define STEP(C0,C1,P0,P1,t,GK,GV,GL) do{ CINIT(C0,C1,t); SBAR(); \
    const lds_cptr vp_=vp0+sl_prev; \
    VRD(0); SBAR(); float sacc=(P0[0]+P0[1]); \
    GAPA(C0=__builtin_amdgcn_mfma_f32_32x32x16_bf16(kf[0],qr[0],C0,0,0,0), P0[2],P0[3],P0[4],P0[5],     pw0[0]=PKW(P0,0), pw0[1]=PKW(P0,2), pw0); \
    VRD(4); SBAR(); GAPA(C1=__builtin_amdgcn_mfma_f32_32x32x16_bf16(kf[1],qr[0],C1,0,0,0), P0[6],P0[7],P0[8],P0[9],     pw0[2]=PKW(P0,4), pw0[3]=PKW(P0,6), pw0); \
    VRD(1); SBAR(); GAPA(C0=__builtin_amdgcn_mfma_f32_32x32x16_bf16(kf[2],qr[1],C0,0,0,0),   P0[10],P0[11],P0[12],P0[13], pw1[0]=PKW(P0,8), pw1[1]=PKW(P0,10), pw1); \
    VRD(5); SBAR(); GAPA(C1=__builtin_amdgcn_mfma_f32_32x32x16_bf16(kf[3],qr[1],C1,0,0,0),   P0[14],P0[15],P1[0],P1[1],   pw1[2]=PKW(P0,12),pw1[3]=PKW(P0,14), pw1); \
    VRD(2); SBAR(); GAPA(C0=__builtin_amdgcn_mfma_f32_32x32x16_bf16(kf[4],qr[2],C0,0,0,0),   P1[2],P1[3],P1[4],P1[5],     pw2[0]=PKW(P1,0), pw2[1]=PKW(P1,2), pw2); \
    VRD(6); SBAR(); GAPA(C1=__builtin_amdgcn_mfma_f32_32x32x16_bf16(kf[5],qr[2],C1,0,0,0),   P1[6],P1[7],P1[8],P1[9],     pw2[2]=PKW(P1,4), pw2[3]=PKW(P1,6), pw2); \
    VRD(3); SBAR(); GAPA(C0=__builtin_amdgcn_mfma_f32_32x32x16_bf16(kf[6],qr[3],C0,0,0,0),   P1[10],P1[11],P1[12],P1[13], pw3[0]=PKW(P1,8), pw3[1]=PKW(P1,10), pw3); \
    VRD(7); SBAR(); GAPA(C1=__builtin_amdgcn_mfma_f32_32x32x16_bf16(kf[7],qr[3],C1,0,0,0),   P1[14],P1[15],0.f,0.f,       pw3[2]=PKW(P1,12),pw3[3]=PKW(P1,14), pw3); \
    l_reg+=sacc; \
    if(GK){DMA_K((t)+3,sl_cur);} if(GV){DMA_V((t)+1,sl_next);} \
    CMASK(C0,C1,t); \
    { float a=MX3(C0[0],C0[1],C1[0]),b=MX3(C0[2],C0[3],C1[1]); a=MX3(a,C1[2],C1[3]); \
      _Pragma("unroll") for(int r=4;r<16;r+=4){a=MX3(a,C0[r],C0[r+1]);b=MX3(b,C0[r+2],C0[r+3]);a=MX3(a,C1[r],C1[r+1]);b=MX3(b,C1[r+2],C1[r+3]);} \
      float rm=__builtin_fmaxf(a,b); { auto rr=__builtin_amdgcn_permlane32_swap(__float_as_uint(rm),__float_as_uint(rm),false,false); rm=__builtin_fmaxf(__uint_as_float(rr[0]),__uint_as_float(rr[1])); } \
      resc=false; \
      if(__builtin_expect(__any(rm>(float)THRL),0)){ const float dl=__builtin_fmaxf(rm,0.f); mhat+=dl; nb-=dl; \
        _Pragma("unroll") for(int r=0;r<16;++r){C0[r]-=dl;C1[r]-=dl;} \
        const float f=__builtin_amdgcn_exp2f(-dl); l_reg*=f; if(hi==0)wsf[r32]=f; resc=true; } } \
    SBAR(); \
    GAPB(o[0]=__builtin_amdgcn_mfma_f32_32x32x16_bf16(PAF(0),VFR(0),o[0],0,0,0), C0,0); \
    GAPB(o[1]=__builtin_amdgcn_mfma_f32_32x32x16_bf16(PAF(0),VFR(4),o[1],0,0,0), C0,4); \
    KRD(GL,0); GAPB(o[0]=__builtin_amdgcn_mfma_f32_32x32x16_bf16(PAF(1),VFR(1),o[0],0,0,0), C0,8); \
    KRD(GL,1); GAPB(o[1]=__builtin_amdgcn_mfma_f32_32x32x16_bf16(PAF(1),VFR(5),o[1],0,0,0), C0,12); \
    KRD(GL,2); GAPB(o[0]=__builtin_amdgcn_mfma_f32_32x32x16_bf16(PAF(2),VFR(2),o[0],0,0,0), C1,0); \
    KRD(GL,3); GAPB(o[1]=__builtin_amdgcn_mfma_f32_32x32x16_bf16(PAF(2),VFR(6),o[1],0,0,0), C1,4); \
    GAPB(o[0]=__builtin_amdgcn_mfma_f32_32x32x16_bf16(PAF(3),VFR(3),o[0],0,0,0), C1,8); \
    GAPB(o[1]=__builtin_amdgcn_mfma_f32_32x32x16_bf16(PAF(3),VFR(7),o[1],0,0,0), C1,12); \
    }while(0)
  int t=1;
  #undef CMASK
  #define CMASK(P0,P1,t) do{}while(0)
  for(;t+5<NT;t+=2){
    STEP(pB0,pB1,pA0,pA1,t,true,true,true);     WAIT_BAR(2); RESC(); ROT();
    STEP(pA0,pA1,pB0,pB1,t+1,true,true,true);   WAIT_BAR(2); RESC(); ROT();
  }
  #undef CMASK
  #define CMASK(P0,P1,t) do{ if(MODE==0&&a.band){int jb_=(t)-(NT-4); if(jb_>=0)cmask(P0,P1,jb_,qrel,hi);} }while(0)
  #define ENDW(tt) do{ if((tt)+3<NT){WAIT_BAR(2);} else if((tt)+2<NT){WAIT_BAR(1);} else {WAIT_BAR(0);} }while(0)
  for(;t+1<NT;t+=2){
    STEP(pB0,pB1,pA0,pA1,t,(t+3<NT),(t+1<NT),(t+1<NT));       ENDW(t);   RESC(); ROT();
    STEP(pA0,pA1,pB0,pB1,t+1,(t+4<NT),(t+2<NT),(t+2<NT));     ENDW(t+1); RESC(); ROT();
  }
  STEP(pB0,pB1,pA0,pA1,NT-1,false,false,false); RESC();
  { float sacc=pB0[0]+pB0[1]; _Pragma("unroll") for(int r=2;r<16;++r)sacc+=pB0[r]; _Pragma("unroll") for(int r=0;r<16;++r)sacc+=pB1[r]; l_reg+=sacc;
    pw0=(u32x4){PKW(pB0,0),PKW(pB0,2),PKW(pB0,4),PKW(pB0,6)};pw1=(u32x4){PKW(pB0,8),PKW(pB0,10),PKW(pB0,12),PKW(pB0,14)};pw2=(u32x4){PKW(pB1,0),PKW(pB1,2),PKW(pB1,4),PKW(pB1,6)};pw3=(u32x4){PKW(pB1,8),PKW(pB1,10),PKW(pB1,12),PKW(pB1,14)};
    SBAR(); pv(o,vb0+sl_cur,PAF(0),PAF(1),PAF(2),PAF(3)); }
  #undef PKW
  #undef PAF
  #undef VFR
  #undef PIN
  #undef MX3
  #undef GAPA
  #undef GAPB
  #undef EX
  #undef VRD
  #undef KRD
  #undef STEP
  #undef ENDW
  {auto rr=__builtin_amdgcn_permlane32_swap(__float_as_uint(l_reg),__float_as_uint(l_reg),false,false);l_reg=__uint_as_float(rr[0])+__uint_as_float(rr[1]);}
  if(MODE==1||(MODE==0&&a.lse)){ if(hi==0) a.lse[(long)(q0+qrel)*a.lse_stride]=mhat+__builtin_amdgcn_logf(l_reg); }
  if(hi==0)wsf[32+r32]=l_reg;asm volatile("s_waitcnt lgkmcnt(0)":::"memory");
  float rli[16];
  #pragma unroll
  for(int r=0;r<16;++r)rli[r]=__builtin_amdgcn_rcpf(wsf[32+crow(r,hi)]);
  bf16*Ow=a.O+(long)(q0+wid*QBLK)*a.op;
  { bf16*stg=(bf16*)(shm+LDS_OST)+wid*2048;
    #pragma unroll
    for(int r=0;r<16;++r){const int orow=crow(r,hi);
      #pragma unroll
      for(int d0=0;d0<2;++d0)stg[orow*64+d0*32+r32]=__float2bfloat16(o[d0][r]*rli[r]);}
    asm volatile("s_waitcnt lgkmcnt(0)":::"memory");
    #pragma unroll
    for(int i=0;i<4;++i){const int row=i*8+(lane>>3),ch=lane&7; const u32x4 v=*(const u32x4*)(stg+row*64+ch*8); ATTN_STORE16(Ow+(long)row*a.op+ch*8,v);} }
  asm volatile("s_waitcnt lgkmcnt(0)\n\ts_barrier":::"memory");
  #undef DMA_K
  #undef DMA_V
  #undef CMASK
  #undef CINIT
  #undef START
  #undef RESC
  #undef ROT
}
constexpr int ATTN_LDS_BYTES=LDS_TOTAL;
#undef SBAR
#undef WAIT_BAR
}
#define GAS __attribute__((address_space(1)))
#define LAS __attribute__((address_space(3)))
typedef unsigned short bf16;
typedef unsigned v4u __attribute__((ext_vector_type(4)));
typedef float f32x4 __attribute__((ext_vector_type(4)));
typedef short bf16x8 __attribute__((ext_vector_type(8)));
typedef GAS unsigned gu32;
typedef GAS unsigned long long gu64;
#define RLX_AGENT __ATOMIC_RELAXED, __HIP_MEMORY_SCOPE_AGENT
#define LDS_WAIT() asm volatile("s_waitcnt lgkmcnt(0)" ::: "memory")
#define VM_WAIT() asm volatile("s_waitcnt vmcnt(0)" ::: "memory")
__device__ __forceinline__ unsigned long long rt() { return __builtin_amdgcn_s_memrealtime(); }
__device__ __forceinline__ unsigned f2bf(float f) { unsigned u = __builtin_bit_cast(unsigned, f); return (u + 0x7fffu + ((u >> 16) & 1u)) >> 16; }
__device__ __forceinline__ unsigned pk4_fp8(float a, float b, float c, float d) { int w = __builtin_amdgcn_cvt_pk_fp8_f32(a, b, 0, false); w = __builtin_amdgcn_cvt_pk_fp8_f32(c, d, w, true); return (unsigned)w; }
__device__ __forceinline__ unsigned pk2(float lo, float hi) { typedef float f2_t __attribute__((ext_vector_type(2))); typedef __bf16 b2_t __attribute__((ext_vector_type(2))); f2_t v = {lo, hi}; b2_t b = __builtin_convertvector(v, b2_t); return __builtin_bit_cast(unsigned, b); }

#define XB_TMO      128
#define XB_XCNT(j)  (256  + 64 * (j))
#define XB_XSUB(j)  (1280 + 64 * (j))
#define XB_XGEN(j)  (2304 + 64 * (j))
#define XB_TOP      3328
#define XB_TOPGEN   3392
#define XCD_BAR_WORDS 3456
#define XB_SPIN_CAP (1u << 18)

__device__ __forceinline__ unsigned xb_ld(unsigned* p)              { return __hip_atomic_load(p, __ATOMIC_RELAXED, __HIP_MEMORY_SCOPE_AGENT); }
__device__ __forceinline__ unsigned xb_add(unsigned* p, unsigned v) { return __hip_atomic_fetch_add(p, v, __ATOMIC_RELAXED, __HIP_MEMORY_SCOPE_AGENT); }
__device__ __forceinline__ unsigned xb_xcc_id() { return (unsigned)__builtin_amdgcn_s_getreg((3 << 11) | 20) & 0xFu; }
#define XB_SPIN(cond, bar) do { unsigned _sp = 0; while (cond) { __builtin_amdgcn_s_sleep(1); \
    if ((++_sp & 255u) == 0u) { if (xb_ld(&(bar)[XB_TMO])) break; if (_sp > XB_SPIN_CAP) { atomicAdd(&(bar)[XB_TMO], 1u); break; } } } } while (0)

struct XcdBarrier {
    unsigned* bar; unsigned x;
    volatile LAS unsigned* st;
};

__device__ __forceinline__ XcdBarrier xcd_barrier_post(unsigned* bar, volatile LAS unsigned* st) {
    XcdBarrier b; b.bar = bar; b.x = xb_xcc_id(); b.st = st;
    if (threadIdx.x == 0) (void)xb_add(&bar[XB_XCNT(b.x)], 1u);
    return b;
}
__device__ __forceinline__ void xcd_barrier_complete(unsigned* bar, unsigned x, unsigned& nloc, unsigned& nx) {
    const unsigned G = gridDim.x * gridDim.y * gridDim.z;
    unsigned sum, cnt, mine, sp = 0u;
    for (;;) {
        sum = 0u; cnt = 0u; mine = 0u;
#pragma unroll
        for (unsigned j = 0; j < 16; ++j) { const unsigned c = xb_ld(&bar[XB_XCNT(j)]); sum += c; cnt += (c > 0u) ? 1u : 0u; mine = (j == x) ? c : mine; }
        if (sum == G) break;
        __builtin_amdgcn_s_sleep(1);
        if ((++sp & 255u) == 0u) { if (xb_ld(&bar[XB_TMO])) break; if (sp > XB_SPIN_CAP) { atomicAdd(&bar[XB_TMO], 1u); break; } }
    }
    nloc = mine > 0u ? mine : 1u; nx = cnt > 0u ? cnt : 1u;
}

__device__ __forceinline__ void xcd_barrier(const XcdBarrier& b) {
    asm volatile("s_waitcnt vmcnt(0)" ::: "memory");
    __syncthreads();
    if (threadIdx.x == 0) {
        unsigned* bar = b.bar;
        __builtin_amdgcn_s_waitcnt(0);
        unsigned nloc = b.st[0], nx = b.st[1];
        if (nloc == 0u) { xcd_barrier_complete(bar, b.x, nloc, nx); b.st[0] = nloc; b.st[1] = nx; }
        const unsigned old = xb_add(&bar[XB_XSUB(b.x)], 1u);
        const unsigned gen = old / nloc;
        if (old + 1u == (gen + 1u) * nloc) {
            __builtin_amdgcn_fence(__ATOMIC_RELEASE, "agent");
            asm volatile("s_waitcnt vmcnt(0)" ::: "memory");
            const unsigned og = xb_add(&bar[XB_TOP], 1u);
            const unsigned tg = og / nx;
            if (og + 1u == (tg + 1u) * nx) xb_add(&bar[XB_TOPGEN], 1u);
            else XB_SPIN(xb_ld(&bar[XB_TOPGEN]) == tg, bar);
            __builtin_amdgcn_fence(__ATOMIC_ACQUIRE, "agent");
            xb_add(&bar[XB_XGEN(b.x)], 1u);
            asm volatile("s_waitcnt vmcnt(0)" ::: "memory");
        } else {
            XB_SPIN(xb_ld(&bar[XB_XGEN(b.x)]) == gen, bar);
            __builtin_amdgcn_fence(__ATOMIC_ACQUIRE, "agent");
            asm volatile("s_waitcnt vmcnt(0)" ::: "memory");
        }
    }
    __syncthreads();
}

constexpr int NWAVES = 8;
constexpr int S = 16384, DM = 1024, NPROJ = 5632, NE = 32, MEML = 256;
constexpr int PC_FQ = 0, PC_FK = 384, PC_FV = 768, PC_DQ = 1152, PC_DK = 1536, PC_DV = 1920, PC_MQ = 2304, PC_GT = 2560;
constexpr int W_IN_LD = 5638, W_IN_F = 1152;
constexpr float LN_EPS = 1e-5f, ALPHA = 1.189207115002721f;
constexpr float LOG2E = 1.4426950408889634f, C2F = 0.125f * 1.4426950408889634f;
constexpr int MAXROWS = 65536 + 32 * 256;
constexpr int NPHASE = 11;
#ifndef MK_N_LAUNCHES
#define MK_N_LAUNCHES 1
#endif
constexpr int N_LAUNCHES = MK_N_LAUNCHES;

constexpr size_t MiB = 1u << 20, KiB = 1u << 10;
constexpr size_t WS_CTL = 0, CTL_ZERO_BYTES = 256 * KiB;
constexpr size_t WS_WIN = 2 * MiB;
constexpr size_t WS_WBF = 748 * MiB, WS_WBD = WS_WBF + 768 * KiB, WS_WBM = WS_WBD + 768 * KiB, WS_WOUT = 15 * MiB, WS_WMKV = 17 * MiB;
constexpr size_t WS_LF2 = 18 * MiB, WS_C2 = WS_LF2 + 512 * KiB, WS_LSE = 19 * MiB, WS_TBL = WS_LSE + 512 * KiB, WS_MEMB = 20 * MiB, WS_MEMKV = WS_MEMB + 512 * KiB;
constexpr size_t WS_TOPI = 21 * MiB, WS_TOPG = WS_TOPI + 256 * KiB, WS_RANK = WS_TOPG + 256 * KiB, WS_DEST = WS_RANK + 256 * KiB, WS_BLKCNT = 22 * MiB, WS_TST = WS_BLKCNT + 64 * KiB;
constexpr size_t WS_TOKROW = 23 * MiB;
constexpr size_t WS_IDMAP = 23 * MiB + 512 * KiB;
constexpr size_t WS_XB = 24 * MiB;
constexpr size_t WS_PBUF = 56 * MiB;
constexpr size_t WS_Y = WS_PBUF;
constexpr size_t WS_OFOX = 712 * MiB, WS_ODIL = 724 * MiB, WS_OMEM = 736 * MiB;
constexpr size_t WS_W1 = 264 * MiB, WS_W2 = 392 * MiB;
constexpr size_t WS_STASH = 456 * MiB, WS_MERGED = 520 * MiB;
constexpr size_t WS_R1 = 552 * MiB, WS_H1F8 = 616 * MiB, WS_XF8 = 632 * MiB, WS_WGF8 = 648 * MiB, WS_H1B = 680 * MiB;
constexpr int W1_SHIFT = 5;
constexpr size_t WS_XS = 712 * MiB, WS_ACT = 856 * MiB, WS_END = 1000 * MiB;
static_assert(WS_XS + (size_t)MAXROWS * 1024 * 2 <= WS_ACT && WS_ACT + (size_t)MAXROWS * 1024 * 2 <= WS_END && WS_Y + (size_t)MAXROWS * 1024 * 2 <= 232 * MiB && WS_WBM + 768 * KiB <= WS_ACT, "ws map");
constexpr int CW_BAR = 4096;
constexpr int CW_NRM = 64, CW_QHEAD = 128;
constexpr size_t WS_OPART = WS_STASH, WS_LSEF = WS_STASH + 48 * MiB;

constexpr int RING_OFF = 0;
constexpr int LDSCTL_OFF = attn_body::ATTN_LDS_BYTES, MISC_OFF = LDSCTL_OFF + 320, TBL_OFF = MISC_OFF + 128;
constexpr int LDS_BYTES = 150528;
static_assert(TBL_OFF + 256 <= LDS_BYTES && pg8::STAGE_BYTES <= LDSCTL_OFF, "LDS map");

struct Args { const float* in[20]; float* out; unsigned char* ws; int ph_lo, ph_hi, li, pad; };
struct Frame {
    LAS unsigned char* lds;
    volatile LAS unsigned* MISC;
    gu32* ctl;
    int tid, lane, wave;
    int vcu, G;
    float* out; unsigned char* ws;
};
__device__ __forceinline__ float wave_sum(float v) {
#pragma unroll
    for (int o = 1; o < 64; o <<= 1) v += __shfl_xor(v, o);
    return v;
}
typedef float f4u __attribute__((ext_vector_type(4), aligned(4)));
typedef float f32x2 __attribute__((ext_vector_type(2)));
typedef unsigned v2u __attribute__((ext_vector_type(2)));
__device__ __forceinline__ void p0_tr_item(const float* W, int ldw, int k0, int src_n0, bf16* WT, int K, int dst_n0, float scale, LAS float* scr, int lane) {
    f4u v[16];
#pragma unroll
    for (int i = 0; i < 16; ++i) v[i] = *(const f4u*)(W + (size_t)(k0 + 4 * i + (lane >> 4)) * ldw + src_n0 + (lane & 15) * 4);
#pragma unroll
    for (int i = 0; i < 16; ++i) { LAS float* d = scr + (4 * i + (lane >> 4)) * 65 + (lane & 15) * 4; d[0] = v[i].x * scale; d[1] = v[i].y * scale; d[2] = v[i].z * scale; d[3] = v[i].w * scale; }
    LDS_WAIT(); asm volatile("" ::: "memory");
    const int c = lane & 7;
#pragma unroll
    for (int j = 0; j < 8; ++j) { const int n = (lane >> 3) + 8 * j; const LAS float* s = scr + (8 * c) * 65 + n;
        v4u o; o.x = pk2(s[0 * 65], s[1 * 65]); o.y = pk2(s[2 * 65], s[3 * 65]); o.z = pk2(s[4 * 65], s[5 * 65]); o.w = pk2(s[6 * 65], s[7 * 65]);
        *(GAS v4u*)(WT + (size_t)(dst_n0 + n) * K + k0 + 8 * c) = o; }
    LDS_WAIT(); asm volatile("" ::: "memory");
}
constexpr int CV_E1 = 32 * 512, CV_E2 = 32 * 256, CV_UNITS = (CV_E1 + CV_E2) / 64;
struct CvItem { const float* W; bf16* WT; int ldw, k0, sn, dn, f8; };
__device__ __forceinline__ CvItem cv_decode(const Args& A, unsigned char* ws, int r) {
    CvItem c;
    if (r < CV_E1) { const int e = r >> 9, rr = r & 511, kb = rr >> 5, nb = rr & 31, dn = nb * 64; c.sn = ((dn >> 7) & 1) * 1024 + (dn >> 8) * 128 + (dn & 127); c.dn = dn; c.k0 = kb * 64; c.ldw = 2048;
        c.W = A.in[14] + (size_t)e * 1024 * 2048; c.WT = (bf16*)(ws + WS_W1 + (size_t)e * 2048 * 1024); c.f8 = 1 + W1_SHIFT; }
    else { r -= CV_E1; const int e = r >> 8, rr = r & 255, kb = rr >> 4, nb = rr & 15; c.sn = nb * 64; c.dn = nb * 64; c.k0 = kb * 64; c.ldw = 1024;
        c.W = A.in[16] + (size_t)e * 1024 * 1024; c.WT = (bf16*)(ws + WS_W2 + (size_t)e * 1024 * 1024); c.f8 = 1 + W1_SHIFT; }
    return c;
}
__device__ __forceinline__ void cv_load(f4u (&v)[16], const CvItem& c, int lane) {
#pragma unroll
    for (int i = 0; i < 16; ++i) v[i] = *(const f4u*)(c.W + (size_t)(c.k0 + 4 * i + (lane >> 4)) * c.ldw + c.sn + (lane & 15) * 4);
}
__device__ __forceinline__ void cv_store(const f4u (&v)[16], const CvItem& c, LAS float* scr, int lane) {
#pragma unroll
    for (int i = 0; i < 16; ++i) { LAS float* d = scr + (4 * i + (lane >> 4)) * 65 + (lane & 15) * 4; d[0] = v[i].x; d[1] = v[i].y; d[2] = v[i].z; d[3] = v[i].w; }
    LDS_WAIT(); asm volatile("" ::: "memory");
    const int cc = lane & 7;
#pragma unroll
    for (int j = 0; j < 8; ++j) { const int n = (lane >> 3) + 8 * j; const LAS float* sp = scr + (8 * cc) * 65 + n;
        v4u o; o.x = pk2(sp[0 * 65], sp[1 * 65]); o.y = pk2(sp[2 * 65], sp[3 * 65]); o.z = pk2(sp[4 * 65], sp[5 * 65]); o.w = pk2(sp[6 * 65], sp[7 * 65]);
        *(GAS v4u*)(c.WT + (size_t)(c.dn + n) * 1024 + c.k0 + 8 * cc) = o; }
    LDS_WAIT(); asm volatile("" ::: "memory");
}
__device__ __forceinline__ void cv_store_f8(const f4u (&v)[16], const CvItem& c, LAS float* scr, int lane) {
    const float sc = (float)(1 << (c.f8 - 1));
#pragma unroll
    for (int i = 0; i < 16; ++i) { LAS float* d = scr + (4 * i + (lane >> 4)) * 65 + (lane & 15) * 4; d[0] = v[i].x * sc; d[1] = v[i].y * sc; d[2] = v[i].z * sc; d[3] = v[i].w * sc; }
    LDS_WAIT(); asm volatile("" ::: "memory");
    const int cc = lane & 7; unsigned char* const WT8 = (unsigned char*)c.WT;
#pragma unroll
    for (int j = 0; j < 8; ++j) { const int n = (lane >> 3) + 8 * j; const LAS float* sp = scr + (8 * cc) * 65 + n;
        v2u o; o.x = pk4_fp8(sp[0 * 65], sp[1 * 65], sp[2 * 65], sp[3 * 65]); o.y = pk4_fp8(sp[4 * 65], sp[5 * 65], sp[6 * 65], sp[7 * 65]);
        *(GAS v2u*)(WT8 + (size_t)(c.dn + n) * 1024 + c.k0 + 8 * cc) = o; }
    LDS_WAIT(); asm volatile("" ::: "memory");
}
__device__ __forceinline__ void conv_unit(Frame& F, const Args& A, int cu) {
    LAS float* scr = (LAS float*)(F.lds + RING_OFF + F.wave * 16640);
    const int r0 = cu * 64 + F.wave * 8;
    f4u va[16], vb[16];
    CvItem ca = cv_decode(A, F.ws, r0), cb; cv_load(va, ca, F.lane);
#pragma unroll 1
    for (int i = 0; i < 8; i += 2) {
        cb = cv_decode(A, F.ws, r0 + i + 1); cv_load(vb, cb, F.lane);
        if (ca.f8) cv_store_f8(va, ca, scr, F.lane); else cv_store(va, ca, scr, F.lane);
        if (i + 2 < 8) { ca = cv_decode(A, F.ws, r0 + i + 2); cv_load(va, ca, F.lane); }
        if (cb.f8) cv_store_f8(vb, cb, scr, F.lane); else cv_store(vb, cb, scr, F.lane);
    }
}
__device__ __forceinline__ void p0_prologue(Frame& F, const Args& A) {
    LAS float* scr = (LAS float*)(F.lds + RING_OFF + F.wave * 16640);
    const int gw = F.vcu * NWAVES + F.wave, NGW = F.G * NWAVES;
    bf16* const WIN = (bf16*)(F.ws + WS_WIN); bf16* const WBF = (bf16*)(F.ws + WS_WBF); bf16* const WBD = (bf16*)(F.ws + WS_WBD); bf16* const WBM = (bf16*)(F.ws + WS_WBM);
    bf16* const WOUT = (bf16*)(F.ws + WS_WOUT); bf16* const WMKV = (bf16*)(F.ws + WS_WMKV);
    constexpr int I_IN = 16 * 88, I_BF = 6 * 16, I_BD = 6 * 16, I_BM = 4 * 16, I_WO = 16 * 16, I_MKV = 16 * 8;
    constexpr int NITEMS = I_IN + I_BF + I_BD + I_BM + I_WO + I_MKV;
    for (int it = gw; it < NITEMS; it += NGW) {
        int r = it;
        if (r < I_IN) { const int kb = r / 88, nb = r % 88, dn = nb * 64; const int sn = dn + (dn >= W_IN_F ? 6 : 0);
            const float sc = (dn < PC_FK || (dn >= PC_DQ && dn < PC_DK) || (dn >= PC_MQ && dn < PC_GT)) ? C2F : 1.0f;
            { CvItem c; c.W = A.in[2]; c.WT = (bf16*)(F.ws + WS_WGF8); c.ldw = W_IN_LD; c.k0 = kb * 64; c.sn = sn; c.dn = dn; c.f8 = 1 + 6;
              f4u v[16]; cv_load(v, c, F.lane);
              if (sc != 1.0f) {
#pragma unroll
                  for (int i = 0; i < 16; ++i) { v[i].x *= sc; v[i].y *= sc; v[i].z *= sc; v[i].w *= sc; } }
              cv_store_f8(v, c, scr, F.lane); }
            continue; } r -= I_IN;
        if (r < I_BF) { const int kb = r >> 4, nb = r & 15; p0_tr_item(A.in[6], 1024, kb * 64, nb * 64, WBF, 384, nb * 64, 1.0f, scr, F.lane); continue; } r -= I_BF;
        if (r < I_BD) { const int kb = r >> 4, nb = r & 15; p0_tr_item(A.in[7], 1024, kb * 64, nb * 64, WBD, 384, nb * 64, 1.0f, scr, F.lane); continue; } r -= I_BD;
        if (r < I_BM) { const int kb = r >> 4, nb = r & 15; p0_tr_item(A.in[8], 1024, kb * 64, nb * 64, WBM, 384, nb * 64, 1.0f, scr, F.lane); continue; } r -= I_BM;
        if (r < I_WO) { const int kb = r >> 4, nb = r & 15; p0_tr_item(A.in[9], 1024, kb * 64, nb * 64, WOUT, 1024, nb * 64, 1.0f, scr, F.lane); continue; } r -= I_WO;
        { const int kb = r >> 3, nb = r & 7; p0_tr_item(A.in[5], 512, kb * 64, nb * 64, WMKV, 1024, nb * 64, 1.0f, scr, F.lane); }
    }
    {
        float wf[4][4][6];
#pragma unroll
        for (int j = 0; j < 4; ++j)
#pragma unroll
            for (int i = 0; i < 4; ++i)
#pragma unroll
                for (int h = 0; h < 6; ++h) wf[j][i][h] = A.in[2][(size_t)(4 * F.lane + i + 256 * j) * W_IN_LD + W_IN_F + h];
        float* const LF2 = (float*)(F.ws + WS_LF2);
        f32x4 vnx[4];
        if (gw < S) { const GAS f32x4* xr0 = (const GAS f32x4*)(A.in[0] + (size_t)gw * DM) + F.lane;
#pragma unroll
            for (int j = 0; j < 4; ++j) vnx[j] = xr0[64 * j]; }
        for (int m = gw; m < S; m += NGW) {
            f32x4 v[4]; float d[6] = {0.f, 0.f, 0.f, 0.f, 0.f, 0.f};
#pragma unroll
            for (int j = 0; j < 4; ++j) v[j] = vnx[j];
            if (m + NGW < S) { const GAS f32x4* xr1 = (const GAS f32x4*)(A.in[0] + (size_t)(m + NGW) * DM) + F.lane;
#pragma unroll
                for (int j = 0; j < 4; ++j) vnx[j] = xr1[64 * j]; }
#pragma unroll
            for (int j = 0; j < 4; ++j)
#pragma unroll
                for (int h = 0; h < 6; ++h) d[h] += v[j].x * wf[j][0][h] + v[j].y * wf[j][1][h] + v[j].z * wf[j][2][h] + v[j].w * wf[j][3][h];
#pragma unroll
            for (int h = 0; h < 6; ++h) d[h] = wave_sum(d[h]);
            { GAS unsigned* o4 = (GAS unsigned*)(F.ws + WS_XF8 + (size_t)m * DM) + F.lane;
#pragma unroll
              for (int j = 0; j < 4; ++j) o4[64 * j] = pk4_fp8(v[j].x, v[j].y, v[j].z, v[j].w); }
            if (F.lane < 6) { const int h = F.lane; float f = h == 0 ? d[0] : h == 1 ? d[1] : h == 2 ? d[2] : h == 3 ? d[3] : h == 4 ? d[4] : d[5];
                f += A.in[3][h]; const float ls = fminf(f, 0.f) - log1pf(expf(-fabsf(f)));
                LF2[(size_t)h * S + m] = ls * LOG2E; }
        }
        bf16* const MEMB = (bf16*)(F.ws + WS_MEMB);
        for (int m = gw; m < MEML; m += NGW) {
            const GAS f32x4* xr = (const GAS f32x4*)(A.in[1] + (size_t)m * DM) + F.lane; GAS unsigned long long* o8 = (GAS unsigned long long*)(MEMB + (size_t)m * DM) + F.lane;
#pragma unroll
            for (int j = 0; j < 4; ++j) { const f32x4 v = xr[64 * j]; o8[64 * j] = (unsigned long long)pk2(v.x, v.y) | ((unsigned long long)pk2(v.z, v.w) << 32); }
        }
    }
    { const int gt = F.vcu * (NWAVES * 64) + F.tid, GT = F.G * NWAVES * 64; const v4u z = {0u, 0u, 0u, 0u};
      for (int i = gt; i < 1024 * 16; i += GT) *(GAS v4u*)((bf16*)(F.ws + WS_WBM) + (size_t)(i >> 4) * 384 + 256 + (i & 15) * 8) = z;
      for (int i = gt; i < S * 16; i += GT) *(GAS v4u*)((bf16*)(F.ws + WS_OMEM) + (size_t)(i >> 4) * 384 + 256 + (i & 15) * 8) = z; }
    {
        float* const TBL = (float*)(F.ws + WS_TBL);
        for (int idx = F.vcu * (NWAVES * 64) + F.tid; idx < 6 * attn_body::TBL_N; idx += F.G * NWAVES * 64) {
            const int hd = idx / attn_body::TBL_N, i = idx - hd * attn_body::TBL_N, rel = i - attn_body::TBL_ZERO, g = hd >> 1, dil = g == 0 ? 1 : (g == 1 ? 4 : 16);
            float val = -INFINITY;
            if (rel >= 0 && rel <= 128) { const int dist = rel * dil; int bucket = dist;
                if (dist >= 16) { const float nf = (float)dist; bucket = 16 + (int)(logf(nf / 16.0f) / 4.852030263919617f * 16.0f); bucket = bucket > 31 ? 31 : bucket; }
                val = A.in[4][bucket * 6 + hd] * LOG2E; }
            TBL[idx] = val;
        }
    }
}

__device__ __forceinline__ void p1_cumsum(Frame& F, int h) {
    const float* src = (const float*)(F.ws + WS_LF2) + (size_t)h * S + F.tid * 32; float* dst = (float*)(F.ws + WS_C2) + (size_t)h * S + F.tid * 32;
    LAS double* part = (LAS double*)(F.lds + RING_OFF);
    f32x4 v[8]; double s = 0.0;
#pragma unroll
    for (int i = 0; i < 8; ++i) { v[i] = *(const f32x4*)(src + 4 * i); s += (double)v[i].x; s += (double)v[i].y; s += (double)v[i].z; s += (double)v[i].w; }
    part[F.tid] = s; __syncthreads();
    double run = 0.0;
    for (int j = 0; j < F.tid; ++j) run += part[j];
#pragma unroll
    for (int i = 0; i < 8; ++i) { f32x4 o; run += (double)v[i].x; o.x = (float)run; run += (double)v[i].y; o.y = (float)run; run += (double)v[i].z; o.z = (float)run; run += (double)v[i].w; o.w = (float)run; *(f32x4*)(dst + 4 * i) = o; }
    __syncthreads();
}

constexpr int P2_NA = 600, P2_NB = 360, P2_NC = 384, P2_ND = 256, P2_UNITS = P2_NA + P2_NB + P2_NC + P2_ND;
__device__ __forceinline__ void p2_attention(Frame& F, const Args& A, char* lds, int li) {
    typedef attn_body::bf16 abf;
    abf* const PB = (abf*)(F.ws + WS_PBUF);
    volatile LAS int* qslot = (volatile LAS int*)(F.lds + MISC_OFF + 64);
    for (;;) {
        if (F.tid == 0) qslot[0] = (int)__hip_atomic_fetch_add(F.ctl + CW_QHEAD + 64 * li, 1u, __ATOMIC_RELAXED, __HIP_MEMORY_SCOPE_AGENT);
        __syncthreads();
        const int pos = __builtin_amdgcn_readfirstlane(qslot[0]);
        __syncthreads();
        if (pos >= P2_UNITS + CV_UNITS) break;
        if (pos % 4 == 3 && pos / 4 < CV_UNITS) { conv_unit(F, A, pos / 4); __syncthreads(); continue; }
        const int idx = pos - (pos / 4 < CV_UNITS ? pos / 4 : CV_UNITS);
        attn_body::AttnArgs a; a.tlo = 0; a.thi = 0; a.band = 0; a.thr = 0.f;
        if (idx < P2_NA + P2_NB) {
            int h, qb, sgm;
            if (idx < P2_NA) { h = idx % 6; const int b = idx / 6; if (b < 49) { sgm = 0; qb = 15 + b; } else if (b < 82) { sgm = 1; qb = 31 + (b - 49); } else if (b < 99) { sgm = 2; qb = 47 + (b - 82); } else { sgm = 3; qb = 63; } }
            else { const int b2 = idx - P2_NA; h = b2 % 6; const int c = b2 / 6; const int L = 60 - 4 * (c >> 2); sgm = c & 3; qb = 16 * sgm + L / 4 - 1; }
            const int ntf = 4 * qb + 4, nseg = (ntf + 63) >> 6;
            const float q2 = __uint_as_float(__hip_atomic_load(F.ctl + CW_NRM + 2 * h, RLX_AGENT)) + __uint_as_float(__hip_atomic_load(F.ctl + CW_NRM + 2 * h + 1, RLX_AGENT)), k2 = __uint_as_float(__hip_atomic_load(F.ctl + CW_NRM + 12 + 2 * h, RLX_AGENT)) + __uint_as_float(__hip_atomic_load(F.ctl + CW_NRM + 13 + 2 * h, RLX_AGENT));
            const float qkmax = 1.02f * sqrtf(q2 * k2);
            a.Q = PB + PC_FQ + h * 64; a.K = PB + PC_FK + h * 64; a.V = PB + PC_FV + h * 64; a.qp = NPROJ; a.kp = NPROJ; a.op = 384;
            a.q0 = qb * 256; a.NT = 0; a.kv0 = 0; a.aux = (const float*)(F.ws + WS_C2) + (size_t)h * S;
            a.tlo = 64 * sgm; a.thi = (a.tlo + 64 < ntf) ? a.tlo + 64 : ntf; a.band = (sgm == nseg - 1) ? 1 : 0;
            a.thr = 160.0f + 2.0f * qkmax;
            if (nseg == 1) { a.O = (abf*)(F.ws + WS_OFOX) + h * 64; a.lse = nullptr; a.lse_stride = 0; }
            else { a.O = (abf*)(F.ws + WS_OPART) + (size_t)sgm * S * 384 + h * 64; a.lse = (float*)(F.ws + WS_LSEF) + (size_t)sgm * S * 6 + h; a.lse_stride = 6; }
            attn_body::attn_unit<0, 8>(a, lds);
        } else if (idx < P2_NA + P2_NB + P2_NC) { const int du = idx - (P2_NA + P2_NB); const int g = du >> 7, hs = (du >> 6) & 1, w = du & 63; const int dl = g == 0 ? 1 : (g == 1 ? 4 : 16); const int r = w % dl, qb = w / dl, hd = g * 2 + hs;
            const int t0 = 4 * qb - 2 > 0 ? 4 * qb - 2 : 0; const long pitch = (long)dl * NPROJ;
            a.Q = PB + PC_DQ + hd * 64 + (long)r * NPROJ; a.K = PB + PC_DK + hd * 64 + (long)r * NPROJ + (long)t0 * 64 * pitch; a.V = PB + PC_DV + hd * 64 + (long)r * NPROJ + (long)t0 * 64 * pitch;
            a.O = (abf*)(F.ws + WS_ODIL) + hd * 64 + (long)r * 384; a.qp = pitch; a.kp = pitch; a.op = (long)dl * 384;
            a.q0 = qb * 256; a.NT = 4 * qb + 4 - t0; a.kv0 = t0 * 64; a.aux = (const float*)(F.ws + WS_TBL) + hd * attn_body::TBL_N; a.lse = (float*)(F.ws + WS_LSE) + r * 6 + hd; a.lse_stride = (long)dl * 6;
            attn_body::attn_unit<1, 8>(a, lds);
        } else { const int mu = idx - (P2_NA + P2_NB + P2_NC); const int h = mu >> 6, qb = mu & 63; abf* const MKV = (abf*)(F.ws + WS_MEMKV);
            a.Q = PB + PC_MQ + h * 64; a.K = MKV + h * 64; a.V = MKV + 256 + h * 64; a.O = (abf*)(F.ws + WS_OMEM) + h * 64; a.qp = NPROJ; a.kp = 512; a.op = 384;
            a.q0 = qb * 256; a.NT = 4; a.kv0 = 0; a.aux = nullptr; a.lse = nullptr; a.lse_stride = 0;
            attn_body::attn_unit<2, 8>(a, lds);
        }
    }
}
__device__ __forceinline__ void p3_fox_combine(Frame& F) {
    const float* LSEF = (const float*)(F.ws + WS_LSEF); const bf16* OP = (const bf16*)(F.ws + WS_OPART); bf16* const OF = (bf16*)(F.ws + WS_OFOX);
    for (int it = blockIdx.x * (NWAVES * 64) + F.tid; it < (S - 4096) * 48; it += F.G * NWAVES * 64) {
        const int tok = 4096 + it / 48, rem = it % 48, h = rem >> 3, ch = rem & 7, nseg = (tok >> 12) + 1;
        float l[4]; float mx = -INFINITY;
#pragma unroll
        for (int sg = 0; sg < 4; ++sg) { l[sg] = (sg < nseg) ? LSEF[((size_t)sg * S + tok) * 6 + h] : -INFINITY; mx = fmaxf(mx, l[sg]); }
        float acc[8] = {0.f, 0.f, 0.f, 0.f, 0.f, 0.f, 0.f, 0.f}; float den = 0.f;
#pragma unroll
        for (int sg = 0; sg < 4; ++sg) { const float w = __builtin_amdgcn_exp2f(l[sg] - mx);
            if (w > 0.f) { const v4u x = *(const v4u*)(OP + ((size_t)sg * S + tok) * 384 + h * 64 + ch * 8); den += w;
                acc[0] += w * __uint_as_float(x.x << 16); acc[1] += w * __uint_as_float(x.x & 0xffff0000u); acc[2] += w * __uint_as_float(x.y << 16); acc[3] += w * __uint_as_float(x.y & 0xffff0000u);
                acc[4] += w * __uint_as_float(x.z << 16); acc[5] += w * __uint_as_float(x.z & 0xffff0000u); acc[6] += w * __uint_as_float(x.w << 16); acc[7] += w * __uint_as_float(x.w & 0xffff0000u); } }
        const float inv = 1.0f / den; v4u o; o.x = pk2(acc[0] * inv, acc[1] * inv); o.y = pk2(acc[2] * inv, acc[3] * inv); o.z = pk2(acc[4] * inv, acc[5] * inv); o.w = pk2(acc[6] * inv, acc[7] * inv);
        *(v4u*)(OF + (size_t)tok * 384 + h * 64 + ch * 8) = o;
    }
}
__device__ __forceinline__ void p3_dil_weights(Frame& F) {
    const float* LSE = (const float*)(F.ws + WS_LSE); bf16* const OD = (bf16*)(F.ws + WS_ODIL);
    for (int it = blockIdx.x * (NWAVES * 64) + F.tid; it < S * 48; it += F.G * NWAVES * 64) {
        const int tok = it / 48, rem = it - tok * 48, hd = rem >> 3, ch = rem & 7, hs = hd & 1, g = hd >> 1;
        const float l0 = LSE[tok * 6 + hs], l1 = LSE[tok * 6 + 2 + hs], l2 = LSE[tok * 6 + 4 + hs];
        const float mx = fmaxf(l0, fmaxf(l1, l2)); const float e0 = __builtin_amdgcn_exp2f(l0 - mx), e1 = __builtin_amdgcn_exp2f(l1 - mx), e2 = __builtin_amdgcn_exp2f(l2 - mx);
        const float w = (g == 0 ? e0 : (g == 1 ? e1 : e2)) / (e0 + e1 + e2);
        v4u* p = (v4u*)(OD + (size_t)tok * 384 + hd * 64 + ch * 8); v4u x = *p;
        x.x = pk2(__uint_as_float(x.x << 16) * w, __uint_as_float(x.x & 0xffff0000u) * w); x.y = pk2(__uint_as_float(x.y << 16) * w, __uint_as_float(x.y & 0xffff0000u) * w);
        x.z = pk2(__uint_as_float(x.z << 16) * w, __uint_as_float(x.z & 0xffff0000u) * w); x.w = pk2(__uint_as_float(x.w << 16) * w, __uint_as_float(x.w & 0xffff0000u) * w);
        *p = x;
    }
}
typedef float f32x16m __attribute__((ext_vector_type(16)));
__device__ __forceinline__ void p6_ln_router(Frame& F, const Args& A) {
    LAS float* hl = (LAS float*)(F.lds + RING_OFF);
    LAS float* part = hl;
    LAS float* lgt = (LAS float*)(F.lds + RING_OFF + 32768);
    LAS int* se = (LAS int*)(F.lds + RING_OFF + 131328);
    const bf16* R1 = (const bf16*)(F.ws + WS_R1); bf16* const H1B = (bf16*)(F.ws + WS_H1B); unsigned char* const H1F8 = F.ws + WS_H1F8;
    int* const TOPI = (int*)(F.ws + WS_TOPI); float* const TOPG = (float*)(F.ws + WS_TOPG); int* const RANK = (int*)(F.ws + WS_RANK); int* const BLKCNT = (int*)(F.ws + WS_BLKCNT);
    const float* lg1 = A.in[10]; const float* lb1 = A.in[11]; const float* wr = A.in[12]; const float* br = A.in[13];
    float wreg[64];
    { const float* bp = wr + (size_t)(128 * F.wave + (F.lane >> 5)) * 32 + (F.lane & 31);
#pragma unroll
      for (int st = 0; st < 64; ++st) wreg[st] = bp[64 * st]; }
    for (int rb = blockIdx.x; rb < S / 64; rb += F.G) {
        for (int half = 0; half < 2; ++half) {
            f32x4 vr[4][4];
#pragma unroll
            for (int j = 0; j < 4; ++j)
#pragma unroll
                for (int q = 0; q < 4; ++q) { const v2u t = *((const v2u*)(R1 + ((size_t)rb * 64 + half * 32 + F.wave * 4 + j) * DM) + F.lane + 64 * q);
                    vr[j][q] = (f32x4){__builtin_bit_cast(float, t.x << 16), __builtin_bit_cast(float, t.x & 0xffff0000u), __builtin_bit_cast(float, t.y << 16), __builtin_bit_cast(float, t.y & 0xffff0000u)}; }
#pragma unroll
            for (int j = 0; j < 4; ++j) {
                const int lr = F.wave * 4 + j; const size_t row = (size_t)rb * 64 + half * 32 + lr;
                f32x4 v[4]; float s = 0.f;
#pragma unroll
                for (int q = 0; q < 4; ++q) { v[q] = vr[j][q]; s += (v[q].x + v[q].y) + (v[q].z + v[q].w); }
                const float mean = wave_sum(s) * (1.f / DM); float s2 = 0.f;
#pragma unroll
                for (int q = 0; q < 4; ++q) { v[q] = v[q] - mean; s2 += (v[q].x * v[q].x + v[q].y * v[q].y) + (v[q].z * v[q].z + v[q].w * v[q].w); }
                const float rstd = 1.f / sqrtf(wave_sum(s2) * (1.f / DM) + LN_EPS);
#pragma unroll
                for (int q = 0; q < 4; ++q) { const f32x4 gv = *((const f32x4*)lg1 + F.lane + 64 * q), bv = *((const f32x4*)lb1 + F.lane + 64 * q); const f32x4 h = v[q] * rstd * gv + bv;
                    *((v2u*)(H1B + row * DM) + F.lane + 64 * q) = (v2u){pk2(h.x, h.y), pk2(h.z, h.w)};
                    *((unsigned*)(H1F8 + row * DM) + F.lane + 64 * q) = pk4_fp8(h.x, h.y, h.z, h.w);
                    LAS float* d = hl + lr * 1025 + 4 * F.lane + 256 * q; d[0] = h.x; d[1] = h.y; d[2] = h.z; d[3] = h.w; }
            }
            __syncthreads();
            f32x16m acc = {0.f, 0.f, 0.f, 0.f, 0.f, 0.f, 0.f, 0.f, 0.f, 0.f, 0.f, 0.f, 0.f, 0.f, 0.f, 0.f};
            { const int kk = F.lane >> 5; const LAS float* ap = hl + (F.lane & 31) * 1025 + 128 * F.wave + kk;
#pragma unroll
              for (int st = 0; st < 64; ++st) acc = __builtin_amdgcn_mfma_f32_32x32x2f32(ap[2 * st], wreg[st], acc, 0, 0, 0); }
            __syncthreads();
            { const int kk = F.lane >> 5;
#pragma unroll
              for (int r = 0; r < 16; ++r) part[(F.wave * 32 + ((r & 3) + 8 * (r >> 2) + 4 * kk)) * 32 + (F.lane & 31)] = acc[r]; }
            __syncthreads();
#pragma unroll
            for (int q = 0; q < 2; ++q) { const int p = F.tid + 512 * q, i = p >> 5, jx = p & 31; float sm = 0.f;
#pragma unroll
                for (int w = 0; w < 8; ++w) sm += part[(w * 32 + i) * 32 + jx];
                lgt[i * 33 + jx] = sm + br[jx]; }
            __syncthreads();
            if (F.tid < 32) { const int i = F.tid; const size_t row = (size_t)rb * 64 + half * 32 + i; float bv[4]; int bi[4];
                unsigned taken = 0u;
#pragma unroll
                for (int kx = 0; kx < 4; ++kx) { float best = -INFINITY; int be = 0;
                    for (int e = 0; e < 32; ++e) { const float x = lgt[i * 33 + e]; const bool take = (((taken >> e) & 1u) == 0u) && (x > best); best = take ? x : best; be = take ? e : be; }
                    bv[kx] = best; bi[kx] = be; taken |= 1u << be; }
                const float e1 = expf(bv[1] - bv[0]), e2 = expf(bv[2] - bv[0]), e3 = expf(bv[3] - bv[0]); const float inv = 1.f / (1.f + e1 + e2 + e3);
                *(int4*)(TOPI + row * 4) = make_int4(bi[0], bi[1], bi[2], bi[3]); *(f32x4*)(TOPG + row * 4) = (f32x4){inv, e1 * inv, e2 * inv, e3 * inv};
                const int lrow = half * 32 + i; se[lrow * 4 + 0] = bi[0]; se[lrow * 4 + 1] = bi[1]; se[lrow * 4 + 2] = bi[2]; se[lrow * 4 + 3] = bi[3]; }
            __syncthreads();
        }
        if (F.tid < 256) { const int e = se[F.tid]; int rk = 0; for (int q = 0; q < F.tid; ++q) rk += (se[q] == e) ? 1 : 0; RANK[rb * 256 + F.tid] = rk; }
        else if (F.tid < 288) { const int e = F.tid - 256; int c = 0; for (int q = 0; q < 256; ++q) c += (se[q] == e) ? 1 : 0; BLKCNT[rb * 32 + e] = c; }
        __syncthreads();
    }
}
__device__ __forceinline__ void p7_scatter(Frame& F) {
    LAS int* ptot = (LAS int*)(F.lds + RING_OFF); LAS int* ppre = ptot + 512; LAS int* epre = ppre + 512; LAS int* tst = epre + 32; LAS int* dsts = tst + 64;
    const int* BLKCNT = (const int*)(F.ws + WS_BLKCNT); const int* TOPI = (const int*)(F.ws + WS_TOPI); const int* RANK = (const int*)(F.ws + WS_RANK);
    int* const DEST = (int*)(F.ws + WS_DEST); int* const TST = (int*)(F.ws + WS_TST); int* const TOKROW = (int*)(F.ws + WS_TOKROW);
    { int* const IDM = (int*)(F.ws + WS_IDMAP); for (int i = blockIdx.x * (NWAVES * 64) + F.tid; i < MAXROWS; i += F.G * NWAVES * 64) IDM[i] = i; }
    for (int rb = blockIdx.x; rb < S / 64; rb += F.G) {
        { const int part = F.tid >> 5, e = F.tid & 31; int tot = 0, pre = 0;
          for (int b = part * 16; b < part * 16 + 16; ++b) { const int c = BLKCNT[b * 32 + e]; tot += c; pre += (b < rb) ? c : 0; }
          ptot[part * 32 + e] = tot; ppre[part * 32 + e] = pre; }
        __syncthreads();
        if (F.tid < 32) { int T = 0, P = 0; for (int p = 0; p < 16; ++p) { T += ptot[p * 32 + F.tid]; P += ppre[p * 32 + F.tid]; } ptot[F.tid] = T; epre[F.tid] = P; }
        __syncthreads();
        if (F.tid == 0) { int t = 0; for (int e = 0; e < 32; ++e) { tst[e] = t; t += (ptot[e] + 255) >> 8; } tst[32] = t;
            if (rb == 0) { for (int e = 0; e <= 32; ++e) TST[e] = tst[e]; } }
        __syncthreads();
        if (F.tid < 256) { const size_t a = (size_t)rb * 256 + F.tid; const int e = TOPI[a]; const int d = tst[e] * 256 + epre[e] + RANK[a]; DEST[a] = d; TOKROW[d] = (int)(a >> 2); }
        if (rb == 0) { for (int e = 0; e < 32; ++e) { const int c = ptot[e], base = tst[e] * 256, padn = (tst[e + 1] - tst[e]) * 256 - c; for (int p = F.tid; p < padn; p += NWAVES * 64) TOKROW[base + c + p] = 0; } }
        __syncthreads();
    }
}
__device__ __forceinline__ void p10_combine(Frame& F, const Args& A) {
    const int gw = F.vcu * NWAVES + F.wave, NGW = F.G * NWAVES;
    const bf16* H1B = (const bf16*)(F.ws + WS_H1B); const bf16* Y = (const bf16*)(F.ws + WS_Y); const int* DEST = (const int*)(F.ws + WS_DEST); const float* TOPG = (const float*)(F.ws + WS_TOPG);
    const float* g2 = A.in[18]; const float* b2 = A.in[19];
    int4 ddn; f32x4 ggn; v2u hbn[4]; unsigned yn[4][4];
#define P10_LOAD_IDX(m_) do { ddn = *(const int4*)(DEST + (size_t)(m_) * 4); ggn = *(const f32x4*)(TOPG + (size_t)(m_) * 4); } while (0)
#define P10_LOAD_ROWS(m_) do { _Pragma("unroll") for (int j = 0; j < 4; ++j) hbn[j] = *((const v2u*)(H1B + (size_t)(m_) * DM) + F.lane + 64 * j); \
        _Pragma("unroll") for (int k = 0; k < 4; ++k) { const int d_ = k == 0 ? ddn.x : (k == 1 ? ddn.y : (k == 2 ? ddn.z : ddn.w)); \
            _Pragma("unroll") for (int j = 0; j < 4; ++j) yn[k][j] = *((const unsigned*)((const unsigned char*)Y + (size_t)d_ * DM) + F.lane + 64 * j); } } while (0)
    int m = gw; if (m >= S) return;
    P10_LOAD_IDX(m); P10_LOAD_ROWS(m);
    for (; m < S; m += NGW) {
        const f32x4 gg = ggn; f32x4 v[4]; float s = 0.f;
#pragma unroll
        for (int j = 0; j < 4; ++j) v[j] = (f32x4){__uint_as_float(hbn[j].x << 16), __uint_as_float(hbn[j].x & 0xffff0000u), __uint_as_float(hbn[j].y << 16), __uint_as_float(hbn[j].y & 0xffff0000u)} * ALPHA;
#pragma unroll
        for (int k = 0; k < 4; ++k) { const float g = k == 0 ? gg.x : (k == 1 ? gg.y : (k == 2 ? gg.z : gg.w));
#pragma unroll
            for (int j = 0; j < 4; ++j) { const unsigned y = yn[k][j]; typedef float f2_ __attribute__((ext_vector_type(2)));
                const f2_ lo = __builtin_amdgcn_cvt_pk_f32_fp8((int)y, false), hi = __builtin_amdgcn_cvt_pk_f32_fp8((int)y, true);
                v[j].x += g * lo.x; v[j].y += g * lo.y; v[j].z += g * hi.x; v[j].w += g * hi.y; } }
        const int mn = m + NGW;
        if (mn < S) { P10_LOAD_IDX(mn); P10_LOAD_ROWS(mn); }
#pragma unroll
        for (int j = 0; j < 4; ++j) s += (v[j].x + v[j].y) + (v[j].z + v[j].w);
        const float mean = wave_sum(s) * (1.f / DM); float s2 = 0.f;
#pragma unroll
        for (int j = 0; j < 4; ++j) { v[j] = v[j] - mean; s2 += (v[j].x * v[j].x + v[j].y * v[j].y) + (v[j].z * v[j].z + v[j].w * v[j].w); }
        const float rstd = 1.f / sqrtf(wave_sum(s2) * (1.f / DM) + LN_EPS);
#pragma unroll
        for (int j = 0; j < 4; ++j) { const f32x4 gv = *((const f32x4*)g2 + F.lane + 64 * j), bv = *((const f32x4*)b2 + F.lane + 64 * j);
            *((f32x4*)(F.out + (size_t)m * DM) + F.lane + 64 * j) = v[j] * rstd * gv + bv; }
    }
#undef P10_LOAD_IDX
#undef P10_LOAD_ROWS
}

__global__ void __launch_bounds__(NWAVES * 64, 2) mk_fwd(Args args) {
    extern __shared__ __attribute__((aligned(16))) unsigned char lds[];
    Frame F;
    F.lds = (LAS unsigned char*)lds;
    F.MISC = (volatile LAS unsigned*)(F.lds + MISC_OFF);
    F.tid = threadIdx.x; F.lane = F.tid & 63; F.wave = __builtin_amdgcn_readfirstlane(F.tid >> 6);
    F.G = gridDim.x; { const int bx = blockIdx.x; F.vcu = (F.G % 8 == 0) ? (bx % 8) * (F.G / 8) + bx / 8 : bx; }
    F.ws = args.ws; F.out = args.out; F.ctl = (gu32*)(args.ws + WS_CTL);
    unsigned char* const ws = args.ws;
    for (int u = F.tid; u < (LDS_BYTES - LDSCTL_OFF) / 4; u += NWAVES * 64) ((LAS unsigned*)(F.lds + LDSCTL_OFF))[u] = 0u;
    __syncthreads();
    XcdBarrier bar = xcd_barrier_post((unsigned*)(F.ctl + CW_BAR) + args.li * XCD_BAR_WORDS, F.MISC + 8);
#define GRID_BAR() xcd_barrier(bar)
    const int lo = args.ph_lo, hi = args.ph_hi;
#ifndef PHASE_MASK
#define PHASE_MASK 0x7ff
#endif
#define IN(k) (((PHASE_MASK >> (k)) & 1) && lo <= (k) && (k) < hi)
#define BOTH(k) (IN(k) && IN((k) + 1))
    typedef pg8::bf16_t pbf;
    pbf* const PBUF = (pbf*)(ws + WS_PBUF);

    if (IN(0)) { p0_prologue(F, args); if (BOTH(0)) GRID_BAR(); }

    if (IN(1)) {
        { pg8::Gemm g{(const pbf*)(ws + WS_XF8), (const pbf*)(ws + WS_WGF8), S, NPROJ, DM / 2, nullptr, 0x7C7C7C7C, 0x7C7C7C7C}; pg8::StaticOrder So; So.init(S, NPROJ, F.G, (int)blockIdx.x);
          pg8::EpiProj E{PBUF, NPROJ, PC_GT / 256, (unsigned*)(F.ctl + CW_NRM)};
          pg8::gemm_phase<pg8::EpiProj, pg8::StaticOrder, true, true, true, true>(F.lds + RING_OFF, g, So, E); }
        { pg8::Gemm g{(const pbf*)(ws + WS_MEMB), (const pbf*)(ws + WS_WMKV), MEML, 512, DM, nullptr, 0, 0}; pg8::StaticOrder So; So.init(MEML, 512, F.G, (int)((blockIdx.x + F.G / 2) % F.G));
          pg8::EpiBf16Plain E{(pbf*)(ws + WS_MEMKV), 512};
          pg8::gemm_phase<pg8::EpiBf16Plain, pg8::StaticOrder, true, true>(F.lds + RING_OFF, g, So, E); }
        if ((int)blockIdx.x >= F.G - 6) p1_cumsum(F, F.G - 1 - (int)blockIdx.x);
        if (BOTH(1)) GRID_BAR();
    }

    if (IN(2)) { p2_attention(F, args, (char*)lds + RING_OFF, args.li); if (BOTH(2)) GRID_BAR(); }

    if (IN(3)) { p3_fox_combine(F); p3_dil_weights(F); if (BOTH(3)) GRID_BAR(); }

    if (IN(4)) {
        pg8::Gemm g{(const pbf*)(ws + WS_OFOX), (const pbf*)(ws + WS_WBF), S, DM, 384, nullptr, 0, 0, (size_t)S * 384 * 2, (size_t)DM * 384 * 2};
        pg8::MergeOrder So; So.so.init(S, DM, F.G, (int)blockIdx.x);
        pg8::EpiMergeChain E{PBUF + PC_GT, NPROJ, (pbf*)(ws + WS_MERGED), DM};
        pg8::gemm_phase<pg8::EpiMergeChain, pg8::MergeOrder, true, true>(F.lds + RING_OFF, g, So, E);
        if (BOTH(4)) GRID_BAR();
    }

    if (IN(5)) {
        pg8::Gemm g{(const pbf*)(ws + WS_MERGED), (const pbf*)(ws + WS_WOUT), S, DM, DM, nullptr, 0, 0}; pg8::StaticOrder So; So.init(S, DM, F.G, (int)blockIdx.x);
        pg8::EpiRes E{args.in[0], (pbf*)(ws + WS_R1), DM, ALPHA};
        pg8::gemm_phase<pg8::EpiRes, pg8::StaticOrder, true, true>(F.lds + RING_OFF, g, So, E);
        if (BOTH(5)) GRID_BAR();
    }

    if (IN(6)) { p6_ln_router(F, args); if (BOTH(6)) GRID_BAR(); }

    if (IN(7)) { p7_scatter(F); if (BOTH(7)) GRID_BAR(); }

    if (IN(8)) {
        LAS int* tbl = (LAS int*)(F.lds + TBL_OFF);
        if (F.tid < 33) tbl[F.tid] = ((const int*)(ws + WS_TST))[F.tid];
        __syncthreads();
        pg8::Gemm g{(const pbf*)(ws + WS_H1F8), (const pbf*)(ws + WS_W1), MAXROWS, 2048, DM / 2, (const int*)(ws + WS_TOKROW), 0x7F7F7F7F, 0x7F7F7F7F}; pg8::MoeOrder So{tbl, 8, F.G, F.vcu};
        pg8::EpiSwiglu E{(pbf*)(ws + WS_ACT), args.in[15], 1.0f / (float)(1 << W1_SHIFT), (const LAS float*)(F.lds + RING_OFF + pg8::STAGE_BYTES + 5120)};
        pg8::gemm_phase<pg8::EpiSwiglu, pg8::MoeOrder, true, true, true, true>(F.lds + RING_OFF, g, So, E);
        if (BOTH(8)) GRID_BAR();
    }

    if (IN(9)) {
        LAS int* tbl = (LAS int*)(F.lds + TBL_OFF);
        if (F.tid < 33) tbl[F.tid] = ((const int*)(ws + WS_TST))[F.tid];
        __syncthreads();
        pg8::Gemm g{(const pbf*)(ws + WS_ACT), (const pbf*)(ws + WS_W2), MAXROWS, 1024, DM / 2, nullptr, 0x7F7F7F7F, 0x7F7F7F7F}; pg8::MoeOrder So{tbl, 4, F.G, F.vcu};
        pg8::EpiY E{(pbf*)(ws + WS_Y), args.in[17], 1.0f / (float)(1 << W1_SHIFT), (const LAS float*)(F.lds + RING_OFF + pg8::STAGE_BYTES + 5120)};
        pg8::gemm_phase<pg8::EpiY, pg8::MoeOrder, true, true, true, true>(F.lds + RING_OFF, g, So, E);
        if (BOTH(9)) GRID_BAR();
    }

    if (IN(10)) { p10_combine(F, args); }
#undef IN
#undef BOTH
#undef GRID_BAR
}

extern "C" void kernel_launch(void* const* d_in, const int* in_sizes, int n_in, void* d_out, int out_size, void* d_ws, size_t ws_size, hipStream_t stream) {
    static int grid = 0;
    if (grid == 0) {
        if (n_in != 20 || in_sizes[0] != S * DM || out_size != S * DM || ws_size < WS_END) { fprintf(stderr, "kernel_launch: built for 20 inputs, x/out of %d floats, >= %zu bytes of workspace; got n_in %d, in0 %d, out %d, ws %zu; nothing launched\n", S * DM, (size_t)WS_END, n_in, n_in > 0 ? in_sizes[0] : -1, out_size, ws_size); grid = -1; return; }
        int dev = 0, cus = 0, per_cu = 0;
        if (hipGetDevice(&dev) != hipSuccess || hipDeviceGetAttribute(&cus, hipDeviceAttributeMultiprocessorCount, dev) != hipSuccess) { fprintf(stderr, "kernel_launch: hipGetDevice / hipDeviceGetAttribute failed; nothing launched\n"); grid = -1; return; }
        if (hipFuncSetAttribute((const void*)mk_fwd, hipFuncAttributeMaxDynamicSharedMemorySize, LDS_BYTES) != hipSuccess) { fprintf(stderr, "kernel_launch: hipFuncSetAttribute failed (%d bytes of dynamic LDS); nothing launched\n", LDS_BYTES); grid = -1; return; }
        if (hipOccupancyMaxActiveBlocksPerMultiprocessor(&per_cu, (const void*)mk_fwd, NWAVES * 64, LDS_BYTES) != hipSuccess || per_cu < 1)
            fprintf(stderr, "kernel_launch: note: the occupancy query reports %d workgroups per CU\n", per_cu);
        (void)hipGetLastError();
        grid = cus;
    }
    if (grid < 0) return;
    if (hipMemsetAsync((char*)d_ws + WS_CTL, 0, CTL_ZERO_BYTES, stream) != hipSuccess) { fprintf(stderr, "kernel_launch: hipMemsetAsync of the control words failed; nothing launched\n"); return; }
    Args a{};
    for (int i = 0; i < 20; ++i) a.in[i] = (const float*)d_in[i];
    a.out = (float*)d_out; a.ws = (unsigned char*)d_ws;
#ifdef PROBE_PHASE
    const int nl = (PROBE_PHASE + 1 < NPHASE) ? 3 : 2; const int cut_lo[3] = {0, PROBE_PHASE, PROBE_PHASE + 1}, cut_hi[3] = {PROBE_PHASE + 1, PROBE_PHASE + 1, NPHASE};
#else
    const int nl = N_LAUNCHES; int cut_lo[NPHASE], cut_hi[NPHASE]; for (int i = 0; i < NPHASE; ++i) { cut_lo[i] = (N_LAUNCHES == 1) ? 0 : i; cut_hi[i] = (N_LAUNCHES == 1) ? NPHASE : i + 1; }
#endif
    for (int li = 0; li < nl; ++li) {
        a.ph_lo = cut_lo[li]; a.ph_hi = cut_hi[li]; a.li = li;
        hipLaunchKernelGGL(mk_fwd, dim3(grid), dim3(NWAVES * 64), LDS_BYTES, stream, a);
        const hipError_t le = hipPeekAtLastError();
        if (le != hipSuccess) { fprintf(stderr, "kernel_launch: launch %d failed: %s\n", li, hipGetErrorName(le)); break; }
    }
}
```

```cpp
#include <hip/hip_runtime.h>
#include <hip/hip_bf16.h>
#include <cstdio>
#include <cstdint>
#include <cmath>
namespace pg8 {
#define PG8_LAS __attribute__((address_space(3)))
typedef unsigned short bf16_t;
typedef short bf16x8 __attribute__((ext_vector_type(8)));
typedef float f32x4 __attribute__((ext_vector_type(4)));
typedef unsigned u32x4 __attribute__((ext_vector_type(4)));
constexpr int BM = 256, BK = 64, HALF = 128, HTB = HALF * BK * 2  , STAGE_BYTES = 8 * HTB, NXCD = 8, WGM = 8;

__host__ __device__ __forceinline__ int lds_byte(int r, int c) { const int st = (r >> 4) * 2 + (c >> 5), rr = r & 15, cc = c & 31, ob = rr * 64 + cc * 2; return st * 1024 + (ob ^ (((ob >> 9) & 1) << 5)); }
__host__ __device__ __forceinline__ void stage_rc(int b, int& R, int& C) { const int st = b / 1024, sb = b % 1024, swz = sb ^ (((sb >> 9) & 1) << 5); R = (st >> 1) * 16 + swz / 64; C = (st & 1) * 32 + (swz % 64) / 2; }
__host__ __device__ __forceinline__ int perm32(int rho) { const int n = rho >> 4, i = rho & 15; return 8 * (i >> 2) + 4 * n + (i & 3); }

struct Unit { int pm, pn, e, slot, b; };
typedef int v8i_t_half __attribute__((ext_vector_type(4)));
typedef int v8i_t __attribute__((ext_vector_type(8)));
typedef short s16x16_t __attribute__((ext_vector_type(16)));
struct Gemm { const bf16_t* A; const bf16_t* Bt; int M, N, K; const int* rowmap; int scale_a, scale_b; size_t strideA = 0, strideB = 0; };

struct StaticOrder {
    int nM, nN, nwg, G, c;
    __host__ __device__ void init(int M, int N, int G_, int c_) { nM = M / BM; nN = N / BM; nwg = nM * nN; G = G_; c = c_; }
    __host__ __device__ bool next(int i, Unit& u) const {
        const long L = (long)i * G + c; if (L >= nwg) return false;
        int wgid = (int)L; { const int q = nwg / NXCD, r = nwg % NXCD, xcd = wgid % NXCD, off = wgid / NXCD; wgid = (xcd < r ? xcd * (q + 1) : r * (q + 1) + (xcd - r) * q) + off; }
        const int nig = WGM * nN, gid = wgid / nig, fm = gid * WGM, gsz = (nM - fm) < WGM ? (nM - fm) : WGM;
        u.pm = fm + ((wgid % nig) % gsz); u.pn = (wgid % nig) / gsz; u.e = 0; u.b = 0; return true;
    }
    __device__ __forceinline__ void a_ready(const Unit&) const {}
    __device__ __forceinline__ void done(const Unit&) const {}
};

__device__ __forceinline__ unsigned cvt_pk_bf16(float lo, float hi) { unsigned r; asm volatile("v_cvt_pk_bf16_f32 %0, %1, %2" : "=v"(r) : "v"(lo), "v"(hi)); return r; }
__device__ __forceinline__ float bf_lo(unsigned w) { return __uint_as_float(w << 16); }
__device__ __forceinline__ float bf_hi(unsigned w) { return __uint_as_float(w & 0xffff0000u); }
__device__ __forceinline__ float sigmoid_f(float v) { return __builtin_amdgcn_rcpf(1.0f + __builtin_amdgcn_exp2f(-1.4426950408889634f * v)); }
typedef unsigned u32x2 __attribute__((ext_vector_type(2)));
__device__ __forceinline__ unsigned ror8(unsigned v) { return (unsigned)__builtin_amdgcn_update_dpp(0, (int)v, 0x128, 0xf, 0xf, false); }
__device__ __forceinline__ u32x4 sel4(bool c, const u32x4& a, const u32x4& b) { u32x4 r; r.x = c ? a.x : b.x; r.y = c ? a.y : b.y; r.z = c ? a.z : b.z; r.w = c ? a.w : b.w; return r; }
__device__ __forceinline__ u32x4 ror8x4(const u32x4& a) { u32x4 r; r.x = ror8(a.x); r.y = ror8(a.y); r.z = ror8(a.z); r.w = ror8(a.w); return r; }
__device__ __forceinline__ void fl_store(unsigned char* lanep, size_t pitch8, const u32x4& p0, const u32x4& p1, bool lo) {
    const u32x4 y = ror8x4(sel4(lo, p1, p0)); *(u32x4*)lanep = sel4(lo, p0, y); *(u32x4*)(lanep + pitch8) = sel4(lo, y, p1); }
__device__ __forceinline__ void fl_load(const unsigned char* lanep, size_t pitch8, u32x4& p0, u32x4& p1, bool lo) {
    const u32x4 a = *(const u32x4*)lanep, b = *(const u32x4*)(lanep + pitch8); const u32x4 y = ror8x4(sel4(lo, b, a)); p0 = sel4(lo, a, y); p1 = sel4(lo, y, b); }

struct EpiBf16Plain {
    static constexpr bool PERM = true, AFTER_DRAIN = false; static constexpr bool CHAIN = false; static constexpr bool LDS_BIAS = false;
    bf16_t* O; int ldc;
    __device__ __forceinline__ void operator()(const f32x4 (&acc)[2][2][4][2], const Unit& u, int wr, int wc, int fr, int fq) const {
        const int row0 = u.pm * BM + wr * 64 + fr, col0 = u.pn * BM + wc * 32 + 8 * fq;
#pragma unroll
        for (int ai = 0; ai < 2; ++ai)
#pragma unroll
            for (int m = 0; m < 4; ++m) { bf16_t* rowp = O + (size_t)(row0 + ai * HALF + m * 16) * ldc + col0;
#pragma unroll
                for (int bj = 0; bj < 2; ++bj) { const f32x4 v0 = acc[ai][bj][m][0], v1 = acc[ai][bj][m][1];
                    u32x4 w; w.x = cvt_pk_bf16(v0[0], v0[1]); w.y = cvt_pk_bf16(v0[2], v0[3]); w.z = cvt_pk_bf16(v1[0], v1[1]); w.w = cvt_pk_bf16(v1[2], v1[3]);
                    *(u32x4*)(rowp + bj * HALF) = w; } }
    }
};
struct EpiProj {
    static constexpr bool PERM = true, PERM16 = true, AFTER_DRAIN = false; static constexpr bool CHAIN = false; static constexpr bool LDS_BIAS = false;
    bf16_t* O; int ldc; int sig_from; unsigned* nrm;
    __device__ __forceinline__ void operator()(const f32x4 (&acc)[2][2][4][2], const Unit& u, int wr, int wc, int fr, int fq) const {
        const bool sg = u.pn >= sig_from, lo = fr < 8;
        if (u.pn < 3) {
            float mx = 0.f;
#pragma unroll
            for (int ai = 0; ai < 2; ++ai)
#pragma unroll
                for (int m = 0; m < 4; ++m) { float ss = 0.f;
#pragma unroll
                    for (int bj = 0; bj < 2; ++bj) { const f32x4 a0 = acc[ai][bj][m][0], a1 = acc[ai][bj][m][1];
                        ss += (a0[0] * a0[0] + a0[1] * a0[1]) + (a0[2] * a0[2] + a0[3] * a0[3]) + (a1[0] * a1[0] + a1[1] * a1[1]) + (a1[2] * a1[2] + a1[3] * a1[3]); }
                    ss += __shfl_xor(ss, 16); ss += __shfl_xor(ss, 32); mx = fmaxf(mx, ss); }
            mx = fmaxf(mx, __shfl_xor(mx, 1)); mx = fmaxf(mx, __shfl_xor(mx, 2)); mx = fmaxf(mx, __shfl_xor(mx, 4)); mx = fmaxf(mx, __shfl_xor(mx, 8));
            if (fr == 0 && fq == 0) atomicMax(nrm + 2 * (u.pn * 4 + wc), __float_as_uint(mx));
        }
        unsigned char* const lanep = (unsigned char*)(O + (size_t)(u.pm * BM + wr * 64 + (fr & 7)) * ldc + u.pn * BM + wc * 64) + (2 * fq + (fr >> 3)) * 16; const size_t pitch = (size_t)ldc * 2;
#pragma unroll
        for (int ai = 0; ai < 2; ++ai)
#pragma unroll
            for (int m = 0; m < 4; ++m) { u32x4 p[2];
#pragma unroll
                for (int bj = 0; bj < 2; ++bj) { f32x4 v0 = acc[ai][bj][m][0], v1 = acc[ai][bj][m][1];
                    if (sg) {
#pragma unroll
                        for (int j = 0; j < 4; ++j) { v0[j] = sigmoid_f(v0[j]); v1[j] = sigmoid_f(v1[j]); } }
                    p[bj].x = cvt_pk_bf16(v0[0], v0[1]); p[bj].y = cvt_pk_bf16(v0[2], v0[3]); p[bj].z = cvt_pk_bf16(v1[0], v1[1]); p[bj].w = cvt_pk_bf16(v1[2], v1[3]); }
                fl_store(lanep + (size_t)(ai * HALF + m * 16) * pitch, 8 * pitch, p[0], p[1], lo); }
    }
};
struct EpiGate {
    static constexpr bool PERM = true, AFTER_DRAIN = false; static constexpr bool CHAIN = false; static constexpr bool LDS_BIAS = false;
    bf16_t* O; int ldc; int col_off; float ascale;
    __device__ __forceinline__ void operator()(const f32x4 (&acc)[2][2][4][2], const Unit& u, int wr, int wc, int fr, int fq) const {
        const int row0 = u.pm * BM + wr * 64 + fr, col0 = col_off + u.pn * BM + wc * 32 + 8 * fq;
#pragma unroll
        for (int ai = 0; ai < 2; ++ai)
#pragma unroll
            for (int m = 0; m < 4; ++m) { bf16_t* rowp = O + (size_t)(row0 + ai * HALF + m * 16) * ldc + col0;
#pragma unroll
                for (int bj = 0; bj < 2; ++bj) { f32x4 v0 = acc[ai][bj][m][0] * ascale, v1 = acc[ai][bj][m][1] * ascale;
#pragma unroll
                    for (int j = 0; j < 4; ++j) { v0[j] = sigmoid_f(v0[j]); v1[j] = sigmoid_f(v1[j]); }
                    u32x4 w; w.x = cvt_pk_bf16(v0[0], v0[1]); w.y = cvt_pk_bf16(v0[2], v0[3]); w.z = cvt_pk_bf16(v1[0], v1[1]); w.w = cvt_pk_bf16(v1[2], v1[3]);
                    *(u32x4*)(rowp + bj * HALF) = w; } }
    }
};
template <int PASS> struct EpiMerge {
    static constexpr bool PERM = false, AFTER_DRAIN = false; static constexpr bool CHAIN = false; static constexpr bool LDS_BIAS = false;
    const bf16_t* gate; int ldg; bf16_t* stash; bf16_t* outb; int ldc;
    __device__ __forceinline__ void operator()(const f32x4 (&acc)[2][2][4][2], const Unit& u, int wr, int wc, int fr, int fq) const {
        const int row0 = u.pm * BM + wr * 64 + fr, col0 = u.pn * BM + wc * 32 + 4 * fq;
#pragma unroll
        for (int ai = 0; ai < 2; ++ai)
#pragma unroll
            for (int m = 0; m < 4; ++m) { const size_t r = (size_t)(row0 + ai * HALF + m * 16);
#pragma unroll
                for (int bj = 0; bj < 2; ++bj)
#pragma unroll
                    for (int n = 0; n < 2; ++n) { const int c = col0 + bj * HALF + n * 16;
                        const u32x2 gv = *(const u32x2*)(gate + r * ldg + c);
                        f32x4 v = acc[ai][bj][m][n]; v[0] *= bf_lo(gv.x); v[1] *= bf_hi(gv.x); v[2] *= bf_lo(gv.y); v[3] *= bf_hi(gv.y);
                        if (PASS > 0) { const u32x2 sv = *(const u32x2*)(stash + r * ldc + c); v[0] += bf_lo(sv.x); v[1] += bf_hi(sv.x); v[2] += bf_lo(sv.y); v[3] += bf_hi(sv.y); }
                        u32x2 w; w.x = cvt_pk_bf16(v[0], v[1]); w.y = cvt_pk_bf16(v[2], v[3]);
                        if (PASS < 2) *(u32x2*)(stash + r * ldc + c) = w; else *(u32x2*)(outb + r * ldc + c) = w; }
                asm volatile("" ::: "memory"); }
    }
};
struct EpiRes {
    static constexpr bool PERM = true, AFTER_DRAIN = false; static constexpr bool CHAIN = false; static constexpr bool LDS_BIAS = false;
    const float* x; bf16_t* out; int ldc; float alpha;
    __device__ __forceinline__ void operator()(const f32x4 (&acc)[2][2][4][2], const Unit& u, int wr, int wc, int fr, int fq) const {
        const int row0 = u.pm * BM + wr * 64 + fr, col0 = u.pn * BM + wc * 32 + 8 * fq; const bool lo = fr < 8; const size_t xp = (size_t)ldc * 4;
        const unsigned char* const xl = (const unsigned char*)(x + (size_t)(u.pm * BM + wr * 64 + (fr & 7)) * ldc + u.pn * BM + wc * 32) + (2 * fq + (fr >> 3)) * 16;
#pragma unroll
        for (int ai = 0; ai < 2; ++ai)
#pragma unroll
            for (int m = 0; m < 4; ++m) { const size_t off = (size_t)(row0 + ai * HALF + m * 16) * ldc + col0;
#pragma unroll
                for (int bj = 0; bj < 2; ++bj) { u32x4 q0, q1; fl_load(xl + (size_t)(ai * HALF + m * 16) * xp + bj * HALF * 4, 8 * xp, q0, q1, lo);
                    const f32x4 x0 = __builtin_bit_cast(f32x4, q0), x1 = __builtin_bit_cast(f32x4, q1);
                    const f32x4 v0 = x0 * alpha + acc[ai][bj][m][0], v1 = x1 * alpha + acc[ai][bj][m][1];
                    u32x4 w; w.x = cvt_pk_bf16(v0[0], v0[1]); w.y = cvt_pk_bf16(v0[2], v0[3]); w.z = cvt_pk_bf16(v1[0], v1[1]); w.w = cvt_pk_bf16(v1[2], v1[3]);
                    *(u32x4*)(out + off + bj * HALF) = w; } }
    }
};
struct EpiMergeChain {
    static constexpr bool PERM = true, PERM16 = true, AFTER_DRAIN = false; static constexpr bool LDS_BIAS = false; static constexpr bool CHAIN = true;
    const bf16_t* gate; int ldg; bf16_t* outb; int ldc;
    __device__ __forceinline__ void operator()(f32x4 (&acc)[2][2][4][2], const Unit& u, int wr, int wc, int fr, int fq) const {
        const int b = u.b; const bool lo = fr < 8; const size_t gp = (size_t)ldg * 2, op = (size_t)ldc * 2;
        const size_t lrow = (size_t)(u.pm * BM + wr * 64 + (fr & 7)); const int lcol = u.pn * BM + wc * 64, lpc = (2 * fq + (fr >> 3)) * 16;
        const unsigned char* const gl = (const unsigned char*)(gate + lrow * ldg + b * 1024 + lcol) + lpc; unsigned char* const ol = (unsigned char*)(outb + lrow * ldc + lcol) + lpc;
#pragma unroll
        for (int ai = 0; ai < 2; ++ai)
#pragma unroll
            for (int m = 0; m < 4; ++m) { const size_t ro = (size_t)(ai * HALF + m * 16);
                u32x4 gq[2], gn[2] = {{0u, 0u, 0u, 0u}, {0u, 0u, 0u, 0u}}; fl_load(gl + ro * gp, 8 * gp, gq[0], gq[1], lo);
                if (b < 2) fl_load(gl + ro * gp + 2048, 8 * gp, gn[0], gn[1], lo);
                u32x4 w[2];
#pragma unroll
                for (int bj = 0; bj < 2; ++bj) { const u32x4 gv = gq[bj];
                    f32x4 g0, g1; g0[0] = bf_lo(gv.x); g0[1] = bf_hi(gv.x); g0[2] = bf_lo(gv.y); g0[3] = bf_hi(gv.y); g1[0] = bf_lo(gv.z); g1[1] = bf_hi(gv.z); g1[2] = bf_lo(gv.w); g1[3] = bf_hi(gv.w);
                    if (b > 0) {
#pragma unroll
                        for (int j = 0; j < 4; ++j) { g0[j] = fmaxf(g0[j], 1e-6f); g1[j] = fmaxf(g1[j], 1e-6f); } }
                    f32x4 v0 = acc[ai][bj][m][0] * g0, v1 = acc[ai][bj][m][1] * g1;
                    if (b < 2) { const u32x4 gx = gn[bj];
                        v0[0] *= __builtin_amdgcn_rcpf(fmaxf(bf_lo(gx.x), 1e-6f)); v0[1] *= __builtin_amdgcn_rcpf(fmaxf(bf_hi(gx.x), 1e-6f)); v0[2] *= __builtin_amdgcn_rcpf(fmaxf(bf_lo(gx.y), 1e-6f)); v0[3] *= __builtin_amdgcn_rcpf(fmaxf(bf_hi(gx.y), 1e-6f));
                        v1[0] *= __builtin_amdgcn_rcpf(fmaxf(bf_lo(gx.z), 1e-6f)); v1[1] *= __builtin_amdgcn_rcpf(fmaxf(bf_hi(gx.z), 1e-6f)); v1[2] *= __builtin_amdgcn_rcpf(fmaxf(bf_lo(gx.w), 1e-6f)); v1[3] *= __builtin_amdgcn_rcpf(fmaxf(bf_hi(gx.w), 1e-6f));
                        acc[ai][bj][m][0] = v0; acc[ai][bj][m][1] = v1; }
                    else { w[bj].x = cvt_pk_bf16(v0[0], v0[1]); w[bj].y = cvt_pk_bf16(v0[2], v0[3]); w[bj].z = cvt_pk_bf16(v1[0], v1[1]); w[bj].w = cvt_pk_bf16(v1[2], v1[3]); } }
                if (b == 2) fl_store(ol + ro * op, 8 * op, w[0], w[1], lo);
                asm volatile("" ::: "memory"); }
    }
};
struct MergeOrder {
    StaticOrder so;
    __device__ __forceinline__ bool next(int i, Unit& u) const { if (!so.next(i / 3, u)) return false; u.b = i % 3; return true; }
    __device__ __forceinline__ void a_ready(const Unit&) const {}
    __device__ __forceinline__ void done(const Unit&) const {}
};
struct EpiSwiglu {
    static constexpr bool PERM = true, AFTER_DRAIN = false; static constexpr bool CHAIN = false;
    bf16_t* O; const float* b1; float ascale; const PG8_LAS float* lb;
    static constexpr bool LDS_BIAS = true;
    __device__ __forceinline__ const float* bias_src(const Unit& u, int lane) const { const int e = u.e, pnl = u.pn - e * 8; return b1 + (size_t)e * 2048 + (lane >> 5) * 1024 + pnl * 128 + (lane & 31) * 4; }
    __device__ __forceinline__ void operator()(const f32x4 (&acc)[2][2][4][2], const Unit& u, int wr, int wc, int fr, int fq) const {
        const int e = u.e, pnl = u.pn - e * 8; const int row0 = u.pm * BM + wr * 64 + fr;
        f32x4 bg[2], bl[2]; const PG8_LAS float* lbs = lb + u.slot * 256 + wc * 32 + 8 * fq;
#pragma unroll
        for (int n = 0; n < 2; ++n) { bg[n] = *(const PG8_LAS f32x4*)(lbs + 4 * n); bl[n] = *(const PG8_LAS f32x4*)(lbs + 128 + 4 * n); }
        unsigned char* const lanep = (unsigned char*)O + (size_t)(row0 + (fq & 1) * 16) * 1024 + pnl * 128 + wc * 32 + 8 * (fq & 2);
#pragma unroll
        for (int ai = 0; ai < 2; ++ai)
#pragma unroll
            for (int p = 0; p < 2; ++p) { u32x2 w[2];
#pragma unroll
                for (int q = 0; q < 2; ++q) { const int m = 2 * p + q; f32x4 o[2];
#pragma unroll
                    for (int n = 0; n < 2; ++n) { const f32x4 g = acc[ai][0][m][n] * ascale + bg[n], l = acc[ai][1][m][n] * ascale + bl[n];
#pragma unroll
                        for (int j = 0; j < 4; ++j) { const float gg = fminf(g[j], 7.0f), ll = fminf(fmaxf(l[j], -7.0f), 7.0f);
                            o[n][j] = gg * __builtin_amdgcn_rcpf(1.0f + __builtin_amdgcn_exp2f(-1.702f * 1.4426950408889634f * gg)) * (ll + 1.0f); } }
                    int t0 = __builtin_amdgcn_cvt_pk_fp8_f32(o[0][0], o[0][1], 0, false); t0 = __builtin_amdgcn_cvt_pk_fp8_f32(o[0][2], o[0][3], t0, true);
                    int t1 = __builtin_amdgcn_cvt_pk_fp8_f32(o[1][0], o[1][1], 0, false); t1 = __builtin_amdgcn_cvt_pk_fp8_f32(o[1][2], o[1][3], t1, true); w[q].x = (unsigned)t0; w[q].y = (unsigned)t1; }
                const auto r0 = __builtin_amdgcn_permlane16_swap(w[0].x, w[1].x, false, false), r1 = __builtin_amdgcn_permlane16_swap(w[0].y, w[1].y, false, false);
                u32x4 out; out.x = r0[0]; out.y = r1[0]; out.z = r0[1]; out.w = r1[1];
                *(u32x4*)(lanep + (size_t)(ai * HALF + p * 32) * 1024) = out; }
    }
};
struct EpiY {
    static constexpr bool PERM = true, PERM16 = true, AFTER_DRAIN = false; static constexpr bool CHAIN = false;
    bf16_t* O; const float* b2; float ascale; const PG8_LAS float* lb;
    static constexpr bool LDS_BIAS = true;
    __device__ __forceinline__ const float* bias_src(const Unit& u, int lane) const { const int e = u.e, pnl = u.pn - e * 4; return b2 + (size_t)e * 1024 + pnl * BM + lane * 4; }
    __device__ __forceinline__ void operator()(const f32x4 (&acc)[2][2][4][2], const Unit& u, int wr, int wc, int fr, int fq) const {
        const int e = u.e, pnl = u.pn - e * 4; const int row0 = u.pm * BM + wr * 64 + fr, col0 = pnl * BM + wc * 64 + 16 * fq;
        f32x4 bv[2][2]; const PG8_LAS float* lbs = lb + u.slot * 256 + wc * 64 + 16 * fq;
#pragma unroll
        for (int bj = 0; bj < 2; ++bj)
#pragma unroll
            for (int n = 0; n < 2; ++n) bv[bj][n] = *(const PG8_LAS f32x4*)(lbs + 8 * bj + 4 * n);
#pragma unroll
        for (int ai = 0; ai < 2; ++ai)
#pragma unroll
            for (int m = 0; m < 4; ++m) { unsigned char* rowp = (unsigned char*)O + (size_t)(row0 + ai * HALF + m * 16) * 1024 + col0;
                u32x4 w;
#pragma unroll
                for (int bj = 0; bj < 2; ++bj) { const f32x4 v0 = acc[ai][bj][m][0] * ascale + bv[bj][0], v1 = acc[ai][bj][m][1] * ascale + bv[bj][1];
                    int t0 = __builtin_amdgcn_cvt_pk_fp8_f32(v0[0], v0[1], 0, false); t0 = __builtin_amdgcn_cvt_pk_fp8_f32(v0[2], v0[3], t0, true);
                    int t1 = __builtin_amdgcn_cvt_pk_fp8_f32(v1[0], v1[1], 0, false); t1 = __builtin_amdgcn_cvt_pk_fp8_f32(v1[2], v1[3], t1, true);
                    if (bj == 0) { w.x = (unsigned)t0; w.y = (unsigned)t1; } else { w.z = (unsigned)t0; w.w = (unsigned)t1; } }
                *(u32x4*)rowp = w; }
    }
};
struct MoeOrder {
    const PG8_LAS int* tstart; int nN, G, vcu;
    __device__ __forceinline__ int ts(int k) const { return __builtin_amdgcn_readfirstlane(tstart[k]); }
    __device__ __forceinline__ bool next(int i, Unit& u) const {
        const int L = i * G + vcu; const int T = ts(32); if (L >= T * nN) return false;
        int e = 0;
#pragma unroll
        for (int k = 1; k < 32; ++k) e += (L >= ts(k) * nN) ? 1 : 0;
        const int t0 = ts(e), R = ts(e + 1) - t0; const int rem = L - t0 * nN; const int ng = rem / (4 * R); const int r2 = rem - ng * 4 * R; const int pnl = r2 / R; const int pmi = r2 - pnl * R;
        u.pm = t0 + pmi; u.pn = e * nN + ng * 4 + pnl; u.e = e; u.b = 0; return true;
    }
    __device__ __forceinline__ void a_ready(const Unit&) const {}
    __device__ __forceinline__ void done(const Unit&) const {}
};
template <class E, class = void> struct has_p16 { static constexpr bool v = false; };
template <class E> struct has_p16<E, decltype((void)E::PERM16)> { static constexpr bool v = E::PERM16; };
template <class Epi, class Sched, bool ALIGN_EPI = false, bool SP2 = false, bool GATHER = false, bool FP8 = false>
__device__ __forceinline__ void gemm_phase(PG8_LAS unsigned char* lds, const Gemm g, const Sched& S, const Epi& E) {
    static_assert(!GATHER || SP2, "GATHER is wired into the SP2 loop only");
    int tid_ = threadIdx.x; asm volatile("" : "+v"(tid_));
    const int tid = tid_, wid = __builtin_amdgcn_readfirstlane(tid >> 6), lane = tid & 63, wr = wid >> 2, wc = wid & 3, fr = lane & 15, fq = lane >> 4;
    int K_ = g.K; asm volatile("" : "+s"(K_));
    const int K = K_, nt = K / BK;
    constexpr bool P16 = has_p16<Epi>::v;
    unsigned voffA[2], voffB[2];
#pragma unroll
    for (int i = 0; i < 2; ++i) { int R, C; stage_rc(tid * 16 + i * 8192, R, C); const int Rb = P16 ? ((R >> 5) * 64 + 16 * ((R & 15) >> 2) + 4 * ((R >> 4) & 1) + (R & 3)) : Epi::PERM ? ((R & ~31) + perm32(R & 31)) : R;
        voffA[i] = (unsigned)(R * K + C) * 2u; voffB[i] = (unsigned)(Rb * K + C) * 2u; }
    unsigned vC[2][2] = {{0u, 0u}, {0u, 0u}};
    const PG8_LAS int* const rowlds = (const PG8_LAS int*)(lds + STAGE_BYTES + 4096);
#define PG8_ROWS(dst, pm_) do { if constexpr (GATHER) { _Pragma("unroll") for (int h_ = 0; h_ < 2; ++h_) _Pragma("unroll") for (int i_ = 0; i_ < 2; ++i_) { int R_, C_; stage_rc(tid * 16 + i_ * 8192, R_, C_); \
        const int ix_ = (pm_) * BM + h_ * HALF + R_; dst[h_][i_] = ((g.rowmap ? (unsigned)g.rowmap[ix_] : (unsigned)ix_) * (unsigned)K + (unsigned)C_) * 2u; } } } while (0)
#define PG8_ROWS_LDS(dst) do { _Pragma("unroll") for (int h_ = 0; h_ < 2; ++h_) _Pragma("unroll") for (int i_ = 0; i_ < 2; ++i_) { int R_, C_; stage_rc(tid * 16 + i_ * 8192, R_, C_); \
        dst[h_][i_] = ((unsigned)rowlds[h_ * HALF + R_] * (unsigned)K + (unsigned)C_) * 2u; } } while (0)
    const size_t kstep = (size_t)(BK * 2);
    const size_t hstep = (size_t)HALF * K * 2;
    const size_t b64step = (size_t)64 * K * 2;
    const size_t hB = P16 ? (size_t)8 * K * 2 : hstep, b64B = P16 ? 2 * b64step : b64step;
    const size_t hA = GATHER ? (size_t)0 : hstep;
    const size_t tstep = 2 * hstep;
    const unsigned ldsw = (unsigned)wid * 1024u;
    const int aoff = lds_byte(wr * 64 + fr, fq * 8), boff = lds_byte(wc * 32 + fr, fq * 8);
#define PG8_SA(b, h) (((b) * 2 + (h)) * HTB)
#define PG8_SB(b, h) ((4 + (b) * 2 + (h)) * HTB)
#define PG8_STAGE(bufoff, gbase, voff) do { if constexpr (true) { const bool isB_ = ((const void*)(voff) == (const void*)voffB), isA_ = ((const void*)(voff) == (const void*)voffA); _Pragma("unroll") for (int _i = 0; _i < 2; ++_i) \
        __builtin_amdgcn_global_load_lds((const unsigned*)((const char*)(gbase) + (isB_ ? (size_t)_i * b64B : isA_ ? (size_t)_i * b64step : (size_t)0) + (isB_ ? voffB[0] : (isA_ ? voffA[0] : (voff)[_i]))), (PG8_LAS unsigned*)(lds + (bufoff) + ldsw + _i * 8192), 16, 0, 0); } } while (0)
#define PG8_LD16(off) (*(const PG8_LAS v8i_t_half*)(lds + (off)))
#define PG8_LDA(dst, b, h) do { if constexpr (FP8) { _Pragma("unroll") for (int m = 0; m < 4; ++m) dst##8[m] = __builtin_shufflevector(__builtin_bit_cast(v8i_t_half, *(const PG8_LAS bf16x8*)(lds + PG8_SA(b, h) + aoff + m * 2048)), __builtin_bit_cast(v8i_t_half, *(const PG8_LAS bf16x8*)(lds + PG8_SA(b, h) + aoff + m * 2048 + 1024)), 0, 1, 2, 3, 4, 5, 6, 7); } \
        else { _Pragma("unroll") for (int m = 0; m < 4; ++m) _Pragma("unroll") for (int k = 0; k < 2; ++k) dst[m][k] = *(const PG8_LAS bf16x8*)(lds + PG8_SA(b, h) + aoff + m * 2048 + k * 1024); } } while (0)
#define PG8_LDB(dst, b, h) do { if constexpr (FP8) { _Pragma("unroll") for (int n = 0; n < 2; ++n) dst##8[n] = __builtin_shufflevector(__builtin_bit_cast(v8i_t_half, *(const PG8_LAS bf16x8*)(lds + PG8_SB(b, h) + boff + n * 2048)), __builtin_bit_cast(v8i_t_half, *(const PG8_LAS bf16x8*)(lds + PG8_SB(b, h) + boff + n * 2048 + 1024)), 0, 1, 2, 3, 4, 5, 6, 7); } \
        else { _Pragma("unroll") for (int n = 0; n < 2; ++n) _Pragma("unroll") for (int k = 0; k < 2; ++k) dst[n][k] = *(const PG8_LAS bf16x8*)(lds + PG8_SB(b, h) + boff + n * 2048 + k * 1024); } } while (0)
#define PG8_MMA(ai, bj, At, Bt) do { __builtin_amdgcn_s_setprio(1); _Pragma("unroll") for (int m = 0; m < 4; ++m) _Pragma("unroll") for (int n = 0; n < 2; ++n) { \
        if constexpr (FP8) acc[ai][bj][m][n] = __builtin_amdgcn_mfma_scale_f32_16x16x128_f8f6f4(Bt##8[n], At##8[m], acc[ai][bj][m][n], 0, 0, 0, g.scale_a, 0, g.scale_a); \
        else { _Pragma("unroll") for (int k = 0; k < 2; ++k) acc[ai][bj][m][n] = __builtin_amdgcn_mfma_f32_16x16x32_bf16(Bt[n][k], At[m][k], acc[ai][bj][m][n], 0, 0, 0); } } __builtin_amdgcn_s_setprio(0); } while (0)
#define PG8_WAIT_V(n) asm volatile("s_waitcnt vmcnt(" #n ")" ::: "memory")
#define PG8_WAIT_L(n) asm volatile("s_waitcnt lgkmcnt(" #n ")" ::: "memory")
#define PG8_BAR __builtin_amdgcn_s_barrier()
#define PG8_SCHED __builtin_amdgcn_sched_barrier(0)
    Unit cur, nxt; int ui = 0;
    if (!S.next(0, cur)) return;
    cur.slot = 0;
    f32x4 acc[2][2][4][2];
#pragma unroll
    for (int a = 0; a < 2; ++a)
#pragma unroll
        for (int b = 0; b < 2; ++b)
#pragma unroll
            for (int m = 0; m < 4; ++m)
#pragma unroll
                for (int n = 0; n < 2; ++n) acc[a][b][m][n] = (f32x4){0.f, 0.f, 0.f, 0.f};
    bf16x8 At[4][2], B0[2][2], B1[2][2]; v8i_t At8[4], B08[2], B18[2];
    const char* cA = (const char*)g.A + (GATHER ? (size_t)0 : (size_t)cur.pm * tstep + (size_t)cur.b * g.strideA); const char* cB = (const char*)g.Bt + (size_t)cur.pn * tstep + (size_t)cur.b * g.strideB;
    PG8_ROWS(vC, cur.pm);
    S.a_ready(cur);
    if constexpr (SP2) {
        PG8_STAGE(PG8_SB(0, 0), cB, voffB); PG8_STAGE(PG8_SB(0, 1), cB + hB, voffB); PG8_STAGE(PG8_SA(0, 0), cA, (GATHER ? vC[0] : voffA)); PG8_STAGE(PG8_SA(0, 1), cA + hA, (GATHER ? vC[1] : voffA));
        if (wr == 1) PG8_BAR;
        PG8_WAIT_V(2); PG8_BAR;
        PG8_STAGE(PG8_SB(1, 0), cB + kstep, voffB); PG8_STAGE(PG8_SA(1, 0), cA + kstep, (GATHER ? vC[0] : voffA)); PG8_STAGE(PG8_SB(1, 1), cB + hB + kstep, voffB);
        PG8_WAIT_V(6); PG8_BAR;
    } else {
        PG8_STAGE(PG8_SB(0, 0), cB, voffB); PG8_STAGE(PG8_SA(0, 0), cA, voffA); PG8_STAGE(PG8_SB(0, 1), cB + hB, voffB); PG8_STAGE(PG8_SA(0, 1), cA + hstep, voffA);
        if (wr == 1) PG8_BAR;
        PG8_WAIT_V(4); PG8_BAR;
        PG8_STAGE(PG8_SB(1, 0), cB + kstep, voffB); PG8_STAGE(PG8_SA(1, 0), cA + kstep, voffA); PG8_STAGE(PG8_SB(1, 1), cB + hB + kstep, voffB);
        PG8_WAIT_V(6); PG8_BAR;
    }
    for (;;) {
        const bool has_next = S.next(ui + 1, nxt); nxt.slot = (ui + 1) & 1;
        if constexpr (Epi::LDS_BIAS) { if (wid == 0) __builtin_amdgcn_global_load_lds((const unsigned*)E.bias_src(cur, lane), (PG8_LAS unsigned*)(lds + STAGE_BYTES + 5120 + cur.slot * 1024), 16, 0, 0); }
        const char* nA = (has_next && !GATHER) ? (const char*)g.A + (size_t)nxt.pm * tstep + (size_t)nxt.b * g.strideA : cA; const char* nB = has_next ? (const char*)g.Bt + (size_t)nxt.pn * tstep + (size_t)nxt.b * g.strideB : cB;
        if constexpr (GATHER) { if (g.rowmap && wid == 0) { const int np_ = has_next ? nxt.pm : cur.pm;
            __builtin_amdgcn_global_load_lds((const unsigned*)(g.rowmap + (size_t)np_ * BM + lane * 4), (PG8_LAS unsigned*)(lds + STAGE_BYTES + 4096), 16, 0, 0); } }
        for (int t = 0; t < nt; t += 2) {
            const bool last = (t == nt - 2);
            const char* a1 = cA + (size_t)(t + 1) * kstep;
            const char* a2 = last ? nA : cA + (size_t)(t + 2) * kstep; const char* b2 = last ? nB : cB + (size_t)(t + 2) * kstep;
            const char* a3 = a2 + kstep; const char* b3 = b2 + kstep;
            if (last && has_next) S.a_ready(nxt);
            if constexpr (SP2) {
            PG8_LDB(B0, 0, 0); PG8_LDB(B1, 0, 1); PG8_SCHED; PG8_LDA(At, 0, 0); PG8_STAGE(PG8_SA(1, 1), a1 + hA, (GATHER ? vC[1] : voffA));
            if constexpr (GATHER) { if (last) { if (g.rowmap) PG8_ROWS_LDS(vC); else { const int np_ = has_next ? nxt.pm : cur.pm; PG8_ROWS(vC, np_); } } }
            PG8_WAIT_V(8); PG8_WAIT_L(0); PG8_BAR; PG8_MMA(0, 0, At, B0); PG8_MMA(0, 1, At, B1); PG8_BAR; PG8_SCHED;
            PG8_LDA(At, 0, 1); PG8_STAGE(PG8_SB(0, 0), b2, voffB); PG8_STAGE(PG8_SB(0, 1), b2 + hB, voffB); PG8_STAGE(PG8_SA(0, 0), a2, (GATHER ? vC[0] : voffA));
            PG8_WAIT_V(8); PG8_WAIT_L(0); PG8_BAR; PG8_MMA(1, 0, At, B0); PG8_MMA(1, 1, At, B1); PG8_BAR; PG8_SCHED;
            PG8_LDB(B0, 1, 0); PG8_LDB(B1, 1, 1); PG8_SCHED; PG8_LDA(At, 1, 0); PG8_STAGE(PG8_SA(0, 1), a2 + hA, (GATHER ? vC[1] : voffA));
            PG8_WAIT_V(8); PG8_WAIT_L(0); PG8_BAR; PG8_MMA(0, 0, At, B0); PG8_MMA(0, 1, At, B1); PG8_BAR; PG8_SCHED;
            PG8_LDA(At, 1, 1); PG8_STAGE(PG8_SB(1, 0), b3, voffB); PG8_STAGE(PG8_SB(1, 1), b3 + hB, voffB); PG8_STAGE(PG8_SA(1, 0), a3, (GATHER ? vC[0] : voffA));
            PG8_WAIT_V(8); PG8_WAIT_L(0); PG8_BAR; PG8_MMA(1, 0, At, B0); PG8_MMA(1, 1, At, B1); PG8_BAR; PG8_SCHED;
            } else {
            PG8_LDB(B0, 0, 0); PG8_SCHED; PG8_LDA(At, 0, 0); PG8_STAGE(PG8_SA(1, 1), a1 + hstep, voffA);
            PG8_WAIT_L(8); PG8_BAR; PG8_WAIT_L(0); PG8_MMA(0, 0, At, B0); PG8_BAR; PG8_SCHED;
            PG8_LDB(B1, 0, 1); PG8_STAGE(PG8_SB(0, 0), b2, voffB);
            PG8_BAR; PG8_WAIT_L(0); PG8_MMA(0, 1, At, B1); PG8_BAR;
            PG8_LDA(At, 0, 1); PG8_STAGE(PG8_SA(0, 0), a2, voffA);
            PG8_BAR; PG8_WAIT_L(0); PG8_MMA(1, 0, At, B0); PG8_BAR; PG8_SCHED;
            PG8_STAGE(PG8_SB(0, 1), b2 + hB, voffB);
            PG8_WAIT_V(6); PG8_BAR; PG8_MMA(1, 1, At, B1); PG8_BAR;
            PG8_LDB(B0, 1, 0); PG8_SCHED; PG8_LDA(At, 1, 0); PG8_STAGE(PG8_SA(0, 1), a2 + hstep, voffA);
            PG8_WAIT_L(8); PG8_BAR; PG8_WAIT_L(0); PG8_MMA(0, 0, At, B0); PG8_BAR; PG8_SCHED;
            PG8_LDB(B1, 1, 1); PG8_STAGE(PG8_SB(1, 0), b3, voffB);
            PG8_BAR; PG8_WAIT_L(0); PG8_MMA(0, 1, At, B1); PG8_BAR;
            PG8_LDA(At, 1, 1); PG8_STAGE(PG8_SA(1, 0), a3, voffA);
            PG8_BAR; PG8_WAIT_L(0); PG8_MMA(1, 0, At, B0); PG8_BAR; PG8_SCHED;
            PG8_STAGE(PG8_SB(1, 1), b3 + hB, voffB);
            PG8_WAIT_V(6); PG8_BAR; PG8_MMA(1, 1, At, B1); PG8_BAR;
            }
        }
        if constexpr (ALIGN_EPI) { if (wr == 0) PG8_BAR; }
        if constexpr (!Epi::AFTER_DRAIN) { int t2_ = threadIdx.x; asm volatile("" : "+v"(t2_)); E(acc, cur, wr, wc, t2_ & 15, (t2_ & 63) >> 4); S.done(cur); }
        if (!has_next) break;
        if (!(Epi::CHAIN && cur.b < 2)) {
#pragma unroll
        for (int a = 0; a < 2; ++a)
#pragma unroll
            for (int b = 0; b < 2; ++b)
#pragma unroll
                for (int m = 0; m < 4; ++m)
#pragma unroll
                    for (int n = 0; n < 2; ++n) acc[a][b][m][n] = (f32x4){0.f, 0.f, 0.f, 0.f};
        }
        cur = nxt; cA = nA; cB = nB; ++ui;
        if constexpr (ALIGN_EPI) { if (wr == 1) PG8_BAR; }
    }
    PG8_WAIT_V(0);
    if constexpr (!ALIGN_EPI) { if (wr == 0) PG8_BAR; }
    PG8_BAR;
    if constexpr (Epi::AFTER_DRAIN) { E.fused(acc, cur, wr, wc, fr, fq, lds, wid, lane); S.done(cur); }
#undef PG8_ROWS
#undef PG8_ROWS_LDS
#undef PG8_SA
#undef PG8_SB
#undef PG8_STAGE
#undef PG8_LDA
#undef PG8_LDB
#undef PG8_MMA
#undef PG8_LD16
#undef PG8_WAIT_V
#undef PG8_WAIT_L
#undef PG8_BAR
#undef PG8_SCHED
}
}
namespace attn_body {
using bf16=__hip_bfloat16;
using bf16x8=__attribute__((ext_vector_type(8)))short;
using s16x4=__attribute__((ext_vector_type(4)))short;
using f32x16=__attribute__((ext_vector_type(16)))float;
using f32x4v=__attribute__((ext_vector_type(4)))float;
using u32x4=__attribute__((ext_vector_type(4)))unsigned;
constexpr int D=64;
constexpr int NW=8,QBLK=32,QB=QBLK*NW,KVBLK=64;
__device__ __forceinline__ int crow(int r,int hi){return (r&3)+8*(r>>2)+4*hi;}
#define SBAR() __builtin_amdgcn_sched_barrier(0)
__device__ __forceinline__ void cmask(f32x16&p0,f32x16&p1,int jb,int qrel,int hi){
  const float NEG=-INFINITY; int kb=64*jb+4*hi;
  #pragma unroll
  for(int r=0;r<16;++r){int kv=kb+(r&3)+8*(r>>2); if(kv>qrel)p0[r]=NEG; if(kv+32>qrel)p1[r]=NEG;}
}

constexpr int NSLOT=3, SLOTB=8192;
constexpr int LDS_K=0, LDS_V=NSLOT*SLOTB, LDS_WS=2*NSLOT*SLOTB, LDS_OST=LDS_WS+NW*64*4, LDS_BYTES=LDS_OST+NW*4096;
constexpr int LDS_CS=LDS_BYTES, CS_BYTES=65536, LDS_TOTAL=LDS_CS+CS_BYTES;
constexpr int TBL_N=640, TBL_ZERO=256;
__device__ __forceinline__ void glds16(const void*gsrc,unsigned lds_dst){unsigned keep;
  asm volatile("s_mov_b32 %0, m0\n\ts_mov_b32 m0, %2\n\ts_nop 0\n\tglobal_load_lds_dwordx4 %1, off\n\ts_mov_b32 m0, %0":"=&s"(keep):"v"(gsrc),"s"(lds_dst):"memory");}
__device__ __forceinline__ float max3f(float a,float b,float c){float r;asm("v_max3_f32 %0, %1, %2, %3":"=v"(r):"v"(a),"v"(b),"v"(c));return r;}
__device__ __forceinline__ float max2f(float a,float b){float r;asm("v_max_f32_e32 %0, %1, %2":"=v"(r):"v"(a),"v"(b));return r;}
__device__ __forceinline__ float fadd_s(float a,float b){float r;asm("v_add_f32_e32 %0, %1, %2":"=v"(r):"v"(a),"v"(b));return r;}
__device__ __forceinline__ float fsub_s(float a,float b){float r;asm("v_sub_f32_e32 %0, %1, %2":"=v"(r):"v"(a),"v"(b));return r;}
typedef float f32x2_t __attribute__((ext_vector_type(2))); typedef __bf16 bf16x2_t __attribute__((ext_vector_type(2)));
__device__ __forceinline__ unsigned cvtpk_s(float lo,float hi){f32x2_t v={lo,hi};bf16x2_t b=__builtin_convertvector(v,bf16x2_t);return __builtin_bit_cast(unsigned,b);}
#define WAIT_BAR(N) asm volatile("s_waitcnt vmcnt(" #N ") lgkmcnt(0)\n\ts_barrier":::"memory")

__device__ __forceinline__ void qkt(f32x16&p0,f32x16&p1,const char*Kslot,const bf16x8*qr,int r32,int hi){
  const char*kb=Kslot+hi*1024+r32*16;
  #pragma unroll
  for(int d0=0;d0<4;++d0){
    const bf16x8 b0=*reinterpret_cast<const bf16x8*>(kb+d0*2048);
    const bf16x8 b1=*reinterpret_cast<const bf16x8*>(kb+d0*2048+512);
    p0=__builtin_amdgcn_mfma_f32_32x32x16_bf16(b0,qr[d0],p0,0,0,0);p1=__builtin_amdgcn_mfma_f32_32x32x16_bf16(b1,qr[d0],p1,0,0,0);}
}
typedef __attribute__((address_space(3))) const char* lds_cptr;
typedef __attribute__((address_space(3))) char* lds_ptr;
typedef short v4i16_t __attribute__((ext_vector_type(4)));
__device__ __forceinline__ void kload8(bf16x8*kf,lds_cptr kp){
  kf[0]=*(const __attribute__((address_space(3))) bf16x8*)(kp);      kf[1]=*(const __attribute__((address_space(3))) bf16x8*)(kp+512);
  kf[2]=*(const __attribute__((address_space(3))) bf16x8*)(kp+2048); kf[3]=*(const __attribute__((address_space(3))) bf16x8*)(kp+2560);
  kf[4]=*(const __attribute__((address_space(3))) bf16x8*)(kp+4096); kf[5]=*(const __attribute__((address_space(3))) bf16x8*)(kp+4608);
  kf[6]=*(const __attribute__((address_space(3))) bf16x8*)(kp+6144); kf[7]=*(const __attribute__((address_space(3))) bf16x8*)(kp+6656);
}
__device__ __forceinline__ void kload2(bf16x8*kf,lds_cptr kp,int j){ kf[2*j]=*(const __attribute__((address_space(3))) bf16x8*)(kp+j*2048); kf[2*j+1]=*(const __attribute__((address_space(3))) bf16x8*)(kp+j*2048+512); }
__device__ __forceinline__ s16x4 vtr(lds_cptr p){ return __builtin_bit_cast(s16x4,__builtin_amdgcn_ds_read_tr16_b64_v4i16((__attribute__((address_space(3))) v4i16_t*)p)); }
__device__ __forceinline__ float rowmax(const f32x16&p0,const f32x16&p1){
  float a=max3f(p0[0],p0[1],p1[0]),b=max3f(p0[2],p0[3],p1[1]);a=max3f(a,p1[2],p1[3]);
  #pragma unroll
  for(int r=4;r<16;r+=4){a=max3f(a,p0[r],p0[r+1]);b=max3f(b,p0[r+2],p0[r+3]);a=max3f(a,p1[r],p1[r+1]);b=max3f(b,p1[r+2],p1[r+3]);}
  const float m=max2f(a,b);
  auto rr=__builtin_amdgcn_permlane32_swap(__float_as_uint(m),__float_as_uint(m),false,false);
  return max2f(__uint_as_float(rr[0]),__uint_as_float(rr[1]));
}
__device__ __forceinline__ void pv(f32x16*o,int vb,bf16x8 pa0,bf16x8 pa1,bf16x8 pa2,bf16x8 pa3){
  #pragma unroll
  for(int d0=0;d0<2;++d0){s16x4 lo[4],hi[4];
    #pragma unroll
    for(int ks=0;ks<4;++ks){
      asm volatile("ds_read_b64_tr_b16 %0,%1 offset:%c2":"=&v"(lo[ks]):"v"(vb),"i"(d0*4096+ks*1024):"memory");
      asm volatile("ds_read_b64_tr_b16 %0,%1 offset:%c2":"=&v"(hi[ks]):"v"(vb),"i"(d0*4096+ks*1024+512):"memory");}
    asm volatile("s_waitcnt lgkmcnt(0)":::"memory");SBAR();
    #define PK(k) (bf16x8){lo[k][0],lo[k][1],lo[k][2],lo[k][3],hi[k][0],hi[k][1],hi[k][2],hi[k][3]}
    o[d0]=__builtin_amdgcn_mfma_f32_32x32x16_bf16(pa0,PK(0),o[d0],0,0,0);
    o[d0]=__builtin_amdgcn_mfma_f32_32x32x16_bf16(pa1,PK(1),o[d0],0,0,0);
    o[d0]=__builtin_amdgcn_mfma_f32_32x32x16_bf16(pa2,PK(2),o[d0],0,0,0);
    o[d0]=__builtin_amdgcn_mfma_f32_32x32x16_bf16(pa3,PK(3),o[d0],0,0,0);
    #undef PK
  }
}

struct AttnArgs { const bf16* Q; const bf16* K; const bf16* V; bf16* O; long qp, kp, op; int q0, NT, kv0; const float* aux; float* lse; long lse_stride; int tlo, thi, band; float thr; };
#define ATTN_STORE16(p,v) (*(u32x4*)(p)=(v))
template<int MODE,int THRL> __device__ __forceinline__ void attn_unit(const AttnArgs&a,char*shm){
  int tid_=threadIdx.x; asm volatile("":"+v"(tid_));
  const int tid=tid_,lane=tid&63,r32=lane&31,hi=lane>>5; const int wid=__builtin_amdgcn_readfirstlane(tid>>6);
  const int q0=a.q0; const long KP=a.kp;
  const bf16*Qw=a.Q+(long)(q0+wid*QBLK)*a.qp;
  const bf16*Kh=a.K,*Vh=a.V;
  int NT=a.NT, lo=0;
  if(MODE==0){
    const int nt0=a.thi-a.tlo; const float cq=a.aux[q0];
    const float ck=(lane<nt0)?a.aux[64*(a.tlo+lane)+63]:0.f;
    const unsigned long long need=__ballot((lane<nt0)&&(cq-ck>=-a.thr));
    const int j0=need?(int)__builtin_ctzll(need):nt0;
    if(j0>=nt0){ if(a.lse&&tid<QB)a.lse[(long)(q0+tid)*a.lse_stride]=-INFINITY; return; }
    lo=a.tlo+j0; int n=a.thi-lo; if(n<4){lo=a.thi-4;n=4;} if(n&1){lo-=1;n+=1;} NT=n;
    Kh+=(long)lo*KVBLK*KP; Vh+=(long)lo*KVBLK*KP;
  }
  const unsigned lds0=(unsigned)(uintptr_t)shm;
  float*wsf=(float*)(shm+LDS_WS)+wid*64;
  const lds_cptr shm3=(lds_cptr)shm;
  const __attribute__((address_space(3))) float* cs3=(const __attribute__((address_space(3))) float*)(shm3+LDS_CS);
  float nb=0.f;
  if(MODE==0){ __attribute__((address_space(3))) f32x4v* dst=(__attribute__((address_space(3))) f32x4v*)((lds_ptr)shm+LDS_CS); const f32x4v* src=(const f32x4v*)a.aux+16*lo; const int n4=16*NT;
    for(int i=tid;i<n4;i+=NW*64)dst[i]=src[i];
    nb=a.aux[q0+wid*QBLK+r32]; }
  if(MODE==1){ __attribute__((address_space(3))) float* dst=(__attribute__((address_space(3))) float*)((lds_ptr)shm+LDS_CS);
    for(int i=tid;i<TBL_N;i+=NW*64)dst[i]=a.aux[i]; }
  const bf16*ksrc=Kh+(long)lane*KP+wid*8;
  const bf16*vsrc=Vh+(long)(16*(wid&3)+(lane>>2))*KP+(wid>>2)*32+(lane&3)*8;
  const unsigned kdst=lds0+LDS_K+wid*1024, vdst=lds0+LDS_V+wid*1024;
  #define DMA_K(t,slot) glds16(ksrc+(long)(t)*KVBLK*KP,(unsigned)__builtin_amdgcn_readfirstlane(kdst+(slot)))
  #define DMA_V(t,slot) glds16(vsrc+(long)(t)*KVBLK*KP,(unsigned)__builtin_amdgcn_readfirstlane(vdst+(slot)))
  const int vb0=(int)(lds0+LDS_V)+((lane>>4)&1)*32+(lane&3)*8+(4*hi+((lane&15)>>2))*64;
  const char*Kbase=shm+LDS_K; bf16x8 kf[8];
  const lds_cptr kp0=shm3+LDS_K+hi*1024+r32*16; const lds_cptr vp0=shm3+LDS_V+((lane>>4)&1)*32+(lane&3)*8+(4*hi+((lane&15)>>2))*64;
  DMA_K(0,0);DMA_V(0,0);DMA_K(1,SLOTB);
  bf16x8 qr[4];
  #pragma unroll
  for(int d0=0;d0<4;++d0)qr[d0]=*reinterpret_cast<const bf16x8*>(&Qw[(long)r32*a.qp+d0*16+hi*8]);
  float mhat=0.f,l_reg=0.f;f32x16 o[2];o[0]=f32x16{};o[1]=f32x16{};
  const int qrel=wid*QBLK+r32;
  const int tb0=q0+qrel-a.kv0-4*hi+TBL_ZERO-63;
  #define CINIT(C0,C1,t) do{ \
    if(MODE==0){ const __attribute__((address_space(3))) float* cp_=cs3+64*(t)+4*hi; \
      _Pragma("unroll") for(int g_=0;g_<4;++g_){ const f32x4v a_=*(const __attribute__((address_space(3))) f32x4v*)(cp_+8*g_); const f32x4v b_=*(const __attribute__((address_space(3))) f32x4v*)(cp_+32+8*g_); \
        C0[4*g_]=nb-a_[0];C0[4*g_+1]=nb-a_[1];C0[4*g_+2]=nb-a_[2];C0[4*g_+3]=nb-a_[3]; C1[4*g_]=nb-b_[0];C1[4*g_+1]=nb-b_[1];C1[4*g_+2]=nb-b_[2];C1[4*g_+3]=nb-b_[3]; } } \
    else if(MODE==1){ const __attribute__((address_space(3))) float* tp_=cs3+(tb0-64*(t)); \
      _Pragma("unroll") for(int g_=0;g_<4;++g_) _Pragma("unroll") for(int j_=0;j_<4;++j_){ C0[4*g_+j_]=nb+tp_[63-8*g_-j_]; C1[4*g_+j_]=nb+tp_[31-8*g_-j_]; } } \
    else { _Pragma("unroll") for(int r_=0;r_<16;++r_){C0[r_]=nb;C1[r_]=nb;} } }while(0)
  #define CMASK(P0,P1,t) do{ if(MODE==0&&a.band){int jb_=(t)-(NT-4); if(jb_>=0)cmask(P0,P1,jb_,qrel,hi);} }while(0)
  bool resc=false;
  #define START(P0,P1) do{ const float rm=rowmax(P0,P1); resc=false; \
    { const float dl=(MODE==1)?max2f(rm,-256.0f):rm; mhat=fadd_s(mhat,dl); nb=fsub_s(nb,dl); \
      _Pragma("unroll") for(int r=0;r<16;++r){P0[r]=fsub_s(P0[r],dl);P1[r]=fsub_s(P1[r],dl);} } \
    _Pragma("unroll") for(int r=0;r<16;++r)P0[r]=__builtin_amdgcn_exp2f(P0[r]); }while(0)
  #define RESC() do{ if(resc){ asm volatile("s_waitcnt lgkmcnt(0)":::"memory"); \
      _Pragma("unroll") for(int d_=0;d_<2;++d_) _Pragma("unroll") for(int r=0;r<16;++r)o[d_][r]*=wsf[crow(r,hi)]; } }while(0)
  f32x16 pA0,pA1,pB0,pB1;
  int sl_prev=0,sl_cur=0,sl_next=SLOTB;
  #define ROT() do{sl_prev=sl_cur;sl_cur=sl_next;sl_next=(sl_next==(NSLOT-1)*SLOTB)?0:sl_next+SLOTB;}while(0)
  DMA_K(2,2*SLOTB);
  WAIT_BAR(3);
  CINIT(pA0,pA1,0);
  qkt(pA0,pA1,Kbase,qr,r32,hi);asm volatile("s_nop 15\n\ts_nop 7":"+v"(pA0),"+v"(pA1));CMASK(pA0,pA1,0);
  START(pA0,pA1);
  _Pragma("unroll") for(int r=0;r<16;++r)pA1[r]=__builtin_amdgcn_exp2f(pA1[r]);
  WAIT_BAR(0);
  DMA_K(3,0);DMA_V(1,SLOTB);
  ROT();
  kload8(kf,kp0+sl_cur);
  WAIT_BAR(2);
  s16x4 vlo[8],vhi[8]; u32x4 pw0,pw1,pw2,pw3;
  #define PKW(P,B) cvtpk_s(P[B],P[B+1])
  #define PAF(k) __builtin_bit_cast(bf16x8,pw##k)
  #define VFR(i) (bf16x8){vlo[i][0],vlo[i][1],vlo[i][2],vlo[i][3],vhi[i][0],vhi[i][1],vhi[i][2],vhi[i][3]}
  #define PIN(x) asm volatile("":"+v"(x))
  #define MX3(a,b,c) __builtin_fmaxf(__builtin_fmaxf((a),(b)),(c))
  #define GAPA(MF,A0,A1,A2,A3,W0,W1,PW) do{ MF; sacc+=A0; sacc+=A1; sacc+=A2; sacc+=A3; PIN(sacc); W0; W1; PIN(PW); SBAR(); }while(0)
  #define EX(v) __builtin_amdgcn_exp2f(v)
  #define GAPB(MF,X,B) do{ MF; X[B]=EX(X[B]); X[B+1]=EX(X[B+1]); X[B+2]=EX(X[B+2]); X[B+3]=EX(X[B+3]); PIN(X); SBAR(); }while(0)
  #define VRD(i) do{ vlo[i]=vtr(vp_+(((i)>>2)*4096+((i)&3)*1024)); vhi[i]=vtr(vp_+(((i)>>2)*4096+((i)&3)*1024+512)); }while(0)
  #define KRD(G,j) do{ if(G){ kload2(kf,kp0+sl_next,j); SBAR(); } }while(0)
  #define STEP(C0,C1,P0,P1,t,GK,GV,GL) do{ CINIT(C0,C1,t); SBAR(); \
    const lds_cptr vp_=vp0+sl_prev; \
    VRD(0); SBAR(); float sacc=(P0[0]+P0[1]); \
    GAPA(C0=__builtin_amdgcn_mfma_f32_32x32x16_bf16(kf[0],qr[0],C0,0,0,0), P0[2],P0[3],P0[4],P0[5],     pw0[0]=PKW(P0,0), pw0[1]=PKW(P0,2), pw0); \
    VRD(4); SBAR(); GAPA(C1=__builtin_amdgcn_mfma_f32_32x32x16_bf16(kf[1],qr[0],C1,0,0,0), P0[6],P0[7],P0[8],P0[9],     pw0[2]=PKW(P0,4), pw0[3]=PKW(P0,6), pw0); \
    VRD(1); SBAR(); GAPA(C0=__builtin_amdgcn_mfma_f32_32x32x16_bf16(kf[2],qr[1],C0,0,0,0),   P0[10],P0[11],P0[12],P0[13], pw1[0]=PKW(P0,8), pw1[1]=PKW(P0,10), pw1); \
    VRD(5); SBAR(); GAPA(C1=__builtin_amdgcn_mfma_f32_32x32x16_bf16(kf[3],qr[1],C1,0,0,0),   P0[14],P0[15],P1[0],P1[1],   pw1[2]=PKW(P0,12),pw1[3]=PKW(P0,14), pw1); \
    VRD(2); SBAR(); GAPA(C0=__builtin_amdgcn_mfma_f32_32x32x16_bf16(kf[4],qr[2],C0,0,0,0),   P1[2],P1[3],P1[4],P1[5],     pw2[0]=PKW(P1,0), pw2[1]=PKW(P1,2), pw2); \
    VRD(6); SBAR(); GAPA(C1=__builtin_amdgcn_mfma_f32_32x32x16_bf16(kf[5],qr[2],C1,0,0,0),   P1[6],P1[7],P1[8],P1[9],     pw2[2]=PKW(P1,4), pw2[3]=PKW(P1,6), pw2); \
    VRD(3); SBAR(); GAPA(C0=__builtin_amdgcn_mfma_f32_32x32x16_bf16(kf[6],qr[3],C0,0,0,0),   P1[10],P1[11],P1[12],P1[13], pw3[0]=PKW(P1,8), pw3[1]=PKW(P1,10), pw3); \
    VRD(7); SBAR(); GAPA(C1=__builtin_amdgcn_mfma_f32_32x32x16_bf16(kf[7],qr[3],C1,0,0,0),   P1[14],P1[15],0.f,0.f,       pw3[2]=PKW(P1,12),pw3[3]=PKW(P1,14), pw3); \
    l_reg+=sacc; \
    if(GK){DMA_K((t)+3,sl_cur);} if(GV){DMA_V((t)+1,sl_next);} \
    CMASK(C0,C1,t); \
    { float a=MX3(C0[0],C0[1],C1[0]),b=MX3(C0[2],C0[3],C1[1]); a=MX3(a,C1[2],C1[3]); \
      _Pragma("unroll") for(int r=4;r<16;r+=4){a=MX3(a,C0[r],C0[r+1]);b=MX3(b,C0[r+2],C0[r+3]);a=MX3(a,C1[r],C1[r+1]);b=MX3(b,C1[r+2],C1[r+3]);} \
      float rm=__builtin_fmaxf(a,b); { auto rr=__builtin_amdgcn_permlane32_swap(__float_as_uint(rm),__float_as_uint(rm),false,false); rm=__builtin_fmaxf(__uint_as_float(rr[0]),__uint_as_float(rr[1])); } \
      resc=false; \
      if(__builtin_expect(__any(rm>(float)THRL),0)){ const float dl=__builtin_fmaxf(rm,0.f); mhat+=dl; nb-=dl; \
        _Pragma("unroll") for(int r=0;r<16;++r){C0[r]-=dl;C1[r]-=dl;} \
        const float f=__builtin_amdgcn_exp2f(-dl); l_reg*=f; if(hi==0)wsf[r32]=f; resc=true; } } \
    SBAR(); \
    GAPB(o[0]=__builtin_amdgcn_mfma_f32_32x32x16_bf16(PAF(0),VFR(0),o[0],0,0,0), C0,0); \
    GAPB(o[1]=__builtin_amdgcn_mfma_f32_32x32x16_bf16(PAF(0),VFR(4),o[1],0,0,0), C0,4); \
    KRD(GL,0); GAPB(o[0]=__builtin_amdgcn_mfma_f32_32x32x16_bf16(PAF(1),VFR(1),o[0],0,0,0), C0,8); \
    KRD(GL,1); GAPB(o[1]=__builtin_amdgcn_mfma_f32_32x32x16_bf16(PAF(1),VFR(5),o[1],0,0,0), C0,12); \
    KRD(GL,2); GAPB(o[0]=__builtin_amdgcn_mfma_f32_32x32x16_bf16(PAF(2),VFR(2),o[0],0,0,0), C1,0); \
    KRD(GL,3); GAPB(o[1]=__builtin_amdgcn_mfma_f32_32x32x16_bf16(PAF(2),VFR(6),o[1],0,0,0), C1,4); \
    GAPB(o[0]=__builtin_amdgcn_mfma_f32_32x32x16_bf16(PAF(3),VFR(3),o[0],0,0,0), C1,8); \
    GAPB(o[1]=__builtin_amdgcn_mfma_f32_32x32x16_bf16(PAF(3),VFR(7),o[1],0,0,0), C1,12); \
    }while(0)
  int t=1;
  #undef CMASK
  #define CMASK(P0,P1,t) do{}while(0)
  for(;t+5<NT;t+=2){
    STEP(pB0,pB1,pA0,pA1,t,true,true,true);     WAIT_BAR(2); RESC(); ROT();
    STEP(pA0,pA1,pB0,pB1,t+1,true,true,true);   WAIT_BAR(2); RESC(); ROT();
  }
  #undef CMASK
  #define CMASK(P0,P1,t) do{ if(MODE==0&&a.band){int jb_=(t)-(NT-4); if(jb_>=0)cmask(P0,P1,jb_,qrel,hi);} }while(0)
  #define ENDW(tt) do{ if((tt)+3<NT){WAIT_BAR(2);} else if((tt)+2<NT){WAIT_BAR(1);} else {WAIT_BAR(0);} }while(0)
  for(;t+1<NT;t+=2){
    STEP(pB0,pB1,pA0,pA1,t,(t+3<NT),(t+1<NT),(t+1<NT));       ENDW(t);   RESC(); ROT();
    STEP(pA0,pA1,pB0,pB1,t+1,(t+4<NT),(t+2<NT),(t+2<NT));     ENDW(t+1); RESC(); ROT();
  }
  STEP(pB0,pB1,pA0,pA1,NT-1,false,false,false); RESC();
  { float sacc=pB0[0]+pB0[1]; _Pragma("unroll") for(int r=2;r<16;++r)sacc+=pB0[r]; _Pragma("unroll") for(int r=0;r<16;++r)sacc+=pB1[r]; l_reg+=sacc;
    pw0=(u32x4){PKW(pB0,0),PKW(pB0,2),PKW(pB0,4),PKW(pB0,6)};pw1=(u32x4){PKW(pB0,8),PKW(pB0,10),PKW(pB0,12),PKW(pB0,14)};pw2=(u32x4){PKW(pB1,0),PKW(pB1,2),PKW(pB1,4),PKW(pB1,6)};pw3=(u32x4){PKW(pB1,8),PKW(pB1,10),PKW(pB1,12),PKW(pB1,14)};
    SBAR(); pv(o,vb0+sl_cur,PAF(0),PAF(1),PAF(2),PAF(3)); }
  #undef PKW
  #undef PAF
  #undef VFR
  #undef PIN
  #undef MX3
  #undef GAPA
  #undef GAPB
  #undef EX
  #undef VRD
  #undef KRD
  #undef STEP
  #undef ENDW
  {auto rr=__builtin_amdgcn_permlane32_swap(__float_as_uint(l_reg),__float_as_uint(l_reg),false,false);l_reg=__uint_as_float(rr[0])+__uint_as_float(rr[1]);}
  if(MODE==1||(MODE==0&&a.lse)){ if(hi==0) a.lse[(long)(q0+qrel)*a.lse_stride]=mhat+__builtin_amdgcn_logf(l_reg); }
  if(hi==0)wsf[32+r32]=l_reg;asm volatile("s_waitcnt lgkmcnt(0)":::"memory");
  float rli[16];
  #pragma unroll
  for(int r=0;r<16;++r)rli[r]=__builtin_amdgcn_rcpf(wsf[32+crow(r,hi)]);
  bf16*Ow=a.O+(long)(q0+wid*QBLK)*a.op;
  { bf16*stg=(bf16*)(shm+LDS_OST)+wid*2048;
    #pragma unroll
    for(int r=0;r<16;++r){const int orow=crow(r,hi);
      #pragma unroll
      for(int d0=0;d0<2;++d0)stg[orow*64+d0*32+r32]=__float2bfloat16(o[d0][r]*rli[r]);}
    asm volatile("s_waitcnt lgkmcnt(0)":::"memory");
    #pragma unroll
    for(int i=0;i<4;++i){const int row=i*8+(lane>>3),ch=lane&7; const u32x4 v=*(const u32x4*)(stg+row*64+ch*8); ATTN_STORE16(Ow+(long)row*a.op+ch*8,v);} }
  asm volatile("s_waitcnt lgkmcnt(0)\n\ts_barrier":::"memory");
  #undef DMA_K
  #undef DMA_V
  #undef CMASK
  #undef CINIT
  #undef START
  #undef RESC
  #undef ROT
}
constexpr int ATTN_LDS_BYTES=LDS_TOTAL;
#undef SBAR
#undef WAIT_BAR
}
#define GAS __attribute__((address_space(1)))
#define LAS __attribute__((address_space(3)))
typedef unsigned short bf16;
typedef unsigned v4u __attribute__((ext_vector_type(4)));
typedef float f32x4 __attribute__((ext_vector_type(4)));
typedef short bf16x8 __attribute__((ext_vector_type(8)));
typedef GAS unsigned gu32;
typedef GAS unsigned long long gu64;
#define RLX_AGENT __ATOMIC_RELAXED, __HIP_MEMORY_SCOPE_AGENT
#define LDS_WAIT() asm volatile("s_waitcnt lgkmcnt(0)" ::: "memory")
#define VM_WAIT() asm volatile("s_waitcnt vmcnt(0)" ::: "memory")
__device__ __forceinline__ unsigned long long rt() { return __builtin_amdgcn_s_memrealtime(); }
__device__ __forceinline__ unsigned f2bf(float f) { unsigned u = __builtin_bit_cast(unsigned, f); return (u + 0x7fffu + ((u >> 16) & 1u)) >> 16; }
__device__ __forceinline__ unsigned pk4_fp8(float a, float b, float c, float d) { int w = __builtin_amdgcn_cvt_pk_fp8_f32(a, b, 0, false); w = __builtin_amdgcn_cvt_pk_fp8_f32(c, d, w, true); return (unsigned)w; }
__device__ __forceinline__ unsigned pk2(float lo, float hi) { typedef float f2_t __attribute__((ext_vector_type(2))); typedef __bf16 b2_t __attribute__((ext_vector_type(2))); f2_t v = {lo, hi}; b2_t b = __builtin_convertvector(v, b2_t); return __builtin_bit_cast(unsigned, b); }

#define XB_TMO      128
#define XB_XCNT(j)  (256  + 64 * (j))
#define XB_XSUB(j)  (1280 + 64 * (j))
#define XB_XGEN(j)  (2304 + 64 * (j))
#define XB_TOP      3328
#define XB_TOPGEN   3392
#define XCD_BAR_WORDS 3456
#define XB_SPIN_CAP (1u << 18)

__device__ __forceinline__ unsigned xb_ld(unsigned* p)              { return __hip_atomic_load(p, __ATOMIC_RELAXED, __HIP_MEMORY_SCOPE_AGENT); }
__device__ __forceinline__ unsigned xb_add(unsigned* p, unsigned v) { return __hip_atomic_fetch_add(p, v, __ATOMIC_RELAXED, __HIP_MEMORY_SCOPE_AGENT); }
__device__ __forceinline__ unsigned xb_xcc_id() { return (unsigned)__builtin_amdgcn_s_getreg((3 << 11) | 20) & 0xFu; }
#define XB_SPIN(cond, bar) do { unsigned _sp = 0; while (cond) { __builtin_amdgcn_s_sleep(1); \
    if ((++_sp & 255u) == 0u) { if (xb_ld(&(bar)[XB_TMO])) break; if (_sp > XB_SPIN_CAP) { atomicAdd(&(bar)[XB_TMO], 1u); break; } } } } while (0)

struct XcdBarrier {
    unsigned* bar; unsigned x;
    volatile LAS unsigned* st;
};

__device__ __forceinline__ XcdBarrier xcd_barrier_post(unsigned* bar, volatile LAS unsigned* st) {
    XcdBarrier b; b.bar = bar; b.x = xb_xcc_id(); b.st = st;
    if (threadIdx.x == 0) (void)xb_add(&bar[XB_XCNT(b.x)], 1u);
    return b;
}
__device__ __forceinline__ void xcd_barrier_complete(unsigned* bar, unsigned x, unsigned& nloc, unsigned& nx) {
    const unsigned G = gridDim.x * gridDim.y * gridDim.z;
    unsigned sum, cnt, mine, sp = 0u;
    for (;;) {
        sum = 0u; cnt = 0u; mine = 0u;
#pragma unroll
        for (unsigned j = 0; j < 16; ++j) { const unsigned c = xb_ld(&bar[XB_XCNT(j)]); sum += c; cnt += (c > 0u) ? 1u : 0u; mine = (j == x) ? c : mine; }
        if (sum == G) break;
        __builtin_amdgcn_s_sleep(1);
        if ((++sp & 255u) == 0u) { if (xb_ld(&bar[XB_TMO])) break; if (sp > XB_SPIN_CAP) { atomicAdd(&bar[XB_TMO], 1u); break; } }
    }
    nloc = mine > 0u ? mine : 1u; nx = cnt > 0u ? cnt : 1u;
}

__device__ __forceinline__ void xcd_barrier(const XcdBarrier& b) {
    asm volatile("s_waitcnt vmcnt(0)" ::: "memory");
    __syncthreads();
    if (threadIdx.x == 0) {
        unsigned* bar = b.bar;
        __builtin_amdgcn_s_waitcnt(0);
        unsigned nloc = b.st[0], nx = b.st[1];
        if (nloc == 0u) { xcd_barrier_complete(bar, b.x, nloc, nx); b.st[0] = nloc; b.st[1] = nx; }
        const unsigned old = xb_add(&bar[XB_XSUB(b.x)], 1u);
        const unsigned gen = old / nloc;
        if (old + 1u == (gen + 1u) * nloc) {
            __builtin_amdgcn_fence(__ATOMIC_RELEASE, "agent");
            asm volatile("s_waitcnt vmcnt(0)" ::: "memory");
            const unsigned og = xb_add(&bar[XB_TOP], 1u);
            const unsigned tg = og / nx;
            if (og + 1u == (tg + 1u) * nx) xb_add(&bar[XB_TOPGEN], 1u);
            else XB_SPIN(xb_ld(&bar[XB_TOPGEN]) == tg, bar);
            __builtin_amdgcn_fence(__ATOMIC_ACQUIRE, "agent");
            xb_add(&bar[XB_XGEN(b.x)], 1u);
            asm volatile("s_waitcnt vmcnt(0)" ::: "memory");
        } else {
            XB_SPIN(xb_ld(&bar[XB_XGEN(b.x)]) == gen, bar);
            __builtin_amdgcn_fence(__ATOMIC_ACQUIRE, "agent");
            asm volatile("s_waitcnt vmcnt(0)" ::: "memory");
        }
    }
    __syncthreads();
}

constexpr int NWAVES = 8;
constexpr int S = 16384, DM = 1024, NPROJ = 5632, NE = 32, MEML = 256;
constexpr int PC_FQ = 0, PC_FK = 384, PC_FV = 768, PC_DQ = 1152, PC_DK = 1536, PC_DV = 1920, PC_MQ = 2304, PC_GT = 2560;
constexpr int W_IN_LD = 5638, W_IN_F = 1152;
constexpr float LN_EPS = 1e-5f, ALPHA = 1.189207115002721f;
constexpr float LOG2E = 1.4426950408889634f, C2F = 0.125f * 1.4426950408889634f;
constexpr int MAXROWS = 65536 + 32 * 256;
constexpr int NPHASE = 11;
#ifndef MK_N_LAUNCHES
#define MK_N_LAUNCHES 1
#endif
constexpr int N_LAUNCHES = MK_N_LAUNCHES;

constexpr size_t MiB = 1u << 20, KiB = 1u << 10;
constexpr size_t WS_CTL = 0, CTL_ZERO_BYTES = 256 * KiB;
constexpr size_t WS_WIN = 2 * MiB;
constexpr size_t WS_WBF = 748 * MiB, WS_WBD = WS_WBF + 768 * KiB, WS_WBM = WS_WBD + 768 * KiB, WS_WOUT = 15 * MiB, WS_WMKV = 17 * MiB;
constexpr size_t WS_LF2 = 18 * MiB, WS_C2 = WS_LF2 + 512 * KiB, WS_LSE = 19 * MiB, WS_TBL = WS_LSE + 512 * KiB, WS_MEMB = 20 * MiB, WS_MEMKV = WS_MEMB + 512 * KiB;
constexpr size_t WS_TOPI = 21 * MiB, WS_TOPG = WS_TOPI + 256 * KiB, WS_RANK = WS_TOPG + 256 * KiB, WS_DEST = WS_RANK + 256 * KiB, WS_BLKCNT = 22 * MiB, WS_TST = WS_BLKCNT + 64 * KiB;
constexpr size_t WS_TOKROW = 23 * MiB;
constexpr size_t WS_IDMAP = 23 * MiB + 512 * KiB;
constexpr size_t WS_XB = 24 * MiB;
constexpr size_t WS_PBUF = 56 * MiB;
constexpr size_t WS_Y = WS_PBUF;
constexpr size_t WS_OFOX = 712 * MiB, WS_ODIL = 724 * MiB, WS_OMEM = 736 * MiB;
constexpr size_t WS_W1 = 264 * MiB, WS_W2 = 392 * MiB;
constexpr size_t WS_STASH = 456 * MiB, WS_MERGED = 520 * MiB;
constexpr size_t WS_R1 = 552 * MiB, WS_H1F8 = 616 * MiB, WS_XF8 = 632 * MiB, WS_WGF8 = 648 * MiB, WS_H1B = 680 * MiB;
constexpr int W1_SHIFT = 5;
constexpr size_t WS_XS = 712 * MiB, WS_ACT = 856 * MiB, WS_END = 1000 * MiB;
static_assert(WS_XS + (size_t)MAXROWS * 1024 * 2 <= WS_ACT && WS_ACT + (size_t)MAXROWS * 1024 * 2 <= WS_END && WS_Y + (size_t)MAXROWS * 1024 * 2 <= 232 * MiB && WS_WBM + 768 * KiB <= WS_ACT, "ws map");
constexpr int CW_BAR = 4096;
constexpr int CW_NRM = 64, CW_QHEAD = 128;
constexpr size_t WS_OPART = WS_STASH, WS_LSEF = WS_STASH + 48 * MiB;

constexpr int RING_OFF = 0;
constexpr int LDSCTL_OFF = attn_body::ATTN_LDS_BYTES, MISC_OFF = LDSCTL_OFF + 320, TBL_OFF = MISC_OFF + 128;
constexpr int LDS_BYTES = 150528;
static_assert(TBL_OFF + 256 <= LDS_BYTES && pg8::STAGE_BYTES <= LDSCTL_OFF, "LDS map");

struct Args { const float* in[20]; float* out; unsigned char* ws; int ph_lo, ph_hi, li, pad; };
struct Frame {
    LAS unsigned char* lds;
    volatile LAS unsigned* MISC;
    gu32* ctl;
    int tid, lane, wave;
    int vcu, G;
    float* out; unsigned char* ws;
};
__device__ __forceinline__ float wave_sum(float v) {
#pragma unroll
    for (int o = 1; o < 64; o <<= 1) v += __shfl_xor(v, o);
    return v;
}
typedef float f4u __attribute__((ext_vector_type(4), aligned(4)));
typedef float f32x2 __attribute__((ext_vector_type(2)));
typedef unsigned v2u __attribute__((ext_vector_type(2)));
__device__ __forceinline__ void p0_tr_item(const float* W, int ldw, int k0, int src_n0, bf16* WT, int K, int dst_n0, float scale, LAS float* scr, int lane) {
    f4u v[16];
#pragma unroll
    for (int i = 0; i < 16; ++i) v[i] = *(const f4u*)(W + (size_t)(k0 + 4 * i + (lane >> 4)) * ldw + src_n0 + (lane & 15) * 4);
#pragma unroll
    for (int i = 0; i < 16; ++i) { LAS float* d = scr + (4 * i + (lane >> 4)) * 65 + (lane & 15) * 4; d[0] = v[i].x * scale; d[1] = v[i].y * scale; d[2] = v[i].z * scale; d[3] = v[i].w * scale; }
    LDS_WAIT(); asm volatile("" ::: "memory");
    const int c = lane & 7;
#pragma unroll
    for (int j = 0; j < 8; ++j) { const int n = (lane >> 3) + 8 * j; const LAS float* s = scr + (8 * c) * 65 + n;
        v4u o; o.x = pk2(s[0 * 65], s[1 * 65]); o.y = pk2(s[2 * 65], s[3 * 65]); o.z = pk2(s[4 * 65], s[5 * 65]); o.w = pk2(s[6 * 65], s[7 * 65]);
        *(GAS v4u*)(WT + (size_t)(dst_n0 + n) * K + k0 + 8 * c) = o; }
    LDS_WAIT(); asm volatile("" ::: "memory");
}
constexpr int CV_E1 = 32 * 512, CV_E2 = 32 * 256, CV_UNITS = (CV_E1 + CV_E2) / 64;
struct CvItem { const float* W; bf16* WT; int ldw, k0, sn, dn, f8; };
__device__ __forceinline__ CvItem cv_decode(const Args& A, unsigned char* ws, int r) {
    CvItem c;
    if (r < CV_E1) { const int e = r >> 9, rr = r & 511, kb = rr >> 5, nb = rr & 31, dn = nb * 64; c.sn = ((dn >> 7) & 1) * 1024 + (dn >> 8) * 128 + (dn & 127); c.dn = dn; c.k0 = kb * 64; c.ldw = 2048;
        c.W = A.in[14] + (size_t)e * 1024 * 2048; c.WT = (bf16*)(ws + WS_W1 + (size_t)e * 2048 * 1024); c.f8 = 1 + W1_SHIFT; }
    else { r -= CV_E1; const int e = r >> 8, rr = r & 255, kb = rr >> 4, nb = rr & 15; c.sn = nb * 64; c.dn = nb * 64; c.k0 = kb * 64; c.ldw = 1024;
        c.W = A.in[16] + (size_t)e * 1024 * 1024; c.WT = (bf16*)(ws + WS_W2 + (size_t)e * 1024 * 1024); c.f8 = 1 + W1_SHIFT; }
    return c;
}
__device__ __forceinline__ void cv_load(f4u (&v)[16], const CvItem& c, int lane) {
#pragma unroll
    for (int i = 0; i < 16; ++i) v[i] = *(const f4u*)(c.W + (size_t)(c.k0 + 4 * i + (lane >> 4)) * c.ldw + c.sn + (lane & 15) * 4);
}
__device__ __forceinline__ void cv_store(const f4u (&v)[16], const CvItem& c, LAS float* scr, int lane) {
#pragma unroll
    for (int i = 0; i < 16; ++i) { LAS float* d = scr + (4 * i + (lane >> 4)) * 65 + (lane & 15) * 4; d[0] = v[i].x; d[1] = v[i].y; d[2] = v[i].z; d[3] = v[i].w; }
    LDS_WAIT(); asm volatile("" ::: "memory");
    const int cc = lane & 7;
#pragma unroll
    for (int j = 0; j < 8; ++j) { const int n = (lane >> 3) + 8 * j; const LAS float* sp = scr + (8 * cc) * 65 + n;
        v4u o; o.x = pk2(sp[0 * 65], sp[1 * 65]); o.y = pk2(sp[2 * 65], sp[3 * 65]); o.z = pk2(sp[4 * 65], sp[5 * 65]); o.w = pk2(sp[6 * 65], sp[7 * 65]);
        *(GAS v4u*)(c.WT + (size_t)(c.dn + n) * 1024 + c.k0 + 8 * cc) = o; }
    LDS_WAIT(); asm volatile("" ::: "memory");
}
__device__ __forceinline__ void cv_store_f8(const f4u (&v)[16], const CvItem& c, LAS float* scr, int lane) {
    const float sc = (float)(1 << (c.f8 - 1));
#pragma unroll
    for (int i = 0; i < 16; ++i) { LAS float* d = scr + (4 * i + (lane >> 4)) * 65 + (lane & 15) * 4; d[0] = v[i].x * sc; d[1] = v[i].y * sc; d[2] = v[i].z * sc; d[3] = v[i].w * sc; }
    LDS_WAIT(); asm volatile("" ::: "memory");
    const int cc = lane & 7; unsigned char* const WT8 = (unsigned char*)c.WT;
#pragma unroll
    for (int j = 0; j < 8; ++j) { const int n = (lane >> 3) + 8 * j; const LAS float* sp = scr + (8 * cc) * 65 + n;
        v2u o; o.x = pk4_fp8(sp[0 * 65], sp[1 * 65], sp[2 * 65], sp[3 * 65]); o.y = pk4_fp8(sp[4 * 65], sp[5 * 65], sp[6 * 65], sp[7 * 65]);
        *(GAS v2u*)(WT8 + (size_t)(c.dn + n) * 1024 + c.k0 + 8 * cc) = o; }
    LDS_WAIT(); asm volatile("" ::: "memory");
}
__device__ __forceinline__ void conv_unit(Frame& F, const Args& A, int cu) {
    LAS float* scr = (LAS float*)(F.lds + RING_OFF + F.wave * 16640);
    const int r0 = cu * 64 + F.wave * 8;
    f4u va[16], vb[16];
    CvItem ca = cv_decode(A, F.ws, r0), cb; cv_load(va, ca, F.lane);
#pragma unroll 1
    for (int i = 0; i < 8; i += 2) {
        cb = cv_decode(A, F.ws, r0 + i + 1); cv_load(vb, cb, F.lane);
        if (ca.f8) cv_store_f8(va, ca, scr, F.lane); else cv_store(va, ca, scr, F.lane);
        if (i + 2 < 8) { ca = cv_decode(A, F.ws, r0 + i + 2); cv_load(va, ca, F.lane); }
        if (cb.f8) cv_store_f8(vb, cb, scr, F.lane); else cv_store(vb, cb, scr, F.lane);
    }
}
__device__ __forceinline__ void p0_prologue(Frame& F, const Args& A) {
    LAS float* scr = (LAS float*)(F.lds + RING_OFF + F.wave * 16640);
    const int gw = F.vcu * NWAVES + F.wave, NGW = F.G * NWAVES;
    bf16* const WIN = (bf16*)(F.ws + WS_WIN); bf16* const WBF = (bf16*)(F.ws + WS_WBF); bf16* const WBD = (bf16*)(F.ws + WS_WBD); bf16* const WBM = (bf16*)(F.ws + WS_WBM);
    bf16* const WOUT = (bf16*)(F.ws + WS_WOUT); bf16* const WMKV = (bf16*)(F.ws + WS_WMKV);
    constexpr int I_IN = 16 * 88, I_BF = 6 * 16, I_BD = 6 * 16, I_BM = 4 * 16, I_WO = 16 * 16, I_MKV = 16 * 8;
    constexpr int NITEMS = I_IN + I_BF + I_BD + I_BM + I_WO + I_MKV;
    for (int it = gw; it < NITEMS; it += NGW) {
        int r = it;
        if (r < I_IN) { const int kb = r / 88, nb = r % 88, dn = nb * 64; const int sn = dn + (dn >= W_IN_F ? 6 : 0);
            const float sc = (dn < PC_FK || (dn >= PC_DQ && dn < PC_DK) || (dn >= PC_MQ && dn < PC_GT)) ? C2F : 1.0f;
            { CvItem c; c.W = A.in[2]; c.WT = (bf16*)(F.ws + WS_WGF8); c.ldw = W_IN_LD; c.k0 = kb * 64; c.sn = sn; c.dn = dn; c.f8 = 1 + 6;
              f4u v[16]; cv_load(v, c, F.lane);
              if (sc != 1.0f) {
#pragma unroll
                  for (int i = 0; i < 16; ++i) { v[i].x *= sc; v[i].y *= sc; v[i].z *= sc; v[i].w *= sc; } }
              cv_store_f8(v, c, scr, F.lane); }
            continue; } r -= I_IN;
        if (r < I_BF) { const int kb = r >> 4, nb = r & 15; p0_tr_item(A.in[6], 1024, kb * 64, nb * 64, WBF, 384, nb * 64, 1.0f, scr, F.lane); continue; } r -= I_BF;
        if (r < I_BD) { const int kb = r >> 4, nb = r & 15; p0_tr_item(A.in[7], 1024, kb * 64, nb * 64, WBD, 384, nb * 64, 1.0f, scr, F.lane); continue; } r -= I_BD;
        if (r < I_BM) { const int kb = r >> 4, nb = r & 15; p0_tr_item(A.in[8], 1024, kb * 64, nb * 64, WBM, 384, nb * 64, 1.0f, scr, F.lane); continue; } r -= I_BM;
        if (r < I_WO) { const int kb = r >> 4, nb = r & 15; p0_tr_item(A.in[9], 1024, kb * 64, nb * 64, WOUT, 1024, nb * 64, 1.0f, scr, F.lane); continue; } r -= I_WO;
        { const int kb = r >> 3, nb = r & 7; p0_tr_item(A.in[5], 512, kb * 64, nb * 64, WMKV, 1024, nb * 64, 1.0f, scr, F.lane); }
    }
    {
        float wf[4][4][6];
#pragma unroll
        for (int j = 0; j < 4; ++j)
#pragma unroll
            for (int i = 0; i < 4; ++i)
#pragma unroll
                for (int h = 0; h < 6; ++h) wf[j][i][h] = A.in[2][(size_t)(4 * F.lane + i + 256 * j) * W_IN_LD + W_IN_F + h];
        float* const LF2 = (float*)(F.ws + WS_LF2);
        f32x4 vnx[4];
        if (gw < S) { const GAS f32x4* xr0 = (const GAS f32x4*)(A.in[0] + (size_t)gw * DM) + F.lane;
#pragma unroll
            for (int j = 0; j < 4; ++j) vnx[j] = xr0[64 * j]; }
        for (int m = gw; m < S; m += NGW) {
            f32x4 v[4]; float d[6] = {0.f, 0.f, 0.f, 0.f, 0.f, 0.f};
#pragma unroll
            for (int j = 0; j < 4; ++j) v[j] = vnx[j];
            if (m + NGW < S) { const GAS f32x4* xr1 = (const GAS f32x4*)(A.in[0] + (size_t)(m + NGW) * DM) + F.lane;
#pragma unroll
                for (int j = 0; j < 4; ++j) vnx[j] = xr1[64 * j]; }
#pragma unroll
            for (int j = 0; j < 4; ++j)
#pragma unroll
                for (int h = 0; h < 6; ++h) d[h] += v[j].x * wf[j][0][h] + v[j].y * wf[j][1][h] + v[j].z * wf[j][2][h] + v[j].w * wf[j][3][h];
#pragma unroll
            for (int h = 0; h < 6; ++h) d[h] = wave_sum(d[h]);
            { GAS unsigned* o4 = (GAS unsigned*)(F.ws + WS_XF8 + (size_t)m * DM) + F.lane;
#pragma unroll
              for (int j = 0; j < 4; ++j) o4[64 * j] = pk4_fp8(v[j].x, v[j].y, v[j].z, v[j].w); }
            if (F.lane < 6) { const int h = F.lane; float f = h == 0 ? d[0] : h == 1 ? d[1] : h == 2 ? d[2] : h == 3 ? d[3] : h == 4 ? d[4] : d[5];
                f += A.in[3][h]; const float ls = fminf(f, 0.f) - log1pf(expf(-fabsf(f)));
                LF2[(size_t)h * S + m] = ls * LOG2E; }
        }
        bf16* const MEMB = (bf16*)(F.ws + WS_MEMB);
        for (int m = gw; m < MEML; m += NGW) {
            const GAS f32x4* xr = (const GAS f32x4*)(A.in[1] + (size_t)m * DM) + F.lane; GAS unsigned long long* o8 = (GAS unsigned long long*)(MEMB + (size_t)m * DM) + F.lane;
#pragma unroll
            for (int j = 0; j < 4; ++j) { const f32x4 v = xr[64 * j]; o8[64 * j] = (unsigned long long)pk2(v.x, v.y) | ((unsigned long long)pk2(v.z, v.w) << 32); }
        }
    }
    { const int gt = F.vcu * (NWAVES * 64) + F.tid, GT = F.G * NWAVES * 64; const v4u z = {0u, 0u, 0u, 0u};
      for (int i = gt; i < 1024 * 16; i += GT) *(GAS v4u*)((bf16*)(F.ws + WS_WBM) + (size_t)(i >> 4) * 384 + 256 + (i & 15) * 8) = z;
      for (int i = gt; i < S * 16; i += GT) *(GAS v4u*)((bf16*)(F.ws + WS_OMEM) + (size_t)(i >> 4) * 384 + 256 + (i & 15) * 8) = z; }
    {
        float* const TBL = (float*)(F.ws + WS_TBL);
        for (int idx = F.vcu * (NWAVES * 64) + F.tid; idx < 6 * attn_body::TBL_N; idx += F.G * NWAVES * 64) {
            const int hd = idx / attn_body::TBL_N, i = idx - hd * attn_body::TBL_N, rel = i - attn_body::TBL_ZERO, g = hd >> 1, dil = g == 0 ? 1 : (g == 1 ? 4 : 16);
            float val = -INFINITY;
            if (rel >= 0 && rel <= 128) { const int dist = rel * dil; int bucket = dist;
                if (dist >= 16) { const float nf = (float)dist; bucket = 16 + (int)(logf(nf / 16.0f) / 4.852030263919617f * 16.0f); bucket = bucket > 31 ? 31 : bucket; }
                val = A.in[4][bucket * 6 + hd] * LOG2E; }
            TBL[idx] = val;
        }
    }
}

__device__ __forceinline__ void p1_cumsum(Frame& F, int h) {
    const float* src = (const float*)(F.ws + WS_LF2) + (size_t)h * S + F.tid * 32; float* dst = (float*)(F.ws + WS_C2) + (size_t)h * S + F.tid * 32;
    LAS double* part = (LAS double*)(F.lds + RING_OFF);
    f32x4 v[8]; double s = 0.0;
#pragma unroll
    for (int i = 0; i < 8; ++i) { v[i] = *(const f32x4*)(src + 4 * i); s += (double)v[i].x; s += (double)v[i].y; s += (double)v[i].z; s += (double)v[i].w; }
    part[F.tid] = s; __syncthreads();
    double run = 0.0;
    for (int j = 0; j < F.tid; ++j) run += part[j];
#pragma unroll
    for (int i = 0; i < 8; ++i) { f32x4 o; run += (double)v[i].x; o.x = (float)run; run += (double)v[i].y; o.y = (float)run; run += (double)v[i].z; o.z = (float)run; run += (double)v[i].w; o.w = (float)run; *(f32x4*)(dst + 4 * i) = o; }
    __syncthreads();
}

constexpr int P2_NA = 600, P2_NB = 360, P2_NC = 384, P2_ND = 256, P2_UNITS = P2_NA + P2_NB + P2_NC + P2_ND;
__device__ __forceinline__ void p2_attention(Frame& F, const Args& A, char* lds, int li) {
    typedef attn_body::bf16 abf;
    abf* const PB = (abf*)(F.ws + WS_PBUF);
    volatile LAS int* qslot = (volatile LAS int*)(F.lds + MISC_OFF + 64);
    for (;;) {
        if (F.tid == 0) qslot[0] = (int)__hip_atomic_fetch_add(F.ctl + CW_QHEAD + 64 * li, 1u, __ATOMIC_RELAXED, __HIP_MEMORY_SCOPE_AGENT);
        __syncthreads();
        const int pos = __builtin_amdgcn_readfirstlane(qslot[0]);
        __syncthreads();
        if (pos >= P2_UNITS + CV_UNITS) break;
        if (pos % 4 == 3 && pos / 4 < CV_UNITS) { conv_unit(F, A, pos / 4); __syncthreads(); continue; }
        const int idx = pos - (pos / 4 < CV_UNITS ? pos / 4 : CV_UNITS);
        attn_body::AttnArgs a; a.tlo = 0; a.thi = 0; a.band = 0; a.thr = 0.f;
        if (idx < P2_NA + P2_NB) {
            int h, qb, sgm;
            if (idx < P2_NA) { h = idx % 6; const int b = idx / 6; if (b < 49) { sgm = 0; qb = 15 + b; } else if (b < 82) { sgm = 1; qb = 31 + (b - 49); } else if (b < 99) { sgm = 2; qb = 47 + (b - 82); } else { sgm = 3; qb = 63; } }
            else { const int b2 = idx - P2_NA; h = b2 % 6; const int c = b2 / 6; const int L = 60 - 4 * (c >> 2); sgm = c & 3; qb = 16 * sgm + L / 4 - 1; }
            const int ntf = 4 * qb + 4, nseg = (ntf + 63) >> 6;
            const float q2 = __uint_as_float(__hip_atomic_load(F.ctl + CW_NRM + 2 * h, RLX_AGENT)) + __uint_as_float(__hip_atomic_load(F.ctl + CW_NRM + 2 * h + 1, RLX_AGENT)), k2 = __uint_as_float(__hip_atomic_load(F.ctl + CW_NRM + 12 + 2 * h, RLX_AGENT)) + __uint_as_float(__hip_atomic_load(F.ctl + CW_NRM + 13 + 2 * h, RLX_AGENT));
            const float qkmax = 1.02f * sqrtf(q2 * k2);
            a.Q = PB + PC_FQ + h * 64; a.K = PB + PC_FK + h * 64; a.V = PB + PC_FV + h * 64; a.qp = NPROJ; a.kp = NPROJ; a.op = 384;
            a.q0 = qb * 256; a.NT = 0; a.kv0 = 0; a.aux = (const float*)(F.ws + WS_C2) + (size_t)h * S;
            a.tlo = 64 * sgm; a.thi = (a.tlo + 64 < ntf) ? a.tlo + 64 : ntf; a.band = (sgm == nseg - 1) ? 1 : 0;
            a.thr = 160.0f + 2.0f * qkmax;
            if (nseg == 1) { a.O = (abf*)(F.ws + WS_OFOX) + h * 64; a.lse = nullptr; a.lse_stride = 0; }
            else { a.O = (abf*)(F.ws + WS_OPART) + (size_t)sgm * S * 384 + h * 64; a.lse = (float*)(F.ws + WS_LSEF) + (size_t)sgm * S * 6 + h; a.lse_stride = 6; }
            attn_body::attn_unit<0, 8>(a, lds);
        } else if (idx < P2_NA + P2_NB + P2_NC) { const int du = idx - (P2_NA + P2_NB); const int g = du >> 7, hs = (du >> 6) & 1, w = du & 63; const int dl = g == 0 ? 1 : (g == 1 ? 4 : 16); const int r = w % dl, qb = w / dl, hd = g * 2 + hs;
            const int t0 = 4 * qb - 2 > 0 ? 4 * qb - 2 : 0; const long pitch = (long)dl * NPROJ;
            a.Q = PB + PC_DQ + hd * 64 + (long)r * NPROJ; a.K = PB + PC_DK + hd * 64 + (long)r * NPROJ + (long)t0 * 64 * pitch; a.V = PB + PC_DV + hd * 64 + (long)r * NPROJ + (long)t0 * 64 * pitch;
            a.O = (abf*)(F.ws + WS_ODIL) + hd * 64 + (long)r * 384; a.qp = pitch; a.kp = pitch; a.op = (long)dl * 384;
            a.q0 = qb * 256; a.NT = 4 * qb + 4 - t0; a.kv0 = t0 * 64; a.aux = (const float*)(F.ws + WS_TBL) + hd * attn_body::TBL_N; a.lse = (float*)(F.ws + WS_LSE) + r * 6 + hd; a.lse_stride = (long)dl * 6;
            attn_body::attn_unit<1, 8>(a, lds);
        } else { const int mu = idx - (P2_NA + P2_NB + P2_NC); const int h = mu >> 6, qb = mu & 63; abf* const MKV = (abf*)(F.ws + WS_MEMKV);
            a.Q = PB + PC_MQ + h * 64; a.K = MKV + h * 64; a.V = MKV + 256 + h * 64; a.O = (abf*)(F.ws + WS_OMEM) + h * 64; a.qp = NPROJ; a.kp = 512; a.op = 384;
            a.q0 = qb * 256; a.NT = 4; a.kv0 = 0; a.aux = nullptr; a.lse = nullptr; a.lse_stride = 0;
            attn_body::attn_unit<2, 8>(a, lds);
        }
    }
}
__device__ __forceinline__ void p3_fox_combine(Frame& F) {
    const float* LSEF = (const float*)(F.ws + WS_LSEF); const bf16* OP = (const bf16*)(F.ws + WS_OPART); bf16* const OF = (bf16*)(F.ws + WS_OFOX);
    for (int it = blockIdx.x * (NWAVES * 64) + F.tid; it < (S - 4096) * 48; it += F.G * NWAVES * 64) {
        const int tok = 4096 + it / 48, rem = it % 48, h = rem >> 3, ch = rem & 7, nseg = (tok >> 12) + 1;
        float l[4]; float mx = -INFINITY;
#pragma unroll
        for (int sg = 0; sg < 4; ++sg) { l[sg] = (sg < nseg) ? LSEF[((size_t)sg * S + tok) * 6 + h] : -INFINITY; mx = fmaxf(mx, l[sg]); }
        float acc[8] = {0.f, 0.f, 0.f, 0.f, 0.f, 0.f, 0.f, 0.f}; float den = 0.f;
#pragma unroll
        for (int sg = 0; sg < 4; ++sg) { const float w = __builtin_amdgcn_exp2f(l[sg] - mx);
            if (w > 0.f) { const v4u x = *(const v4u*)(OP + ((size_t)sg * S + tok) * 384 + h * 64 + ch * 8); den += w;
                acc[0] += w * __uint_as_float(x.x << 16); acc[1] += w * __uint_as_float(x.x & 0xffff0000u); acc[2] += w * __uint_as_float(x.y << 16); acc[3] += w * __uint_as_float(x.y & 0xffff0000u);
                acc[4] += w * __uint_as_float(x.z << 16); acc[5] += w * __uint_as_float(x.z & 0xffff0000u); acc[6] += w * __uint_as_float(x.w << 16); acc[7] += w * __uint_as_float(x.w & 0xffff0000u); } }
        const float inv = 1.0f / den; v4u o; o.x = pk2(acc[0] * inv, acc[1] * inv); o.y = pk2(acc[2] * inv, acc[3] * inv); o.z = pk2(acc[4] * inv, acc[5] * inv); o.w = pk2(acc[6] * inv, acc[7] * inv);
        *(v4u*)(OF + (size_t)tok * 384 + h * 64 + ch * 8) = o;
    }
}
__device__ __forceinline__ void p3_dil_weights(Frame& F) {
    const float* LSE = (const float*)(F.ws + WS_LSE); bf16* const OD = (bf16*)(F.ws + WS_ODIL);
    for (int it = blockIdx.x * (NWAVES * 64) + F.tid; it < S * 48; it += F.G * NWAVES * 64) {
        const int tok = it / 48, rem = it - tok * 48, hd = rem >> 3, ch = rem & 7, hs = hd & 1, g = hd >> 1;
        const float l0 = LSE[tok * 6 + hs], l1 = LSE[tok * 6 + 2 + hs], l2 = LSE[tok * 6 + 4 + hs];
        const float mx = fmaxf(l0, fmaxf(l1, l2)); const float e0 = __builtin_amdgcn_exp2f(l0 - mx), e1 = __builtin_amdgcn_exp2f(l1 - mx), e2 = __builtin_amdgcn_exp2f(l2 - mx);
        const float w = (g == 0 ? e0 : (g == 1 ? e1 : e2)) / (e0 + e1 + e2);
        v4u* p = (v4u*)(OD + (size_t)tok * 384 + hd * 64 + ch * 8); v4u x = *p;
        x.x = pk2(__uint_as_float(x.x << 16) * w, __uint_as_float(x.x & 0xffff0000u) * w); x.y = pk2(__uint_as_float(x.y << 16) * w, __uint_as_float(x.y & 0xffff0000u) * w);
        x.z = pk2(__uint_as_float(x.z << 16) * w, __uint_as_float(x.z & 0xffff0000u) * w); x.w = pk2(__uint_as_float(x.w << 16) * w, __uint_as_float(x.w & 0xffff0000u) * w);
        *p = x;
    }
}
typedef float f32x16m __attribute__((ext_vector_type(16)));
__device__ __forceinline__ void p6_ln_router(Frame& F, const Args& A) {
    LAS float* hl = (LAS float*)(F.lds + RING_OFF);
    LAS float* part = hl;
    LAS float* lgt = (LAS float*)(F.lds + RING_OFF + 32768);
    LAS int* se = (LAS int*)(F.lds + RING_OFF + 131328);
    const bf16* R1 = (const bf16*)(F.ws + WS_R1); bf16* const H1B = (bf16*)(F.ws + WS_H1B); unsigned char* const H1F8 = F.ws + WS_H1F8;
    int* const TOPI = (int*)(F.ws + WS_TOPI); float* const TOPG = (float*)(F.ws + WS_TOPG); int* const RANK = (int*)(F.ws + WS_RANK); int* const BLKCNT = (int*)(F.ws + WS_BLKCNT);
    const float* lg1 = A.in[10]; const float* lb1 = A.in[11]; const float* wr = A.in[12]; const float* br = A.in[13];
    float wreg[64];
    { const float* bp = wr + (size_t)(128 * F.wave + (F.lane >> 5)) * 32 + (F.lane & 31);
#pragma unroll
      for (int st = 0; st < 64; ++st) wreg[st] = bp[64 * st]; }
    for (int rb = blockIdx.x; rb < S / 64; rb += F.G) {
        for (int half = 0; half < 2; ++half) {
            f32x4 vr[4][4];
#pragma unroll
            for (int j = 0; j < 4; ++j)
#pragma unroll
                for (int q = 0; q < 4; ++q) { const v2u t = *((const v2u*)(R1 + ((size_t)rb * 64 + half * 32 + F.wave * 4 + j) * DM) + F.lane + 64 * q);
                    vr[j][q] = (f32x4){__builtin_bit_cast(float, t.x << 16), __builtin_bit_cast(float, t.x & 0xffff0000u), __builtin_bit_cast(float, t.y << 16), __builtin_bit_cast(float, t.y & 0xffff0000u)}; }
#pragma unroll
            for (int j = 0; j < 4; ++j) {
                const int lr = F.wave * 4 + j; const size_t row = (size_t)rb * 64 + half * 32 + lr;
                f32x4 v[4]; float s = 0.f;
#pragma unroll
                for (int q = 0; q < 4; ++q) { v[q] = vr[j][q]; s += (v[q].x + v[q].y) + (v[q].z + v[q].w); }
                const float mean = wave_sum(s) * (1.f / DM); float s2 = 0.f;
#pragma unroll
                for (int q = 0; q < 4; ++q) { v[q] = v[q] - mean; s2 += (v[q].x * v[q].x + v[q].y * v[q].y) + (v[q].z * v[q].z + v[q].w * v[q].w); }
                const float rstd = 1.f / sqrtf(wave_sum(s2) * (1.f / DM) + LN_EPS);
#pragma unroll
                for (int q = 0; q < 4; ++q) { const f32x4 gv = *((const f32x4*)lg1 + F.lane + 64 * q), bv = *((const f32x4*)lb1 + F.lane + 64 * q); const f32x4 h = v[q] * rstd * gv + bv;
                    *((v2u*)(H1B + row * DM) + F.lane + 64 * q) = (v2u){pk2(h.x, h.y), pk2(h.z, h.w)};
                    *((unsigned*)(H1F8 + row * DM) + F.lane + 64 * q) = pk4_fp8(h.x, h.y, h.z, h.w);
                    LAS float* d = hl + lr * 1025 + 4 * F.lane + 256 * q; d[0] = h.x; d[1] = h.y; d[2] = h.z; d[3] = h.w; }
            }
            __syncthreads();
            f32x16m acc = {0.f, 0.f, 0.f, 0.f, 0.f, 0.f, 0.f, 0.f, 0.f, 0.f, 0.f, 0.f, 0.f, 0.f, 0.f, 0.f};
            { const int kk = F.lane >> 5; const LAS float* ap = hl + (F.lane & 31) * 1025 + 128 * F.wave + kk;
#pragma unroll
              for (int st = 0; st < 64; ++st) acc = __builtin_amdgcn_mfma_f32_32x32x2f32(ap[2 * st], wreg[st], acc, 0, 0, 0); }
            __syncthreads();
            { const int kk = F.lane >> 5;
#pragma unroll
              for (int r = 0; r < 16; ++r) part[(F.wave * 32 + ((r & 3) + 8 * (r >> 2) + 4 * kk)) * 32 + (F.lane & 31)] = acc[r]; }
            __syncthreads();
#pragma unroll
            for (int q = 0; q < 2; ++q) { const int p = F.tid + 512 * q, i = p >> 5, jx = p & 31; float sm = 0.f;
#pragma unroll
                for (int w = 0; w < 8; ++w) sm += part[(w * 32 + i) * 32 + jx];
                lgt[i * 33 + jx] = sm + br[jx]; }
            __syncthreads();
            if (F.tid < 32) { const int i = F.tid; const size_t row = (size_t)rb * 64 + half * 32 + i; float bv[4]; int bi[4];
                unsigned taken = 0u;
#pragma unroll
                for (int kx = 0; kx < 4; ++kx) { float best = -INFINITY; int be = 0;
                    for (int e = 0; e < 32; ++e) { const float x = lgt[i * 33 + e]; const bool take = (((taken >> e) & 1u) == 0u) && (x > best); best = take ? x : best; be = take ? e : be; }
                    bv[kx] = best; bi[kx] = be; taken |= 1u << be; }
                const float e1 = expf(bv[1] - bv[0]), e2 = expf(bv[2] - bv[0]), e3 = expf(bv[3] - bv[0]); const float inv = 1.f / (1.f + e1 + e2 + e3);
                *(int4*)(TOPI + row * 4) = make_int4(bi[0], bi[1], bi[2], bi[3]); *(f32x4*)(TOPG + row * 4) = (f32x4){inv, e1 * inv, e2 * inv, e3 * inv};
                const int lrow = half * 32 + i; se[lrow * 4 + 0] = bi[0]; se[lrow * 4 + 1] = bi[1]; se[lrow * 4 + 2] = bi[2]; se[lrow * 4 + 3] = bi[3]; }
            __syncthreads();
        }
        if (F.tid < 256) { const int e = se[F.tid]; int rk = 0; for (int q = 0; q < F.tid; ++q) rk += (se[q] == e) ? 1 : 0; RANK[rb * 256 + F.tid] = rk; }
        else if (F.tid < 288) { const int e = F.tid - 256; int c = 0; for (int q = 0; q < 256; ++q) c += (se[q] == e) ? 1 : 0; BLKCNT[rb * 32 + e] = c; }
        __syncthreads();
    }
}
__device__ __forceinline__ void p7_scatter(Frame& F) {
    LAS int* ptot = (LAS int*)(F.lds + RING_OFF); LAS int* ppre = ptot + 512; LAS int* epre = ppre + 512; LAS int* tst = epre + 32; LAS int* dsts = tst + 64;
    const int* BLKCNT = (const int*)(F.ws + WS_BLKCNT); const int* TOPI = (const int*)(F.ws + WS_TOPI); const int* RANK = (const int*)(F.ws + WS_RANK);
    int* const DEST = (int*)(F.ws + WS_DEST); int* const TST = (int*)(F.ws + WS_TST); int* const TOKROW = (int*)(F.ws + WS_TOKROW);
    { int* const IDM = (int*)(F.ws + WS_IDMAP); for (int i = blockIdx.x * (NWAVES * 64) + F.tid; i < MAXROWS; i += F.G * NWAVES * 64) IDM[i] = i; }
    for (int rb = blockIdx.x; rb < S / 64; rb += F.G) {
        { const int part = F.tid >> 5, e = F.tid & 31; int tot = 0, pre = 0;
          for (int b = part * 16; b < part * 16 + 16; ++b) { const int c = BLKCNT[b * 32 + e]; tot += c; pre += (b < rb) ? c : 0; }
          ptot[part * 32 + e] = tot; ppre[part * 32 + e] = pre; }
        __syncthreads();
        if (F.tid < 32) { int T = 0, P = 0; for (int p = 0; p < 16; ++p) { T += ptot[p * 32 + F.tid]; P += ppre[p * 32 + F.tid]; } ptot[F.tid] = T; epre[F.tid] = P; }
        __syncthreads();
        if (F.tid == 0) { int t = 0; for (int e = 0; e < 32; ++e) { tst[e] = t; t += (ptot[e] + 255) >> 8; } tst[32] = t;
            if (rb == 0) { for (int e = 0; e <= 32; ++e) TST[e] = tst[e]; } }
        __syncthreads();
        if (F.tid < 256) { const size_t a = (size_t)rb * 256 + F.tid; const int e = TOPI[a]; const int d = tst[e] * 256 + epre[e] + RANK[a]; DEST[a] = d; TOKROW[d] = (int)(a >> 2); }
        if (rb == 0) { for (int e = 0; e < 32; ++e) { const int c = ptot[e], base = tst[e] * 256, padn = (tst[e + 1] - tst[e]) * 256 - c; for (int p = F.tid; p < padn; p += NWAVES * 64) TOKROW[base + c + p] = 0; } }
        __syncthreads();
    }
}
__device__ __forceinline__ void p10_combine(Frame& F, const Args& A) {
    const int gw = F.vcu * NWAVES + F.wave, NGW = F.G * NWAVES;
    const bf16* H1B = (const bf16*)(F.ws + WS_H1B); const bf16* Y = (const bf16*)(F.ws + WS_Y); const int* DEST = (const int*)(F.ws + WS_DEST); const float* TOPG = (const float*)(F.ws + WS_TOPG);
    const float* g2 = A.in[18]; const float* b2 = A.in[19];
    int4 ddn; f32x4 ggn; v2u hbn[4]; unsigned yn[4][4];
#define P10_LOAD_IDX(m_) do { ddn = *(const int4*)(DEST + (size_t)(m_) * 4); ggn = *(const f32x4*)(TOPG + (size_t)(m_) * 4); } while (0)
#define P10_LOAD_ROWS(m_) do { _Pragma("unroll") for (int j = 0; j < 4; ++j) hbn[j] = *((const v2u*)(H1B + (size_t)(m_) * DM) + F.lane + 64 * j); \
        _Pragma("unroll") for (int k = 0; k < 4; ++k) { const int d_ = k == 0 ? ddn.x : (k == 1 ? ddn.y : (k == 2 ? ddn.z : ddn.w)); \
            _Pragma("unroll") for (int j = 0; j < 4; ++j) yn[k][j] = *((const unsigned*)((const unsigned char*)Y + (size_t)d_ * DM) + F.lane + 64 * j); } } while (0)
    int m = gw; if (m >= S) return;
    P10_LOAD_IDX(m); P10_LOAD_ROWS(m);
    for (; m < S; m += NGW) {
        const f32x4 gg = ggn; f32x4 v[4]; float s = 0.f;
#pragma unroll
        for (int j = 0; j < 4; ++j) v[j] = (f32x4){__uint_as_float(hbn[j].x << 16), __uint_as_float(hbn[j].x & 0xffff0000u), __uint_as_float(hbn[j].y << 16), __uint_as_float(hbn[j].y & 0xffff0000u)} * ALPHA;
#pragma unroll
        for (int k = 0; k < 4; ++k) { const float g = k == 0 ? gg.x : (k == 1 ? gg.y : (k == 2 ? gg.z : gg.w));
#pragma unroll
            for (int j = 0; j < 4; ++j) { const unsigned y = yn[k][j]; typedef float f2_ __attribute__((ext_vector_type(2)));
                const f2_ lo = __builtin_amdgcn_cvt_pk_f32_fp8((int)y, false), hi = __builtin_amdgcn_cvt_pk_f32_fp8((int)y, true);
                v[j].x += g * lo.x; v[j].y += g * lo.y; v[j].z += g * hi.x; v[j].w += g * hi.y; } }
        const int mn = m + NGW;
        if (mn < S) { P10_LOAD_IDX(mn); P10_LOAD_ROWS(mn); }
#pragma unroll
        for (int j = 0; j < 4; ++j) s += (v[j].x + v[j].y) + (v[j].z + v[j].w);
        const float mean = wave_sum(s) * (1.f / DM); float s2 = 0.f;
#pragma unroll
        for (int j = 0; j < 4; ++j) { v[j] = v[j] - mean; s2 += (v[j].x * v[j].x + v[j].y * v[j].y) + (v[j].z * v[j].z + v[j].w * v[j].w); }
        const float rstd = 1.f / sqrtf(wave_sum(s2) * (1.f / DM) + LN_EPS);
#pragma unroll
        for (int j = 0; j < 4; ++j) { const f32x4 gv = *((const f32x4*)g2 + F.lane + 64 * j), bv = *((const f32x4*)b2 + F.lane + 64 * j);
            *((f32x4*)(F.out + (size_t)m * DM) + F.lane + 64 * j) = v[j] * rstd * gv + bv; }
    }
#undef P10_LOAD_IDX
#undef P10_LOAD_ROWS
}

__global__ void __launch_bounds__(NWAVES * 64, 2) mk_fwd(Args args) {
    extern __shared__ __attribute__((aligned(16))) unsigned char lds[];
    Frame F;
    F.lds = (LAS unsigned char*)lds;
    F.MISC = (volatile LAS unsigned*)(F.lds + MISC_OFF);
    F.tid = threadIdx.x; F.lane = F.tid & 63; F.wave = __builtin_amdgcn_readfirstlane(F.tid >> 6);
    F.G = gridDim.x; { const int bx = blockIdx.x; F.vcu = (F.G % 8 == 0) ? (bx % 8) * (F.G / 8) + bx / 8 : bx; }
    F.ws = args.ws; F.out = args.out; F.ctl = (gu32*)(args.ws + WS_CTL);
    unsigned char* const ws = args.ws;
    for (int u = F.tid; u < (LDS_BYTES - LDSCTL_OFF) / 4; u += NWAVES * 64) ((LAS unsigned*)(F.lds + LDSCTL_OFF))[u] = 0u;
    __syncthreads();
    XcdBarrier bar = xcd_barrier_post((unsigned*)(F.ctl + CW_BAR) + args.li * XCD_BAR_WORDS, F.MISC + 8);
#define GRID_BAR() xcd_barrier(bar)
    const int lo = args.ph_lo, hi = args.ph_hi;
#ifndef PHASE_MASK
#define PHASE_MASK 0x7ff
#endif
#define IN(k) (((PHASE_MASK >> (k)) & 1) && lo <= (k) && (k) < hi)
#define BOTH(k) (IN(k) && IN((k) + 1))
    typedef pg8::bf16_t pbf;
    pbf* const PBUF = (pbf*)(ws + WS_PBUF);

    if (IN(0)) { p0_prologue(F, args); if (BOTH(0)) GRID_BAR(); }

    if (IN(1)) {
        { pg8::Gemm g{(const pbf*)(ws + WS_XF8), (const pbf*)(ws + WS_WGF8), S, NPROJ, DM / 2, nullptr, 0x7C7C7C7C, 0x7C7C7C7C}; pg8::StaticOrder So; So.init(S, NPROJ, F.G, (int)blockIdx.x);
          pg8::EpiProj E{PBUF, NPROJ, PC_GT / 256, (unsigned*)(F.ctl + CW_NRM)};
          pg8::gemm_phase<pg8::EpiProj, pg8::StaticOrder, true, true, true, true>(F.lds + RING_OFF, g, So, E); }
        { pg8::Gemm g{(const pbf*)(ws + WS_MEMB), (const pbf*)(ws + WS_WMKV), MEML, 512, DM, nullptr, 0, 0}; pg8::StaticOrder So; So.init(MEML, 512, F.G, (int)((blockIdx.x + F.G / 2) % F.G));
          pg8::EpiBf16Plain E{(pbf*)(ws + WS_MEMKV), 512};
          pg8::gemm_phase<pg8::EpiBf16Plain, pg8::StaticOrder, true, true>(F.lds + RING_OFF, g, So, E); }
        if ((int)blockIdx.x >= F.G - 6) p1_cumsum(F, F.G - 1 - (int)blockIdx.x);
        if (BOTH(1)) GRID_BAR();
    }

    if (IN(2)) { p2_attention(F, args, (char*)lds + RING_OFF, args.li); if (BOTH(2)) GRID_BAR(); }

    if (IN(3)) { p3_fox_combine(F); p3_dil_weights(F); if (BOTH(3)) GRID_BAR(); }

    if (IN(4)) {
        pg8::Gemm g{(const pbf*)(ws + WS_OFOX), (const pbf*)(ws + WS_WBF), S, DM, 384, nullptr, 0, 0, (size_t)S * 384 * 2, (size_t)DM * 384 * 2};
        pg8::MergeOrder So; So.so.init(S, DM, F.G, (int)blockIdx.x);
        pg8::EpiMergeChain E{PBUF + PC_GT, NPROJ, (pbf*)(ws + WS_MERGED), DM};
        pg8::gemm_phase<pg8::EpiMergeChain, pg8::MergeOrder, true, true>(F.lds + RING_OFF, g, So, E);
        if (BOTH(4)) GRID_BAR();
    }

    if (IN(5)) {
        pg8::Gemm g{(const pbf*)(ws + WS_MERGED), (const pbf*)(ws + WS_WOUT), S, DM, DM, nullptr, 0, 0}; pg8::StaticOrder So; So.init(S, DM, F.G, (int)blockIdx.x);
        pg8::EpiRes E{args.in[0], (pbf*)(ws + WS_R1), DM, ALPHA};
        pg8::gemm_phase<pg8::EpiRes, pg8::StaticOrder, true, true>(F.lds + RING_OFF, g, So, E);
        if (BOTH(5)) GRID_BAR();
    }

    if (IN(6)) { p6_ln_router(F, args); if (BOTH(6)) GRID_BAR(); }

    if (IN(7)) { p7_scatter(F); if (BOTH(7)) GRID_BAR(); }

    if (IN(8)) {
        LAS int* tbl = (LAS int*)(F.lds + TBL_OFF);
        if (F.tid < 33) tbl[F.tid] = ((const int*)(ws + WS_TST))[F.tid];
        __syncthreads();
        pg8::Gemm g{(const pbf*)(ws + WS_H1F8), (const pbf*)(ws + WS_W1), MAXROWS, 2048, DM / 2, (const int*)(ws + WS_TOKROW), 0x7F7F7F7F, 0x7F7F7F7F}; pg8::MoeOrder So{tbl, 8, F.G, F.vcu};
        pg8::EpiSwiglu E{(pbf*)(ws + WS_ACT), args.in[15], 1.0f / (float)(1 << W1_SHIFT), (const LAS float*)(F.lds + RING_OFF + pg8::STAGE_BYTES + 5120)};
        pg8::gemm_phase<pg8::EpiSwiglu, pg8::MoeOrder, true, true, true, true>(F.lds + RING_OFF, g, So, E);
        if (BOTH(8)) GRID_BAR();
    }

    if (IN(9)) {
        LAS int* tbl = (LAS int*)(F.lds + TBL_OFF);
        if (F.tid < 33) tbl[F.tid] = ((const int*)(ws + WS_TST))[F.tid];
        __syncthreads();
        pg8::Gemm g{(const pbf*)(ws + WS_ACT), (const pbf*)(ws + WS_W2), MAXROWS, 1024, DM / 2, nullptr, 0x7F7F7F7F, 0x7F7F7F7F}; pg8::MoeOrder So{tbl, 4, F.G, F.vcu};
        pg8::EpiY E{(pbf*)(ws + WS_Y), args.in[17], 1.0f / (float)(1 << W1_SHIFT), (const LAS float*)(F.lds + RING_OFF + pg8::STAGE_BYTES + 5120)};
        pg8::gemm_phase<pg8::EpiY, pg8::MoeOrder, true, true, true, true>(F.lds + RING_OFF, g, So, E);
        if (BOTH(9)) GRID_BAR();
    }

    if (IN(10)) { p10_combine(F, args); }
#undef IN
#undef BOTH
#undef GRID_BAR
}

extern "C" void kernel_launch(void* const* d_in, const int* in_sizes, int n_in, void* d_out, int out_size, void* d_ws, size_t ws_size, hipStream_t stream) {
    static int grid = 0;
    if (grid == 0) {
        if (n_in != 20 || in_sizes[0] != S * DM || out_size != S * DM || ws_size < WS_END) { fprintf(stderr, "kernel_launch: built for 20 inputs, x/out of %d floats, >= %zu bytes of workspace; got n_in %d, in0 %d, out %d, ws %zu; nothing launched\n", S * DM, (size_t)WS_END, n_in, n_in > 0 ? in_sizes[0] : -1, out_size, ws_size); grid = -1; return; }
        int dev = 0, cus = 0, per_cu = 0;
        if (hipGetDevice(&dev) != hipSuccess || hipDeviceGetAttribute(&cus, hipDeviceAttributeMultiprocessorCount, dev) != hipSuccess) { fprintf(stderr, "kernel_launch: hipGetDevice / hipDeviceGetAttribute failed; nothing launched\n"); grid = -1; return; }
        if (hipFuncSetAttribute((const void*)mk_fwd, hipFuncAttributeMaxDynamicSharedMemorySize, LDS_BYTES) != hipSuccess) { fprintf(stderr, "kernel_launch: hipFuncSetAttribute failed (%d bytes of dynamic LDS); nothing launched\n", LDS_BYTES); grid = -1; return; }
        if (hipOccupancyMaxActiveBlocksPerMultiprocessor(&per_cu, (const void*)mk_fwd, NWAVES * 64, LDS_BYTES) != hipSuccess || per_cu < 1)
            fprintf(stderr, "kernel_launch: note: the occupancy query reports %d workgroups per CU\n", per_cu);
        (void)hipGetLastError();
        grid = cus;
    }
    if (grid < 0) return;
    if (hipMemsetAsync((char*)d_ws + WS_CTL, 0, CTL_ZERO_BYTES, stream) != hipSuccess) { fprintf(stderr, "kernel_launch: hipMemsetAsync of the control words failed; nothing launched\n"); return; }
    Args a{};
    for (int i = 0; i < 20; ++i) a.in[i] = (const float*)d_in[i];
    a.out = (float*)d_out; a.ws = (unsigned char*)d_ws;
#ifdef PROBE_PHASE
    const int nl = (PROBE_PHASE + 1 < NPHASE) ? 3 : 2; const int cut_lo[3] = {0, PROBE_PHASE, PROBE_PHASE + 1}, cut_hi[3] = {PROBE_PHASE + 1, PROBE_PHASE + 1, NPHASE};
#else
    const int nl = N_LAUNCHES; int cut_lo[NPHASE], cut_hi[NPHASE]; for (int i = 0; i < NPHASE; ++i) { cut_lo[i] = (N_LAUNCHES == 1) ? 0 : i; cut_hi[i] = (N_LAUNCHES == 1) ? NPHASE : i + 1; }
#endif
    for (int li = 0; li < nl; ++li) {
        a.ph_lo = cut_lo[li]; a.ph_hi = cut_hi[li]; a.li = li;
        hipLaunchKernelGGL(mk_fwd, dim3(grid), dim3(NWAVES * 64), LDS_BYTES, stream, a);
        const hipError_t le = hipPeekAtLastError();
        if (le != hipSuccess) { fprintf(stderr, "kernel_launch: launch %d failed: %s\n", li, hipGetErrorName(le)); break; }
    }
}
```

```cpp
#include <hip/hip_runtime.h>
#include <hip/hip_bf16.h>
#include <cstdio>
#include <cstdint>
#include <cmath>
namespace pg8 {
#define PG8_LAS __attribute__((address_space(3)))
typedef unsigned short bf16_t;
typedef short bf16x8 __attribute__((ext_vector_type(8)));
typedef float f32x4 __attribute__((ext_vector_type(4)));
typedef unsigned u32x4 __attribute__((ext_vector_type(4)));
constexpr int BM = 256, BK = 64, HALF = 128, HTB = HALF * BK * 2  , STAGE_BYTES = 8 * HTB, NXCD = 8, WGM = 8;

__host__ __device__ __forceinline__ int lds_byte(int r, int c) { const int st = (r >> 4) * 2 + (c >> 5), rr = r & 15, cc = c & 31, ob = rr * 64 + cc * 2; return st * 1024 + (ob ^ (((ob >> 9) & 1) << 5)); }
__host__ __device__ __forceinline__ void stage_rc(int b, int& R, int& C) { const int st = b / 1024, sb = b % 1024, swz = sb ^ (((sb >> 9) & 1) << 5); R = (st >> 1) * 16 + swz / 64; C = (st & 1) * 32 + (swz % 64) / 2; }
__host__ __device__ __forceinline__ int perm32(int rho) { const int n = rho >> 4, i = rho & 15; return 8 * (i >> 2) + 4 * n + (i & 3); }

struct Unit { int pm, pn, e, slot, b; };
typedef int v8i_t_half __attribute__((ext_vector_type(4)));
typedef int v8i_t __attribute__((ext_vector_type(8)));
typedef short s16x16_t __attribute__((ext_vector_type(16)));
struct Gemm { const bf16_t* A; const bf16_t* Bt; int M, N, K; const int* rowmap; int scale_a, scale_b; size_t strideA = 0, strideB = 0; };

struct StaticOrder {
    int nM, nN, nwg, G, c; int lightA = -1, lightB = -1, RL = 0;
    __host__ __device__ void init(int M, int N, int G_, int c_) { nM = M / BM; nN = N / BM; nwg = nM * nN; G = G_; c = c_; }
    __host__ __device__ bool next(int i, Unit& u) const {
        long L = (long)i * G + c;
        if (lightA >= 0 && i >= RL) { if (c == lightA || c == lightB) return false; L = (long)RL * G + (long)(i - RL) * (G - 2) + (c - (c > lightA ? 1 : 0) - (c > lightB ? 1 : 0)); }
        if (L >= nwg) return false;
        int wgid = (int)L; { const int q = nwg / NXCD, r = nwg % NXCD, xcd = wgid % NXCD, off = wgid / NXCD; wgid = (xcd < r ? xcd * (q + 1) : r * (q + 1) + (xcd - r) * q) + off; }
        const int nig = WGM * nN, gid = wgid / nig, fm = gid * WGM, gsz = (nM - fm) < WGM ? (nM - fm) : WGM;
        u.pm = fm + ((wgid % nig) % gsz); u.pn = (wgid % nig) / gsz; u.e = 0; u.b = 0; return true;
    }
    __device__ __forceinline__ void a_ready(const Unit&) const {}
    __device__ __forceinline__ void done(const Unit&) const {}
};

__device__ __forceinline__ unsigned cvt_pk_bf16(float lo, float hi) { unsigned r; asm volatile("v_cvt_pk_bf16_f32 %0, %1, %2" : "=v"(r) : "v"(lo), "v"(hi)); return r; }
__device__ __forceinline__ float bf_lo(unsigned w) { return __uint_as_float(w << 16); }
__device__ __forceinline__ float bf_hi(unsigned w) { return __uint_as_float(w & 0xffff0000u); }
__device__ __forceinline__ float sigmoid_f(float v) { return __builtin_amdgcn_rcpf(1.0f + __builtin_amdgcn_exp2f(-1.4426950408889634f * v)); }
typedef unsigned u32x2 __attribute__((ext_vector_type(2)));
__device__ __forceinline__ unsigned ror8(unsigned v) { return (unsigned)__builtin_amdgcn_update_dpp(0, (int)v, 0x128, 0xf, 0xf, false); }
__device__ __forceinline__ u32x4 sel4(bool c, const u32x4& a, const u32x4& b) { u32x4 r; r.x = c ? a.x : b.x; r.y = c ? a.y : b.y; r.z = c ? a.z : b.z; r.w = c ? a.w : b.w; return r; }
__device__ __forceinline__ u32x4 ror8x4(const u32x4& a) { u32x4 r; r.x = ror8(a.x); r.y = ror8(a.y); r.z = ror8(a.z); r.w = ror8(a.w); return r; }
__device__ __forceinline__ void fl_store(unsigned char* lanep, size_t pitch8, const u32x4& p0, const u32x4& p1, bool lo) {
    const u32x4 y = ror8x4(sel4(lo, p1, p0)); *(u32x4*)lanep = sel4(lo, p0, y); *(u32x4*)(lanep + pitch8) = sel4(lo, y, p1); }
__device__ __forceinline__ void fl_load(const unsigned char* lanep, size_t pitch8, u32x4& p0, u32x4& p1, bool lo) {
    const u32x4 a = *(const u32x4*)lanep, b = *(const u32x4*)(lanep + pitch8); const u32x4 y = ror8x4(sel4(lo, b, a)); p0 = sel4(lo, a, y); p1 = sel4(lo, y, b); }

struct EpiBf16Plain {
    static constexpr bool PERM = true, AFTER_DRAIN = false; static constexpr bool CHAIN = false; static constexpr bool LDS_BIAS = false;
    bf16_t* O; int ldc;
    __device__ __forceinline__ void operator()(const f32x4 (&acc)[2][2][4][2], const Unit& u, int wr, int wc, int fr, int fq) const {
        const int row0 = u.pm * BM + wr * 64 + fr, col0 = u.pn * BM + wc * 32 + 8 * fq;
#pragma unroll
        for (int ai = 0; ai < 2; ++ai)
#pragma unroll
            for (int m = 0; m < 4; ++m) { bf16_t* rowp = O + (size_t)(row0 + ai * HALF + m * 16) * ldc + col0;
#pragma unroll
                for (int bj = 0; bj < 2; ++bj) { const f32x4 v0 = acc[ai][bj][m][0], v1 = acc[ai][bj][m][1];
                    u32x4 w; w.x = cvt_pk_bf16(v0[0], v0[1]); w.y = cvt_pk_bf16(v0[2], v0[3]); w.z = cvt_pk_bf16(v1[0], v1[1]); w.w = cvt_pk_bf16(v1[2], v1[3]);
                    *(u32x4*)(rowp + bj * HALF) = w; } }
    }
};
struct EpiProj {
    static constexpr bool PERM = true, PERM16 = true, AFTER_DRAIN = false; static constexpr bool CHAIN = false; static constexpr bool LDS_BIAS = false;
    bf16_t* O; int ldc; int sig_from; unsigned* nrm;
    __device__ __forceinline__ void operator()(const f32x4 (&acc)[2][2][4][2], const Unit& u, int wr, int wc, int fr, int fq) const {
        const bool sg = u.pn >= sig_from, lo = fr < 8;
        if (u.pn < 3) {
            float mx = 0.f;
#pragma unroll
            for (int ai = 0; ai < 2; ++ai)
#pragma unroll
                for (int m = 0; m < 4; ++m) { float ss = 0.f;
#pragma unroll
                    for (int bj = 0; bj < 2; ++bj) { const f32x4 a0 = acc[ai][bj][m][0], a1 = acc[ai][bj][m][1];
                        ss += (a0[0] * a0[0] + a0[1] * a0[1]) + (a0[2] * a0[2] + a0[3] * a0[3]) + (a1[0] * a1[0] + a1[1] * a1[1]) + (a1[2] * a1[2] + a1[3] * a1[3]); }
                    ss += __shfl_xor(ss, 16); ss += __shfl_xor(ss, 32); mx = fmaxf(mx, ss); }
            mx = fmaxf(mx, __shfl_xor(mx, 1)); mx = fmaxf(mx, __shfl_xor(mx, 2)); mx = fmaxf(mx, __shfl_xor(mx, 4)); mx = fmaxf(mx, __shfl_xor(mx, 8));
            if (fr == 0 && fq == 0) atomicMax(nrm + 2 * (u.pn * 4 + wc), __float_as_uint(mx));
        }
        unsigned char* const lanep = (unsigned char*)(O + (size_t)(u.pm * BM + wr * 64 + (fr & 7)) * ldc + u.pn * BM + wc * 64) + (2 * fq + (fr >> 3)) * 16; const size_t pitch = (size_t)ldc * 2;
#pragma unroll
        for (int ai = 0; ai < 2; ++ai)
#pragma unroll
            for (int m = 0; m < 4; ++m) { u32x4 p[2];
#pragma unroll
                for (int bj = 0; bj < 2; ++bj) { f32x4 v0 = acc[ai][bj][m][0], v1 = acc[ai][bj][m][1];
                    if (sg) {
#pragma unroll
                        for (int j = 0; j < 4; ++j) { v0[j] = sigmoid_f(v0[j]); v1[j] = sigmoid_f(v1[j]); } }
                    p[bj].x = cvt_pk_bf16(v0[0], v0[1]); p[bj].y = cvt_pk_bf16(v0[2], v0[3]); p[bj].z = cvt_pk_bf16(v1[0], v1[1]); p[bj].w = cvt_pk_bf16(v1[2], v1[3]); }
                fl_store(lanep + (size_t)(ai * HALF + m * 16) * pitch, 8 * pitch, p[0], p[1], lo); }
    }
};
struct EpiGate {
    static constexpr bool PERM = true, AFTER_DRAIN = false; static constexpr bool CHAIN = false; static constexpr bool LDS_BIAS = false;
    bf16_t* O; int ldc; int col_off; float ascale;
    __device__ __forceinline__ void operator()(const f32x4 (&acc)[2][2][4][2], const Unit& u, int wr, int wc, int fr, int fq) const {
        const int row0 = u.pm * BM + wr * 64 + fr, col0 = col_off + u.pn * BM + wc * 32 + 8 * fq;
#pragma unroll
        for (int ai = 0; ai < 2; ++ai)
#pragma unroll
            for (int m = 0; m < 4; ++m) { bf16_t* rowp = O + (size_t)(row0 + ai * HALF + m * 16) * ldc + col0;
#pragma unroll
                for (int bj = 0; bj < 2; ++bj) { f32x4 v0 = acc[ai][bj][m][0] * ascale, v1 = acc[ai][bj][m][1] * ascale;
#pragma unroll
                    for (int j = 0; j < 4; ++j) { v0[j] = sigmoid_f(v0[j]); v1[j] = sigmoid_f(v1[j]); }
                    u32x4 w; w.x = cvt_pk_bf16(v0[0], v0[1]); w.y = cvt_pk_bf16(v0[2], v0[3]); w.z = cvt_pk_bf16(v1[0], v1[1]); w.w = cvt_pk_bf16(v1[2], v1[3]);
                    *(u32x4*)(rowp + bj * HALF) = w; } }
    }
};
template <int PASS> struct EpiMerge {
    static constexpr bool PERM = false, AFTER_DRAIN = false; static constexpr bool CHAIN = false; static constexpr bool LDS_BIAS = false;
    const bf16_t* gate; int ldg; bf16_t* stash; bf16_t* outb; int ldc;
    __device__ __forceinline__ void operator()(const f32x4 (&acc)[2][2][4][2], const Unit& u, int wr, int wc, int fr, int fq) const {
        const int row0 = u.pm * BM + wr * 64 + fr, col0 = u.pn * BM + wc * 32 + 4 * fq;
#pragma unroll
        for (int ai = 0; ai < 2; ++ai)
#pragma unroll
            for (int m = 0; m < 4; ++m) { const size_t r = (size_t)(row0 + ai * HALF + m * 16);
#pragma unroll
                for (int bj = 0; bj < 2; ++bj)
#pragma unroll
                    for (int n = 0; n < 2; ++n) { const int c = col0 + bj * HALF + n * 16;
                        const u32x2 gv = *(const u32x2*)(gate + r * ldg + c);
                        f32x4 v = acc[ai][bj][m][n]; v[0] *= bf_lo(gv.x); v[1] *= bf_hi(gv.x); v[2] *= bf_lo(gv.y); v[3] *= bf_hi(gv.y);
                        if (PASS > 0) { const u32x2 sv = *(const u32x2*)(stash + r * ldc + c); v[0] += bf_lo(sv.x); v[1] += bf_hi(sv.x); v[2] += bf_lo(sv.y); v[3] += bf_hi(sv.y); }
                        u32x2 w; w.x = cvt_pk_bf16(v[0], v[1]); w.y = cvt_pk_bf16(v[2], v[3]);
                        if (PASS < 2) *(u32x2*)(stash + r * ldc + c) = w; else *(u32x2*)(outb + r * ldc + c) = w; }
                asm volatile("" ::: "memory"); }
    }
};
struct EpiRes {
    static constexpr bool PERM = true, AFTER_DRAIN = false; static constexpr bool CHAIN = false; static constexpr bool LDS_BIAS = false;
    const float* x; bf16_t* out; int ldc; float alpha;
    __device__ __forceinline__ void operator()(const f32x4 (&acc)[2][2][4][2], const Unit& u, int wr, int wc, int fr, int fq) const {
        const int row0 = u.pm * BM + wr * 64 + fr, col0 = u.pn * BM + wc * 32 + 8 * fq; const bool lo = fr < 8; const size_t xp = (size_t)ldc * 4;
        const unsigned char* const xl = (const unsigned char*)(x + (size_t)(u.pm * BM + wr * 64 + (fr & 7)) * ldc + u.pn * BM + wc * 32) + (2 * fq + (fr >> 3)) * 16;
#pragma unroll
        for (int ai = 0; ai < 2; ++ai)
#pragma unroll
            for (int m = 0; m < 4; ++m) { const size_t off = (size_t)(row0 + ai * HALF + m * 16) * ldc + col0;
#pragma unroll
                for (int bj = 0; bj < 2; ++bj) { u32x4 q0, q1; fl_load(xl + (size_t)(ai * HALF + m * 16) * xp + bj * HALF * 4, 8 * xp, q0, q1, lo);
                    const f32x4 x0 = __builtin_bit_cast(f32x4, q0), x1 = __builtin_bit_cast(f32x4, q1);
                    const f32x4 v0 = x0 * alpha + acc[ai][bj][m][0], v1 = x1 * alpha + acc[ai][bj][m][1];
                    u32x4 w; w.x = cvt_pk_bf16(v0[0], v0[1]); w.y = cvt_pk_bf16(v0[2], v0[3]); w.z = cvt_pk_bf16(v1[0], v1[1]); w.w = cvt_pk_bf16(v1[2], v1[3]);
                    *(u32x4*)(out + off + bj * HALF) = w; } }
    }
};
struct EpiMergeChain {
    static constexpr bool PERM = true, PERM16 = true, AFTER_DRAIN = false; static constexpr bool LDS_BIAS = false; static constexpr bool CHAIN = true;
    const bf16_t* gate; int ldg; bf16_t* outb; int ldc;
    __device__ __forceinline__ void operator()(f32x4 (&acc)[2][2][4][2], const Unit& u, int wr, int wc, int fr, int fq) const {
        const int b = u.b; const bool lo = fr < 8; const size_t gp = (size_t)ldg * 2, op = (size_t)ldc * 2;
        const size_t lrow = (size_t)(u.pm * BM + wr * 64 + (fr & 7)); const int lcol = u.pn * BM + wc * 64, lpc = (2 * fq + (fr >> 3)) * 16;
        const unsigned char* const gl = (const unsigned char*)(gate + lrow * ldg + b * 1024 + lcol) + lpc; unsigned char* const ol = (unsigned char*)(outb + lrow * ldc + lcol) + lpc;
#pragma unroll
        for (int ai = 0; ai < 2; ++ai)
#pragma unroll
            for (int m = 0; m < 4; ++m) { const size_t ro = (size_t)(ai * HALF + m * 16);
                u32x4 gq[2], gn[2] = {{0u, 0u, 0u, 0u}, {0u, 0u, 0u, 0u}}; fl_load(gl + ro * gp, 8 * gp, gq[0], gq[1], lo);
                if (b < 2) fl_load(gl + ro * gp + 2048, 8 * gp, gn[0], gn[1], lo);
                u32x4 w[2];
#pragma unroll
                for (int bj = 0; bj < 2; ++bj) { const u32x4 gv = gq[bj];
                    f32x4 g0, g1; g0[0] = bf_lo(gv.x); g0[1] = bf_hi(gv.x); g0[2] = bf_lo(gv.y); g0[3] = bf_hi(gv.y); g1[0] = bf_lo(gv.z); g1[1] = bf_hi(gv.z); g1[2] = bf_lo(gv.w); g1[3] = bf_hi(gv.w);
                    if (b > 0) {
#pragma unroll
                        for (int j = 0; j < 4; ++j) { g0[j] = fmaxf(g0[j], 1e-6f); g1[j] = fmaxf(g1[j], 1e-6f); } }
                    f32x4 v0 = acc[ai][bj][m][0] * g0, v1 = acc[ai][bj][m][1] * g1;
                    if (b < 2) { const u32x4 gx = gn[bj];
                        v0[0] *= __builtin_amdgcn_rcpf(fmaxf(bf_lo(gx.x), 1e-6f)); v0[1] *= __builtin_amdgcn_rcpf(fmaxf(bf_hi(gx.x), 1e-6f)); v0[2] *= __builtin_amdgcn_rcpf(fmaxf(bf_lo(gx.y), 1e-6f)); v0[3] *= __builtin_amdgcn_rcpf(fmaxf(bf_hi(gx.y), 1e-6f));
                        v1[0] *= __builtin_amdgcn_rcpf(fmaxf(bf_lo(gx.z), 1e-6f)); v1[1] *= __builtin_amdgcn_rcpf(fmaxf(bf_hi(gx.z), 1e-6f)); v1[2] *= __builtin_amdgcn_rcpf(fmaxf(bf_lo(gx.w), 1e-6f)); v1[3] *= __builtin_amdgcn_rcpf(fmaxf(bf_hi(gx.w), 1e-6f));
                        acc[ai][bj][m][0] = v0; acc[ai][bj][m][1] = v1; }
                    else { w[bj].x = cvt_pk_bf16(v0[0], v0[1]); w[bj].y = cvt_pk_bf16(v0[2], v0[3]); w[bj].z = cvt_pk_bf16(v1[0], v1[1]); w[bj].w = cvt_pk_bf16(v1[2], v1[3]); } }
                if (b == 2) fl_store(ol + ro * op, 8 * op, w[0], w[1], lo);
                asm volatile("" ::: "memory"); }
    }
};
struct MergeOrder {
    StaticOrder so;
    __device__ __forceinline__ bool next(int i, Unit& u) const { if (!so.next(i / 3, u)) return false; u.b = i % 3; return true; }
    __device__ __forceinline__ void a_ready(const Unit&) const {}
    __device__ __forceinline__ void done(const Unit&) const {}
};
struct EpiSwiglu {
    static constexpr bool PERM = true, AFTER_DRAIN = false; static constexpr bool CHAIN = false;
    bf16_t* O; const float* b1; float ascale; const PG8_LAS float* lb;
    static constexpr bool LDS_BIAS = true;
    __device__ __forceinline__ const float* bias_src(const Unit& u, int lane) const { const int e = u.e, pnl = u.pn - e * 8; return b1 + (size_t)e * 2048 + (lane >> 5) * 1024 + pnl * 128 + (lane & 31) * 4; }
    __device__ __forceinline__ void operator()(const f32x4 (&acc)[2][2][4][2], const Unit& u, int wr, int wc, int fr, int fq) const {
        const int e = u.e, pnl = u.pn - e * 8; const int row0 = u.pm * BM + wr * 64 + fr;
        f32x4 bg[2], bl[2]; const PG8_LAS float* lbs = lb + u.slot * 256 + wc * 32 + 8 * fq;
#pragma unroll
        for (int n = 0; n < 2; ++n) { bg[n] = *(const PG8_LAS f32x4*)(lbs + 4 * n); bl[n] = *(const PG8_LAS f32x4*)(lbs + 128 + 4 * n); }
        unsigned char* const lanep = (unsigned char*)O + (size_t)(row0 + (fq & 1) * 16) * 1024 + pnl * 128 + wc * 32 + 8 * (fq & 2);
#pragma unroll
        for (int ai = 0; ai < 2; ++ai)
#pragma unroll
            for (int p = 0; p < 2; ++p) { u32x2 w[2];
#pragma unroll
                for (int q = 0; q < 2; ++q) { const int m = 2 * p + q; f32x4 o[2];
#pragma unroll
                    for (int n = 0; n < 2; ++n) { const f32x4 g = acc[ai][0][m][n] * ascale + bg[n], l = acc[ai][1][m][n] * ascale + bl[n];
#pragma unroll
                        for (int j = 0; j < 4; ++j) { const float gg = fminf(g[j], 7.0f), ll = fminf(fmaxf(l[j], -7.0f), 7.0f);
                            o[n][j] = gg * __builtin_amdgcn_rcpf(1.0f + __builtin_amdgcn_exp2f(-1.702f * 1.4426950408889634f * gg)) * (ll + 1.0f); } }
                    int t0 = __builtin_amdgcn_cvt_pk_fp8_f32(o[0][0], o[0][1], 0, false); t0 = __builtin_amdgcn_cvt_pk_fp8_f32(o[0][2], o[0][3], t0, true);
                    int t1 = __builtin_amdgcn_cvt_pk_fp8_f32(o[1][0], o[1][1], 0, false); t1 = __builtin_amdgcn_cvt_pk_fp8_f32(o[1][2], o[1][3], t1, true); w[q].x = (unsigned)t0; w[q].y = (unsigned)t1; }
                const auto r0 = __builtin_amdgcn_permlane16_swap(w[0].x, w[1].x, false, false), r1 = __builtin_amdgcn_permlane16_swap(w[0].y, w[1].y, false, false);
                u32x4 out; out.x = r0[0]; out.y = r1[0]; out.z = r0[1]; out.w = r1[1];
                *(u32x4*)(lanep + (size_t)(ai * HALF + p * 32) * 1024) = out; }
    }
};
struct EpiY {
    static constexpr bool PERM = true, PERM16 = true, AFTER_DRAIN = false; static constexpr bool CHAIN = false;
    bf16_t* O; const float* b2; float ascale; const PG8_LAS float* lb;
    static constexpr bool LDS_BIAS = true;
    __device__ __forceinline__ const float* bias_src(const Unit& u, int lane) const { const int e = u.e, pnl = u.pn - e * 4; return b2 + (size_t)e * 1024 + pnl * BM + lane * 4; }
    __device__ __forceinline__ void operator()(const f32x4 (&acc)[2][2][4][2], const Unit& u, int wr, int wc, int fr, int fq) const {
        const int e = u.e, pnl = u.pn - e * 4; const int row0 = u.pm * BM + wr * 64 + fr, col0 = pnl * BM + wc * 64 + 16 * fq;
        f32x4 bv[2][2]; const PG8_LAS float* lbs = lb + u.slot * 256 + wc * 64 + 16 * fq;
#pragma unroll
        for (int bj = 0; bj < 2; ++bj)
#pragma unroll
            for (int n = 0; n < 2; ++n) bv[bj][n] = *(const PG8_LAS f32x4*)(lbs + 8 * bj + 4 * n);
#pragma unroll
        for (int ai = 0; ai < 2; ++ai)
#pragma unroll
            for (int m = 0; m < 4; ++m) { unsigned char* rowp = (unsigned char*)O + (size_t)(row0 + ai * HALF + m * 16) * 1024 + col0;
                u32x4 w;
#pragma unroll
                for (int bj = 0; bj < 2; ++bj) { const f32x4 v0 = acc[ai][bj][m][0] * ascale + bv[bj][0], v1 = acc[ai][bj][m][1] * ascale + bv[bj][1];
                    int t0 = __builtin_amdgcn_cvt_pk_fp8_f32(v0[0], v0[1], 0, false); t0 = __builtin_amdgcn_cvt_pk_fp8_f32(v0[2], v0[3], t0, true);
                    int t1 = __builtin_amdgcn_cvt_pk_fp8_f32(v1[0], v1[1], 0, false); t1 = __builtin_amdgcn_cvt_pk_fp8_f32(v1[2], v1[3], t1, true);
                    if (bj == 0) { w.x = (unsigned)t0; w.y = (unsigned)t1; } else { w.z = (unsigned)t0; w.w = (unsigned)t1; } }
                *(u32x4*)rowp = w; }
    }
};
struct MoeOrder {
    const PG8_LAS int* tstart; int nN, G, vcu;
    __device__ __forceinline__ int ts(int k) const { return __builtin_amdgcn_readfirstlane(tstart[k]); }
    __device__ __forceinline__ bool next(int i, Unit& u) const {
        const int L = i * G + vcu; const int T = ts(32); if (L >= T * nN) return false;
        int e = 0;
#pragma unroll
        for (int k = 1; k < 32; ++k) e += (L >= ts(k) * nN) ? 1 : 0;
        const int t0 = ts(e), R = ts(e + 1) - t0; const int rem = L - t0 * nN; const int ng = rem / (4 * R); const int r2 = rem - ng * 4 * R; const int pnl = r2 / R; const int pmi = r2 - pnl * R;
        u.pm = t0 + pmi; u.pn = e * nN + ng * 4 + pnl; u.e = e; u.b = 0; return true;
    }
    __device__ __forceinline__ void a_ready(const Unit&) const {}
    __device__ __forceinline__ void done(const Unit&) const {}
};
template <class E, class = void> struct has_p16 { static constexpr bool v = false; };
template <class E> struct has_p16<E, decltype((void)E::PERM16)> { static constexpr bool v = E::PERM16; };
template <class Epi, class Sched, bool ALIGN_EPI = false, bool SP2 = false, bool GATHER = false, bool FP8 = false>
__device__ __forceinline__ void gemm_phase(PG8_LAS unsigned char* lds, const Gemm g, const Sched& S, const Epi& E) {
    static_assert(!GATHER || SP2, "GATHER is wired into the SP2 loop only");
    int tid_ = threadIdx.x; asm volatile("" : "+v"(tid_));
    const int tid = tid_, wid = __builtin_amdgcn_readfirstlane(tid >> 6), lane = tid & 63, wr = wid >> 2, wc = wid & 3, fr = lane & 15, fq = lane >> 4;
    int K_ = g.K; asm volatile("" : "+s"(K_));
    const int K = K_, nt = K / BK;
    constexpr bool P16 = has_p16<Epi>::v;
    unsigned voffA[2], voffB[2];
#pragma unroll
    for (int i = 0; i < 2; ++i) { int R, C; stage_rc(tid * 16 + i * 8192, R, C); const int Rb = P16 ? ((R >> 5) * 64 + 16 * ((R & 15) >> 2) + 4 * ((R >> 4) & 1) + (R & 3)) : Epi::PERM ? ((R & ~31) + perm32(R & 31)) : R;
        voffA[i] = (unsigned)(R * K + C) * 2u; voffB[i] = (unsigned)(Rb * K + C) * 2u; }
    unsigned vC[2][2] = {{0u, 0u}, {0u, 0u}};
    const PG8_LAS int* const rowlds = (const PG8_LAS int*)(lds + STAGE_BYTES + 4096);
#define PG8_ROWS(dst, pm_) do { if constexpr (GATHER) { _Pragma("unroll") for (int h_ = 0; h_ < 2; ++h_) _Pragma("unroll") for (int i_ = 0; i_ < 2; ++i_) { int R_, C_; stage_rc(tid * 16 + i_ * 8192, R_, C_); \
        const int ix_ = (pm_) * BM + h_ * HALF + R_; dst[h_][i_] = ((g.rowmap ? (unsigned)g.rowmap[ix_] : (unsigned)ix_) * (unsigned)K + (unsigned)C_) * 2u; } } } while (0)
#define PG8_ROWS_LDS(dst) do { _Pragma("unroll") for (int h_ = 0; h_ < 2; ++h_) _Pragma("unroll") for (int i_ = 0; i_ < 2; ++i_) { int R_, C_; stage_rc(tid * 16 + i_ * 8192, R_, C_); \
        dst[h_][i_] = ((unsigned)rowlds[h_ * HALF + R_] * (unsigned)K + (unsigned)C_) * 2u; } } while (0)
    const size_t kstep = (size_t)(BK * 2);
    const size_t hstep = (size_t)HALF * K * 2;
    const size_t b64step = (size_t)64 * K * 2;
    const size_t hB = P16 ? (size_t)8 * K * 2 : hstep, b64B = P16 ? 2 * b64step : b64step;
    const size_t hA = GATHER ? (size_t)0 : hstep;
    const size_t tstep = 2 * hstep;
    const unsigned ldsw = (unsigned)wid * 1024u;
    const int aoff = lds_byte(wr * 64 + fr, fq * 8), boff = lds_byte(wc * 32 + fr, fq * 8);
#define PG8_SA(b, h) (((b) * 2 + (h)) * HTB)
#define PG8_SB(b, h) ((4 + (b) * 2 + (h)) * HTB)
#define PG8_STAGE(bufoff, gbase, voff) do { if constexpr (true) { const bool isB_ = ((const void*)(voff) == (const void*)voffB), isA_ = ((const void*)(voff) == (const void*)voffA); _Pragma("unroll") for (int _i = 0; _i < 2; ++_i) \
        __builtin_amdgcn_global_load_lds((const unsigned*)((const char*)(gbase) + (isB_ ? (size_t)_i * b64B : isA_ ? (size_t)_i * b64step : (size_t)0) + (isB_ ? voffB[0] : (isA_ ? voffA[0] : (voff)[_i]))), (PG8_LAS unsigned*)(lds + (bufoff) + ldsw + _i * 8192), 16, 0, 0); } } while (0)
#define PG8_LD16(off) (*(const PG8_LAS v8i_t_half*)(lds + (off)))
#define PG8_LDA(dst, b, h) do { if constexpr (FP8) { _Pragma("unroll") for (int m = 0; m < 4; ++m) dst##8[m] = __builtin_shufflevector(__builtin_bit_cast(v8i_t_half, *(const PG8_LAS bf16x8*)(lds + PG8_SA(b, h) + aoff + m * 2048)), __builtin_bit_cast(v8i_t_half, *(const PG8_LAS bf16x8*)(lds + PG8_SA(b, h) + aoff + m * 2048 + 1024)), 0, 1, 2, 3, 4, 5, 6, 7); } \
        else { _Pragma("unroll") for (int m = 0; m < 4; ++m) _Pragma("unroll") for (int k = 0; k < 2; ++k) dst[m][k] = *(const PG8_LAS bf16x8*)(lds + PG8_SA(b, h) + aoff + m * 2048 + k * 1024); } } while (0)
#define PG8_LDB(dst, b, h) do { if constexpr (FP8) { _Pragma("unroll") for (int n = 0; n < 2; ++n) dst##8[n] = __builtin_shufflevector(__builtin_bit_cast(v8i_t_half, *(const PG8_LAS bf16x8*)(lds + PG8_SB(b, h) + boff + n * 2048)), __builtin_bit_cast(v8i_t_half, *(const PG8_LAS bf16x8*)(lds + PG8_SB(b, h) + boff + n * 2048 + 1024)), 0, 1, 2, 3, 4, 5, 6, 7); } \
        else { _Pragma("unroll") for (int n = 0; n < 2; ++n) _Pragma("unroll") for (int k = 0; k < 2; ++k) dst[n][k] = *(const PG8_LAS bf16x8*)(lds + PG8_SB(b, h) + boff + n * 2048 + k * 1024); } } while (0)
#define PG8_MMA(ai, bj, At, Bt) do { __builtin_amdgcn_s_setprio(1); _Pragma("unroll") for (int m = 0; m < 4; ++m) _Pragma("unroll") for (int n = 0; n < 2; ++n) { \
        if constexpr (FP8) acc[ai][bj][m][n] = __builtin_amdgcn_mfma_scale_f32_16x16x128_f8f6f4(Bt##8[n], At##8[m], acc[ai][bj][m][n], 0, 0, 0, g.scale_a, 0, g.scale_a); \
        else { _Pragma("unroll") for (int k = 0; k < 2; ++k) acc[ai][bj][m][n] = __builtin_amdgcn_mfma_f32_16x16x32_bf16(Bt[n][k], At[m][k], acc[ai][bj][m][n], 0, 0, 0); } } __builtin_amdgcn_s_setprio(0); } while (0)
#define PG8_WAIT_V(n) asm volatile("s_waitcnt vmcnt(" #n ")" ::: "memory")
#define PG8_WAIT_L(n) asm volatile("s_waitcnt lgkmcnt(" #n ")" ::: "memory")
#define PG8_BAR __builtin_amdgcn_s_barrier()
#define PG8_SCHED __builtin_amdgcn_sched_barrier(0)
    Unit cur, nxt; int ui = 0;
    if (!S.next(0, cur)) return;
    cur.slot = 0;
    f32x4 acc[2][2][4][2];
#pragma unroll
    for (int a = 0; a < 2; ++a)
#pragma unroll
        for (int b = 0; b < 2; ++b)
#pragma unroll
            for (int m = 0; m < 4; ++m)
#pragma unroll
                for (int n = 0; n < 2; ++n) acc[a][b][m][n] = (f32x4){0.f, 0.f, 0.f, 0.f};
    bf16x8 At[4][2], B0[2][2], B1[2][2]; v8i_t At8[4], B08[2], B18[2];
    const char* cA = (const char*)g.A + (GATHER ? (size_t)0 : (size_t)cur.pm * tstep + (size_t)cur.b * g.strideA); const char* cB = (const char*)g.Bt + (size_t)cur.pn * tstep + (size_t)cur.b * g.strideB;
    PG8_ROWS(vC, cur.pm);
    S.a_ready(cur);
    if constexpr (SP2) {
        PG8_STAGE(PG8_SB(0, 0), cB, voffB); PG8_STAGE(PG8_SB(0, 1), cB + hB, voffB); PG8_STAGE(PG8_SA(0, 0), cA, (GATHER ? vC[0] : voffA)); PG8_STAGE(PG8_SA(0, 1), cA + hA, (GATHER ? vC[1] : voffA));
        if (wr == 1) PG8_BAR;
        PG8_WAIT_V(2); PG8_BAR;
        PG8_STAGE(PG8_SB(1, 0), cB + kstep, voffB); PG8_STAGE(PG8_SA(1, 0), cA + kstep, (GATHER ? vC[0] : voffA)); PG8_STAGE(PG8_SB(1, 1), cB + hB + kstep, voffB);
        PG8_WAIT_V(6); PG8_BAR;
    } else {
        PG8_STAGE(PG8_SB(0, 0), cB, voffB); PG8_STAGE(PG8_SA(0, 0), cA, voffA); PG8_STAGE(PG8_SB(0, 1), cB + hB, voffB); PG8_STAGE(PG8_SA(0, 1), cA + hstep, voffA);
        if (wr == 1) PG8_BAR;
        PG8_WAIT_V(4); PG8_BAR;
        PG8_STAGE(PG8_SB(1, 0), cB + kstep, voffB); PG8_STAGE(PG8_SA(1, 0), cA + kstep, voffA); PG8_STAGE(PG8_SB(1, 1), cB + hB + kstep, voffB);
        PG8_WAIT_V(6); PG8_BAR;
    }
    for (;;) {
        const bool has_next = S.next(ui + 1, nxt); nxt.slot = (ui + 1) & 1;
        if constexpr (Epi::LDS_BIAS) { if (wid == 0) __builtin_amdgcn_global_load_lds((const unsigned*)E.bias_src(cur, lane), (PG8_LAS unsigned*)(lds + STAGE_BYTES + 5120 + cur.slot * 1024), 16, 0, 0); }
        const char* nA = (has_next && !GATHER) ? (const char*)g.A + (size_t)nxt.pm * tstep + (size_t)nxt.b * g.strideA : cA; const char* nB = has_next ? (const char*)g.Bt + (size_t)nxt.pn * tstep + (size_t)nxt.b * g.strideB : cB;
        if constexpr (GATHER) { if (g.rowmap && wid == 0) { const int np_ = has_next ? nxt.pm : cur.pm;
            __builtin_amdgcn_global_load_lds((const unsigned*)(g.rowmap + (size_t)np_ * BM + lane * 4), (PG8_LAS unsigned*)(lds + STAGE_BYTES + 4096), 16, 0, 0); } }
        for (int t = 0; t < nt; t += 2) {
            const bool last = (t == nt - 2);
            const char* a1 = cA + (size_t)(t + 1) * kstep;
            const char* a2 = last ? nA : cA + (size_t)(t + 2) * kstep; const char* b2 = last ? nB : cB + (size_t)(t + 2) * kstep;
            const char* a3 = a2 + kstep; const char* b3 = b2 + kstep;
            if (last && has_next) S.a_ready(nxt);
            if constexpr (SP2) {
            PG8_LDB(B0, 0, 0); PG8_LDB(B1, 0, 1); PG8_SCHED; PG8_LDA(At, 0, 0); PG8_STAGE(PG8_SA(1, 1), a1 + hA, (GATHER ? vC[1] : voffA));
            if constexpr (GATHER) { if (last) { if (g.rowmap) PG8_ROWS_LDS(vC); else { const int np_ = has_next ? nxt.pm : cur.pm; PG8_ROWS(vC, np_); } } }
            PG8_WAIT_V(8); PG8_WAIT_L(0); PG8_BAR; PG8_MMA(0, 0, At, B0); PG8_MMA(0, 1, At, B1); PG8_BAR; PG8_SCHED;
            PG8_LDA(At, 0, 1); PG8_STAGE(PG8_SB(0, 0), b2, voffB); PG8_STAGE(PG8_SB(0, 1), b2 + hB, voffB); PG8_STAGE(PG8_SA(0, 0), a2, (GATHER ? vC[0] : voffA));
            PG8_WAIT_V(8); PG8_WAIT_L(0); PG8_BAR; PG8_MMA(1, 0, At, B0); PG8_MMA(1, 1, At, B1); PG8_BAR; PG8_SCHED;
            PG8_LDB(B0, 1, 0); PG8_LDB(B1, 1, 1); PG8_SCHED; PG8_LDA(At, 1, 0); PG8_STAGE(PG8_SA(0, 1), a2 + hA, (GATHER ? vC[1] : voffA));
            PG8_WAIT_V(8); PG8_WAIT_L(0); PG8_BAR; PG8_MMA(0, 0, At, B0); PG8_MMA(0, 1, At, B1); PG8_BAR; PG8_SCHED;
            PG8_LDA(At, 1, 1); PG8_STAGE(PG8_SB(1, 0), b3, voffB); PG8_STAGE(PG8_SB(1, 1), b3 + hB, voffB); PG8_STAGE(PG8_SA(1, 0), a3, (GATHER ? vC[0] : voffA));
            PG8_WAIT_V(8); PG8_WAIT_L(0); PG8_BAR; PG8_MMA(1, 0, At, B0); PG8_MMA(1, 1, At, B1); PG8_BAR; PG8_SCHED;
            } else {
            PG8_LDB(B0, 0, 0); PG8_SCHED; PG8_LDA(At, 0, 0); PG8_STAGE(PG8_SA(1, 1), a1 + hstep, voffA);
            PG8_WAIT_L(8); PG8_BAR; PG8_WAIT_L(0); PG8_MMA(0, 0, At, B0); PG8_BAR; PG8_SCHED;
            PG8_LDB(B1, 0, 1); PG8_STAGE(PG8_SB(0, 0), b2, voffB);
            PG8_BAR; PG8_WAIT_L(0); PG8_MMA(0, 1, At, B1); PG8_BAR;
            PG8_LDA(At, 0, 1); PG8_STAGE(PG8_SA(0, 0), a2, voffA);
            PG8_BAR; PG8_WAIT_L(0); PG8_MMA(1, 0, At, B0); PG8_BAR; PG8_SCHED;
            PG8_STAGE(PG8_SB(0, 1), b2 + hB, voffB);
            PG8_WAIT_V(6); PG8_BAR; PG8_MMA(1, 1, At, B1); PG8_BAR;
            PG8_LDB(B0, 1, 0); PG8_SCHED; PG8_LDA(At, 1, 0); PG8_STAGE(PG8_SA(0, 1), a2 + hstep, voffA);
            PG8_WAIT_L(8); PG8_BAR; PG8_WAIT_L(0); PG8_MMA(0, 0, At, B0); PG8_BAR; PG8_SCHED;
            PG8_LDB(B1, 1, 1); PG8_STAGE(PG8_SB(1, 0), b3, voffB);
            PG8_BAR; PG8_WAIT_L(0); PG8_MMA(0, 1, At, B1); PG8_BAR;
            PG8_LDA(At, 1, 1); PG8_STAGE(PG8_SA(1, 0), a3, voffA);
            PG8_BAR; PG8_WAIT_L(0); PG8_MMA(1, 0, At, B0); PG8_BAR; PG8_SCHED;
            PG8_STAGE(PG8_SB(1, 1), b3 + hB, voffB);
            PG8_WAIT_V(6); PG8_BAR; PG8_MMA(1, 1, At, B1); PG8_BAR;
            }
        }
        if constexpr (ALIGN_EPI) { if (wr == 0) PG8_BAR; }
        if constexpr (!Epi::AFTER_DRAIN) { int t2_ = threadIdx.x; asm volatile("" : "+v"(t2_)); E(acc, cur, wr, wc, t2_ & 15, (t2_ & 63) >> 4); S.done(cur); }
        if (!has_next) break;
        if (!(Epi::CHAIN && cur.b < 2)) {
#pragma unroll
        for (int a = 0; a < 2; ++a)
#pragma unroll
            for (int b = 0; b < 2; ++b)
#pragma unroll
                for (int m = 0; m < 4; ++m)
#pragma unroll
                    for (int n = 0; n < 2; ++n) acc[a][b][m][n] = (f32x4){0.f, 0.f, 0.f, 0.f};
        }
        cur = nxt; cA = nA; cB = nB; ++ui;
        if constexpr (ALIGN_EPI) { if (wr == 1) PG8_BAR; }
    }
    PG8_WAIT_V(0);
    if constexpr (!ALIGN_EPI) { if (wr == 0) PG8_BAR; }
    PG8_BAR;
    if constexpr (Epi::AFTER_DRAIN) { E.fused(acc, cur, wr, wc, fr, fq, lds, wid, lane); S.done(cur); }
#undef PG8_ROWS
#undef PG8_ROWS_LDS
#undef PG8_SA
#undef PG8_SB
#undef PG8_STAGE
#undef PG8_LDA
#undef PG8_LDB
#undef PG8_MMA
#undef PG8_LD16
#undef PG8_WAIT_V
#undef PG8_WAIT_L
#undef PG8_BAR
#undef PG8_SCHED
}
}
namespace attn_body {
using bf16=__hip_bfloat16;
using bf16x8=__attribute__((ext_vector_type(8)))short;
using s16x4=__attribute__((ext_vector_type(4)))short;
using f32x16=__attribute__((ext_vector_type(16)))float;
using f32x4v=__attribute__((ext_vector_type(4)))float;
using u32x4=__attribute__((ext_vector_type(4)))unsigned;
constexpr int D=64;
constexpr int NW=8,QBLK=32,QB=QBLK*NW,KVBLK=64;
__device__ __forceinline__ int crow(int r,int hi){return (r&3)+8*(r>>2)+4*hi;}
#define SBAR() __builtin_amdgcn_sched_barrier(0)
__device__ __forceinline__ void cmask(f32x16&p0,f32x16&p1,int jb,int qrel,int hi){
  const float NEG=-INFINITY; int kb=64*jb+4*hi;
  #pragma unroll
  for(int r=0;r<16;++r){int kv=kb+(r&3)+8*(r>>2); if(kv>qrel)p0[r]=NEG; if(kv+32>qrel)p1[r]=NEG;}
}

constexpr int NSLOT=3, SLOTB=8192;
constexpr int LDS_K=0, LDS_V=NSLOT*SLOTB, LDS_WS=2*NSLOT*SLOTB, LDS_OST=LDS_WS+NW*64*4, LDS_BYTES=LDS_OST+NW*4096;
constexpr int LDS_CS=LDS_BYTES, CS_BYTES=65536, LDS_TOTAL=LDS_CS+CS_BYTES;
constexpr int TBL_N=640, TBL_ZERO=256;
__device__ __forceinline__ void glds16(const void*gsrc,unsigned lds_dst){unsigned keep;
  asm volatile("s_mov_b32 %0, m0\n\ts_mov_b32 m0, %2\n\ts_nop 0\n\tglobal_load_lds_dwordx4 %1, off\n\ts_mov_b32 m0, %0":"=&s"(keep):"v"(gsrc),"s"(lds_dst):"memory");}
__device__ __forceinline__ float max3f(float a,float b,float c){float r;asm("v_max3_f32 %0, %1, %2, %3":"=v"(r):"v"(a),"v"(b),"v"(c));return r;}
__device__ __forceinline__ float max2f(float a,float b){float r;asm("v_max_f32_e32 %0, %1, %2":"=v"(r):"v"(a),"v"(b));return r;}
__device__ __forceinline__ float fadd_s(float a,float b){float r;asm("v_add_f32_e32 %0, %1, %2":"=v"(r):"v"(a),"v"(b));return r;}
__device__ __forceinline__ float fsub_s(float a,float b){float r;asm("v_sub_f32_e32 %0, %1, %2":"=v"(r):"v"(a),"v"(b));return r;}
typedef float f32x2_t __attribute__((ext_vector_type(2))); typedef __bf16 bf16x2_t __attribute__((ext_vector_type(2)));
__device__ __forceinline__ unsigned cvtpk_s(float lo,float hi){f32x2_t v={lo,hi};bf16x2_t b=__builtin_convertvector(v,bf16x2_t);return __builtin_bit_cast(unsigned,b);}
#define WAIT_BAR(N) asm volatile("s_waitcnt vmcnt(" #N ") lgkmcnt(0)\n\ts_barrier":::"memory")

__device__ __forceinline__ void qkt(f32x16&p0,f32x16&p1,const char*Kslot,const bf16x8*qr,int r32,int hi){
  const char*kb=Kslot+hi*1024+r32*16;
  #pragma unroll
  for(int d0=0;d0<4;++d0){
    const bf16x8 b0=*reinterpret_cast<const bf16x8*>(kb+d0*2048);
    const bf16x8 b1=*reinterpret_cast<const bf16x8*>(kb+d0*2048+512);
    p0=__builtin_amdgcn_mfma_f32_32x32x16_bf16(b0,qr[d0],p0,0,0,0);p1=__builtin_amdgcn_mfma_f32_32x32x16_bf16(b1,qr[d0],p1,0,0,0);}
}
typedef __attribute__((address_space(3))) const char* lds_cptr;
typedef __attribute__((address_space(3))) char* lds_ptr;
typedef short v4i16_t __attribute__((ext_vector_type(4)));
__device__ __forceinline__ void kload8(bf16x8*kf,lds_cptr kp){
  kf[0]=*(const __attribute__((address_space(3))) bf16x8*)(kp);      kf[1]=*(const __attribute__((address_space(3))) bf16x8*)(kp+512);
  kf[2]=*(const __attribute__((address_space(3))) bf16x8*)(kp+2048); kf[3]=*(const __attribute__((address_space(3))) bf16x8*)(kp+2560);
  kf[4]=*(const __attribute__((address_space(3))) bf16x8*)(kp+4096); kf[5]=*(const __attribute__((address_space(3))) bf16x8*)(kp+4608);
  kf[6]=*(const __attribute__((address_space(3))) bf16x8*)(kp+6144); kf[7]=*(const __attribute__((address_space(3))) bf16x8*)(kp+6656);
}
__device__ __forceinline__ void kload2(bf16x8*kf,lds_cptr kp,int j){ kf[2*j]=*(const __attribute__((address_space(3))) bf16x8*)(kp+j*2048); kf[2*j+1]=*(const __attribute__((address_space(3))) bf16x8*)(kp+j*2048+512); }
__device__ __forceinline__ s16x4 vtr(lds_cptr p){ return __builtin_bit_cast(s16x4,__builtin_amdgcn_ds_read_tr16_b64_v4i16((__attribute__((address_space(3))) v4i16_t*)p)); }
__device__ __forceinline__ float rowmax(const f32x16&p0,const f32x16&p1){
  float a=max3f(p0[0],p0[1],p1[0]),b=max3f(p0[2],p0[3],p1[1]);a=max3f(a,p1[2],p1[3]);
  #pragma unroll
  for(int r=4;r<16;r+=4){a=max3f(a,p0[r],p0[r+1]);b=max3f(b,p0[r+2],p0[r+3]);a=max3f(a,p1[r],p1[r+1]);b=max3f(b,p1[r+2],p1[r+3]);}
  const float m=max2f(a,b);
  auto rr=__builtin_amdgcn_permlane32_swap(__float_as_uint(m),__float_as_uint(m),false,false);
  return max2f(__uint_as_float(rr[0]),__uint_as_float(rr[1]));
}
__device__ __forceinline__ void pv(f32x16*o,int vb,bf16x8 pa0,bf16x8 pa1,bf16x8 pa2,bf16x8 pa3){
  #pragma unroll
  for(int d0=0;d0<2;++d0){s16x4 lo[4],hi[4];
    #pragma unroll
    for(int ks=0;ks<4;++ks){
      asm volatile("ds_read_b64_tr_b16 %0,%1 offset:%c2":"=&v"(lo[ks]):"v"(vb),"i"(d0*4096+ks*1024):"memory");
      asm volatile("ds_read_b64_tr_b16 %0,%1 offset:%c2":"=&v"(hi[ks]):"v"(vb),"i"(d0*4096+ks*1024+512):"memory");}
    asm volatile("s_waitcnt lgkmcnt(0)":::"memory");SBAR();
    #define PK(k) (bf16x8){lo[k][0],lo[k][1],lo[k][2],lo[k][3],hi[k][0],hi[k][1],hi[k][2],hi[k][3]}
    o[d0]=__builtin_amdgcn_mfma_f32_32x32x16_bf16(pa0,PK(0),o[d0],0,0,0);
    o[d0]=__builtin_amdgcn_mfma_f32_32x32x16_bf16(pa1,PK(1),o[d0],0,0,0);
    o[d0]=__builtin_amdgcn_mfma_f32_32x32x16_bf16(pa2,PK(2),o[d0],0,0,0);
    o[d0]=__builtin_amdgcn_mfma_f32_32x32x16_bf16(pa3,PK(3),o[d0],0,0,0);
    #undef PK
  }
}

struct AttnArgs { const bf16* Q; const bf16* K; const bf16* V; bf16* O; long qp, kp, op; int q0, NT, kv0; const float* aux; float* lse; long lse_stride; int tlo, thi, band; float thr; };
#define ATTN_STORE16(p,v) (*(u32x4*)(p)=(v))
template<int MODE,int THRL> __device__ __forceinline__ void attn_unit(const AttnArgs&a,char*shm){
  int tid_=threadIdx.x; asm volatile("":"+v"(tid_));
  const int tid=tid_,lane=tid&63,r32=lane&31,hi=lane>>5; const int wid=__builtin_amdgcn_readfirstlane(tid>>6);
  const int q0=a.q0; const long KP=a.kp;
  const bf16*Qw=a.Q+(long)(q0+wid*QBLK)*a.qp;
  const bf16*Kh=a.K,*Vh=a.V;
  int NT=a.NT, lo=0;
  if(MODE==0){
    const int nt0=a.thi-a.tlo; const float cq=a.aux[q0];
    const float ck=(lane<nt0)?a.aux[64*(a.tlo+lane)+63]:0.f;
    const unsigned long long need=__ballot((lane<nt0)&&(cq-ck>=-a.thr));
    const int j0=need?(int)__builtin_ctzll(need):nt0;
    if(j0>=nt0){ if(a.lse&&tid<QB)a.lse[(long)(q0+tid)*a.lse_stride]=-INFINITY; return; }
    lo=a.tlo+j0; int n=a.thi-lo; if(n<4){lo=a.thi-4;n=4;} if(n&1){lo-=1;n+=1;} NT=n;
    Kh+=(long)lo*KVBLK*KP; Vh+=(long)lo*KVBLK*KP;
  }
  const unsigned lds0=(unsigned)(uintptr_t)shm;
  float*wsf=(float*)(shm+LDS_WS)+wid*64;
  const lds_cptr shm3=(lds_cptr)shm;
  const __attribute__((address_space(3))) float* cs3=(const __attribute__((address_space(3))) float*)(shm3+LDS_CS);
  float nb=0.f;
  if(MODE==0){ __attribute__((address_space(3))) f32x4v* dst=(__attribute__((address_space(3))) f32x4v*)((lds_ptr)shm+LDS_CS); const f32x4v* src=(const f32x4v*)a.aux+16*lo; const int n4=16*NT;
    for(int i=tid;i<n4;i+=NW*64)dst[i]=src[i];
    nb=a.aux[q0+wid*QBLK+r32]; }
  if(MODE==1){ __attribute__((address_space(3))) float* dst=(__attribute__((address_space(3))) float*)((lds_ptr)shm+LDS_CS);
    for(int i=tid;i<TBL_N;i+=NW*64)dst[i]=a.aux[i]; }
  const bf16*ksrc=Kh+(long)lane*KP+wid*8;
  const bf16*vsrc=Vh+(long)(16*(wid&3)+(lane>>2))*KP+(wid>>2)*32+(lane&3)*8;
  const unsigned kdst=lds0+LDS_K+wid*1024, vdst=lds0+LDS_V+wid*1024;
  #define DMA_K(t,slot) glds16(ksrc+(long)(t)*KVBLK*KP,(unsigned)__builtin_amdgcn_readfirstlane(kdst+(slot)))
  #define DMA_V(t,slot) glds16(vsrc+(long)(t)*KVBLK*KP,(unsigned)__builtin_amdgcn_readfirstlane(vdst+(slot)))
  const int vb0=(int)(lds0+LDS_V)+((lane>>4)&1)*32+(lane&3)*8+(4*hi+((lane&15)>>2))*64;
  const char*Kbase=shm+LDS_K; bf16x8 kf[8];
  const lds_cptr kp0=shm3+LDS_K+hi*1024+r32*16; const lds_cptr vp0=shm3+LDS_V+((lane>>4)&1)*32+(lane&3)*8+(4*hi+((lane&15)>>2))*64;
  DMA_K(0,0);DMA_V(0,0);DMA_K(1,SLOTB);
  bf16x8 qr[4];
  #pragma unroll
  for(int d0=0;d0<4;++d0)qr[d0]=*reinterpret_cast<const bf16x8*>(&Qw[(long)r32*a.qp+d0*16+hi*8]);
  float mhat=0.f,l_reg=0.f;f32x16 o[2];o[0]=f32x16{};o[1]=f32x16{};
  const int qrel=wid*QBLK+r32;
  const int tb0=q0+qrel-a.kv0-4*hi+TBL_ZERO-63;
  #define CINIT(C0,C1,t) do{ \
    if(MODE==0){ const __attribute__((address_space(3))) float* cp_=cs3+64*(t)+4*hi; \
      _Pragma("unroll") for(int g_=0;g_<4;++g_){ const f32x4v a_=*(const __attribute__((address_space(3))) f32x4v*)(cp_+8*g_); const f32x4v b_=*(const __attribute__((address_space(3))) f32x4v*)(cp_+32+8*g_); \
        C0[4*g_]=nb-a_[0];C0[4*g_+1]=nb-a_[1];C0[4*g_+2]=nb-a_[2];C0[4*g_+3]=nb-a_[3]; C1[4*g_]=nb-b_[0];C1[4*g_+1]=nb-b_[1];C1[4*g_+2]=nb-b_[2];C1[4*g_+3]=nb-b_[3]; } } \
    else if(MODE==1){ const __attribute__((address_space(3))) float* tp_=cs3+(tb0-64*(t)); \
      _Pragma("unroll") for(int g_=0;g_<4;++g_) _Pragma("unroll") for(int j_=0;j_<4;++j_){ C0[4*g_+j_]=nb+tp_[63-8*g_-j_]; C1[4*g_+j_]=nb+tp_[31-8*g_-j_]; } } \
    else { _Pragma("unroll") for(int r_=0;r_<16;++r_){C0[r_]=nb;C1[r_]=nb;} } }while(0)
  #define CMASK(P0,P1,t) do{ if(MODE==0&&a.band){int jb_=(t)-(NT-4); if(jb_>=0)cmask(P0,P1,jb_,qrel,hi);} }while(0)
  bool resc=false;
  #define START(P0,P1) do{ const float rm=rowmax(P0,P1); resc=false; \
    { const float dl=(MODE==1)?max2f(rm,-256.0f):rm; mhat=fadd_s(mhat,dl); nb=fsub_s(nb,dl); \
      _Pragma("unroll") for(int r=0;r<16;++r){P0[r]=fsub_s(P0[r],dl);P1[r]=fsub_s(P1[r],dl);} } \
    _Pragma("unroll") for(int r=0;r<16;++r)P0[r]=__builtin_amdgcn_exp2f(P0[r]); }while(0)
  #define RESC() do{ if(resc){ asm volatile("s_waitcnt lgkmcnt(0)":::"memory"); \
      _Pragma("unroll") for(int d_=0;d_<2;++d_) _Pragma("unroll") for(int r=0;r<16;++r)o[d_][r]*=wsf[crow(r,hi)]; } }while(0)
  f32x16 pA0,pA1,pB0,pB1;
  int sl_prev=0,sl_cur=0,sl_next=SLOTB;
  #define ROT() do{sl_prev=sl_cur;sl_cur=sl_next;sl_next=(sl_next==(NSLOT-1)*SLOTB)?0:sl_next+SLOTB;}while(0)
  DMA_K(2,2*SLOTB);
  WAIT_BAR(3);
  CINIT(pA0,pA1,0);
  qkt(pA0,pA1,Kbase,qr,r32,hi);asm volatile("s_nop 15\n\ts_nop 7":"+v"(pA0),"+v"(pA1));CMASK(pA0,pA1,0);
  START(pA0,pA1);
  _Pragma("unroll") for(int r=0;r<16;++r)pA1[r]=__builtin_amdgcn_exp2f(pA1[r]);
  WAIT_BAR(0);
  DMA_K(3,0);DMA_V(1,SLOTB);
  ROT();
  kload8(kf,kp0+sl_cur);
  WAIT_BAR(2);
  s16x4 vlo[8],vhi[8]; u32x4 pw0,pw1,pw2,pw3;
  #define PKW(P,B) cvtpk_s(P[B],P[B+1])
  #define PAF(k) __builtin_bit_cast(bf16x8,pw##k)
  #define VFR(i) (bf16x8){vlo[i][0],vlo[i][1],vlo[i][2],vlo[i][3],vhi[i][0],vhi[i][1],vhi[i][2],vhi[i][3]}
  #define PIN(x) asm volatile("":"+v"(x))
  #define MX3(a,b,c) __builtin_fmaxf(__builtin_fmaxf((a),(b)),(c))
  #define GAPA(MF,A0,A1,A2,A3,W0,W1,PW) do{ MF; sacc+=A0; sacc+=A1; sacc+=A2; sacc+=A3; PIN(sacc); W0; W1; PIN(PW); SBAR(); }while(0)
  #define EX(v) __builtin_amdgcn_exp2f(v)
  #define GAPB(MF,X,B) do{ MF; X[B]=EX(X[B]); X[B+1]=EX(X[B+1]); X[B+2]=EX(X[B+2]); X[B+3]=EX(X[B+3]); PIN(X); SBAR(); }while(0)
  #define VRD(i) do{ vlo[i]=vtr(vp_+(((i)>>2)*4096+((i)&3)*1024)); vhi[i]=vtr(vp_+(((i)>>2)*4096+((i)&3)*1024+512)); }while(0)
  #define KRD(G,j) do{ if(G){ kload2(kf,kp0+sl_next,j); SBAR(); } }while(0)
  #define STEP(C0,C1,P0,P1,t,GK,GV,GL) do{ CINIT(C0,C1,t); SBAR(); \
    const lds_cptr vp_=vp0+sl_prev; \
    VRD(0); SBAR(); float sacc=(P0[0]+P0[1]); \
    GAPA(C0=__builtin_amdgcn_mfma_f32_32x32x16_bf16(kf[0],qr[0],C0,0,0,0), P0[2],P0[3],P0[4],P0[5],     pw0[0]=PKW(P0,0), pw0[1]=PKW(P0,2), pw0); \
    VRD(4); SBAR(); GAPA(C1=__builtin_amdgcn_mfma_f32_32x32x16_bf16(kf[1],qr[0],C1,0,0,0), P0[6],P0[7],P0[8],P0[9],     pw0[2]=PKW(P0,4), pw0[3]=PKW(P0,6), pw0); \
    VRD(1); SBAR(); GAPA(C0=__builtin_amdgcn_mfma_f32_32x32x16_bf16(kf[2],qr[1],C0,0,0,0),   P0[10],P0[11],P0[12],P0[13], pw1[0]=PKW(P0,8), pw1[1]=PKW(P0,10), pw1); \
    VRD(5); SBAR(); GAPA(C1=__builtin_amdgcn_mfma_f32_32x32x16_bf16(kf[3],qr[1],C1,0,0,0),   P0[14],P0[15],P1[0],P1[1],   pw1[2]=PKW(P0,12),pw1[3]=PKW(P0,14), pw1); \
    VRD(2); SBAR(); GAPA(C0=__builtin_amdgcn_mfma_f32_32x32x16_bf16(kf[4],qr[2],C0,0,0,0),   P1[2],P1[3],P1[4],P1[5],     pw2[0]=PKW(P1,0), pw2[1]=PKW(P1,2), pw2); \
    VRD(6); SBAR(); GAPA(C1=__builtin_amdgcn_mfma_f32_32x32x16_bf16(kf[5],qr[2],C1,0,0,0),   P1[6],P1[7],P1[8],P1[9],     pw2[2]=PKW(P1,4), pw2[3]=PKW(P1,6), pw2); \
    VRD(3); SBAR(); GAPA(C0=__builtin_amdgcn_mfma_f32_32x32x16_bf16(kf[6],qr[3],C0,0,0,0),   P1[10],P1[11],P1[12],P1[13], pw3[0]=PKW(P1,8), pw3[1]=PKW(P1,10), pw3); \
    VRD(7); SBAR(); GAPA(C1=__builtin_amdgcn_mfma_f32_32x32x16_bf16(kf[7],qr[3],C1,0,0,0),   P1[14],P1[15],0.f,0.f,       pw3[2]=PKW(P1,12),pw3[3]=PKW(P1,14), pw3); \
    l_reg+=sacc; \
    if(GK){DMA_K((t)+3,sl_cur);} if(GV){DMA_V((t)+1,sl_next);} \
    CMASK(C0,C1,t); \
    { float a=MX3(C0[0],C0[1],C1[0]),b=MX3(C0[2],C0[3],C1[1]); a=MX3(a,C1[2],C1[3]); \
      _Pragma("unroll") for(int r=4;r<16;r+=4){a=MX3(a,C0[r],C0[r+1]);b=MX3(b,C0[r+2],C0[r+3]);a=MX3(a,C1[r],C1[r+1]);b=MX3(b,C1[r+2],C1[r+3]);} \
      float rm=__builtin_fmaxf(a,b); { auto rr=__builtin_amdgcn_permlane32_swap(__float_as_uint(rm),__float_as_uint(rm),false,false); rm=__builtin_fmaxf(__uint_as_float(rr[0]),__uint_as_float(rr[1])); } \
      resc=false; \
      if(__builtin_expect(__any(rm>(float)THRL),0)){ const float dl=__builtin_fmaxf(rm,0.f); mhat+=dl; nb-=dl; \
        _Pragma("unroll") for(int r=0;r<16;++r){C0[r]-=dl;C1[r]-=dl;} \
        const float f=__builtin_amdgcn_exp2f(-dl); l_reg*=f; if(hi==0)wsf[r32]=f; resc=true; } } \
    SBAR(); \
    GAPB(o[0]=__builtin_amdgcn_mfma_f32_32x32x16_bf16(PAF(0),VFR(0),o[0],0,0,0), C0,0); \
    GAPB(o[1]=__builtin_amdgcn_mfma_f32_32x32x16_bf16(PAF(0),VFR(4),o[1],0,0,0), C0,4); \
    KRD(GL,0); GAPB(o[0]=__builtin_amdgcn_mfma_f32_32x32x16_bf16(PAF(1),VFR(1),o[0],0,0,0), C0,8); \
    KRD(GL,1); GAPB(o[1]=__builtin_amdgcn_mfma_f32_32x32x16_bf16(PAF(1),VFR(5),o[1],0,0,0), C0,12); \
    KRD(GL,2); GAPB(o[0]=__builtin_amdgcn_mfma_f32_32x32x16_bf16(PAF(2),VFR(2),o[0],0,0,0), C1,0); \
    KRD(GL,3); GAPB(o[1]=__builtin_amdgcn_mfma_f32_32x32x16_bf16(PAF(2),VFR(6),o[1],0,0,0), C1,4); \
    GAPB(o[0]=__builtin_amdgcn_mfma_f32_32x32x16_bf16(PAF(3),VFR(3),o[0],0,0,0), C1,8); \
    GAPB(o[1]=__builtin_amdgcn_mfma_f32_32x32x16_bf16(PAF(3),VFR(7),o[1],0,0,0), C1,12); \
    }while(0)
  int t=1;
  #undef CMASK
  #define CMASK(P0,P1,t) do{}while(0)
  for(;t+5<NT;t+=2){
    STEP(pB0,pB1,pA0,pA1,t,true,true,true);     WAIT_BAR(2); RESC(); ROT();
    STEP(pA0,pA1,pB0,pB1,t+1,true,true,true);   WAIT_BAR(2); RESC(); ROT();
  }
  #undef CMASK
  #define CMASK(P0,P1,t) do{ if(MODE==0&&a.band){int jb_=(t)-(NT-4); if(jb_>=0)cmask(P0,P1,jb_,qrel,hi);} }while(0)
  #define ENDW(tt) do{ if((tt)+3<NT){WAIT_BAR(2);} else if((tt)+2<NT){WAIT_BAR(1);} else {WAIT_BAR(0);} }while(0)
  for(;t+1<NT;t+=2){
    STEP(pB0,pB1,pA0,pA1,t,(t+3<NT),(t+1<NT),(t+1<NT));       ENDW(t);   RESC(); ROT();
    STEP(pA0,pA1,pB0,pB1,t+1,(t+4<NT),(t+2<NT),(t+2<NT));     ENDW(t+1); RESC(); ROT();
  }
  STEP(pB0,pB1,pA0,pA1,NT-1,false,false,false); RESC();
  { float sacc=pB0[0]+pB0[1]; _Pragma("unroll") for(int r=2;r<16;++r)sacc+=pB0[r]; _Pragma("unroll") for(int r=0;r<16;++r)sacc+=pB1[r]; l_reg+=sacc;
    pw0=(u32x4){PKW(pB0,0),PKW(pB0,2),PKW(pB0,4),PKW(pB0,6)};pw1=(u32x4){PKW(pB0,8),PKW(pB0,10),PKW(pB0,12),PKW(pB0,14)};pw2=(u32x4){PKW(pB1,0),PKW(pB1,2),PKW(pB1,4),PKW(pB1,6)};pw3=(u32x4){PKW(pB1,8),PKW(pB1,10),PKW(pB1,12),PKW(pB1,14)};
    SBAR(); pv(o,vb0+sl_cur,PAF(0),PAF(1),PAF(2),PAF(3)); }
  #undef PKW
  #undef PAF
  #undef VFR
  #undef PIN
  #undef MX3
  #undef GAPA
  #undef GAPB
  #undef EX
  #undef VRD
  #undef KRD
  #undef STEP
  #undef ENDW
  {auto rr=__builtin_amdgcn_permlane32_swap(__float_as_uint(l_reg),__float_as_uint(l_reg),false,false);l_reg=__uint_as_float(rr[0])+__uint_as_float(rr[1]);}
  if(MODE==1||(MODE==0&&a.lse)){ if(hi==0) a.lse[(long)(q0+qrel)*a.lse_stride]=mhat+__builtin_amdgcn_logf(l_reg); }
  if(hi==0)wsf[32+r32]=l_reg;asm volatile("s_waitcnt lgkmcnt(0)":::"memory");
  float rli[16];
  #pragma unroll
  for(int r=0;r<16;++r)rli[r]=__builtin_amdgcn_rcpf(wsf[32+crow(r,hi)]);
  bf16*Ow=a.O+(long)(q0+wid*QBLK)*a.op;
  { bf16*stg=(bf16*)(shm+LDS_OST)+wid*2048;
    #pragma unroll
    for(int r=0;r<16;++r){const int orow=crow(r,hi);
      #pragma unroll
      for(int d0=0;d0<2;++d0)stg[orow*64+d0*32+r32]=__float2bfloat16(o[d0][r]*rli[r]);}
    asm volatile("s_waitcnt lgkmcnt(0)":::"memory");
    #pragma unroll
    for(int i=0;i<4;++i){const int row=i*8+(lane>>3),ch=lane&7; const u32x4 v=*(const u32x4*)(stg+row*64+ch*8); ATTN_STORE16(Ow+(long)row*a.op+ch*8,v);} }
  asm volatile("s_waitcnt lgkmcnt(0)\n\ts_barrier":::"memory");
  #undef DMA_K
  #undef DMA_V
  #undef CMASK
  #undef CINIT
  #undef START
  #undef RESC
  #undef ROT
}
constexpr int ATTN_LDS_BYTES=LDS_TOTAL;
#undef SBAR
#undef WAIT_BAR
}
#define GAS __attribute__((address_space(1)))
#define LAS __attribute__((address_space(3)))
typedef unsigned short bf16;
typedef unsigned v4u __attribute__((ext_vector_type(4)));
typedef float f32x4 __attribute__((ext_vector_type(4)));
typedef short bf16x8 __attribute__((ext_vector_type(8)));
typedef GAS unsigned gu32;
typedef GAS unsigned long long gu64;
#define RLX_AGENT __ATOMIC_RELAXED, __HIP_MEMORY_SCOPE_AGENT
#define LDS_WAIT() asm volatile("s_waitcnt lgkmcnt(0)" ::: "memory")
#define VM_WAIT() asm volatile("s_waitcnt vmcnt(0)" ::: "memory")
__device__ __forceinline__ unsigned long long rt() { return __builtin_amdgcn_s_memrealtime(); }
__device__ __forceinline__ unsigned f2bf(float f) { unsigned u = __builtin_bit_cast(unsigned, f); return (u + 0x7fffu + ((u >> 16) & 1u)) >> 16; }
__device__ __forceinline__ unsigned pk4_fp8(float a, float b, float c, float d) { int w = __builtin_amdgcn_cvt_pk_fp8_f32(a, b, 0, false); w = __builtin_amdgcn_cvt_pk_fp8_f32(c, d, w, true); return (unsigned)w; }
__device__ __forceinline__ unsigned pk2(float lo, float hi) { typedef float f2_t __attribute__((ext_vector_type(2))); typedef __bf16 b2_t __attribute__((ext_vector_type(2))); f2_t v = {lo, hi}; b2_t b = __builtin_convertvector(v, b2_t); return __builtin_bit_cast(unsigned, b); }

#define XB_TMO      128
#define XB_XCNT(j)  (256  + 64 * (j))
#define XB_XSUB(j)  (1280 + 64 * (j))
#define XB_XGEN(j)  (2304 + 64 * (j))
#define XB_TOP      3328
#define XB_TOPGEN   3392
#define XCD_BAR_WORDS 3456
#define XB_SPIN_CAP (1u << 18)

__device__ __forceinline__ unsigned xb_ld(unsigned* p)              { return __hip_atomic_load(p, __ATOMIC_RELAXED, __HIP_MEMORY_SCOPE_AGENT); }
__device__ __forceinline__ unsigned xb_add(unsigned* p, unsigned v) { return __hip_atomic_fetch_add(p, v, __ATOMIC_RELAXED, __HIP_MEMORY_SCOPE_AGENT); }
__device__ __forceinline__ unsigned xb_xcc_id() { return (unsigned)__builtin_amdgcn_s_getreg((3 << 11) | 20) & 0xFu; }
#define XB_SPIN(cond, bar) do { unsigned _sp = 0; while (cond) { __builtin_amdgcn_s_sleep(1); \
    if ((++_sp & 255u) == 0u) { if (xb_ld(&(bar)[XB_TMO])) break; if (_sp > XB_SPIN_CAP) { atomicAdd(&(bar)[XB_TMO], 1u); break; } } } } while (0)

struct XcdBarrier {
    unsigned* bar; unsigned x;
    volatile LAS unsigned* st;
};

__device__ __forceinline__ XcdBarrier xcd_barrier_post(unsigned* bar, volatile LAS unsigned* st) {
    XcdBarrier b; b.bar = bar; b.x = xb_xcc_id(); b.st = st;
    if (threadIdx.x == 0) (void)xb_add(&bar[XB_XCNT(b.x)], 1u);
    return b;
}
__device__ __forceinline__ void xcd_barrier_complete(unsigned* bar, unsigned x, unsigned& nloc, unsigned& nx) {
    const unsigned G = gridDim.x * gridDim.y * gridDim.z;
    unsigned sum, cnt, mine, sp = 0u;
    for (;;) {
        sum = 0u; cnt = 0u; mine = 0u;
#pragma unroll
        for (unsigned j = 0; j < 16; ++j) { const unsigned c = xb_ld(&bar[XB_XCNT(j)]); sum += c; cnt += (c > 0u) ? 1u : 0u; mine = (j == x) ? c : mine; }
        if (sum == G) break;
        __builtin_amdgcn_s_sleep(1);
        if ((++sp & 255u) == 0u) { if (xb_ld(&bar[XB_TMO])) break; if (sp > XB_SPIN_CAP) { atomicAdd(&bar[XB_TMO], 1u); break; } }
    }
    nloc = mine > 0u ? mine : 1u; nx = cnt > 0u ? cnt : 1u;
}

__device__ __forceinline__ void xcd_barrier(const XcdBarrier& b) {
    asm volatile("s_waitcnt vmcnt(0)" ::: "memory");
    __syncthreads();
    if (threadIdx.x == 0) {
        unsigned* bar = b.bar;
        __builtin_amdgcn_s_waitcnt(0);
        unsigned nloc = b.st[0], nx = b.st[1];
        if (nloc == 0u) { xcd_barrier_complete(bar, b.x, nloc, nx); b.st[0] = nloc; b.st[1] = nx; }
        const unsigned old = xb_add(&bar[XB_XSUB(b.x)], 1u);
        const unsigned gen = old / nloc;
        if (old + 1u == (gen + 1u) * nloc) {
            __builtin_amdgcn_fence(__ATOMIC_RELEASE, "agent");
            asm volatile("s_waitcnt vmcnt(0)" ::: "memory");
            const unsigned og = xb_add(&bar[XB_TOP], 1u);
            const unsigned tg = og / nx;
            if (og + 1u == (tg + 1u) * nx) xb_add(&bar[XB_TOPGEN], 1u);
            else XB_SPIN(xb_ld(&bar[XB_TOPGEN]) == tg, bar);
            __builtin_amdgcn_fence(__ATOMIC_ACQUIRE, "agent");
            xb_add(&bar[XB_XGEN(b.x)], 1u);
            asm volatile("s_waitcnt vmcnt(0)" ::: "memory");
        } else {
            XB_SPIN(xb_ld(&bar[XB_XGEN(b.x)]) == gen, bar);
            __builtin_amdgcn_fence(__ATOMIC_ACQUIRE, "agent");
            asm volatile("s_waitcnt vmcnt(0)" ::: "memory");
        }
    }
    __syncthreads();
}

constexpr int NWAVES = 8;
constexpr int S = 16384, DM = 1024, NPROJ = 5632, NE = 32, MEML = 256;
constexpr int PC_FQ = 0, PC_FK = 384, PC_FV = 768, PC_DQ = 1152, PC_DK = 1536, PC_DV = 1920, PC_MQ = 2304, PC_GT = 2560;
constexpr int W_IN_LD = 5638, W_IN_F = 1152;
constexpr float LN_EPS = 1e-5f, ALPHA = 1.189207115002721f;
constexpr float LOG2E = 1.4426950408889634f, C2F = 0.125f * 1.4426950408889634f;
constexpr int MAXROWS = 65536 + 32 * 256;
constexpr int NPHASE = 11;
#ifndef MK_N_LAUNCHES
#define MK_N_LAUNCHES 1
#endif
constexpr int N_LAUNCHES = MK_N_LAUNCHES;

constexpr size_t MiB = 1u << 20, KiB = 1u << 10;
constexpr size_t WS_CTL = 0, CTL_ZERO_BYTES = 256 * KiB;
constexpr size_t WS_WIN = 2 * MiB;
constexpr size_t WS_WBF = 748 * MiB, WS_WBD = WS_WBF + 768 * KiB, WS_WBM = WS_WBD + 768 * KiB, WS_WOUT = 15 * MiB, WS_WMKV = 17 * MiB;
constexpr size_t WS_LF2 = 18 * MiB, WS_C2 = WS_LF2 + 512 * KiB, WS_LSE = 19 * MiB, WS_TBL = WS_LSE + 512 * KiB, WS_MEMB = 20 * MiB, WS_MEMKV = WS_MEMB + 512 * KiB;
constexpr size_t WS_TOPI = 21 * MiB, WS_TOPG = WS_TOPI + 256 * KiB, WS_RANK = WS_TOPG + 256 * KiB, WS_DEST = WS_RANK + 256 * KiB, WS_BLKCNT = 22 * MiB, WS_TST = WS_BLKCNT + 64 * KiB;
constexpr size_t WS_TOKROW = 23 * MiB;
constexpr size_t WS_IDMAP = 23 * MiB + 512 * KiB;
constexpr size_t WS_XB = 24 * MiB;
constexpr size_t WS_PBUF = 56 * MiB;
constexpr size_t WS_Y = WS_PBUF;
constexpr size_t WS_OFOX = 712 * MiB, WS_ODIL = 724 * MiB, WS_OMEM = 736 * MiB;
constexpr size_t WS_W1 = 264 * MiB, WS_W2 = 392 * MiB;
constexpr size_t WS_STASH = 456 * MiB, WS_MERGED = 520 * MiB;
constexpr size_t WS_R1 = 552 * MiB, WS_H1F8 = 616 * MiB, WS_XF8 = 632 * MiB, WS_WGF8 = 648 * MiB, WS_H1B = 680 * MiB;
constexpr int W1_SHIFT = 5;
constexpr size_t WS_XS = 712 * MiB, WS_ACT = 856 * MiB, WS_END = 1000 * MiB;
static_assert(WS_XS + (size_t)MAXROWS * 1024 * 2 <= WS_ACT && WS_ACT + (size_t)MAXROWS * 1024 * 2 <= WS_END && WS_Y + (size_t)MAXROWS * 1024 * 2 <= 232 * MiB && WS_WBM + 768 * KiB <= WS_ACT, "ws map");
constexpr int CW_BAR = 4096;
constexpr int CW_NRM = 64, CW_QHEAD = 128;
constexpr size_t WS_OPART = WS_STASH, WS_LSEF = WS_STASH + 48 * MiB;

constexpr int RING_OFF = 0;
constexpr int LDSCTL_OFF = attn_body::ATTN_LDS_BYTES, MISC_OFF = LDSCTL_OFF + 320, TBL_OFF = MISC_OFF + 128;
constexpr int LDS_BYTES = 150528;
static_assert(TBL_OFF + 256 <= LDS_BYTES && pg8::STAGE_BYTES <= LDSCTL_OFF, "LDS map");

struct Args { const float* in[20]; float* out; unsigned char* ws; int ph_lo, ph_hi, li, pad; };
struct Frame {
    LAS unsigned char* lds;
    volatile LAS unsigned* MISC;
    gu32* ctl;
    int tid, lane, wave;
    int vcu, G;
    float* out; unsigned char* ws;
};
__device__ __forceinline__ float wave_sum(float v) {
#pragma unroll
    for (int o = 1; o < 64; o <<= 1) v += __shfl_xor(v, o);
    return v;
}
typedef float f4u __attribute__((ext_vector_type(4), aligned(4)));
typedef float f32x2 __attribute__((ext_vector_type(2)));
typedef unsigned v2u __attribute__((ext_vector_type(2)));
__device__ __forceinline__ void p0_tr_item(const float* W, int ldw, int k0, int src_n0, bf16* WT, int K, int dst_n0, float scale, LAS float* scr, int lane) {
    f4u v[16];
#pragma unroll
    for (int i = 0; i < 16; ++i) v[i] = *(const f4u*)(W + (size_t)(k0 + 4 * i + (lane >> 4)) * ldw + src_n0 + (lane & 15) * 4);
#pragma unroll
    for (int i = 0; i < 16; ++i) { LAS float* d = scr + (4 * i + (lane >> 4)) * 65 + (lane & 15) * 4; d[0] = v[i].x * scale; d[1] = v[i].y * scale; d[2] = v[i].z * scale; d[3] = v[i].w * scale; }
    LDS_WAIT(); asm volatile("" ::: "memory");
    const int c = lane & 7;
#pragma unroll
    for (int j = 0; j < 8; ++j) { const int n = (lane >> 3) + 8 * j; const LAS float* s = scr + (8 * c) * 65 + n;
        v4u o; o.x = pk2(s[0 * 65], s[1 * 65]); o.y = pk2(s[2 * 65], s[3 * 65]); o.z = pk2(s[4 * 65], s[5 * 65]); o.w = pk2(s[6 * 65], s[7 * 65]);
        *(GAS v4u*)(WT + (size_t)(dst_n0 + n) * K + k0 + 8 * c) = o; }
    LDS_WAIT(); asm volatile("" ::: "memory");
}
constexpr int CV_E1 = 32 * 512, CV_E2 = 32 * 256, CV_UNITS = (CV_E1 + CV_E2) / 64;
struct CvItem { const float* W; bf16* WT; int ldw, k0, sn, dn, f8; };
__device__ __forceinline__ CvItem cv_decode(const Args& A, unsigned char* ws, int r) {
    CvItem c;
    if (r < CV_E1) { const int e = r >> 9, rr = r & 511, kb = rr >> 5, nb = rr & 31, dn = nb * 64; c.sn = ((dn >> 7) & 1) * 1024 + (dn >> 8) * 128 + (dn & 127); c.dn = dn; c.k0 = kb * 64; c.ldw = 2048;
        c.W = A.in[14] + (size_t)e * 1024 * 2048; c.WT = (bf16*)(ws + WS_W1 + (size_t)e * 2048 * 1024); c.f8 = 1 + W1_SHIFT; }
    else { r -= CV_E1; const int e = r >> 8, rr = r & 255, kb = rr >> 4, nb = rr & 15; c.sn = nb * 64; c.dn = nb * 64; c.k0 = kb * 64; c.ldw = 1024;
        c.W = A.in[16] + (size_t)e * 1024 * 1024; c.WT = (bf16*)(ws + WS_W2 + (size_t)e * 1024 * 1024); c.f8 = 1 + W1_SHIFT; }
    return c;
}
__device__ __forceinline__ void cv_load(f4u (&v)[16], const CvItem& c, int lane) {
#pragma unroll
    for (int i = 0; i < 16; ++i) v[i] = *(const f4u*)(c.W + (size_t)(c.k0 + 4 * i + (lane >> 4)) * c.ldw + c.sn + (lane & 15) * 4);
}
__device__ __forceinline__ void cv_store(const f4u (&v)[16], const CvItem& c, LAS float* scr, int lane) {
#pragma unroll
    for (int i = 0; i < 16; ++i) { LAS float* d = scr + (4 * i + (lane >> 4)) * 65 + (lane & 15) * 4; d[0] = v[i].x; d[1] = v[i].y; d[2] = v[i].z; d[3] = v[i].w; }
    LDS_WAIT(); asm volatile("" ::: "memory");
    const int cc = lane & 7;
#pragma unroll
    for (int j = 0; j < 8; ++j) { const int n = (lane >> 3) + 8 * j; const LAS float* sp = scr + (8 * cc) * 65 + n;
        v4u o; o.x = pk2(sp[0 * 65], sp[1 * 65]); o.y = pk2(sp[2 * 65], sp[3 * 65]); o.z = pk2(sp[4 * 65], sp[5 * 65]); o.w = pk2(sp[6 * 65], sp[7 * 65]);
        *(GAS v4u*)(c.WT + (size_t)(c.dn + n) * 1024 + c.k0 + 8 * cc) = o; }
    LDS_WAIT(); asm volatile("" ::: "memory");
}
__device__ __forceinline__ void cv_store_f8(const f4u (&v)[16], const CvItem& c, LAS float* scr, int lane) {
    const float sc = (float)(1 << (c.f8 - 1));
#pragma unroll
    for (int i = 0; i < 16; ++i) { LAS float* d = scr + (4 * i + (lane >> 4)) * 65 + (lane & 15) * 4; d[0] = v[i].x * sc; d[1] = v[i].y * sc; d[2] = v[i].z * sc; d[3] = v[i].w * sc; }
    LDS_WAIT(); asm volatile("" ::: "memory");
    const int cc = lane & 7; unsigned char* const WT8 = (unsigned char*)c.WT;
#pragma unroll
    for (int j = 0; j < 8; ++j) { const int n = (lane >> 3) + 8 * j; const LAS float* sp = scr + (8 * cc) * 65 + n;
        v2u o; o.x = pk4_fp8(sp[0 * 65], sp[1 * 65], sp[2 * 65], sp[3 * 65]); o.y = pk4_fp8(sp[4 * 65], sp[5 * 65], sp[6 * 65], sp[7 * 65]);
        *(GAS v2u*)(WT8 + (size_t)(c.dn + n) * 1024 + c.k0 + 8 * cc) = o; }
    LDS_WAIT(); asm volatile("" ::: "memory");
}
__device__ __forceinline__ void conv_unit(Frame& F, const Args& A, int cu) {
    LAS float* scr = (LAS float*)(F.lds + RING_OFF + F.wave * 16640);
    const int r0 = cu * 64 + F.wave * 8;
    f4u va[16], vb[16];
    CvItem ca = cv_decode(A, F.ws, r0), cb; cv_load(va, ca, F.lane);
#pragma unroll 1
    for (int i = 0; i < 8; i += 2) {
        cb = cv_decode(A, F.ws, r0 + i + 1); cv_load(vb, cb, F.lane);
        if (ca.f8) cv_store_f8(va, ca, scr, F.lane); else cv_store(va, ca, scr, F.lane);
        if (i + 2 < 8) { ca = cv_decode(A, F.ws, r0 + i + 2); cv_load(va, ca, F.lane); }
        if (cb.f8) cv_store_f8(vb, cb, scr, F.lane); else cv_store(vb, cb, scr, F.lane);
    }
}
__device__ __forceinline__ void p0_prologue(Frame& F, const Args& A) {
    LAS float* scr = (LAS float*)(F.lds + RING_OFF + F.wave * 16640);
    const int gw = F.vcu * NWAVES + F.wave, NGW = F.G * NWAVES;
    bf16* const WIN = (bf16*)(F.ws + WS_WIN); bf16* const WBF = (bf16*)(F.ws + WS_WBF); bf16* const WBD = (bf16*)(F.ws + WS_WBD); bf16* const WBM = (bf16*)(F.ws + WS_WBM);
    bf16* const WOUT = (bf16*)(F.ws + WS_WOUT); bf16* const WMKV = (bf16*)(F.ws + WS_WMKV);
    constexpr int I_IN = 16 * 88, I_BF = 6 * 16, I_BD = 6 * 16, I_BM = 4 * 16, I_WO = 16 * 16, I_MKV = 16 * 8;
    constexpr int NITEMS = I_IN + I_BF + I_BD + I_BM + I_WO + I_MKV;
    for (int it = gw; it < NITEMS; it += NGW) {
        int r = it;
        if (r < I_IN) { const int kb = r / 88, nb = r % 88, dn = nb * 64; const int sn = dn + (dn >= W_IN_F ? 6 : 0);
            const float sc = (dn < PC_FK || (dn >= PC_DQ && dn < PC_DK) || (dn >= PC_MQ && dn < PC_GT)) ? C2F : 1.0f;
            { CvItem c; c.W = A.in[2]; c.WT = (bf16*)(F.ws + WS_WGF8); c.ldw = W_IN_LD; c.k0 = kb * 64; c.sn = sn; c.dn = dn; c.f8 = 1 + 6;
              f4u v[16]; cv_load(v, c, F.lane);
              if (sc != 1.0f) {
#pragma unroll
                  for (int i = 0; i < 16; ++i) { v[i].x *= sc; v[i].y *= sc; v[i].z *= sc; v[i].w *= sc; } }
              cv_store_f8(v, c, scr, F.lane); }
            continue; } r -= I_IN;
        if (r < I_BF) { const int kb = r >> 4, nb = r & 15; p0_tr_item(A.in[6], 1024, kb * 64, nb * 64, WBF, 384, nb * 64, 1.0f, scr, F.lane); continue; } r -= I_BF;
        if (r < I_BD) { const int kb = r >> 4, nb = r & 15; p0_tr_item(A.in[7], 1024, kb * 64, nb * 64, WBD, 384, nb * 64, 1.0f, scr, F.lane); continue; } r -= I_BD;
        if (r < I_BM) { const int kb = r >> 4, nb = r & 15; p0_tr_item(A.in[8], 1024, kb * 64, nb * 64, WBM, 384, nb * 64, 1.0f, scr, F.lane); continue; } r -= I_BM;
        if (r < I_WO) { const int kb = r >> 4, nb = r & 15; p0_tr_item(A.in[9], 1024, kb * 64, nb * 64, WOUT, 1024, nb * 64, 1.0f, scr, F.lane); continue; } r -= I_WO;
        { const int kb = r >> 3, nb = r & 7; p0_tr_item(A.in[5], 512, kb * 64, nb * 64, WMKV, 1024, nb * 64, 1.0f, scr, F.lane); }
    }
    {
        float wf[4][4][6];
#pragma unroll
        for (int j = 0; j < 4; ++j)
#pragma unroll
            for (int i = 0; i < 4; ++i)
#pragma unroll
                for (int h = 0; h < 6; ++h) wf[j][i][h] = A.in[2][(size_t)(4 * F.lane + i + 256 * j) * W_IN_LD + W_IN_F + h];
        float* const LF2 = (float*)(F.ws + WS_LF2);
        f32x4 vnx[4];
        if (gw < S) { const GAS f32x4* xr0 = (const GAS f32x4*)(A.in[0] + (size_t)gw * DM) + F.lane;
#pragma unroll
            for (int j = 0; j < 4; ++j) vnx[j] = xr0[64 * j]; }
        for (int m = gw; m < S; m += NGW) {
            f32x4 v[4]; float d[6] = {0.f, 0.f, 0.f, 0.f, 0.f, 0.f};
#pragma unroll
            for (int j = 0; j < 4; ++j) v[j] = vnx[j];
            if (m + NGW < S) { const GAS f32x4* xr1 = (const GAS f32x4*)(A.in[0] + (size_t)(m + NGW) * DM) + F.lane;
#pragma unroll
                for (int j = 0; j < 4; ++j) vnx[j] = xr1[64 * j]; }
#pragma unroll
            for (int j = 0; j < 4; ++j)
#pragma unroll
                for (int h = 0; h < 6; ++h) d[h] += v[j].x * wf[j][0][h] + v[j].y * wf[j][1][h] + v[j].z * wf[j][2][h] + v[j].w * wf[j][3][h];
#pragma unroll
            for (int h = 0; h < 6; ++h) d[h] = wave_sum(d[h]);
            { GAS unsigned* o4 = (GAS unsigned*)(F.ws + WS_XF8 + (size_t)m * DM) + F.lane;
#pragma unroll
              for (int j = 0; j < 4; ++j) o4[64 * j] = pk4_fp8(v[j].x, v[j].y, v[j].z, v[j].w); }
            if (F.lane < 6) { const int h = F.lane; float f = h == 0 ? d[0] : h == 1 ? d[1] : h == 2 ? d[2] : h == 3 ? d[3] : h == 4 ? d[4] : d[5];
                f += A.in[3][h]; const float ls = fminf(f, 0.f) - log1pf(expf(-fabsf(f)));
                LF2[(size_t)h * S + m] = ls * LOG2E; }
        }
        bf16* const MEMB = (bf16*)(F.ws + WS_MEMB);
        for (int m = gw; m < MEML; m += NGW) {
            const GAS f32x4* xr = (const GAS f32x4*)(A.in[1] + (size_t)m * DM) + F.lane; GAS unsigned long long* o8 = (GAS unsigned long long*)(MEMB + (size_t)m * DM) + F.lane;
#pragma unroll
            for (int j = 0; j < 4; ++j) { const f32x4 v = xr[64 * j]; o8[64 * j] = (unsigned long long)pk2(v.x, v.y) | ((unsigned long long)pk2(v.z, v.w) << 32); }
        }
    }
    { const int gt = F.vcu * (NWAVES * 64) + F.tid, GT = F.G * NWAVES * 64; const v4u z = {0u, 0u, 0u, 0u};
      for (int i = gt; i < 1024 * 16; i += GT) *(GAS v4u*)((bf16*)(F.ws + WS_WBM) + (size_t)(i >> 4) * 384 + 256 + (i & 15) * 8) = z;
      for (int i = gt; i < S * 16; i += GT) *(GAS v4u*)((bf16*)(F.ws + WS_OMEM) + (size_t)(i >> 4) * 384 + 256 + (i & 15) * 8) = z; }
    {
        float* const TBL = (float*)(F.ws + WS_TBL);
        for (int idx = F.vcu * (NWAVES * 64) + F.tid; idx < 6 * attn_body::TBL_N; idx += F.G * NWAVES * 64) {
            const int hd = idx / attn_body::TBL_N, i = idx - hd * attn_body::TBL_N, rel = i - attn_body::TBL_ZERO, g = hd >> 1, dil = g == 0 ? 1 : (g == 1 ? 4 : 16);
            float val = -INFINITY;
            if (rel >= 0 && rel <= 128) { const int dist = rel * dil; int bucket = dist;
                if (dist >= 16) { const float nf = (float)dist; bucket = 16 + (int)(logf(nf / 16.0f) / 4.852030263919617f * 16.0f); bucket = bucket > 31 ? 31 : bucket; }
                val = A.in[4][bucket * 6 + hd] * LOG2E; }
            TBL[idx] = val;
        }
    }
}

__device__ __forceinline__ void p1_cumsum(Frame& F, int h) {
    const float* src = (const float*)(F.ws + WS_LF2) + (size_t)h * S + F.tid * 32; float* dst = (float*)(F.ws + WS_C2) + (size_t)h * S + F.tid * 32;
    LAS double* part = (LAS double*)(F.lds + RING_OFF);
    f32x4 v[8]; double s = 0.0;
#pragma unroll
    for (int i = 0; i < 8; ++i) { v[i] = *(const f32x4*)(src + 4 * i); s += (double)v[i].x; s += (double)v[i].y; s += (double)v[i].z; s += (double)v[i].w; }
    part[F.tid] = s; __syncthreads();
    double run = 0.0;
    for (int j = 0; j < F.tid; ++j) run += part[j];
#pragma unroll
    for (int i = 0; i < 8; ++i) { f32x4 o; run += (double)v[i].x; o.x = (float)run; run += (double)v[i].y; o.y = (float)run; run += (double)v[i].z; o.z = (float)run; run += (double)v[i].w; o.w = (float)run; *(f32x4*)(dst + 4 * i) = o; }
    __syncthreads();
}

constexpr int P2_NA = 600, P2_NB = 360, P2_NC = 384, P2_ND = 256, P2_UNITS = P2_NA + P2_NB + P2_NC + P2_ND;
__device__ __forceinline__ void p2_attention(Frame& F, const Args& A, char* lds, int li) {
    typedef attn_body::bf16 abf;
    abf* const PB = (abf*)(F.ws + WS_PBUF);
    volatile LAS int* qslot = (volatile LAS int*)(F.lds + MISC_OFF + 64);
    for (;;) {
        if (F.tid == 0) qslot[0] = (int)__hip_atomic_fetch_add(F.ctl + CW_QHEAD + 64 * li, 1u, __ATOMIC_RELAXED, __HIP_MEMORY_SCOPE_AGENT);
        __syncthreads();
        const int pos = __builtin_amdgcn_readfirstlane(qslot[0]);
        __syncthreads();
        if (pos >= P2_UNITS + CV_UNITS) break;
        if (pos % 4 == 3 && pos / 4 < CV_UNITS) { conv_unit(F, A, pos / 4); __syncthreads(); continue; }
        const int idx = pos - (pos / 4 < CV_UNITS ? pos / 4 : CV_UNITS);
        attn_body::AttnArgs a; a.tlo = 0; a.thi = 0; a.band = 0; a.thr = 0.f;
        if (idx < P2_NA + P2_NB) {
            int h, qb, sgm;
            if (idx < P2_NA) { h = idx % 6; const int b = idx / 6; if (b < 49) { sgm = 0; qb = 15 + b; } else if (b < 82) { sgm = 1; qb = 31 + (b - 49); } else if (b < 99) { sgm = 2; qb = 47 + (b - 82); } else { sgm = 3; qb = 63; } }
            else { const int b2 = idx - P2_NA; h = b2 % 6; const int c = b2 / 6; const int L = 60 - 4 * (c >> 2); sgm = c & 3; qb = 16 * sgm + L / 4 - 1; }
            const int ntf = 4 * qb + 4, nseg = (ntf + 63) >> 6;
            const float q2 = __uint_as_float(__hip_atomic_load(F.ctl + CW_NRM + 2 * h, RLX_AGENT)) + __uint_as_float(__hip_atomic_load(F.ctl + CW_NRM + 2 * h + 1, RLX_AGENT)), k2 = __uint_as_float(__hip_atomic_load(F.ctl + CW_NRM + 12 + 2 * h, RLX_AGENT)) + __uint_as_float(__hip_atomic_load(F.ctl + CW_NRM + 13 + 2 * h, RLX_AGENT));
            const float qkmax = 1.02f * sqrtf(q2 * k2);
            a.Q = PB + PC_FQ + h * 64; a.K = PB + PC_FK + h * 64; a.V = PB + PC_FV + h * 64; a.qp = NPROJ; a.kp = NPROJ; a.op = 384;
            a.q0 = qb * 256; a.NT = 0; a.kv0 = 0; a.aux = (const float*)(F.ws + WS_C2) + (size_t)h * S;
            a.tlo = 64 * sgm; a.thi = (a.tlo + 64 < ntf) ? a.tlo + 64 : ntf; a.band = (sgm == nseg - 1) ? 1 : 0;
            a.thr = 160.0f + 2.0f * qkmax;
            if (nseg == 1) { a.O = (abf*)(F.ws + WS_OFOX) + h * 64; a.lse = nullptr; a.lse_stride = 0; }
            else { a.O = (abf*)(F.ws + WS_OPART) + (size_t)sgm * S * 384 + h * 64; a.lse = (float*)(F.ws + WS_LSEF) + (size_t)sgm * S * 6 + h; a.lse_stride = 6; }
            attn_body::attn_unit<0, 8>(a, lds);
        } else if (idx < P2_NA + P2_NB + P2_NC) { const int du = idx - (P2_NA + P2_NB); const int g = du >> 7, hs = (du >> 6) & 1, w = du & 63; const int dl = g == 0 ? 1 : (g == 1 ? 4 : 16); const int r = w % dl, qb = w / dl, hd = g * 2 + hs;
            const int t0 = 4 * qb - 2 > 0 ? 4 * qb - 2 : 0; const long pitch = (long)dl * NPROJ;
            a.Q = PB + PC_DQ + hd * 64 + (long)r * NPROJ; a.K = PB + PC_DK + hd * 64 + (long)r * NPROJ + (long)t0 * 64 * pitch; a.V = PB + PC_DV + hd * 64 + (long)r * NPROJ + (long)t0 * 64 * pitch;
            a.O = (abf*)(F.ws + WS_ODIL) + hd * 64 + (long)r * 384; a.qp = pitch; a.kp = pitch; a.op = (long)dl * 384;
            a.q0 = qb * 256; a.NT = 4 * qb + 4 - t0; a.kv0 = t0 * 64; a.aux = (const float*)(F.ws + WS_TBL) + hd * attn_body::TBL_N; a.lse = (float*)(F.ws + WS_LSE) + r * 6 + hd; a.lse_stride = (long)dl * 6;
            attn_body::attn_unit<1, 8>(a, lds);
        } else { const int mu = idx - (P2_NA + P2_NB + P2_NC); const int h = mu >> 6, qb = mu & 63; abf* const MKV = (abf*)(F.ws + WS_MEMKV);
            a.Q = PB + PC_MQ + h * 64; a.K = MKV + h * 64; a.V = MKV + 256 + h * 64; a.O = (abf*)(F.ws + WS_OMEM) + h * 64; a.qp = NPROJ; a.kp = 512; a.op = 384;
            a.q0 = qb * 256; a.NT = 4; a.kv0 = 0; a.aux = nullptr; a.lse = nullptr; a.lse_stride = 0;
            attn_body::attn_unit<2, 8>(a, lds);
        }
    }
}
__device__ __forceinline__ void p3_fox_combine(Frame& F) {
    const float* LSEF = (const float*)(F.ws + WS_LSEF); const bf16* OP = (const bf16*)(F.ws + WS_OPART); bf16* const OF = (bf16*)(F.ws + WS_OFOX);
    for (int it = blockIdx.x * (NWAVES * 64) + F.tid; it < (S - 4096) * 48; it += F.G * NWAVES * 64) {
        const int tok = 4096 + it / 48, rem = it % 48, h = rem >> 3, ch = rem & 7, nseg = (tok >> 12) + 1;
        float l[4]; float mx = -INFINITY;
#pragma unroll
        for (int sg = 0; sg < 4; ++sg) { l[sg] = (sg < nseg) ? LSEF[((size_t)sg * S + tok) * 6 + h] : -INFINITY; mx = fmaxf(mx, l[sg]); }
        float acc[8] = {0.f, 0.f, 0.f, 0.f, 0.f, 0.f, 0.f, 0.f}; float den = 0.f;
#pragma unroll
        for (int sg = 0; sg < 4; ++sg) { const float w = __builtin_amdgcn_exp2f(l[sg] - mx);
            if (w > 0.f) { const v4u x = *(const v4u*)(OP + ((size_t)sg * S + tok) * 384 + h * 64 + ch * 8); den += w;
                acc[0] += w * __uint_as_float(x.x << 16); acc[1] += w * __uint_as_float(x.x & 0xffff0000u); acc[2] += w * __uint_as_float(x.y << 16); acc[3] += w * __uint_as_float(x.y & 0xffff0000u);
                acc[4] += w * __uint_as_float(x.z << 16); acc[5] += w * __uint_as_float(x.z & 0xffff0000u); acc[6] += w * __uint_as_float(x.w << 16); acc[7] += w * __uint_as_float(x.w & 0xffff0000u); } }
        const float inv = 1.0f / den; v4u o; o.x = pk2(acc[0] * inv, acc[1] * inv); o.y = pk2(acc[2] * inv, acc[3] * inv); o.z = pk2(acc[4] * inv, acc[5] * inv); o.w = pk2(acc[6] * inv, acc[7] * inv);
        *(v4u*)(OF + (size_t)tok * 384 + h * 64 + ch * 8) = o;
    }
}
__device__ __forceinline__ void p3_dil_weights(Frame& F) {
    const float* LSE = (const float*)(F.ws + WS_LSE); bf16* const OD = (bf16*)(F.ws + WS_ODIL);
    for (int it = blockIdx.x * (NWAVES * 64) + F.tid; it < S * 48; it += F.G * NWAVES * 64) {
        const int tok = it / 48, rem = it - tok * 48, hd = rem >> 3, ch = rem & 7, hs = hd & 1, g = hd >> 1;
        const float l0 = LSE[tok * 6 + hs], l1 = LSE[tok * 6 + 2 + hs], l2 = LSE[tok * 6 + 4 + hs];
        const float mx = fmaxf(l0, fmaxf(l1, l2)); const float e0 = __builtin_amdgcn_exp2f(l0 - mx), e1 = __builtin_amdgcn_exp2f(l1 - mx), e2 = __builtin_amdgcn_exp2f(l2 - mx);
        const float w = (g == 0 ? e0 : (g == 1 ? e1 : e2)) / (e0 + e1 + e2);
        v4u* p = (v4u*)(OD + (size_t)tok * 384 + hd * 64 + ch * 8); v4u x = *p;
        x.x = pk2(__uint_as_float(x.x << 16) * w, __uint_as_float(x.x & 0xffff0000u) * w); x.y = pk2(__uint_as_float(x.y << 16) * w, __uint_as_float(x.y & 0xffff0000u) * w);
        x.z = pk2(__uint_as_float(x.z << 16) * w, __uint_as_float(x.z & 0xffff0000u) * w); x.w = pk2(__uint_as_float(x.w << 16) * w, __uint_as_float(x.w & 0xffff0000u) * w);
        *p = x;
    }
}
typedef float f32x16m __attribute__((ext_vector_type(16)));
__device__ __forceinline__ void p6_ln_router(Frame& F, const Args& A) {
    LAS float* hl = (LAS float*)(F.lds + RING_OFF);
    LAS float* part = hl;
    LAS float* lgt = (LAS float*)(F.lds + RING_OFF + 32768);
    LAS int* se = (LAS int*)(F.lds + RING_OFF + 131328);
    const bf16* R1 = (const bf16*)(F.ws + WS_R1); bf16* const H1B = (bf16*)(F.ws + WS_H1B); unsigned char* const H1F8 = F.ws + WS_H1F8;
    int* const TOPI = (int*)(F.ws + WS_TOPI); float* const TOPG = (float*)(F.ws + WS_TOPG); int* const RANK = (int*)(F.ws + WS_RANK); int* const BLKCNT = (int*)(F.ws + WS_BLKCNT);
    const float* lg1 = A.in[10]; const float* lb1 = A.in[11]; const float* wr = A.in[12]; const float* br = A.in[13];
    float wreg[64];
    { const float* bp = wr + (size_t)(128 * F.wave + (F.lane >> 5)) * 32 + (F.lane & 31);
#pragma unroll
      for (int st = 0; st < 64; ++st) wreg[st] = bp[64 * st]; }
    for (int rb = blockIdx.x; rb < S / 64; rb += F.G) {
        for (int half = 0; half < 2; ++half) {
            f32x4 vr[4][4];
#pragma unroll
            for (int j = 0; j < 4; ++j)
#pragma unroll
                for (int q = 0; q < 4; ++q) { const v2u t = *((const v2u*)(R1 + ((size_t)rb * 64 + half * 32 + F.wave * 4 + j) * DM) + F.lane + 64 * q);
                    vr[j][q] = (f32x4){__builtin_bit_cast(float, t.x << 16), __builtin_bit_cast(float, t.x & 0xffff0000u), __builtin_bit_cast(float, t.y << 16), __builtin_bit_cast(float, t.y & 0xffff0000u)}; }
#pragma unroll
            for (int j = 0; j < 4; ++j) {
                const int lr = F.wave * 4 + j; const size_t row = (size_t)rb * 64 + half * 32 + lr;
                f32x4 v[4]; float s = 0.f;
#pragma unroll
                for (int q = 0; q < 4; ++q) { v[q] = vr[j][q]; s += (v[q].x + v[q].y) + (v[q].z + v[q].w); }
                const float mean = wave_sum(s) * (1.f / DM); float s2 = 0.f;
#pragma unroll
                for (int q = 0; q < 4; ++q) { v[q] = v[q] - mean; s2 += (v[q].x * v[q].x + v[q].y * v[q].y) + (v[q].z * v[q].z + v[q].w * v[q].w); }
                const float rstd = 1.f / sqrtf(wave_sum(s2) * (1.f / DM) + LN_EPS);
#pragma unroll
                for (int q = 0; q < 4; ++q) { const f32x4 gv = *((const f32x4*)lg1 + F.lane + 64 * q), bv = *((const f32x4*)lb1 + F.lane + 64 * q); const f32x4 h = v[q] * rstd * gv + bv;
                    *((v2u*)(H1B + row * DM) + F.lane + 64 * q) = (v2u){pk2(h.x, h.y), pk2(h.z, h.w)};
                    *((unsigned*)(H1F8 + row * DM) + F.lane + 64 * q) = pk4_fp8(h.x, h.y, h.z, h.w);
                    LAS float* d = hl + lr * 1025 + 4 * F.lane + 256 * q; d[0] = h.x; d[1] = h.y; d[2] = h.z; d[3] = h.w; }
            }
            __syncthreads();
            f32x16m acc = {0.f, 0.f, 0.f, 0.f, 0.f, 0.f, 0.f, 0.f, 0.f, 0.f, 0.f, 0.f, 0.f, 0.f, 0.f, 0.f};
            { const int kk = F.lane >> 5; const LAS float* ap = hl + (F.lane & 31) * 1025 + 128 * F.wave + kk;
#pragma unroll
              for (int st = 0; st < 64; ++st) acc = __builtin_amdgcn_mfma_f32_32x32x2f32(ap[2 * st], wreg[st], acc, 0, 0, 0); }
            __syncthreads();
            { const int kk = F.lane >> 5;
#pragma unroll
              for (int r = 0; r < 16; ++r) part[(F.wave * 32 + ((r & 3) + 8 * (r >> 2) + 4 * kk)) * 32 + (F.lane & 31)] = acc[r]; }
            __syncthreads();
#pragma unroll
            for (int q = 0; q < 2; ++q) { const int p = F.tid + 512 * q, i = p >> 5, jx = p & 31; float sm = 0.f;
#pragma unroll
                for (int w = 0; w < 8; ++w) sm += part[(w * 32 + i) * 32 + jx];
                lgt[i * 33 + jx] = sm + br[jx]; }
            __syncthreads();
            if (F.tid < 32) { const int i = F.tid; const size_t row = (size_t)rb * 64 + half * 32 + i; float bv[4]; int bi[4];
                unsigned taken = 0u;
#pragma unroll
                for (int kx = 0; kx < 4; ++kx) { float best = -INFINITY; int be = 0;
                    for (int e = 0; e < 32; ++e) { const float x = lgt[i * 33 + e]; const bool take = (((taken >> e) & 1u) == 0u) && (x > best); best = take ? x : best; be = take ? e : be; }
                    bv[kx] = best; bi[kx] = be; taken |= 1u << be; }
                const float e1 = expf(bv[1] - bv[0]), e2 = expf(bv[2] - bv[0]), e3 = expf(bv[3] - bv[0]); const float inv = 1.f / (1.f + e1 + e2 + e3);
                *(int4*)(TOPI + row * 4) = make_int4(bi[0], bi[1], bi[2], bi[3]); *(f32x4*)(TOPG + row * 4) = (f32x4){inv, e1 * inv, e2 * inv, e3 * inv};
                const int lrow = half * 32 + i; se[lrow * 4 + 0] = bi[0]; se[lrow * 4 + 1] = bi[1]; se[lrow * 4 + 2] = bi[2]; se[lrow * 4 + 3] = bi[3]; }
            __syncthreads();
        }
        if (F.tid < 256) { const int e = se[F.tid]; int rk = 0; for (int q = 0; q < F.tid; ++q) rk += (se[q] == e) ? 1 : 0; RANK[rb * 256 + F.tid] = rk; }
        else if (F.tid < 288) { const int e = F.tid - 256; int c = 0; for (int q = 0; q < 256; ++q) c += (se[q] == e) ? 1 : 0; BLKCNT[rb * 32 + e] = c; }
        __syncthreads();
    }
}
__device__ __forceinline__ void p7_scatter(Frame& F) {
    LAS int* ptot = (LAS int*)(F.lds + RING_OFF); LAS int* ppre = ptot + 512; LAS int* epre = ppre + 512; LAS int* tst = epre + 32; LAS int* dsts = tst + 64;
    const int* BLKCNT = (const int*)(F.ws + WS_BLKCNT); const int* TOPI = (const int*)(F.ws + WS_TOPI); const int* RANK = (const int*)(F.ws + WS_RANK);
    int* const DEST = (int*)(F.ws + WS_DEST); int* const TST = (int*)(F.ws + WS_TST); int* const TOKROW = (int*)(F.ws + WS_TOKROW);
    { int* const IDM = (int*)(F.ws + WS_IDMAP); for (int i = blockIdx.x * (NWAVES * 64) + F.tid; i < MAXROWS; i += F.G * NWAVES * 64) IDM[i] = i; }
    for (int rb = blockIdx.x; rb < S / 64; rb += F.G) {
        { const int part = F.tid >> 5, e = F.tid & 31; int tot = 0, pre = 0;
          for (int b = part * 16; b < part * 16 + 16; ++b) { const int c = BLKCNT[b * 32 + e]; tot += c; pre += (b < rb) ? c : 0; }
          ptot[part * 32 + e] = tot; ppre[part * 32 + e] = pre; }
        __syncthreads();
        if (F.tid < 32) { int T = 0, P = 0; for (int p = 0; p < 16; ++p) { T += ptot[p * 32 + F.tid]; P += ppre[p * 32 + F.tid]; } ptot[F.tid] = T; epre[F.tid] = P; }
        __syncthreads();
        if (F.tid == 0) { int t = 0; for (int e = 0; e < 32; ++e) { tst[e] = t; t += (ptot[e] + 255) >> 8; } tst[32] = t;
            if (rb == 0) { for (int e = 0; e <= 32; ++e) TST[e] = tst[e]; } }
        __syncthreads();
        if (F.tid < 256) { const size_t a = (size_t)rb * 256 + F.tid; const int e = TOPI[a]; const int d = tst[e] * 256 + epre[e] + RANK[a]; DEST[a] = d; TOKROW[d] = (int)(a >> 2); }
        if (rb == 0) { for (int e = 0; e < 32; ++e) { const int c = ptot[e], base = tst[e] * 256, padn = (tst[e + 1] - tst[e]) * 256 - c; for (int p = F.tid; p < padn; p += NWAVES * 64) TOKROW[base + c + p] = 0; } }
        __syncthreads();
    }
}
__device__ __forceinline__ void p10_combine(Frame& F, const Args& A) {
    const int gw = F.vcu * NWAVES + F.wave, NGW = F.G * NWAVES;
    const bf16* H1B = (const bf16*)(F.ws + WS_H1B); const bf16* Y = (const bf16*)(F.ws + WS_Y); const int* DEST = (const int*)(F.ws + WS_DEST); const float* TOPG = (const float*)(F.ws + WS_TOPG);
    const float* g2 = A.in[18]; const float* b2 = A.in[19];
    int4 ddn; f32x4 ggn; v2u hbn[4]; unsigned yn[4][4];
#define P10_LOAD_IDX(m_) do { ddn = *(const int4*)(DEST + (size_t)(m_) * 4); ggn = *(const f32x4*)(TOPG + (size_t)(m_) * 4); } while (0)
#define P10_LOAD_ROWS(m_) do { _Pragma("unroll") for (int j = 0; j < 4; ++j) hbn[j] = *((const v2u*)(H1B + (size_t)(m_) * DM) + F.lane + 64 * j); \
        _Pragma("unroll") for (int k = 0; k < 4; ++k) { const int d_ = k == 0 ? ddn.x : (k == 1 ? ddn.y : (k == 2 ? ddn.z : ddn.w)); \
            _Pragma("unroll") for (int j = 0; j < 4; ++j) yn[k][j] = *((const unsigned*)((const unsigned char*)Y + (size_t)d_ * DM) + F.lane + 64 * j); } } while (0)
    int m = gw; if (m >= S) return;
    P10_LOAD_IDX(m); P10_LOAD_ROWS(m);
    for (; m < S; m += NGW) {
        const f32x4 gg = ggn; f32x4 v[4]; float s = 0.f;
#pragma unroll
        for (int j = 0; j < 4; ++j) v[j] = (f32x4){__uint_as_float(hbn[j].x << 16), __uint_as_float(hbn[j].x & 0xffff0000u), __uint_as_float(hbn[j].y << 16), __uint_as_float(hbn[j].y & 0xffff0000u)} * ALPHA;
#pragma unroll
        for (int k = 0; k < 4; ++k) { const float g = k == 0 ? gg.x : (k == 1 ? gg.y : (k == 2 ? gg.z : gg.w));
#pragma unroll
            for (int j = 0; j < 4; ++j) { const unsigned y = yn[k][j]; typedef float f2_ __attribute__((ext_vector_type(2)));
                const f2_ lo = __builtin_amdgcn_cvt_pk_f32_fp8((int)y, false), hi = __builtin_amdgcn_cvt_pk_f32_fp8((int)y, true);
                v[j].x += g * lo.x; v[j].y += g * lo.y; v[j].z += g * hi.x; v[j].w += g * hi.y; } }
        const int mn = m + NGW;
        if (mn < S) { P10_LOAD_IDX(mn); P10_LOAD_ROWS(mn); }
#pragma unroll
        for (int j = 0; j < 4; ++j) s += (v[j].x + v[j].y) + (v[j].z + v[j].w);
        const float mean = wave_sum(s) * (1.f / DM); float s2 = 0.f;
#pragma unroll
        for (int j = 0; j < 4; ++j) { v[j] = v[j] - mean; s2 += (v[j].x * v[j].x + v[j].y * v[j].y) + (v[j].z * v[j].z + v[j].w * v[j].w); }
        const float rstd = 1.f / sqrtf(wave_sum(s2) * (1.f / DM) + LN_EPS);
#pragma unroll
        for (int j = 0; j < 4; ++j) { const f32x4 gv = *((const f32x4*)g2 + F.lane + 64 * j), bv = *((const f32x4*)b2 + F.lane + 64 * j);
            *((f32x4*)(F.out + (size_t)m * DM) + F.lane + 64 * j) = v[j] * rstd * gv + bv; }
    }
#undef P10_LOAD_IDX
#undef P10_LOAD_ROWS
}

__global__ void __launch_bounds__(NWAVES * 64, 2) mk_fwd(Args args) {
    extern __shared__ __attribute__((aligned(16))) unsigned char lds[];
    Frame F;
    F.lds = (LAS unsigned char*)lds;
    F.MISC = (volatile LAS unsigned*)(F.lds + MISC_OFF);
    F.tid = threadIdx.x; F.lane = F.tid & 63; F.wave = __builtin_amdgcn_readfirstlane(F.tid >> 6);
    F.G = gridDim.x; { const int bx = blockIdx.x; F.vcu = (F.G % 8 == 0) ? (bx % 8) * (F.G / 8) + bx / 8 : bx; }
    F.ws = args.ws; F.out = args.out; F.ctl = (gu32*)(args.ws + WS_CTL);
    unsigned char* const ws = args.ws;
    for (int u = F.tid; u < (LDS_BYTES - LDSCTL_OFF) / 4; u += NWAVES * 64) ((LAS unsigned*)(F.lds + LDSCTL_OFF))[u] = 0u;
    __syncthreads();
    XcdBarrier bar = xcd_barrier_post((unsigned*)(F.ctl + CW_BAR) + args.li * XCD_BAR_WORDS, F.MISC + 8);
#define GRID_BAR() xcd_barrier(bar)
    const int lo = args.ph_lo, hi = args.ph_hi;
#ifndef PHASE_MASK
#define PHASE_MASK 0x7ff
#endif
#define IN(k) (((PHASE_MASK >> (k)) & 1) && lo <= (k) && (k) < hi)
#define BOTH(k) (IN(k) && IN((k) + 1))
    typedef pg8::bf16_t pbf;
    pbf* const PBUF = (pbf*)(ws + WS_PBUF);

    if (IN(0)) { p0_prologue(F, args); if (BOTH(0)) GRID_BAR(); }

    if (IN(1)) {
        { pg8::Gemm g{(const pbf*)(ws + WS_XF8), (const pbf*)(ws + WS_WGF8), S, NPROJ, DM / 2, nullptr, 0x7C7C7C7C, 0x7C7C7C7C}; pg8::StaticOrder So; So.init(S, NPROJ, F.G, (int)blockIdx.x); So.lightA = F.G / 2; So.lightB = F.G / 2 + 1; So.RL = 4;
          pg8::EpiProj E{PBUF, NPROJ, PC_GT / 256, (unsigned*)(F.ctl + CW_NRM)};
          pg8::gemm_phase<pg8::EpiProj, pg8::StaticOrder, true, true, true, true>(F.lds + RING_OFF, g, So, E); }
        { pg8::Gemm g{(const pbf*)(ws + WS_MEMB), (const pbf*)(ws + WS_WMKV), MEML, 512, DM, nullptr, 0, 0}; pg8::StaticOrder So; So.init(MEML, 512, F.G, (int)((blockIdx.x + F.G / 2) % F.G));
          pg8::EpiBf16Plain E{(pbf*)(ws + WS_MEMKV), 512};
          pg8::gemm_phase<pg8::EpiBf16Plain, pg8::StaticOrder, true, true>(F.lds + RING_OFF, g, So, E); }
        if ((int)blockIdx.x >= F.G - 6) p1_cumsum(F, F.G - 1 - (int)blockIdx.x);
        if (BOTH(1)) GRID_BAR();
    }

    if (IN(2)) { p2_attention(F, args, (char*)lds + RING_OFF, args.li); if (BOTH(2)) GRID_BAR(); }

    if (IN(3)) { p3_fox_combine(F); p3_dil_weights(F); if (BOTH(3)) GRID_BAR(); }

    if (IN(4)) {
        pg8::Gemm g{(const pbf*)(ws + WS_OFOX), (const pbf*)(ws + WS_WBF), S, DM, 384, nullptr, 0, 0, (size_t)S * 384 * 2, (size_t)DM * 384 * 2};
        pg8::MergeOrder So; So.so.init(S, DM, F.G, (int)blockIdx.x);
        pg8::EpiMergeChain E{PBUF + PC_GT, NPROJ, (pbf*)(ws + WS_MERGED), DM};
        pg8::gemm_phase<pg8::EpiMergeChain, pg8::MergeOrder, true, true>(F.lds + RING_OFF, g, So, E);
        if (BOTH(4)) GRID_BAR();
    }

    if (IN(5)) {
        pg8::Gemm g{(const pbf*)(ws + WS_MERGED), (const pbf*)(ws + WS_WOUT), S, DM, DM, nullptr, 0, 0}; pg8::StaticOrder So; So.init(S, DM, F.G, (int)blockIdx.x);
        pg8::EpiRes E{args.in[0], (pbf*)(ws + WS_R1), DM, ALPHA};
        pg8::gemm_phase<pg8::EpiRes, pg8::StaticOrder, true, true>(F.lds + RING_OFF, g, So, E);
        if (BOTH(5)) GRID_BAR();
    }

    if (IN(6)) { p6_ln_router(F, args); if (BOTH(6)) GRID_BAR(); }

    if (IN(7)) { p7_scatter(F); if (BOTH(7)) GRID_BAR(); }

    if (IN(8)) {
        LAS int* tbl = (LAS int*)(F.lds + TBL_OFF);
        if (F.tid < 33) tbl[F.tid] = ((const int*)(ws + WS_TST))[F.tid];
        __syncthreads();
        pg8::Gemm g{(const pbf*)(ws + WS_H1F8), (const pbf*)(ws + WS_W1), MAXROWS, 2048, DM / 2, (const int*)(ws + WS_TOKROW), 0x7F7F7F7F, 0x7F7F7F7F}; pg8::MoeOrder So{tbl, 8, F.G, F.vcu};
        pg8::EpiSwiglu E{(pbf*)(ws + WS_ACT), args.in[15], 1.0f / (float)(1 << W1_SHIFT), (const LAS float*)(F.lds + RING_OFF + pg8::STAGE_BYTES + 5120)};
        pg8::gemm_phase<pg8::EpiSwiglu, pg8::MoeOrder, true, true, true, true>(F.lds + RING_OFF, g, So, E);
        if (BOTH(8)) GRID_BAR();
    }

    if (IN(9)) {
        LAS int* tbl = (LAS int*)(F.lds + TBL_OFF);
        if (F.tid < 33) tbl[F.tid] = ((const int*)(ws + WS_TST))[F.tid];
        __syncthreads();
        pg8::Gemm g{(const pbf*)(ws + WS_ACT), (const pbf*)(ws + WS_W2), MAXROWS, 1024, DM / 2, nullptr, 0x7F7F7F7F, 0x7F7F7F7F}; pg8::MoeOrder So{tbl, 4, F.G, F.vcu};
        pg8::EpiY E{(pbf*)(ws + WS_Y), args.in[17], 1.0f / (float)(1 << W1_SHIFT), (const LAS float*)(F.lds + RING_OFF + pg8::STAGE_BYTES + 5120)};
        pg8::gemm_phase<pg8::EpiY, pg8::MoeOrder, true, true, true, true>(F.lds + RING_OFF, g, So, E);
        if (BOTH(9)) GRID_BAR();
    }

    if (IN(10)) { p10_combine(F, args); }
#undef IN
#undef BOTH
#undef GRID_BAR
}

extern "C" void kernel_launch(void* const* d_in, const int* in_sizes, int n_in, void* d_out, int out_size, void* d_ws, size_t ws_size, hipStream_t stream) {
    static int grid = 0;
    if (grid == 0) {
        if (n_in != 20 || in_sizes[0] != S * DM || out_size != S * DM || ws_size < WS_END) { fprintf(stderr, "kernel_launch: built for 20 inputs, x/out of %d floats, >= %zu bytes of workspace; got n_in %d, in0 %d, out %d, ws %zu; nothing launched\n", S * DM, (size_t)WS_END, n_in, n_in > 0 ? in_sizes[0] : -1, out_size, ws_size); grid = -1; return; }
        int dev = 0, cus = 0, per_cu = 0;
        if (hipGetDevice(&dev) != hipSuccess || hipDeviceGetAttribute(&cus, hipDeviceAttributeMultiprocessorCount, dev) != hipSuccess) { fprintf(stderr, "kernel_launch: hipGetDevice / hipDeviceGetAttribute failed; nothing launched\n"); grid = -1; return; }
        if (hipFuncSetAttribute((const void*)mk_fwd, hipFuncAttributeMaxDynamicSharedMemorySize, LDS_BYTES) != hipSuccess) { fprintf(stderr, "kernel_launch: hipFuncSetAttribute failed (%d bytes of dynamic LDS); nothing launched\n", LDS_BYTES); grid = -1; return; }
        if (hipOccupancyMaxActiveBlocksPerMultiprocessor(&per_cu, (const void*)mk_fwd, NWAVES * 64, LDS_BYTES) != hipSuccess || per_cu < 1)
            fprintf(stderr, "kernel_launch: note: the occupancy query reports %d workgroups per CU\n", per_cu);
        (void)hipGetLastError();
        grid = cus;
    }
    if (grid < 0) return;
    if (hipMemsetAsync((char*)d_ws + WS_CTL, 0, CTL_ZERO_BYTES, stream) != hipSuccess) { fprintf(stderr, "kernel_launch: hipMemsetAsync of the control words failed; nothing launched\n"); return; }
    Args a{};
    for (int i = 0; i < 20; ++i) a.in[i] = (const float*)d_in[i];
    a.out = (float*)d_out; a.ws = (unsigned char*)d_ws;
#ifdef PROBE_PHASE
    const int nl = (PROBE_PHASE + 1 < NPHASE) ? 3 : 2; const int cut_lo[3] = {0, PROBE_PHASE, PROBE_PHASE + 1}, cut_hi[3] = {PROBE_PHASE + 1, PROBE_PHASE + 1, NPHASE};
#else
    const int nl = N_LAUNCHES; int cut_lo[NPHASE], cut_hi[NPHASE]; for (int i = 0; i < NPHASE; ++i) { cut_lo[i] = (N_LAUNCHES == 1) ? 0 : i; cut_hi[i] = (N_LAUNCHES == 1) ? NPHASE : i + 1; }
#endif
    for (int li = 0; li < nl; ++li) {
        a.ph_lo = cut_lo[li]; a.ph_hi = cut_hi[li]; a.li = li;
        hipLaunchKernelGGL(mk_fwd, dim3(grid), dim3(NWAVES * 64), LDS_BYTES, stream, a);
        const hipError_t le = hipPeekAtLastError();
        if (le != hipSuccess) { fprintf(stderr, "kernel_launch: launch %d failed: %s\n", li, hipGetErrorName(le)); break; }
    }
}
```

```cpp
#include <hip/hip_runtime.h>
#include <hip/hip_bf16.h>
#include <cstdio>
#include <cstdint>
#include <cmath>
namespace pg8 {
#define PG8_LAS __attribute__((address_space(3)))
typedef unsigned short bf16_t;
typedef short bf16x8 __attribute__((ext_vector_type(8)));
typedef float f32x4 __attribute__((ext_vector_type(4)));
typedef unsigned u32x4 __attribute__((ext_vector_type(4)));
constexpr int BM = 256, BK = 64, HALF = 128, HTB = HALF * BK * 2  , STAGE_BYTES = 8 * HTB, NXCD = 8, WGM = 8;

__host__ __device__ __forceinline__ int lds_byte(int r, int c) { const int st = (r >> 4) * 2 + (c >> 5), rr = r & 15, cc = c & 31, ob = rr * 64 + cc * 2; return st * 1024 + (ob ^ (((ob >> 9) & 1) << 5)); }
__host__ __device__ __forceinline__ void stage_rc(int b, int& R, int& C) { const int st = b / 1024, sb = b % 1024, swz = sb ^ (((sb >> 9) & 1) << 5); R = (st >> 1) * 16 + swz / 64; C = (st & 1) * 32 + (swz % 64) / 2; }
__host__ __device__ __forceinline__ int perm32(int rho) { const int n = rho >> 4, i = rho & 15; return 8 * (i >> 2) + 4 * n + (i & 3); }

struct Unit { int pm, pn, e, slot, b; };
typedef int v8i_t_half __attribute__((ext_vector_type(4)));
typedef int v8i_t __attribute__((ext_vector_type(8)));
typedef short s16x16_t __attribute__((ext_vector_type(16)));
struct Gemm { const bf16_t* A; const bf16_t* Bt; int M, N, K; const int* rowmap; int scale_a, scale_b; size_t strideA = 0, strideB = 0; };

struct StaticOrder {
    int nM, nN, nwg, G, c; int lightA = -1, lightB = -1, RL = 0;
    __host__ __device__ void init(int M, int N, int G_, int c_) { nM = M / BM; nN = N / BM; nwg = nM * nN; G = G_; c = c_; }
    __host__ __device__ bool next(int i, Unit& u) const {
        long L = (long)i * G + c;
        if (lightA >= 0 && i >= RL) { if (c == lightA || c == lightB) return false; L = (long)RL * G + (long)(i - RL) * (G - 2) + (c - (c > lightA ? 1 : 0) - (c > lightB ? 1 : 0)); }
        if (L >= nwg) return false;
        int wgid = (int)L; { const int q = nwg / NXCD, r = nwg % NXCD, xcd = wgid % NXCD, off = wgid / NXCD; wgid = (xcd < r ? xcd * (q + 1) : r * (q + 1) + (xcd - r) * q) + off; }
        const int nig = WGM * nN, gid = wgid / nig, fm = gid * WGM, gsz = (nM - fm) < WGM ? (nM - fm) : WGM;
        u.pm = fm + ((wgid % nig) % gsz); u.pn = (wgid % nig) / gsz; u.e = 0; u.b = 0; return true;
    }
    __device__ __forceinline__ void a_ready(const Unit&) const {}
    __device__ __forceinline__ void done(const Unit&) const {}
};

__device__ __forceinline__ unsigned cvt_pk_bf16(float lo, float hi) { unsigned r; asm volatile("v_cvt_pk_bf16_f32 %0, %1, %2" : "=v"(r) : "v"(lo), "v"(hi)); return r; }
__device__ __forceinline__ float bf_lo(unsigned w) { return __uint_as_float(w << 16); }
__device__ __forceinline__ float bf_hi(unsigned w) { return __uint_as_float(w & 0xffff0000u); }
__device__ __forceinline__ float sigmoid_f(float v) { return __builtin_amdgcn_rcpf(1.0f + __builtin_amdgcn_exp2f(-1.4426950408889634f * v)); }
typedef unsigned u32x2 __attribute__((ext_vector_type(2)));
__device__ __forceinline__ unsigned ror8(unsigned v) { return (unsigned)__builtin_amdgcn_update_dpp(0, (int)v, 0x128, 0xf, 0xf, false); }
__device__ __forceinline__ u32x4 sel4(bool c, const u32x4& a, const u32x4& b) { u32x4 r; r.x = c ? a.x : b.x; r.y = c ? a.y : b.y; r.z = c ? a.z : b.z; r.w = c ? a.w : b.w; return r; }
__device__ __forceinline__ u32x4 ror8x4(const u32x4& a) { u32x4 r; r.x = ror8(a.x); r.y = ror8(a.y); r.z = ror8(a.z); r.w = ror8(a.w); return r; }
__device__ __forceinline__ void fl_store(unsigned char* lanep, size_t pitch8, const u32x4& p0, const u32x4& p1, bool lo) {
    const u32x4 y = ror8x4(sel4(lo, p1, p0)); *(u32x4*)lanep = sel4(lo, p0, y); *(u32x4*)(lanep + pitch8) = sel4(lo, y, p1); }
__device__ __forceinline__ void fl_load(const unsigned char* lanep, size_t pitch8, u32x4& p0, u32x4& p1, bool lo) {
    const u32x4 a = *(const u32x4*)lanep, b = *(const u32x4*)(lanep + pitch8); const u32x4 y = ror8x4(sel4(lo, b, a)); p0 = sel4(lo, a, y); p1 = sel4(lo, y, b); }

struct EpiBf16Plain {
    static constexpr bool PERM = true, AFTER_DRAIN = false; static constexpr bool CHAIN = false; static constexpr bool LDS_BIAS = false;
    bf16_t* O; int ldc;
    __device__ __forceinline__ void operator()(const f32x4 (&acc)[2][2][4][2], const Unit& u, int wr, int wc, int fr, int fq) const {
        const int row0 = u.pm * BM + wr * 64 + fr, col0 = u.pn * BM + wc * 32 + 8 * fq;
#pragma unroll
        for (int ai = 0; ai < 2; ++ai)
#pragma unroll
            for (int m = 0; m < 4; ++m) { bf16_t* rowp = O + (size_t)(row0 + ai * HALF + m * 16) * ldc + col0;
#pragma unroll
                for (int bj = 0; bj < 2; ++bj) { const f32x4 v0 = acc[ai][bj][m][0], v1 = acc[ai][bj][m][1];
                    u32x4 w; w.x = cvt_pk_bf16(v0[0], v0[1]); w.y = cvt_pk_bf16(v0[2], v0[3]); w.z = cvt_pk_bf16(v1[0], v1[1]); w.w = cvt_pk_bf16(v1[2], v1[3]);
                    *(u32x4*)(rowp + bj * HALF) = w; } }
    }
};
struct EpiProj {
    static constexpr bool PERM = true, PERM16 = true, AFTER_DRAIN = false; static constexpr bool CHAIN = false; static constexpr bool LDS_BIAS = false;
    bf16_t* O; int ldc; int sig_from; unsigned* nrm;
    __device__ __forceinline__ void operator()(const f32x4 (&acc)[2][2][4][2], const Unit& u, int wr, int wc, int fr, int fq) const {
        const bool sg = u.pn >= sig_from, lo = fr < 8;
        if (u.pn < 3) {
            float mx = 0.f;
#pragma unroll
            for (int ai = 0; ai < 2; ++ai)
#pragma unroll
                for (int m = 0; m < 4; ++m) { float ss = 0.f;
#pragma unroll
                    for (int bj = 0; bj < 2; ++bj) { const f32x4 a0 = acc[ai][bj][m][0], a1 = acc[ai][bj][m][1];
                        ss += (a0[0] * a0[0] + a0[1] * a0[1]) + (a0[2] * a0[2] + a0[3] * a0[3]) + (a1[0] * a1[0] + a1[1] * a1[1]) + (a1[2] * a1[2] + a1[3] * a1[3]); }
                    ss += __shfl_xor(ss, 16); ss += __shfl_xor(ss, 32); mx = fmaxf(mx, ss); }
            mx = fmaxf(mx, __shfl_xor(mx, 1)); mx = fmaxf(mx, __shfl_xor(mx, 2)); mx = fmaxf(mx, __shfl_xor(mx, 4)); mx = fmaxf(mx, __shfl_xor(mx, 8));
            if (fr == 0 && fq == 0) atomicMax(nrm + 2 * (u.pn * 4 + wc), __float_as_uint(mx));
        }
        unsigned char* const lanep = (unsigned char*)(O + (size_t)(u.pm * BM + wr * 64 + (fr & 7)) * ldc + u.pn * BM + wc * 64) + (2 * fq + (fr >> 3)) * 16; const size_t pitch = (size_t)ldc * 2;
#pragma unroll
        for (int ai = 0; ai < 2; ++ai)
#pragma unroll
            for (int m = 0; m < 4; ++m) { u32x4 p[2];
#pragma unroll
                for (int bj = 0; bj < 2; ++bj) { f32x4 v0 = acc[ai][bj][m][0], v1 = acc[ai][bj][m][1];
                    if (sg) {
#pragma unroll
                        for (int j = 0; j < 4; ++j) { v0[j] = sigmoid_f(v0[j]); v1[j] = sigmoid_f(v1[j]); } }
                    p[bj].x = cvt_pk_bf16(v0[0], v0[1]); p[bj].y = cvt_pk_bf16(v0[2], v0[3]); p[bj].z = cvt_pk_bf16(v1[0], v1[1]); p[bj].w = cvt_pk_bf16(v1[2], v1[3]); }
                fl_store(lanep + (size_t)(ai * HALF + m * 16) * pitch, 8 * pitch, p[0], p[1], lo); }
    }
};
struct EpiGate {
    static constexpr bool PERM = true, AFTER_DRAIN = false; static constexpr bool CHAIN = false; static constexpr bool LDS_BIAS = false;
    bf16_t* O; int ldc; int col_off; float ascale;
    __device__ __forceinline__ void operator()(const f32x4 (&acc)[2][2][4][2], const Unit& u, int wr, int wc, int fr, int fq) const {
        const int row0 = u.pm * BM + wr * 64 + fr, col0 = col_off + u.pn * BM + wc * 32 + 8 * fq;
#pragma unroll
        for (int ai = 0; ai < 2; ++ai)
#pragma unroll
            for (int m = 0; m < 4; ++m) { bf16_t* rowp = O + (size_t)(row0 + ai * HALF + m * 16) * ldc + col0;
#pragma unroll
                for (int bj = 0; bj < 2; ++bj) { f32x4 v0 = acc[ai][bj][m][0] * ascale, v1 = acc[ai][bj][m][1] * ascale;
#pragma unroll
                    for (int j = 0; j < 4; ++j) { v0[j] = sigmoid_f(v0[j]); v1[j] = sigmoid_f(v1[j]); }
                    u32x4 w; w.x = cvt_pk_bf16(v0[0], v0[1]); w.y = cvt_pk_bf16(v0[2], v0[3]); w.z = cvt_pk_bf16(v1[0], v1[1]); w.w = cvt_pk_bf16(v1[2], v1[3]);
                    *(u32x4*)(rowp + bj * HALF) = w; } }
    }
};
template <int PASS> struct EpiMerge {
    static constexpr bool PERM = false, AFTER_DRAIN = false; static constexpr bool CHAIN = false; static constexpr bool LDS_BIAS = false;
    const bf16_t* gate; int ldg; bf16_t* stash; bf16_t* outb; int ldc;
    __device__ __forceinline__ void operator()(const f32x4 (&acc)[2][2][4][2], const Unit& u, int wr, int wc, int fr, int fq) const {
        const int row0 = u.pm * BM + wr * 64 + fr, col0 = u.pn * BM + wc * 32 + 4 * fq;
#pragma unroll
        for (int ai = 0; ai < 2; ++ai)
#pragma unroll
            for (int m = 0; m < 4; ++m) { const size_t r = (size_t)(row0 + ai * HALF + m * 16);
#pragma unroll
                for (int bj = 0; bj < 2; ++bj)
#pragma unroll
                    for (int n = 0; n < 2; ++n) { const int c = col0 + bj * HALF + n * 16;
                        const u32x2 gv = *(const u32x2*)(gate + r * ldg + c);
                        f32x4 v = acc[ai][bj][m][n]; v[0] *= bf_lo(gv.x); v[1] *= bf_hi(gv.x); v[2] *= bf_lo(gv.y); v[3] *= bf_hi(gv.y);
                        if (PASS > 0) { const u32x2 sv = *(const u32x2*)(stash + r * ldc + c); v[0] += bf_lo(sv.x); v[1] += bf_hi(sv.x); v[2] += bf_lo(sv.y); v[3] += bf_hi(sv.y); }
                        u32x2 w; w.x = cvt_pk_bf16(v[0], v[1]); w.y = cvt_pk_bf16(v[2], v[3]);
                        if (PASS < 2) *(u32x2*)(stash + r * ldc + c) = w; else *(u32x2*)(outb + r * ldc + c) = w; }
                asm volatile("" ::: "memory"); }
    }
};
struct EpiRes {
    static constexpr bool PERM = true, AFTER_DRAIN = false; static constexpr bool CHAIN = false; static constexpr bool LDS_BIAS = false;
    const float* x; bf16_t* out; int ldc; float alpha;
    __device__ __forceinline__ void operator()(const f32x4 (&acc)[2][2][4][2], const Unit& u, int wr, int wc, int fr, int fq) const {
        const int row0 = u.pm * BM + wr * 64 + fr, col0 = u.pn * BM + wc * 32 + 8 * fq; const bool lo = fr < 8; const size_t xp = (size_t)ldc * 4;
        const unsigned char* const xl = (const unsigned char*)(x + (size_t)(u.pm * BM + wr * 64 + (fr & 7)) * ldc + u.pn * BM + wc * 32) + (2 * fq + (fr >> 3)) * 16;
#pragma unroll
        for (int ai = 0; ai < 2; ++ai)
#pragma unroll
            for (int m = 0; m < 4; ++m) { const size_t off = (size_t)(row0 + ai * HALF + m * 16) * ldc + col0;
#pragma unroll
                for (int bj = 0; bj < 2; ++bj) { u32x4 q0, q1; fl_load(xl + (size_t)(ai * HALF + m * 16) * xp + bj * HALF * 4, 8 * xp, q0, q1, lo);
                    const f32x4 x0 = __builtin_bit_cast(f32x4, q0), x1 = __builtin_bit_cast(f32x4, q1);
                    const f32x4 v0 = x0 * alpha + acc[ai][bj][m][0], v1 = x1 * alpha + acc[ai][bj][m][1];
                    u32x4 w; w.x = cvt_pk_bf16(v0[0], v0[1]); w.y = cvt_pk_bf16(v0[2], v0[3]); w.z = cvt_pk_bf16(v1[0], v1[1]); w.w = cvt_pk_bf16(v1[2], v1[3]);
                    *(u32x4*)(out + off + bj * HALF) = w; } }
    }
};
struct EpiMergeChain {
    static constexpr bool PERM = true, PERM16 = true, AFTER_DRAIN = false; static constexpr bool LDS_BIAS = false; static constexpr bool CHAIN = true;
    const bf16_t* gate; int ldg; bf16_t* outb; int ldc;
    __device__ __forceinline__ void operator()(f32x4 (&acc)[2][2][4][2], const Unit& u, int wr, int wc, int fr, int fq) const {
        const int b = u.b; const bool lo = fr < 8; const size_t gp = (size_t)ldg * 2, op = (size_t)ldc * 2;
        const size_t lrow = (size_t)(u.pm * BM + wr * 64 + (fr & 7)); const int lcol = u.pn * BM + wc * 64, lpc = (2 * fq + (fr >> 3)) * 16;
        const unsigned char* const gl = (const unsigned char*)(gate + lrow * ldg + b * 1024 + lcol) + lpc; unsigned char* const ol = (unsigned char*)(outb + lrow * ldc + lcol) + lpc;
#pragma unroll
        for (int ai = 0; ai < 2; ++ai)
#pragma unroll
            for (int m = 0; m < 4; ++m) { const size_t ro = (size_t)(ai * HALF + m * 16);
                u32x4 gq[2], gn[2] = {{0u, 0u, 0u, 0u}, {0u, 0u, 0u, 0u}}; fl_load(gl + ro * gp, 8 * gp, gq[0], gq[1], lo);
                if (b < 2) fl_load(gl + ro * gp + 2048, 8 * gp, gn[0], gn[1], lo);
                u32x4 w[2];
#pragma unroll
                for (int bj = 0; bj < 2; ++bj) { const u32x4 gv = gq[bj];
                    f32x4 g0, g1; g0[0] = bf_lo(gv.x); g0[1] = bf_hi(gv.x); g0[2] = bf_lo(gv.y); g0[3] = bf_hi(gv.y); g1[0] = bf_lo(gv.z); g1[1] = bf_hi(gv.z); g1[2] = bf_lo(gv.w); g1[3] = bf_hi(gv.w);
                    if (b > 0) {
#pragma unroll
                        for (int j = 0; j < 4; ++j) { g0[j] = fmaxf(g0[j], 1e-6f); g1[j] = fmaxf(g1[j], 1e-6f); } }
                    f32x4 v0 = acc[ai][bj][m][0] * g0, v1 = acc[ai][bj][m][1] * g1;
                    if (b < 2) { const u32x4 gx = gn[bj];
                        v0[0] *= __builtin_amdgcn_rcpf(fmaxf(bf_lo(gx.x), 1e-6f)); v0[1] *= __builtin_amdgcn_rcpf(fmaxf(bf_hi(gx.x), 1e-6f)); v0[2] *= __builtin_amdgcn_rcpf(fmaxf(bf_lo(gx.y), 1e-6f)); v0[3] *= __builtin_amdgcn_rcpf(fmaxf(bf_hi(gx.y), 1e-6f));
                        v1[0] *= __builtin_amdgcn_rcpf(fmaxf(bf_lo(gx.z), 1e-6f)); v1[1] *= __builtin_amdgcn_rcpf(fmaxf(bf_hi(gx.z), 1e-6f)); v1[2] *= __builtin_amdgcn_rcpf(fmaxf(bf_lo(gx.w), 1e-6f)); v1[3] *= __builtin_amdgcn_rcpf(fmaxf(bf_hi(gx.w), 1e-6f));
                        acc[ai][bj][m][0] = v0; acc[ai][bj][m][1] = v1; }
                    else { w[bj].x = cvt_pk_bf16(v0[0], v0[1]); w[bj].y = cvt_pk_bf16(v0[2], v0[3]); w[bj].z = cvt_pk_bf16(v1[0], v1[1]); w[bj].w = cvt_pk_bf16(v1[2], v1[3]); } }
                if (b == 2) fl_store(ol + ro * op, 8 * op, w[0], w[1], lo);
                asm volatile("" ::: "memory"); }
    }
};
struct MergeOrder {
    StaticOrder so;
    __device__ __forceinline__ bool next(int i, Unit& u) const { if (!so.next(i / 3, u)) return false; u.b = i % 3; return true; }
    __device__ __forceinline__ void a_ready(const Unit&) const {}
    __device__ __forceinline__ void done(const Unit&) const {}
};
struct EpiSwiglu {
    static constexpr bool PERM = true, AFTER_DRAIN = false; static constexpr bool CHAIN = false;
    bf16_t* O; const float* b1; float ascale; const PG8_LAS float* lb;
    static constexpr bool LDS_BIAS = true;
    __device__ __forceinline__ const float* bias_src(const Unit& u, int lane) const { const int e = u.e, pnl = u.pn - e * 8; return b1 + (size_t)e * 2048 + (lane >> 5) * 1024 + pnl * 128 + (lane & 31) * 4; }
    __device__ __forceinline__ void operator()(const f32x4 (&acc)[2][2][4][2], const Unit& u, int wr, int wc, int fr, int fq) const {
        const int e = u.e, pnl = u.pn - e * 8; const int row0 = u.pm * BM + wr * 64 + fr;
        f32x4 bg[2], bl[2]; const PG8_LAS float* lbs = lb + u.slot * 256 + wc * 32 + 8 * fq;
#pragma unroll
        for (int n = 0; n < 2; ++n) { bg[n] = *(const PG8_LAS f32x4*)(lbs + 4 * n); bl[n] = *(const PG8_LAS f32x4*)(lbs + 128 + 4 * n); }
        unsigned char* const lanep = (unsigned char*)O + (size_t)(row0 + (fq & 1) * 16) * 1024 + pnl * 128 + wc * 32 + 8 * (fq & 2);
#pragma unroll
        for (int ai = 0; ai < 2; ++ai)
#pragma unroll
            for (int p = 0; p < 2; ++p) { u32x2 w[2];
#pragma unroll
                for (int q = 0; q < 2; ++q) { const int m = 2 * p + q; f32x4 o[2];
#pragma unroll
                    for (int n = 0; n < 2; ++n) { const f32x4 g = acc[ai][0][m][n] * ascale + bg[n], l = acc[ai][1][m][n] * ascale + bl[n];
#pragma unroll
                        for (int j = 0; j < 4; ++j) { const float gg = fminf(g[j], 7.0f), ll = fminf(fmaxf(l[j], -7.0f), 7.0f);
                            o[n][j] = gg * __builtin_amdgcn_rcpf(1.0f + __builtin_amdgcn_exp2f(-1.702f * 1.4426950408889634f * gg)) * (ll + 1.0f); } }
                    int t0 = __builtin_amdgcn_cvt_pk_fp8_f32(o[0][0], o[0][1], 0, false); t0 = __builtin_amdgcn_cvt_pk_fp8_f32(o[0][2], o[0][3], t0, true);
                    int t1 = __builtin_amdgcn_cvt_pk_fp8_f32(o[1][0], o[1][1], 0, false); t1 = __builtin_amdgcn_cvt_pk_fp8_f32(o[1][2], o[1][3], t1, true); w[q].x = (unsigned)t0; w[q].y = (unsigned)t1; }
                const auto r0 = __builtin_amdgcn_permlane16_swap(w[0].x, w[1].x, false, false), r1 = __builtin_amdgcn_permlane16_swap(w[0].y, w[1].y, false, false);
                u32x4 out; out.x = r0[0]; out.y = r1[0]; out.z = r0[1]; out.w = r1[1];
                *(u32x4*)(lanep + (size_t)(ai * HALF + p * 32) * 1024) = out; }
    }
};
struct EpiY {
    static constexpr bool PERM = true, PERM16 = true, AFTER_DRAIN = false; static constexpr bool CHAIN = false;
    bf16_t* O; const float* b2; float ascale; const PG8_LAS float* lb;
    static constexpr bool LDS_BIAS = true;
    __device__ __forceinline__ const float* bias_src(const Unit& u, int lane) const { const int e = u.e, pnl = u.pn - e * 4; return b2 + (size_t)e * 1024 + pnl * BM + lane * 4; }
    __device__ __forceinline__ void operator()(const f32x4 (&acc)[2][2][4][2], const Unit& u, int wr, int wc, int fr, int fq) const {
        const int e = u.e, pnl = u.pn - e * 4; const int row0 = u.pm * BM + wr * 64 + fr, col0 = pnl * BM + wc * 64 + 16 * fq;
        f32x4 bv[2][2]; const PG8_LAS float* lbs = lb + u.slot * 256 + wc * 64 + 16 * fq;
#pragma unroll
        for (int bj = 0; bj < 2; ++bj)
#pragma unroll
            for (int n = 0; n < 2; ++n) bv[bj][n] = *(const PG8_LAS f32x4*)(lbs + 8 * bj + 4 * n);
#pragma unroll
        for (int ai = 0; ai < 2; ++ai)
#pragma unroll
            for (int m = 0; m < 4; ++m) { unsigned char* rowp = (unsigned char*)O + (size_t)(row0 + ai * HALF + m * 16) * 1024 + col0;
                u32x4 w;
#pragma unroll
                for (int bj = 0; bj < 2; ++bj) { const f32x4 v0 = acc[ai][bj][m][0] * ascale + bv[bj][0], v1 = acc[ai][bj][m][1] * ascale + bv[bj][1];
                    int t0 = __builtin_amdgcn_cvt_pk_fp8_f32(v0[0], v0[1], 0, false); t0 = __builtin_amdgcn_cvt_pk_fp8_f32(v0[2], v0[3], t0, true);
                    int t1 = __builtin_amdgcn_cvt_pk_fp8_f32(v1[0], v1[1], 0, false); t1 = __builtin_amdgcn_cvt_pk_fp8_f32(v1[2], v1[3], t1, true);
                    if (bj == 0) { w.x = (unsigned)t0; w.y = (unsigned)t1; } else { w.z = (unsigned)t0; w.w = (unsigned)t1; } }
                *(u32x4*)rowp = w; }
    }
};
struct MoeOrder {
    const PG8_LAS int* tstart; int nN, G, vcu;
    __device__ __forceinline__ int ts(int k) const { return __builtin_amdgcn_readfirstlane(tstart[k]); }
    __device__ __forceinline__ bool next(int i, Unit& u) const {
        const int L = i * G + vcu; const int T = ts(32); if (L >= T * nN) return false;
        int e = 0;
#pragma unroll
        for (int k = 1; k < 32; ++k) e += (L >= ts(k) * nN) ? 1 : 0;
        const int t0 = ts(e), R = ts(e + 1) - t0; const int rem = L - t0 * nN; const int ng = rem / (4 * R); const int r2 = rem - ng * 4 * R; const int pnl = r2 / R; const int pmi = r2 - pnl * R;
        u.pm = t0 + pmi; u.pn = e * nN + ng * 4 + pnl; u.e = e; u.b = 0; return true;
    }
    __device__ __forceinline__ void a_ready(const Unit&) const {}
    __device__ __forceinline__ void done(const Unit&) const {}
};
template <class E, class = void> struct has_p16 { static constexpr bool v = false; };
template <class E> struct has_p16<E, decltype((void)E::PERM16)> { static constexpr bool v = E::PERM16; };
template <class Epi, class Sched, bool ALIGN_EPI = false, bool SP2 = false, bool GATHER = false, bool FP8 = false>
__device__ __forceinline__ void gemm_phase(PG8_LAS unsigned char* lds, const Gemm g, const Sched& S, const Epi& E) {
    static_assert(!GATHER || SP2, "GATHER is wired into the SP2 loop only");
    int tid_ = threadIdx.x; asm volatile("" : "+v"(tid_));
    const int tid = tid_, wid = __builtin_amdgcn_readfirstlane(tid >> 6), lane = tid & 63, wr = wid >> 2, wc = wid & 3, fr = lane & 15, fq = lane >> 4;
    int K_ = g.K; asm volatile("" : "+s"(K_));
    const int K = K_, nt = K / BK;
    constexpr bool P16 = has_p16<Epi>::v;
    unsigned voffA[2], voffB[2];
#pragma unroll
    for (int i = 0; i < 2; ++i) { int R, C; stage_rc(tid * 16 + i * 8192, R, C); const int Rb = P16 ? ((R >> 5) * 64 + 16 * ((R & 15) >> 2) + 4 * ((R >> 4) & 1) + (R & 3)) : Epi::PERM ? ((R & ~31) + perm32(R & 31)) : R;
        voffA[i] = (unsigned)(R * K + C) * 2u; voffB[i] = (unsigned)(Rb * K + C) * 2u; }
    unsigned vC[2][2] = {{0u, 0u}, {0u, 0u}};
    const PG8_LAS int* const rowlds = (const PG8_LAS int*)(lds + STAGE_BYTES + 4096);
#define PG8_ROWS(dst, pm_) do { if constexpr (GATHER) { _Pragma("unroll") for (int h_ = 0; h_ < 2; ++h_) _Pragma("unroll") for (int i_ = 0; i_ < 2; ++i_) { int R_, C_; stage_rc(tid * 16 + i_ * 8192, R_, C_); \
        const int ix_ = (pm_) * BM + h_ * HALF + R_; dst[h_][i_] = ((g.rowmap ? (unsigned)g.rowmap[ix_] : (unsigned)ix_) * (unsigned)K + (unsigned)C_) * 2u; } } } while (0)
#define PG8_ROWS_LDS(dst) do { _Pragma("unroll") for (int h_ = 0; h_ < 2; ++h_) _Pragma("unroll") for (int i_ = 0; i_ < 2; ++i_) { int R_, C_; stage_rc(tid * 16 + i_ * 8192, R_, C_); \
        dst[h_][i_] = ((unsigned)rowlds[h_ * HALF + R_] * (unsigned)K + (unsigned)C_) * 2u; } } while (0)
    const size_t kstep = (size_t)(BK * 2);
    const size_t hstep = (size_t)HALF * K * 2;
    const size_t b64step = (size_t)64 * K * 2;
    const size_t hB = P16 ? (size_t)8 * K * 2 : hstep, b64B = P16 ? 2 * b64step : b64step;
    const size_t hA = GATHER ? (size_t)0 : hstep;
    const size_t tstep = 2 * hstep;
    const unsigned ldsw = (unsigned)wid * 1024u;
    const int aoff = lds_byte(wr * 64 + fr, fq * 8), boff = lds_byte(wc * 32 + fr, fq * 8);
#define PG8_SA(b, h) (((b) * 2 + (h)) * HTB)
#define PG8_SB(b, h) ((4 + (b) * 2 + (h)) * HTB)
#define PG8_STAGE(bufoff, gbase, voff) do { if constexpr (true) { const bool isB_ = ((const void*)(voff) == (const void*)voffB), isA_ = ((const void*)(voff) == (const void*)voffA); _Pragma("unroll") for (int _i = 0; _i < 2; ++_i) \
        __builtin_amdgcn_global_load_lds((const unsigned*)((const char*)(gbase) + (isB_ ? (size_t)_i * b64B : isA_ ? (size_t)_i * b64step : (size_t)0) + (isB_ ? voffB[0] : (isA_ ? voffA[0] : (voff)[_i]))), (PG8_LAS unsigned*)(lds + (bufoff) + ldsw + _i * 8192), 16, 0, 0); } } while (0)
#define PG8_LD16(off) (*(const PG8_LAS v8i_t_half*)(lds + (off)))
#define PG8_LDA(dst, b, h) do { if constexpr (FP8) { _Pragma("unroll") for (int m = 0; m < 4; ++m) dst##8[m] = __builtin_shufflevector(__builtin_bit_cast(v8i_t_half, *(const PG8_LAS bf16x8*)(lds + PG8_SA(b, h) + aoff + m * 2048)), __builtin_bit_cast(v8i_t_half, *(const PG8_LAS bf16x8*)(lds + PG8_SA(b, h) + aoff + m * 2048 + 1024)), 0, 1, 2, 3, 4, 5, 6, 7); } \
        else { _Pragma("unroll") for (int m = 0; m < 4; ++m) _Pragma("unroll") for (int k = 0; k < 2; ++k) dst[m][k] = *(const PG8_LAS bf16x8*)(lds + PG8_SA(b, h) + aoff + m * 2048 + k * 1024); } } while (0)
#define PG8_LDB(dst, b, h) do { if constexpr (FP8) { _Pragma("unroll") for (int n = 0; n < 2; ++n) dst##8[n] = __builtin_shufflevector(__builtin_bit_cast(v8i_t_half, *(const PG8_LAS bf16x8*)(lds + PG8_SB(b, h) + boff + n * 2048)), __builtin_bit_cast(v8i_t_half, *(const PG8_LAS bf16x8*)(lds + PG8_SB(b, h) + boff + n * 2048 + 1024)), 0, 1, 2, 3, 4, 5, 6, 7); } \
        else { _Pragma("unroll") for (int n = 0; n < 2; ++n) _Pragma("unroll") for (int k = 0; k < 2; ++k) dst[n][k] = *(const PG8_LAS bf16x8*)(lds + PG8_SB(b, h) + boff + n * 2048 + k * 1024); } } while (0)
#define PG8_MMA(ai, bj, At, Bt) do { __builtin_amdgcn_s_setprio(1); _Pragma("unroll") for (int m = 0; m < 4; ++m) _Pragma("unroll") for (int n = 0; n < 2; ++n) { \
        if constexpr (FP8) acc[ai][bj][m][n] = __builtin_amdgcn_mfma_scale_f32_16x16x128_f8f6f4(Bt##8[n], At##8[m], acc[ai][bj][m][n], 0, 0, 0, g.scale_a, 0, g.scale_a); \
        else { _Pragma("unroll") for (int k = 0; k < 2; ++k) acc[ai][bj][m][n] = __builtin_amdgcn_mfma_f32_16x16x32_bf16(Bt[n][k], At[m][k], acc[ai][bj][m][n], 0, 0, 0); } } __builtin_amdgcn_s_setprio(0); } while (0)
#define PG8_WAIT_V(n) asm volatile("s_waitcnt vmcnt(" #n ")" ::: "memory")
#define PG8_WAIT_L(n) asm volatile("s_waitcnt lgkmcnt(" #n ")" ::: "memory")
#define PG8_BAR __builtin_amdgcn_s_barrier()
#define PG8_SCHED __builtin_amdgcn_sched_barrier(0)
    Unit cur, nxt; int ui = 0;
    if (!S.next(0, cur)) return;
    cur.slot = 0;
    f32x4 acc[2][2][4][2];
#pragma unroll
    for (int a = 0; a < 2; ++a)
#pragma unroll
        for (int b = 0; b < 2; ++b)
#pragma unroll
            for (int m = 0; m < 4; ++m)
#pragma unroll
                for (int n = 0; n < 2; ++n) acc[a][b][m][n] = (f32x4){0.f, 0.f, 0.f, 0.f};
    bf16x8 At[4][2], B0[2][2], B1[2][2]; v8i_t At8[4], B08[2], B18[2];
    const char* cA = (const char*)g.A + (GATHER ? (size_t)0 : (size_t)cur.pm * tstep + (size_t)cur.b * g.strideA); const char* cB = (const char*)g.Bt + (size_t)cur.pn * tstep + (size_t)cur.b * g.strideB;
    PG8_ROWS(vC, cur.pm);
    S.a_ready(cur);
    if constexpr (SP2) {
        PG8_STAGE(PG8_SB(0, 0), cB, voffB); PG8_STAGE(PG8_SB(0, 1), cB + hB, voffB); PG8_STAGE(PG8_SA(0, 0), cA, (GATHER ? vC[0] : voffA)); PG8_STAGE(PG8_SA(0, 1), cA + hA, (GATHER ? vC[1] : voffA));
        if (wr == 1) PG8_BAR;
        PG8_WAIT_V(2); PG8_BAR;
        PG8_STAGE(PG8_SB(1, 0), cB + kstep, voffB); PG8_STAGE(PG8_SA(1, 0), cA + kstep, (GATHER ? vC[0] : voffA)); PG8_STAGE(PG8_SB(1, 1), cB + hB + kstep, voffB);
        PG8_WAIT_V(6); PG8_BAR;
    } else {
        PG8_STAGE(PG8_SB(0, 0), cB, voffB); PG8_STAGE(PG8_SA(0, 0), cA, voffA); PG8_STAGE(PG8_SB(0, 1), cB + hB, voffB); PG8_STAGE(PG8_SA(0, 1), cA + hstep, voffA);
        if (wr == 1) PG8_BAR;
        PG8_WAIT_V(4); PG8_BAR;
        PG8_STAGE(PG8_SB(1, 0), cB + kstep, voffB); PG8_STAGE(PG8_SA(1, 0), cA + kstep, voffA); PG8_STAGE(PG8_SB(1, 1), cB + hB + kstep, voffB);
        PG8_WAIT_V(6); PG8_BAR;
    }
    for (;;) {
        const bool has_next = S.next(ui + 1, nxt); nxt.slot = (ui + 1) & 1;
        if constexpr (Epi::LDS_BIAS) { if (wid == 0) __builtin_amdgcn_global_load_lds((const unsigned*)E.bias_src(cur, lane), (PG8_LAS unsigned*)(lds + STAGE_BYTES + 5120 + cur.slot * 1024), 16, 0, 0); }
        const char* nA = (has_next && !GATHER) ? (const char*)g.A + (size_t)nxt.pm * tstep + (size_t)nxt.b * g.strideA : cA; const char* nB = has_next ? (const char*)g.Bt + (size_t)nxt.pn * tstep + (size_t)nxt.b * g.strideB : cB;
        if constexpr (GATHER) { if (g.rowmap && wid == 0) { const int np_ = has_next ? nxt.pm : cur.pm;
            __builtin_amdgcn_global_load_lds((const unsigned*)(g.rowmap + (size_t)np_ * BM + lane * 4), (PG8_LAS unsigned*)(lds + STAGE_BYTES + 4096), 16, 0, 0); } }
        for (int t = 0; t < nt; t += 2) {
            const bool last = (t == nt - 2);
            const char* a1 = cA + (size_t)(t + 1) * kstep;
            const char* a2 = last ? nA : cA + (size_t)(t + 2) * kstep; const char* b2 = last ? nB : cB + (size_t)(t + 2) * kstep;
            const char* a3 = a2 + kstep; const char* b3 = b2 + kstep;
            if (last && has_next) S.a_ready(nxt);
            if constexpr (SP2) {
            PG8_LDB(B0, 0, 0); PG8_LDB(B1, 0, 1); PG8_SCHED; PG8_LDA(At, 0, 0); PG8_STAGE(PG8_SA(1, 1), a1 + hA, (GATHER ? vC[1] : voffA));
            if constexpr (GATHER) { if (last) { if (g.rowmap) PG8_ROWS_LDS(vC); else { const int np_ = has_next ? nxt.pm : cur.pm; PG8_ROWS(vC, np_); } } }
            PG8_WAIT_V(8); PG8_WAIT_L(0); PG8_BAR; PG8_MMA(0, 0, At, B0); PG8_MMA(0, 1, At, B1); PG8_BAR; PG8_SCHED;
            PG8_LDA(At, 0, 1); PG8_STAGE(PG8_SB(0, 0), b2, voffB); PG8_STAGE(PG8_SB(0, 1), b2 + hB, voffB); PG8_STAGE(PG8_SA(0, 0), a2, (GATHER ? vC[0] : voffA));
            PG8_WAIT_V(8); PG8_WAIT_L(0); PG8_BAR; PG8_MMA(1, 0, At, B0); PG8_MMA(1, 1, At, B1); PG8_BAR; PG8_SCHED;
            PG8_LDB(B0, 1, 0); PG8_LDB(B1, 1, 1); PG8_SCHED; PG8_LDA(At, 1, 0); PG8_STAGE(PG8_SA(0, 1), a2 + hA, (GATHER ? vC[1] : voffA));
            PG8_WAIT_V(8); PG8_WAIT_L(0); PG8_BAR; PG8_MMA(0, 0, At, B0); PG8_MMA(0, 1, At, B1); PG8_BAR; PG8_SCHED;
            PG8_LDA(At, 1, 1); PG8_STAGE(PG8_SB(1, 0), b3, voffB); PG8_STAGE(PG8_SB(1, 1), b3 + hB, voffB); PG8_STAGE(PG8_SA(1, 0), a3, (GATHER ? vC[0] : voffA));
            PG8_WAIT_V(8); PG8_WAIT_L(0); PG8_BAR; PG8_MMA(1, 0, At, B0); PG8_MMA(1, 1, At, B1); PG8_BAR; PG8_SCHED;
            } else {
            PG8_LDB(B0, 0, 0); PG8_SCHED; PG8_LDA(At, 0, 0); PG8_STAGE(PG8_SA(1, 1), a1 + hstep, voffA);
            PG8_WAIT_L(8); PG8_BAR; PG8_WAIT_L(0); PG8_MMA(0, 0, At, B0); PG8_BAR; PG8_SCHED;
            PG8_LDB(B1, 0, 1); PG8_STAGE(PG8_SB(0, 0), b2, voffB);
            PG8_BAR; PG8_WAIT_L(0); PG8_MMA(0, 1, At, B1); PG8_BAR;
            PG8_LDA(At, 0, 1); PG8_STAGE(PG8_SA(0, 0), a2, voffA);
            PG8_BAR; PG8_WAIT_L(0); PG8_MMA(1, 0, At, B0); PG8_BAR; PG8_SCHED;
            PG8_STAGE(PG8_SB(0, 1), b2 + hB, voffB);
            PG8_WAIT_V(6); PG8_BAR; PG8_MMA(1, 1, At, B1); PG8_BAR;
            PG8_LDB(B0, 1, 0); PG8_SCHED; PG8_LDA(At, 1, 0); PG8_STAGE(PG8_SA(0, 1), a2 + hstep, voffA);
            PG8_WAIT_L(8); PG8_BAR; PG8_WAIT_L(0); PG8_MMA(0, 0, At, B0); PG8_BAR; PG8_SCHED;
            PG8_LDB(B1, 1, 1); PG8_STAGE(PG8_SB(1, 0), b3, voffB);
            PG8_BAR; PG8_WAIT_L(0); PG8_MMA(0, 1, At, B1); PG8_BAR;
            PG8_LDA(At, 1, 1); PG8_STAGE(PG8_SA(1, 0), a3, voffA);
            PG8_BAR; PG8_WAIT_L(0); PG8_MMA(1, 0, At, B0); PG8_BAR; PG8_SCHED;
            PG8_STAGE(PG8_SB(1, 1), b3 + hB, voffB);
            PG8_WAIT_V(6); PG8_BAR; PG8_MMA(1, 1, At, B1); PG8_BAR;
            }
        }
        if constexpr (ALIGN_EPI) { if (wr == 0) PG8_BAR; }
        if constexpr (!Epi::AFTER_DRAIN) { int t2_ = threadIdx.x; asm volatile("" : "+v"(t2_)); E(acc, cur, wr, wc, t2_ & 15, (t2_ & 63) >> 4); S.done(cur); }
        if (!has_next) break;
        if (!(Epi::CHAIN && cur.b < 2)) {
#pragma unroll
        for (int a = 0; a < 2; ++a)
#pragma unroll
            for (int b = 0; b < 2; ++b)
#pragma unroll
                for (int m = 0; m < 4; ++m)
#pragma unroll
                    for (int n = 0; n < 2; ++n) acc[a][b][m][n] = (f32x4){0.f, 0.f, 0.f, 0.f};
        }
        cur = nxt; cA = nA; cB = nB; ++ui;
        if constexpr (ALIGN_EPI) { if (wr == 1) PG8_BAR; }
    }
    PG8_WAIT_V(0);
    if constexpr (!ALIGN_EPI) { if (wr == 0) PG8_BAR; }
    PG8_BAR;
    if constexpr (Epi::AFTER_DRAIN) { E.fused(acc, cur, wr, wc, fr, fq, lds, wid, lane); S.done(cur); }
#undef PG8_ROWS
#undef PG8_ROWS_LDS
#undef PG8_SA
#undef PG8_SB
#undef PG8_STAGE
#undef PG8_LDA
#undef PG8_LDB
#undef PG8_MMA
#undef PG8_LD16
#undef PG8_WAIT_V
#undef PG8_WAIT_L
#undef PG8_BAR
#undef PG8_SCHED
}
}
namespace attn_body {
using bf16=__hip_bfloat16;
using bf16x8=__attribute__((ext_vector_type(8)))short;
using s16x4=__attribute__((ext_vector_type(4)))short;
using f32x16=__attribute__((ext_vector_type(16)))float;
using f32x4v=__attribute__((ext_vector_type(4)))float;
using u32x4=__attribute__((ext_vector_type(4)))unsigned;
constexpr int D=64;
constexpr int NW=8,QBLK=32,QB=QBLK*NW,KVBLK=64;
__device__ __forceinline__ int crow(int r,int hi){return (r&3)+8*(r>>2)+4*hi;}
#define SBAR() __builtin_amdgcn_sched_barrier(0)
__device__ __forceinline__ void cmask(f32x16&p0,f32x16&p1,int jb,int qrel,int hi){
  const float NEG=-INFINITY; int kb=64*jb+4*hi;
  #pragma unroll
  for(int r=0;r<16;++r){int kv=kb+(r&3)+8*(r>>2); if(kv>qrel)p0[r]=NEG; if(kv+32>qrel)p1[r]=NEG;}
}

constexpr int NSLOT=3, SLOTB=8192;
constexpr int LDS_K=0, LDS_V=NSLOT*SLOTB, LDS_WS=2*NSLOT*SLOTB, LDS_OST=LDS_WS+NW*64*4, LDS_BYTES=LDS_OST+NW*4096;
constexpr int LDS_CS=LDS_BYTES, CS_BYTES=65536, LDS_TOTAL=LDS_CS+CS_BYTES;
constexpr int TBL_N=640, TBL_ZERO=256;
__device__ __forceinline__ void glds16(const void*gsrc,unsigned lds_dst){unsigned keep;
  asm volatile("s_mov_b32 %0, m0\n\ts_mov_b32 m0, %2\n\ts_nop 0\n\tglobal_load_lds_dwordx4 %1, off\n\ts_mov_b32 m0, %0":"=&s"(keep):"v"(gsrc),"s"(lds_dst):"memory");}
__device__ __forceinline__ float max3f(float a,float b,float c){float r;asm("v_max3_f32 %0, %1, %2, %3":"=v"(r):"v"(a),"v"(b),"v"(c));return r;}
__device__ __forceinline__ float max2f(float a,float b){float r;asm("v_max_f32_e32 %0, %1, %2":"=v"(r):"v"(a),"v"(b));return r;}
__device__ __forceinline__ float fadd_s(float a,float b){float r;asm("v_add_f32_e32 %0, %1, %2":"=v"(r):"v"(a),"v"(b));return r;}
__device__ __forceinline__ float fsub_s(float a,float b){float r;asm("v_sub_f32_e32 %0, %1, %2":"=v"(r):"v"(a),"v"(b));return r;}
typedef float f32x2_t __attribute__((ext_vector_type(2))); typedef __bf16 bf16x2_t __attribute__((ext_vector_type(2)));
__device__ __forceinline__ unsigned cvtpk_s(float lo,float hi){f32x2_t v={lo,hi};bf16x2_t b=__builtin_convertvector(v,bf16x2_t);return __builtin_bit_cast(unsigned,b);}
#define WAIT_BAR(N) asm volatile("s_waitcnt vmcnt(" #N ") lgkmcnt(0)\n\ts_barrier":::"memory")

__device__ __forceinline__ void qkt(f32x16&p0,f32x16&p1,const char*Kslot,const bf16x8*qr,int r32,int hi){
  const char*kb=Kslot+hi*1024+r32*16;
  #pragma unroll
  for(int d0=0;d0<4;++d0){
    const bf16x8 b0=*reinterpret_cast<const bf16x8*>(kb+d0*2048);
    const bf16x8 b1=*reinterpret_cast<const bf16x8*>(kb+d0*2048+512);
    p0=__builtin_amdgcn_mfma_f32_32x32x16_bf16(b0,qr[d0],p0,0,0,0);p1=__builtin_amdgcn_mfma_f32_32x32x16_bf16(b1,qr[d0],p1,0,0,0);}
}
typedef __attribute__((address_space(3))) const char* lds_cptr;
typedef __attribute__((address_space(3))) char* lds_ptr;
typedef short v4i16_t __attribute__((ext_vector_type(4)));
__device__ __forceinline__ void kload8(bf16x8*kf,lds_cptr kp){
  kf[0]=*(const __attribute__((address_space(3))) bf16x8*)(kp);      kf[1]=*(const __attribute__((address_space(3))) bf16x8*)(kp+512);
  kf[2]=*(const __attribute__((address_space(3))) bf16x8*)(kp+2048); kf[3]=*(const __attribute__((address_space(3))) bf16x8*)(kp+2560);
  kf[4]=*(const __attribute__((address_space(3))) bf16x8*)(kp+4096); kf[5]=*(const __attribute__((address_space(3))) bf16x8*)(kp+4608);
  kf[6]=*(const __attribute__((address_space(3))) bf16x8*)(kp+6144); kf[7]=*(const __attribute__((address_space(3))) bf16x8*)(kp+6656);
}
__device__ __forceinline__ void kload2(bf16x8*kf,lds_cptr kp,int j){ kf[2*j]=*(const __attribute__((address_space(3))) bf16x8*)(kp+j*2048); kf[2*j+1]=*(const __attribute__((address_space(3))) bf16x8*)(kp+j*2048+512); }
__device__ __forceinline__ s16x4 vtr(lds_cptr p){ return __builtin_bit_cast(s16x4,__builtin_amdgcn_ds_read_tr16_b64_v4i16((__attribute__((address_space(3))) v4i16_t*)p)); }
__device__ __forceinline__ float rowmax(const f32x16&p0,const f32x16&p1){
  float a=max3f(p0[0],p0[1],p1[0]),b=max3f(p0[2],p0[3],p1[1]);a=max3f(a,p1[2],p1[3]);
  #pragma unroll
  for(int r=4;r<16;r+=4){a=max3f(a,p0[r],p0[r+1]);b=max3f(b,p0[r+2],p0[r+3]);a=max3f(a,p1[r],p1[r+1]);b=max3f(b,p1[r+2],p1[r+3]);}
  const float m=max2f(a,b);
  auto rr=__builtin_amdgcn_permlane32_swap(__float_as_uint(m),__float_as_uint(m),false,false);
  return max2f(__uint_as_float(rr[0]),__uint_as_float(rr[1]));
}
__device__ __forceinline__ void pv(f32x16*o,int vb,bf16x8 pa0,bf16x8 pa1,bf16x8 pa2,bf16x8 pa3){
  #pragma unroll
  for(int d0=0;d0<2;++d0){s16x4 lo[4],hi[4];
    #pragma unroll
    for(int ks=0;ks<4;++ks){
      asm volatile("ds_read_b64_tr_b16 %0,%1 offset:%c2":"=&v"(lo[ks]):"v"(vb),"i"(d0*4096+ks*1024):"memory");
      asm volatile("ds_read_b64_tr_b16 %0,%1 offset:%c2":"=&v"(hi[ks]):"v"(vb),"i"(d0*4096+ks*1024+512):"memory");}
    asm volatile("s_waitcnt lgkmcnt(0)":::"memory");SBAR();
    #define PK(k) (bf16x8){lo[k][0],lo[k][1],lo[k][2],lo[k][3],hi[k][0],hi[k][1],hi[k][2],hi[k][3]}
    o[d0]=__builtin_amdgcn_mfma_f32_32x32x16_bf16(pa0,PK(0),o[d0],0,0,0);
    o[d0]=__builtin_amdgcn_mfma_f32_32x32x16_bf16(pa1,PK(1),o[d0],0,0,0);
    o[d0]=__builtin_amdgcn_mfma_f32_32x32x16_bf16(pa2,PK(2),o[d0],0,0,0);
    o[d0]=__builtin_amdgcn_mfma_f32_32x32x16_bf16(pa3,PK(3),o[d0],0,0,0);
    #undef PK
  }
}

struct AttnArgs { const bf16* Q; const bf16* K; const bf16* V; bf16* O; long qp, kp, op; int q0, NT, kv0; const float* aux; float* lse; long lse_stride; int tlo, thi, band; float thr; };
#define ATTN_STORE16(p,v) (*(u32x4*)(p)=(v))
template<int MODE,int THRL> __device__ __forceinline__ void attn_unit(const AttnArgs&a,char*shm){
  int tid_=threadIdx.x; asm volatile("":"+v"(tid_));
  const int tid=tid_,lane=tid&63,r32=lane&31,hi=lane>>5; const int wid=__builtin_amdgcn_readfirstlane(tid>>6);
  const int q0=a.q0; const long KP=a.kp;
  const bf16*Qw=a.Q+(long)(q0+wid*QBLK)*a.qp;
  const bf16*Kh=a.K,*Vh=a.V;
  int NT=a.NT, lo=0;
  if(MODE==0){
    const int nt0=a.thi-a.tlo; const float cq=a.aux[q0];
    const float ck=(lane<nt0)?a.aux[64*(a.tlo+lane)+63]:0.f;
    const unsigned long long need=__ballot((lane<nt0)&&(cq-ck>=-a.thr));
    const int j0=need?(int)__builtin_ctzll(need):nt0;
    if(j0>=nt0){ if(a.lse&&tid<QB)a.lse[(long)(q0+tid)*a.lse_stride]=-INFINITY; return; }
    lo=a.tlo+j0; int n=a.thi-lo; if(n<4){lo=a.thi-4;n=4;} if(n&1){lo-=1;n+=1;} NT=n;
    Kh+=(long)lo*KVBLK*KP; Vh+=(long)lo*KVBLK*KP;
  }
  const unsigned lds0=(unsigned)(uintptr_t)shm;
  float*wsf=(float*)(shm+LDS_WS)+wid*64;
  const lds_cptr shm3=(lds_cptr)shm;
  const __attribute__((address_space(3))) float* cs3=(const __attribute__((address_space(3))) float*)(shm3+LDS_CS);
  float nb=0.f;
  if(MODE==0){ __attribute__((address_space(3))) f32x4v* dst=(__attribute__((address_space(3))) f32x4v*)((lds_ptr)shm+LDS_CS); const f32x4v* src=(const f32x4v*)a.aux+16*lo; const int n4=16*NT;
    for(int i=tid;i<n4;i+=NW*64)dst[i]=src[i];
    nb=a.aux[q0+wid*QBLK+r32]; }
  if(MODE==1){ __attribute__((address_space(3))) float* dst=(__attribute__((address_space(3))) float*)((lds_ptr)shm+LDS_CS);
    for(int i=tid;i<TBL_N;i+=NW*64)dst[i]=a.aux[i]; }
  const bf16*ksrc=Kh+(long)lane*KP+wid*8;
  const bf16*vsrc=Vh+(long)(16*(wid&3)+(lane>>2))*KP+(wid>>2)*32+(lane&3)*8;
  const unsigned kdst=lds0+LDS_K+wid*1024, vdst=lds0+LDS_V+wid*1024;
  #define DMA_K(t,slot) glds16(ksrc+(long)(t)*KVBLK*KP,(unsigned)__builtin_amdgcn_readfirstlane(kdst+(slot)))
  #define DMA_V(t,slot) glds16(vsrc+(long)(t)*KVBLK*KP,(unsigned)__builtin_amdgcn_readfirstlane(vdst+(slot)))
  const int vb0=(int)(lds0+LDS_V)+((lane>>4)&1)*32+(lane&3)*8+(4*hi+((lane&15)>>2))*64;
  const char*Kbase=shm+LDS_K; bf16x8 kf[8];
  const lds_cptr kp0=shm3+LDS_K+hi*1024+r32*16; const lds_cptr vp0=shm3+LDS_V+((lane>>4)&1)*32+(lane&3)*8+(4*hi+((lane&15)>>2))*64;
  DMA_K(0,0);DMA_V(0,0);DMA_K(1,SLOTB);
  bf16x8 qr[4];
  #pragma unroll
  for(int d0=0;d0<4;++d0)qr[d0]=*reinterpret_cast<const bf16x8*>(&Qw[(long)r32*a.qp+d0*16+hi*8]);
  float mhat=0.f,l_reg=0.f;f32x16 o[2];o[0]=f32x16{};o[1]=f32x16{};
  const int qrel=wid*QBLK+r32;
  const int tb0=q0+qrel-a.kv0-4*hi+TBL_ZERO-63;
  #define CINIT(C0,C1,t) do{ \
    if(MODE==0){ const __attribute__((address_space(3))) float* cp_=cs3+64*(t)+4*hi; \
      _Pragma("unroll") for(int g_=0;g_<4;++g_){ const f32x4v a_=*(const __attribute__((address_space(3))) f32x4v*)(cp_+8*g_); const f32x4v b_=*(const __attribute__((address_space(3))) f32x4v*)(cp_+32+8*g_); \
        C0[4*g_]=nb-a_[0];C0[4*g_+1]=nb-a_[1];C0[4*g_+2]=nb-a_[2];C0[4*g_+3]=nb-a_[3]; C1[4*g_]=nb-b_[0];C1[4*g_+1]=nb-b_[1];C1[4*g_+2]=nb-b_[2];C1[4*g_+3]=nb-b_[3]; } } \
    else if(MODE==1){ const __attribute__((address_space(3))) float* tp_=cs3+(tb0-64*(t)); \
      _Pragma("unroll") for(int g_=0;g_<4;++g_) _Pragma("unroll") for(int j_=0;j_<4;++j_){ C0[4*g_+j_]=nb+tp_[63-8*g_-j_]; C1[4*g_+j_]=nb+tp_[31-8*g_-j_]; } } \
    else { _Pragma("unroll") for(int r_=0;r_<16;++r_){C0[r_]=nb;C1[r_]=nb;} } }while(0)
  #define CMASK(P0,P1,t) do{ if(MODE==0&&a.band){int jb_=(t)-(NT-4); if(jb_>=0)cmask(P0,P1,jb_,qrel,hi);} }while(0)
  bool resc=false;
  #define START(P0,P1) do{ const float rm=rowmax(P0,P1); resc=false; \
    { const float dl=(MODE==1)?max2f(rm,-256.0f):rm; mhat=fadd_s(mhat,dl); nb=fsub_s(nb,dl); \
      _Pragma("unroll") for(int r=0;r<16;++r){P0[r]=fsub_s(P0[r],dl);P1[r]=fsub_s(P1[r],dl);} } \
    _Pragma("unroll") for(int r=0;r<16;++r)P0[r]=__builtin_amdgcn_exp2f(P0[r]); }while(0)
  #define RESC() do{ if(resc){ asm volatile("s_waitcnt lgkmcnt(0)":::"memory"); \
      _Pragma("unroll") for(int d_=0;d_<2;++d_) _Pragma("unroll") for(int r=0;r<16;++r)o[d_][r]*=wsf[crow(r,hi)]; } }while(0)
  f32x16 pA0,pA1,pB0,pB1;
  int sl_prev=0,sl_cur=0,sl_next=SLOTB;
  #define ROT() do{sl_prev=sl_cur;sl_cur=sl_next;sl_next=(sl_next==(NSLOT-1)*SLOTB)?0:sl_next+SLOTB;}while(0)
  DMA_K(2,2*SLOTB);
  WAIT_BAR(3);
  CINIT(pA0,pA1,0);
  qkt(pA0,pA1,Kbase,qr,r32,hi);asm volatile("s_nop 15\n\ts_nop 7":"+v"(pA0),"+v"(pA1));CMASK(pA0,pA1,0);
  START(pA0,pA1);
  _Pragma("unroll") for(int r=0;r<16;++r)pA1[r]=__builtin_amdgcn_exp2f(pA1[r]);
  WAIT_BAR(0);
  DMA_K(3,0);DMA_V(1,SLOTB);
  ROT();
  kload8(kf,kp0+sl_cur);
  WAIT_BAR(2);
  s16x4 vlo[8],vhi[8]; u32x4 pw0,pw1,pw2,pw3;
  #define PKW(P,B) cvtpk_s(P[B],P[B+1])
  #define PAF(k) __builtin_bit_cast(bf16x8,pw##k)
  #define VFR(i) (bf16x8){vlo[i][0],vlo[i][1],vlo[i][2],vlo[i][3],vhi[i][0],vhi[i][1],vhi[i][2],vhi[i][3]}
  #define PIN(x) asm volatile("":"+v"(x))
  #define MX3(a,b,c) __builtin_fmaxf(__builtin_fmaxf((a),(b)),(c))
  #define GAPA(MF,A0,A1,A2,A3,W0,W1,PW) do{ MF; sacc+=A0; sacc+=A1; sacc+=A2; sacc+=A3; PIN(sacc); W0; W1; PIN(PW); SBAR(); }while(0)
  #define EX(v) __builtin_amdgcn_exp2f(v)
  #define GAPB(MF,X,B) do{ MF; X[B]=EX(X[B]); X[B+1]=EX(X[B+1]); X[B+2]=EX(X[B+2]); X[B+3]=EX(X[B+3]); PIN(X); SBAR(); }while(0)
  #define VRD(i) do{ vlo[i]=vtr(vp_+(((i)>>2)*4096+((i)&3)*1024)); vhi[i]=vtr(vp_+(((i)>>2)*4096+((i)&3)*1024+512)); }while(0)
  #define KRD(G,j) do{ if(G){ kload2(kf,kp0+sl_next,j); SBAR(); } }while(0)
  #define STEP(C0,C1,P0,P1,t,GK,GV,GL) do{ CINIT(C0,C1,t); SBAR(); \
    const lds_cptr vp_=vp0+sl_prev; \
    VRD(0); SBAR(); float sacc=(P0[0]+P0[1]); \
    GAPA(C0=__builtin_amdgcn_mfma_f32_32x32x16_bf16(kf[0],qr[0],C0,0,0,0), P0[2],P0[3],P0[4],P0[5],     pw0[0]=PKW(P0,0), pw0[1]=PKW(P0,2), pw0); \
    VRD(4); SBAR(); GAPA(C1=__builtin_amdgcn_mfma_f32_32x32x16_bf16(kf[1],qr[0],C1,0,0,0), P0[6],P0[7],P0[8],P0[9],     pw0[2]=PKW(P0,4), pw0[3]=PKW(P0,6), pw0); \
    VRD(1); SBAR(); GAPA(C0=__builtin_amdgcn_mfma_f32_32x32x16_bf16(kf[2],qr[1],C0,0,0,0),   P0[10],P0[11],P0[12],P0[13], pw1[0]=PKW(P0,8), pw1[1]=PKW(P0,10), pw1); \
    VRD(5); SBAR(); GAPA(C1=__builtin_amdgcn_mfma_f32_32x32x16_bf16(kf[3],qr[1],C1,0,0,0),   P0[14],P0[15],P1[0],P1[1],   pw1[2]=PKW(P0,12),pw1[3]=PKW(P0,14), pw1); \
    VRD(2); SBAR(); GAPA(C0=__builtin_amdgcn_mfma_f32_32x32x16_bf16(kf[4],qr[2],C0,0,0,0),   P1[2],P1[3],P1[4],P1[5],     pw2[0]=PKW(P1,0), pw2[1]=PKW(P1,2), pw2); \
    VRD(6); SBAR(); GAPA(C1=__builtin_amdgcn_mfma_f32_32x32x16_bf16(kf[5],qr[2],C1,0,0,0),   P1[6],P1[7],P1[8],P1[9],     pw2[2]=PKW(P1,4), pw2[3]=PKW(P1,6), pw2); \
    VRD(3); SBAR(); GAPA(C0=__builtin_amdgcn_mfma_f32_32x32x16_bf16(kf[6],qr[3],C0,0,0,0),   P1[10],P1[11],P1[12],P1[13], pw3[0]=PKW(P1,8), pw3[1]=PKW(P1,10), pw3); \
    VRD(7); SBAR(); GAPA(C1=__builtin_amdgcn_mfma_f32_32x32x16_bf16(kf[7],qr[3],C1,0,0,0),   P1[14],P1[15],0.f,0.f,       pw3[2]=PKW(P1,12),pw3[3]=PKW(P1,14), pw3); \
    l_reg+=sacc; \
    if(GK){DMA_K((t)+3,sl_cur);} if(GV){DMA_V((t)+1,sl_next);} \
    CMASK(C0,C1,t); \
    { float a=MX3(C0[0],C0[1],C1[0]),b=MX3(C0[2],C0[3],C1[1]); a=MX3(a,C1[2],C1[3]); \
      _Pragma("unroll") for(int r=4;r<16;r+=4){a=MX3(a,C0[r],C0[r+1]);b=MX3(b,C0[r+2],C0[r+3]);a=MX3(a,C1[r],C1[r+1]);b=MX3(b,C1[r+2],C1[r+3]);} \
      float rm=__builtin_fmaxf(a,b); { auto rr=__builtin_amdgcn_permlane32_swap(__float_as_uint(rm),__float_as_uint(rm),false,false); rm=__builtin_fmaxf(__uint_as_float(rr[0]),__uint_as_float(rr[1])); } \
      resc=false; \
      if(__builtin_expect(__any(rm>(float)THRL),0)){ const float dl=__builtin_fmaxf(rm,0.f); mhat+=dl; nb-=dl; \
        _Pragma("unroll") for(int r=0;r<16;++r){C0[r]-=dl;C1[r]-=dl;} \
        const float f=__builtin_amdgcn_exp2f(-dl); l_reg*=f; if(hi==0)wsf[r32]=f; resc=true; } } \
    SBAR(); \
    GAPB(o[0]=__builtin_amdgcn_mfma_f32_32x32x16_bf16(PAF(0),VFR(0),o[0],0,0,0), C0,0); \
    GAPB(o[1]=__builtin_amdgcn_mfma_f32_32x32x16_bf16(PAF(0),VFR(4),o[1],0,0,0), C0,4); \
    KRD(GL,0); GAPB(o[0]=__builtin_amdgcn_mfma_f32_32x32x16_bf16(PAF(1),VFR(1),o[0],0,0,0), C0,8); \
    KRD(GL,1); GAPB(o[1]=__builtin_amdgcn_mfma_f32_32x32x16_bf16(PAF(1),VFR(5),o[1],0,0,0), C0,12); \
    KRD(GL,2); GAPB(o[0]=__builtin_amdgcn_mfma_f32_32x32x16_bf16(PAF(2),VFR(2),o[0],0,0,0), C1,0); \
    KRD(GL,3); GAPB(o[1]=__builtin_amdgcn_mfma_f32_32x32x16_bf16(PAF(2),VFR(6),o[1],0,0,0), C1,4); \
    GAPB(o[0]=__builtin_amdgcn_mfma_f32_32x32x16_bf16(PAF(3),VFR(3),o[0],0,0,0), C1,8); \
    GAPB(o[1]=__builtin_amdgcn_mfma_f32_32x32x16_bf16(PAF(3),VFR(7),o[1],0,0,0), C1,12); \
    }while(0)
  int t=1;
  #undef CMASK
  #define CMASK(P0,P1,t) do{}while(0)
  for(;t+5<NT;t+=2){
    STEP(pB0,pB1,pA0,pA1,t,true,true,true);     WAIT_BAR(2); RESC(); ROT();
    STEP(pA0,pA1,pB0,pB1,t+1,true,true,true);   WAIT_BAR(2); RESC(); ROT();
  }
  #undef CMASK
  #define CMASK(P0,P1,t) do{ if(MODE==0&&a.band){int jb_=(t)-(NT-4); if(jb_>=0)cmask(P0,P1,jb_,qrel,hi);} }while(0)
  #define ENDW(tt) do{ if((tt)+3<NT){WAIT_BAR(2);} else if((tt)+2<NT){WAIT_BAR(1);} else {WAIT_BAR(0);} }while(0)
  for(;t+1<NT;t+=2){
    STEP(pB0,pB1,pA0,pA1,t,(t+3<NT),(t+1<NT),(t+1<NT));       ENDW(t);   RESC(); ROT();
    STEP(pA0,pA1,pB0,pB1,t+1,(t+4<NT),(t+2<NT),(t+2<NT));     ENDW(t+1); RESC(); ROT();
  }
  STEP(pB0,pB1,pA0,pA1,NT-1,false,false,false); RESC();
  { float sacc=pB0[0]+pB0[1]; _Pragma("unroll") for(int r=2;r<16;++r)sacc+=pB0[r]; _Pragma("unroll") for(int r=0;r<16;++r)sacc+=pB1[r]; l_reg+=sacc;
    pw0=(u32x4){PKW(pB0,0),PKW(pB0,2),PKW(pB0,4),PKW(pB0,6)};pw1=(u32x4){PKW(pB0,8),PKW(pB0,10),PKW(pB0,12),PKW(pB0,14)};pw2=(u32x4){PKW(pB1,0),PKW(pB1,2),PKW(pB1,4),PKW(pB1,6)};pw3=(u32x4){PKW(pB1,8),PKW(pB1,10),PKW(pB1,12),PKW(pB1,14)};
    SBAR(); pv(o,vb0+sl_cur,PAF(0),PAF(1),PAF(2),PAF(3)); }
  #undef PKW
  #undef PAF
  #undef VFR
  #undef PIN
  #undef MX3
  #undef GAPA
  #undef GAPB
  #undef EX
  #undef VRD
  #undef KRD
  #undef STEP
  #undef ENDW
  {auto rr=__builtin_amdgcn_permlane32_swap(__float_as_uint(l_reg),__float_as_uint(l_reg),false,false);l_reg=__uint_as_float(rr[0])+__uint_as_float(rr[1]);}
  if(MODE==1||(MODE==0&&a.lse)){ if(hi==0) a.lse[(long)(q0+qrel)*a.lse_stride]=mhat+__builtin_amdgcn_logf(l_reg); }
  if(hi==0)wsf[32+r32]=l_reg;asm volatile("s_waitcnt lgkmcnt(0)":::"memory");
  float rli[16];
  #pragma unroll
  for(int r=0;r<16;++r)rli[r]=__builtin_amdgcn_rcpf(wsf[32+crow(r,hi)]);
  bf16*Ow=a.O+(long)(q0+wid*QBLK)*a.op;
  { bf16*stg=(bf16*)(shm+LDS_OST)+wid*2048;
    #pragma unroll
    for(int r=0;r<16;++r){const int orow=crow(r,hi);
      #pragma unroll
      for(int d0=0;d0<2;++d0)stg[orow*64+d0*32+r32]=__float2bfloat16(o[d0][r]*rli[r]);}
    asm volatile("s_waitcnt lgkmcnt(0)":::"memory");
    #pragma unroll
    for(int i=0;i<4;++i){const int row=i*8+(lane>>3),ch=lane&7; const u32x4 v=*(const u32x4*)(stg+row*64+ch*8); ATTN_STORE16(Ow+(long)row*a.op+ch*8,v);} }
  asm volatile("s_waitcnt lgkmcnt(0)\n\ts_barrier":::"memory");
  #undef DMA_K
  #undef DMA_V
  #undef CMASK
  #undef CINIT
  #undef START
  #undef RESC
  #undef ROT
}
constexpr int ATTN_LDS_BYTES=LDS_TOTAL;
#undef SBAR
#undef WAIT_BAR
}
#define GAS __attribute__((address_space(1)))
#define LAS __attribute__((address_space(3)))
typedef unsigned short bf16;
typedef unsigned v4u __attribute__((ext_vector_type(4)));
typedef float f32x4 __attribute__((ext_vector_type(4)));
typedef short bf16x8 __attribute__((ext_vector_type(8)));
typedef GAS unsigned gu32;
typedef GAS unsigned long long gu64;
#define RLX_AGENT __ATOMIC_RELAXED, __HIP_MEMORY_SCOPE_AGENT
#define LDS_WAIT() asm volatile("s_waitcnt lgkmcnt(0)" ::: "memory")
#define VM_WAIT() asm volatile("s_waitcnt vmcnt(0)" ::: "memory")
__device__ __forceinline__ unsigned long long rt() { return __builtin_amdgcn_s_memrealtime(); }
__device__ __forceinline__ unsigned f2bf(float f) { unsigned u = __builtin_bit_cast(unsigned, f); return (u + 0x7fffu + ((u >> 16) & 1u)) >> 16; }
__device__ __forceinline__ unsigned pk4_fp8(float a, float b, float c, float d) { int w = __builtin_amdgcn_cvt_pk_fp8_f32(a, b, 0, false); w = __builtin_amdgcn_cvt_pk_fp8_f32(c, d, w, true); return (unsigned)w; }
__device__ __forceinline__ unsigned pk2(float lo, float hi) { typedef float f2_t __attribute__((ext_vector_type(2))); typedef __bf16 b2_t __attribute__((ext_vector_type(2))); f2_t v = {lo, hi}; b2_t b = __builtin_convertvector(v, b2_t); return __builtin_bit_cast(unsigned, b); }

#define XB_TMO      128
#define XB_XCNT(j)  (256  + 64 * (j))
#define XB_XSUB(j)  (1280 + 64 * (j))
#define XB_XGEN(j)  (2304 + 64 * (j))
#define XB_TOP      3328
#define XB_TOPGEN   3392
#define XCD_BAR_WORDS 3456
#define XB_SPIN_CAP (1u << 18)

__device__ __forceinline__ unsigned xb_ld(unsigned* p)              { return __hip_atomic_load(p, __ATOMIC_RELAXED, __HIP_MEMORY_SCOPE_AGENT); }
__device__ __forceinline__ unsigned xb_add(unsigned* p, unsigned v) { return __hip_atomic_fetch_add(p, v, __ATOMIC_RELAXED, __HIP_MEMORY_SCOPE_AGENT); }
__device__ __forceinline__ unsigned xb_xcc_id() { return (unsigned)__builtin_amdgcn_s_getreg((3 << 11) | 20) & 0xFu; }
#define XB_SPIN(cond, bar) do { unsigned _sp = 0; while (cond) { __builtin_amdgcn_s_sleep(1); \
    if ((++_sp & 255u) == 0u) { if (xb_ld(&(bar)[XB_TMO])) break; if (_sp > XB_SPIN_CAP) { atomicAdd(&(bar)[XB_TMO], 1u); break; } } } } while (0)

struct XcdBarrier {
    unsigned* bar; unsigned x;
    volatile LAS unsigned* st;
};

__device__ __forceinline__ XcdBarrier xcd_barrier_post(unsigned* bar, volatile LAS unsigned* st) {
    XcdBarrier b; b.bar = bar; b.x = xb_xcc_id(); b.st = st;
    if (threadIdx.x == 0) (void)xb_add(&bar[XB_XCNT(b.x)], 1u);
    return b;
}
__device__ __forceinline__ void xcd_barrier_complete(unsigned* bar, unsigned x, unsigned& nloc, unsigned& nx) {
    const unsigned G = gridDim.x * gridDim.y * gridDim.z;
    unsigned sum, cnt, mine, sp = 0u;
    for (;;) {
        sum = 0u; cnt = 0u; mine = 0u;
#pragma unroll
        for (unsigned j = 0; j < 16; ++j) { const unsigned c = xb_ld(&bar[XB_XCNT(j)]); sum += c; cnt += (c > 0u) ? 1u : 0u; mine = (j == x) ? c : mine; }
        if (sum == G) break;
        __builtin_amdgcn_s_sleep(1);
        if ((++sp & 255u) == 0u) { if (xb_ld(&bar[XB_TMO])) break; if (sp > XB_SPIN_CAP) { atomicAdd(&bar[XB_TMO], 1u); break; } }
    }
    nloc = mine > 0u ? mine : 1u; nx = cnt > 0u ? cnt : 1u;
}

__device__ __forceinline__ void xcd_barrier(const XcdBarrier& b) {
    asm volatile("s_waitcnt vmcnt(0)" ::: "memory");
    __syncthreads();
    if (threadIdx.x == 0) {
        unsigned* bar = b.bar;
        __builtin_amdgcn_s_waitcnt(0);
        unsigned nloc = b.st[0], nx = b.st[1];
        if (nloc == 0u) { xcd_barrier_complete(bar, b.x, nloc, nx); b.st[0] = nloc; b.st[1] = nx; }
        const unsigned old = xb_add(&bar[XB_XSUB(b.x)], 1u);
        const unsigned gen = old / nloc;
        if (old + 1u == (gen + 1u) * nloc) {
            __builtin_amdgcn_fence(__ATOMIC_RELEASE, "agent");
            asm volatile("s_waitcnt vmcnt(0)" ::: "memory");
            const unsigned og = xb_add(&bar[XB_TOP], 1u);
            const unsigned tg = og / nx;
            if (og + 1u == (tg + 1u) * nx) xb_add(&bar[XB_TOPGEN], 1u);
            else XB_SPIN(xb_ld(&bar[XB_TOPGEN]) == tg, bar);
            __builtin_amdgcn_fence(__ATOMIC_ACQUIRE, "agent");
            xb_add(&bar[XB_XGEN(b.x)], 1u);
            asm volatile("s_waitcnt vmcnt(0)" ::: "memory");
        } else {
            XB_SPIN(xb_ld(&bar[XB_XGEN(b.x)]) == gen, bar);
            __builtin_amdgcn_fence(__ATOMIC_ACQUIRE, "agent");
            asm volatile("s_waitcnt vmcnt(0)" ::: "memory");
        }
    }
    __syncthreads();
}

constexpr int NWAVES = 8;
constexpr int S = 16384, DM = 1024, NPROJ = 5632, NE = 32, MEML = 256;
constexpr int PC_FQ = 0, PC_FK = 384, PC_FV = 768, PC_DQ = 1152, PC_DK = 1536, PC_DV = 1920, PC_MQ = 2304, PC_GT = 2560;
constexpr int W_IN_LD = 5638, W_IN_F = 1152;
constexpr float LN_EPS = 1e-5f, ALPHA = 1.189207115002721f;
constexpr float LOG2E = 1.4426950408889634f, C2F = 0.125f * 1.4426950408889634f;
constexpr int MAXROWS = 65536 + 32 * 256;
constexpr int NPHASE = 11;
#ifndef MK_N_LAUNCHES
#define MK_N_LAUNCHES 1
#endif
constexpr int N_LAUNCHES = MK_N_LAUNCHES;

constexpr size_t MiB = 1u << 20, KiB = 1u << 10;
constexpr size_t WS_CTL = 0, CTL_ZERO_BYTES = 256 * KiB;
constexpr size_t WS_WIN = 2 * MiB;
constexpr size_t WS_WBF = 748 * MiB, WS_WBD = WS_WBF + 768 * KiB, WS_WBM = WS_WBD + 768 * KiB, WS_WOUT = 15 * MiB, WS_WMKV = 17 * MiB;
constexpr size_t WS_LF2 = 18 * MiB, WS_C2 = WS_LF2 + 512 * KiB, WS_LSE = 19 * MiB, WS_TBL = WS_LSE + 512 * KiB, WS_MEMB = 20 * MiB, WS_MEMKV = WS_MEMB + 512 * KiB;
constexpr size_t WS_TOPI = 21 * MiB, WS_TOPG = WS_TOPI + 256 * KiB, WS_RANK = WS_TOPG + 256 * KiB, WS_DEST = WS_RANK + 256 * KiB, WS_BLKCNT = 22 * MiB, WS_TST = WS_BLKCNT + 64 * KiB;
constexpr size_t WS_TOKROW = 23 * MiB;
constexpr size_t WS_IDMAP = 23 * MiB + 512 * KiB;
constexpr size_t WS_XB = 24 * MiB;
constexpr size_t WS_PBUF = 56 * MiB;
constexpr size_t WS_Y = WS_PBUF;
constexpr size_t WS_OFOX = 712 * MiB, WS_ODIL = 724 * MiB, WS_OMEM = 736 * MiB;
constexpr size_t WS_W1 = 264 * MiB, WS_W2 = 392 * MiB;
constexpr size_t WS_STASH = 456 * MiB, WS_MERGED = 520 * MiB;
constexpr size_t WS_R1 = 552 * MiB, WS_H1F8 = 616 * MiB, WS_XF8 = 632 * MiB, WS_WGF8 = 648 * MiB, WS_H1B = 680 * MiB;
constexpr int W1_SHIFT = 5;
constexpr size_t WS_XS = 712 * MiB, WS_ACT = 856 * MiB, WS_END = 1000 * MiB;
static_assert(WS_XS + (size_t)MAXROWS * 1024 * 2 <= WS_ACT && WS_ACT + (size_t)MAXROWS * 1024 * 2 <= WS_END && WS_Y + (size_t)MAXROWS * 1024 * 2 <= 232 * MiB && WS_WBM + 768 * KiB <= WS_ACT, "ws map");
constexpr int CW_BAR = 4096;
constexpr int CW_NRM = 64, CW_QHEAD = 128;
constexpr size_t WS_OPART = WS_STASH, WS_LSEF = WS_STASH + 48 * MiB;

constexpr int RING_OFF = 0;
constexpr int LDSCTL_OFF = attn_body::ATTN_LDS_BYTES, MISC_OFF = LDSCTL_OFF + 320, TBL_OFF = MISC_OFF + 128;
constexpr int LDS_BYTES = 150528;
static_assert(TBL_OFF + 256 <= LDS_BYTES && pg8::STAGE_BYTES <= LDSCTL_OFF, "LDS map");

struct Args { const float* in[20]; float* out; unsigned char* ws; int ph_lo, ph_hi, li, pad; };
struct Frame {
    LAS unsigned char* lds;
    volatile LAS unsigned* MISC;
    gu32* ctl;
    int tid, lane, wave;
    int vcu, G;
    float* out; unsigned char* ws;
};
__device__ __forceinline__ float wave_sum(float v) {
#pragma unroll
    for (int o = 1; o < 64; o <<= 1) v += __shfl_xor(v, o);
    return v;
}
typedef float f4u __attribute__((ext_vector_type(4), aligned(4)));
typedef float f32x2 __attribute__((ext_vector_type(2)));
typedef unsigned v2u __attribute__((ext_vector_type(2)));
__device__ __forceinline__ void p0_tr_item(const float* W, int ldw, int k0, int src_n0, bf16* WT, int K, int dst_n0, float scale, LAS float* scr, int lane) {
    f4u v[16];
#pragma unroll
    for (int i = 0; i < 16; ++i) v[i] = *(const f4u*)(W + (size_t)(k0 + 4 * i + (lane >> 4)) * ldw + src_n0 + (lane & 15) * 4);
#pragma unroll
    for (int i = 0; i < 16; ++i) { LAS float* d = scr + (4 * i + (lane >> 4)) * 65 + (lane & 15) * 4; d[0] = v[i].x * scale; d[1] = v[i].y * scale; d[2] = v[i].z * scale; d[3] = v[i].w * scale; }
    LDS_WAIT(); asm volatile("" ::: "memory");
    const int c = lane & 7;
#pragma unroll
    for (int j = 0; j < 8; ++j) { const int n = (lane >> 3) + 8 * j; const LAS float* s = scr + (8 * c) * 65 + n;
        v4u o; o.x = pk2(s[0 * 65], s[1 * 65]); o.y = pk2(s[2 * 65], s[3 * 65]); o.z = pk2(s[4 * 65], s[5 * 65]); o.w = pk2(s[6 * 65], s[7 * 65]);
        *(GAS v4u*)(WT + (size_t)(dst_n0 + n) * K + k0 + 8 * c) = o; }
    LDS_WAIT(); asm volatile("" ::: "memory");
}
constexpr int CV_E1 = 32 * 512, CV_E2 = 32 * 256, CV_UNITS = (CV_E1 + CV_E2) / 64;
struct CvItem { const float* W; bf16* WT; int ldw, k0, sn, dn, f8; };
__device__ __forceinline__ CvItem cv_decode(const Args& A, unsigned char* ws, int r) {
    CvItem c;
    if (r < CV_E1) { const int e = r >> 9, rr = r & 511, kb = rr >> 5, nb = rr & 31, dn = nb * 64; c.sn = ((dn >> 7) & 1) * 1024 + (dn >> 8) * 128 + (dn & 127); c.dn = dn; c.k0 = kb * 64; c.ldw = 2048;
        c.W = A.in[14] + (size_t)e * 1024 * 2048; c.WT = (bf16*)(ws + WS_W1 + (size_t)e * 2048 * 1024); c.f8 = 1 + W1_SHIFT; }
    else { r -= CV_E1; const int e = r >> 8, rr = r & 255, kb = rr >> 4, nb = rr & 15; c.sn = nb * 64; c.dn = nb * 64; c.k0 = kb * 64; c.ldw = 1024;
        c.W = A.in[16] + (size_t)e * 1024 * 1024; c.WT = (bf16*)(ws + WS_W2 + (size_t)e * 1024 * 1024); c.f8 = 1 + W1_SHIFT; }
    return c;
}
__device__ __forceinline__ void cv_load(f4u (&v)[16], const CvItem& c, int lane) {
#pragma unroll
    for (int i = 0; i < 16; ++i) v[i] = *(const f4u*)(c.W + (size_t)(c.k0 + 4 * i + (lane >> 4)) * c.ldw + c.sn + (lane & 15) * 4);
}
__device__ __forceinline__ void cv_store(const f4u (&v)[16], const CvItem& c, LAS float* scr, int lane) {
#pragma unroll
    for (int i = 0; i < 16; ++i) { LAS float* d = scr + (4 * i + (lane >> 4)) * 65 + (lane & 15) * 4; d[0] = v[i].x; d[1] = v[i].y; d[2] = v[i].z; d[3] = v[i].w; }
    LDS_WAIT(); asm volatile("" ::: "memory");
    const int cc = lane & 7;
#pragma unroll
    for (int j = 0; j < 8; ++j) { const int n = (lane >> 3) + 8 * j; const LAS float* sp = scr + (8 * cc) * 65 + n;
        v4u o; o.x = pk2(sp[0 * 65], sp[1 * 65]); o.y = pk2(sp[2 * 65], sp[3 * 65]); o.z = pk2(sp[4 * 65], sp[5 * 65]); o.w = pk2(sp[6 * 65], sp[7 * 65]);
        *(GAS v4u*)(c.WT + (size_t)(c.dn + n) * 1024 + c.k0 + 8 * cc) = o; }
    LDS_WAIT(); asm volatile("" ::: "memory");
}
__device__ __forceinline__ void cv_store_f8(const f4u (&v)[16], const CvItem& c, LAS float* scr, int lane) {
    const float sc = (float)(1 << (c.f8 - 1));
#pragma unroll
    for (int i = 0; i < 16; ++i) { LAS float* d = scr + (4 * i + (lane >> 4)) * 65 + (lane & 15) * 4; d[0] = v[i].x * sc; d[1] = v[i].y * sc; d[2] = v[i].z * sc; d[3] = v[i].w * sc; }
    LDS_WAIT(); asm volatile("" ::: "memory");
    const int cc = lane & 7; unsigned char* const WT8 = (unsigned char*)c.WT;
#pragma unroll
    for (int j = 0; j < 8; ++j) { const int n = (lane >> 3) + 8 * j; const LAS float* sp = scr + (8 * cc) * 65 + n;
        v2u o; o.x = pk4_fp8(sp[0 * 65], sp[1 * 65], sp[2 * 65], sp[3 * 65]); o.y = pk4_fp8(sp[4 * 65], sp[5 * 65], sp[6 * 65], sp[7 * 65]);
        *(GAS v2u*)(WT8 + (size_t)(c.dn + n) * 1024 + c.k0 + 8 * cc) = o; }
    LDS_WAIT(); asm volatile("" ::: "memory");
}
__device__ __forceinline__ void conv_unit(Frame& F, const Args& A, int cu) {
    LAS float* scr = (LAS float*)(F.lds + RING_OFF + F.wave * 16640);
    const int r0 = cu * 64 + F.wave * 8;
    f4u va[16], vb[16];
    CvItem ca = cv_decode(A, F.ws, r0), cb; cv_load(va, ca, F.lane);
#pragma unroll 1
    for (int i = 0; i < 8; i += 2) {
        cb = cv_decode(A, F.ws, r0 + i + 1); cv_load(vb, cb, F.lane);
        if (ca.f8) cv_store_f8(va, ca, scr, F.lane); else cv_store(va, ca, scr, F.lane);
        if (i + 2 < 8) { ca = cv_decode(A, F.ws, r0 + i + 2); cv_load(va, ca, F.lane); }
        if (cb.f8) cv_store_f8(vb, cb, scr, F.lane); else cv_store(vb, cb, scr, F.lane);
    }
}
__device__ __forceinline__ void p0_prologue(Frame& F, const Args& A) {
    LAS float* scr = (LAS float*)(F.lds + RING_OFF + F.wave * 16640);
    const int gw = F.vcu * NWAVES + F.wave, NGW = F.G * NWAVES;
    bf16* const WIN = (bf16*)(F.ws + WS_WIN); bf16* const WBF = (bf16*)(F.ws + WS_WBF); bf16* const WBD = (bf16*)(F.ws + WS_WBD); bf16* const WBM = (bf16*)(F.ws + WS_WBM);
    bf16* const WOUT = (bf16*)(F.ws + WS_WOUT); bf16* const WMKV = (bf16*)(F.ws + WS_WMKV);
    constexpr int I_IN = 16 * 88, I_BF = 6 * 16, I_BD = 6 * 16, I_BM = 4 * 16, I_WO = 16 * 16, I_MKV = 16 * 8;
    constexpr int NITEMS = I_IN + I_BF + I_BD + I_BM + I_WO + I_MKV;
    for (int it = gw; it < NITEMS; it += NGW) {
        int r = it;
        if (r < I_IN) { const int kb = r / 88, nb = r % 88, dn = nb * 64; const int sn = dn + (dn >= W_IN_F ? 6 : 0);
            const float sc = (dn < PC_FK || (dn >= PC_DQ && dn < PC_DK) || (dn >= PC_MQ && dn < PC_GT)) ? C2F : 1.0f;
            { CvItem c; c.W = A.in[2]; c.WT = (bf16*)(F.ws + WS_WGF8); c.ldw = W_IN_LD; c.k0 = kb * 64; c.sn = sn; c.dn = dn; c.f8 = 1 + 6;
              f4u v[16]; cv_load(v, c, F.lane);
              if (sc != 1.0f) {
#pragma unroll
                  for (int i = 0; i < 16; ++i) { v[i].x *= sc; v[i].y *= sc; v[i].z *= sc; v[i].w *= sc; } }
              cv_store_f8(v, c, scr, F.lane); }
            continue; } r -= I_IN;
        if (r < I_BF) { const int kb = r >> 4, nb = r & 15; p0_tr_item(A.in[6], 1024, kb * 64, nb * 64, WBF, 384, nb * 64, 1.0f, scr, F.lane); continue; } r -= I_BF;
        if (r < I_BD) { const int kb = r >> 4, nb = r & 15; p0_tr_item(A.in[7], 1024, kb * 64, nb * 64, WBD, 384, nb * 64, 1.0f, scr, F.lane); continue; } r -= I_BD;
        if (r < I_BM) { const int kb = r >> 4, nb = r & 15; p0_tr_item(A.in[8], 1024, kb * 64, nb * 64, WBM, 384, nb * 64, 1.0f, scr, F.lane); continue; } r -= I_BM;
        if (r < I_WO) { const int kb = r >> 4, nb = r & 15; p0_tr_item(A.in[9], 1024, kb * 64, nb * 64, WOUT, 1024, nb * 64, 1.0f, scr, F.lane); continue; } r -= I_WO;
        { const int kb = r >> 3, nb = r & 7; p0_tr_item(A.in[5], 512, kb * 64, nb * 64, WMKV, 1024, nb * 64, 1.0f, scr, F.lane); }
    }
    {
        float wf[4][4][6];
#pragma unroll
        for (int j = 0; j < 4; ++j)
#pragma unroll
            for (int i = 0; i < 4; ++i)
#pragma unroll
                for (int h = 0; h < 6; ++h) wf[j][i][h] = A.in[2][(size_t)(4 * F.lane + i + 256 * j) * W_IN_LD + W_IN_F + h];
        float* const LF2 = (float*)(F.ws + WS_LF2);
        f32x4 vnx[4];
        if (gw < S) { const GAS f32x4* xr0 = (const GAS f32x4*)(A.in[0] + (size_t)gw * DM) + F.lane;
#pragma unroll
            for (int j = 0; j < 4; ++j) vnx[j] = xr0[64 * j]; }
        for (int m = gw; m < S; m += NGW) {
            f32x4 v[4]; float d[6] = {0.f, 0.f, 0.f, 0.f, 0.f, 0.f};
#pragma unroll
            for (int j = 0; j < 4; ++j) v[j] = vnx[j];
            if (m + NGW < S) { const GAS f32x4* xr1 = (const GAS f32x4*)(A.in[0] + (size_t)(m + NGW) * DM) + F.lane;
#pragma unroll
                for (int j = 0; j < 4; ++j) vnx[j] = xr1[64 * j]; }
#pragma unroll
            for (int j = 0; j < 4; ++j)
#pragma unroll
                for (int h = 0; h < 6; ++h) d[h] += v[j].x * wf[j][0][h] + v[j].y * wf[j][1][h] + v[j].z * wf[j][2][h] + v[j].w * wf[j][3][h];
#pragma unroll
            for (int h = 0; h < 6; ++h) d[h] = wave_sum(d[h]);
            { GAS unsigned* o4 = (GAS unsigned*)(F.ws + WS_XF8 + (size_t)m * DM) + F.lane;
#pragma unroll
              for (int j = 0; j < 4; ++j) o4[64 * j] = pk4_fp8(v[j].x, v[j].y, v[j].z, v[j].w); }
            if (F.lane < 6) { const int h = F.lane; float f = h == 0 ? d[0] : h == 1 ? d[1] : h == 2 ? d[2] : h == 3 ? d[3] : h == 4 ? d[4] : d[5];
                f += A.in[3][h]; const float ls = fminf(f, 0.f) - log1pf(expf(-fabsf(f)));
                LF2[(size_t)h * S + m] = ls * LOG2E; }
        }
        bf16* const MEMB = (bf16*)(F.ws + WS_MEMB);
        for (int m = gw; m < MEML; m += NGW) {
            const GAS f32x4* xr = (const GAS f32x4*)(A.in[1] + (size_t)m * DM) + F.lane; GAS unsigned long long* o8 = (GAS unsigned long long*)(MEMB + (size_t)m * DM) + F.lane;
#pragma unroll
            for (int j = 0; j < 4; ++j) { const f32x4 v = xr[64 * j]; o8[64 * j] = (unsigned long long)pk2(v.x, v.y) | ((unsigned long long)pk2(v.z, v.w) << 32); }
        }
    }
    { const int gt = F.vcu * (NWAVES * 64) + F.tid, GT = F.G * NWAVES * 64; const v4u z = {0u, 0u, 0u, 0u};
      for (int i = gt; i < 1024 * 16; i += GT) *(GAS v4u*)((bf16*)(F.ws + WS_WBM) + (size_t)(i >> 4) * 384 + 256 + (i & 15) * 8) = z;
      for (int i = gt; i < S * 16; i += GT) *(GAS v4u*)((bf16*)(F.ws + WS_OMEM) + (size_t)(i >> 4) * 384 + 256 + (i & 15) * 8) = z; }
    {
        float* const TBL = (float*)(F.ws + WS_TBL);
        for (int idx = F.vcu * (NWAVES * 64) + F.tid; idx < 6 * attn_body::TBL_N; idx += F.G * NWAVES * 64) {
            const int hd = idx / attn_body::TBL_N, i = idx - hd * attn_body::TBL_N, rel = i - attn_body::TBL_ZERO, g = hd >> 1, dil = g == 0 ? 1 : (g == 1 ? 4 : 16);
            float val = -INFINITY;
            if (rel >= 0 && rel <= 128) { const int dist = rel * dil; int bucket = dist;
                if (dist >= 16) { const float nf = (float)dist; bucket = 16 + (int)(logf(nf / 16.0f) / 4.852030263919617f * 16.0f); bucket = bucket > 31 ? 31 : bucket; }
                val = A.in[4][bucket * 6 + hd] * LOG2E; }
            TBL[idx] = val;
        }
    }
}

__device__ __forceinline__ void p1_cumsum(Frame& F, int h) {
    const float* src = (const float*)(F.ws + WS_LF2) + (size_t)h * S + F.tid * 32; float* dst = (float*)(F.ws + WS_C2) + (size_t)h * S + F.tid * 32;
    LAS double* part = (LAS double*)(F.lds + RING_OFF);
    f32x4 v[8]; double s = 0.0;
#pragma unroll
    for (int i = 0; i < 8; ++i) { v[i] = *(const f32x4*)(src + 4 * i); s += (double)v[i].x; s += (double)v[i].y; s += (double)v[i].z; s += (double)v[i].w; }
    part[F.tid] = s; __syncthreads();
    double run = 0.0;
    for (int j = 0; j < F.tid; ++j) run += part[j];
#pragma unroll
    for (int i = 0; i < 8; ++i) { f32x4 o; run += (double)v[i].x; o.x = (float)run; run += (double)v[i].y; o.y = (float)run; run += (double)v[i].z; o.z = (float)run; run += (double)v[i].w; o.w = (float)run; *(f32x4*)(dst + 4 * i) = o; }
    __syncthreads();
}

constexpr int P2_NA = 600, P2_NB = 360, P2_NC = 384, P2_ND = 256, P2_UNITS = P2_NA + P2_NB + P2_NC + P2_ND;
__device__ __forceinline__ void p2_attention(Frame& F, const Args& A, char* lds, int li) {
    typedef attn_body::bf16 abf;
    abf* const PB = (abf*)(F.ws + WS_PBUF);
    volatile LAS int* qslot = (volatile LAS int*)(F.lds + MISC_OFF + 64);
    for (;;) {
        if (F.tid == 0) qslot[0] = (int)__hip_atomic_fetch_add(F.ctl + CW_QHEAD + 64 * li, 1u, __ATOMIC_RELAXED, __HIP_MEMORY_SCOPE_AGENT);
        __syncthreads();
        const int pos = __builtin_amdgcn_readfirstlane(qslot[0]);
        __syncthreads();
        if (pos >= P2_UNITS + CV_UNITS) break;
        if (pos % 4 == 3 && pos / 4 < CV_UNITS) { conv_unit(F, A, pos / 4); __syncthreads(); continue; }
        const int idx = pos - (pos / 4 < CV_UNITS ? pos / 4 : CV_UNITS);
        attn_body::AttnArgs a; a.tlo = 0; a.thi = 0; a.band = 0; a.thr = 0.f;
        if (idx < P2_NA + P2_NB) {
            int h, qb, sgm;
            if (idx < P2_NA) { h = idx % 6; const int b = idx / 6; if (b < 49) { sgm = 0; qb = 15 + b; } else if (b < 82) { sgm = 1; qb = 31 + (b - 49); } else if (b < 99) { sgm = 2; qb = 47 + (b - 82); } else { sgm = 3; qb = 63; } }
            else { const int b2 = idx - P2_NA; h = b2 % 6; const int c = b2 / 6; const int L = 60 - 4 * (c >> 2); sgm = c & 3; qb = 16 * sgm + L / 4 - 1; }
            const int ntf = 4 * qb + 4, nseg = (ntf + 63) >> 6;
            const float q2 = __uint_as_float(__hip_atomic_load(F.ctl + CW_NRM + 2 * h, RLX_AGENT)) + __uint_as_float(__hip_atomic_load(F.ctl + CW_NRM + 2 * h + 1, RLX_AGENT)), k2 = __uint_as_float(__hip_atomic_load(F.ctl + CW_NRM + 12 + 2 * h, RLX_AGENT)) + __uint_as_float(__hip_atomic_load(F.ctl + CW_NRM + 13 + 2 * h, RLX_AGENT));
            const float qkmax = 1.02f * sqrtf(q2 * k2);
            a.Q = PB + PC_FQ + h * 64; a.K = PB + PC_FK + h * 64; a.V = PB + PC_FV + h * 64; a.qp = NPROJ; a.kp = NPROJ; a.op = 384;
            a.q0 = qb * 256; a.NT = 0; a.kv0 = 0; a.aux = (const float*)(F.ws + WS_C2) + (size_t)h * S;
            a.tlo = 64 * sgm; a.thi = (a.tlo + 64 < ntf) ? a.tlo + 64 : ntf; a.band = (sgm == nseg - 1) ? 1 : 0;
            a.thr = 48.0f + 2.0f * qkmax;
            if (nseg == 1) { a.O = (abf*)(F.ws + WS_OFOX) + h * 64; a.lse = nullptr; a.lse_stride = 0; }
            else { a.O = (abf*)(F.ws + WS_OPART) + (size_t)sgm * S * 384 + h * 64; a.lse = (float*)(F.ws + WS_LSEF) + (size_t)sgm * S * 6 + h; a.lse_stride = 6; }
            attn_body::attn_unit<0, 8>(a, lds);
        } else if (idx < P2_NA + P2_NB + P2_NC) { const int du = idx - (P2_NA + P2_NB); const int g = du >> 7, hs = (du >> 6) & 1, w = du & 63; const int dl = g == 0 ? 1 : (g == 1 ? 4 : 16); const int r = w % dl, qb = w / dl, hd = g * 2 + hs;
            const int t0 = 4 * qb - 2 > 0 ? 4 * qb - 2 : 0; const long pitch = (long)dl * NPROJ;
            a.Q = PB + PC_DQ + hd * 64 + (long)r * NPROJ; a.K = PB + PC_DK + hd * 64 + (long)r * NPROJ + (long)t0 * 64 * pitch; a.V = PB + PC_DV + hd * 64 + (long)r * NPROJ + (long)t0 * 64 * pitch;
            a.O = (abf*)(F.ws + WS_ODIL) + hd * 64 + (long)r * 384; a.qp = pitch; a.kp = pitch; a.op = (long)dl * 384;
            a.q0 = qb * 256; a.NT = 4 * qb + 4 - t0; a.kv0 = t0 * 64; a.aux = (const float*)(F.ws + WS_TBL) + hd * attn_body::TBL_N; a.lse = (float*)(F.ws + WS_LSE) + r * 6 + hd; a.lse_stride = (long)dl * 6;
            attn_body::attn_unit<1, 8>(a, lds);
        } else { const int mu = idx - (P2_NA + P2_NB + P2_NC); const int h = mu >> 6, qb = mu & 63; abf* const MKV = (abf*)(F.ws + WS_MEMKV);
            a.Q = PB + PC_MQ + h * 64; a.K = MKV + h * 64; a.V = MKV + 256 + h * 64; a.O = (abf*)(F.ws + WS_OMEM) + h * 64; a.qp = NPROJ; a.kp = 512; a.op = 384;
            a.q0 = qb * 256; a.NT = 4; a.kv0 = 0; a.aux = nullptr; a.lse = nullptr; a.lse_stride = 0;
            attn_body::attn_unit<2, 8>(a, lds);
        }
    }
}
__device__ __forceinline__ void p3_fox_combine(Frame& F) {
    const float* LSEF = (const float*)(F.ws + WS_LSEF); const bf16* OP = (const bf16*)(F.ws + WS_OPART); bf16* const OF = (bf16*)(F.ws + WS_OFOX);
    for (int it = blockIdx.x * (NWAVES * 64) + F.tid; it < (S - 4096) * 48; it += F.G * NWAVES * 64) {
        const int tok = 4096 + it / 48, rem = it % 48, h = rem >> 3, ch = rem & 7, nseg = (tok >> 12) + 1;
        float l[4]; float mx = -INFINITY;
#pragma unroll
        for (int sg = 0; sg < 4; ++sg) { l[sg] = (sg < nseg) ? LSEF[((size_t)sg * S + tok) * 6 + h] : -INFINITY; mx = fmaxf(mx, l[sg]); }
        float acc[8] = {0.f, 0.f, 0.f, 0.f, 0.f, 0.f, 0.f, 0.f}; float den = 0.f;
#pragma unroll
        for (int sg = 0; sg < 4; ++sg) { const float w = __builtin_amdgcn_exp2f(l[sg] - mx);
            if (w > 0.f) { const v4u x = *(const v4u*)(OP + ((size_t)sg * S + tok) * 384 + h * 64 + ch * 8); den += w;
                acc[0] += w * __uint_as_float(x.x << 16); acc[1] += w * __uint_as_float(x.x & 0xffff0000u); acc[2] += w * __uint_as_float(x.y << 16); acc[3] += w * __uint_as_float(x.y & 0xffff0000u);
                acc[4] += w * __uint_as_float(x.z << 16); acc[5] += w * __uint_as_float(x.z & 0xffff0000u); acc[6] += w * __uint_as_float(x.w << 16); acc[7] += w * __uint_as_float(x.w & 0xffff0000u); } }
        const float inv = 1.0f / den; v4u o; o.x = pk2(acc[0] * inv, acc[1] * inv); o.y = pk2(acc[2] * inv, acc[3] * inv); o.z = pk2(acc[4] * inv, acc[5] * inv); o.w = pk2(acc[6] * inv, acc[7] * inv);
        *(v4u*)(OF + (size_t)tok * 384 + h * 64 + ch * 8) = o;
    }
}
__device__ __forceinline__ void p3_dil_weights(Frame& F) {
    const float* LSE = (const float*)(F.ws + WS_LSE); bf16* const OD = (bf16*)(F.ws + WS_ODIL);
    for (int it = blockIdx.x * (NWAVES * 64) + F.tid; it < S * 48; it += F.G * NWAVES * 64) {
        const int tok = it / 48, rem = it - tok * 48, hd = rem >> 3, ch = rem & 7, hs = hd & 1, g = hd >> 1;
        const float l0 = LSE[tok * 6 + hs], l1 = LSE[tok * 6 + 2 + hs], l2 = LSE[tok * 6 + 4 + hs];
        const float mx = fmaxf(l0, fmaxf(l1, l2)); const float e0 = __builtin_amdgcn_exp2f(l0 - mx), e1 = __builtin_amdgcn_exp2f(l1 - mx), e2 = __builtin_amdgcn_exp2f(l2 - mx);
        const float w = (g == 0 ? e0 : (g == 1 ? e1 : e2)) / (e0 + e1 + e2);
        v4u* p = (v4u*)(OD + (size_t)tok * 384 + hd * 64 + ch * 8); v4u x = *p;
        x.x = pk2(__uint_as_float(x.x << 16) * w, __uint_as_float(x.x & 0xffff0000u) * w); x.y = pk2(__uint_as_float(x.y << 16) * w, __uint_as_float(x.y & 0xffff0000u) * w);
        x.z = pk2(__uint_as_float(x.z << 16) * w, __uint_as_float(x.z & 0xffff0000u) * w); x.w = pk2(__uint_as_float(x.w << 16) * w, __uint_as_float(x.w & 0xffff0000u) * w);
        *p = x;
    }
}
typedef float f32x16m __attribute__((ext_vector_type(16)));
__device__ __forceinline__ void p6_ln_router(Frame& F, const Args& A) {
    LAS float* hl = (LAS float*)(F.lds + RING_OFF);
    LAS float* part = hl;
    LAS float* lgt = (LAS float*)(F.lds + RING_OFF + 32768);
    LAS int* se = (LAS int*)(F.lds + RING_OFF + 131328);
    const bf16* R1 = (const bf16*)(F.ws + WS_R1); bf16* const H1B = (bf16*)(F.ws + WS_H1B); unsigned char* const H1F8 = F.ws + WS_H1F8;
    int* const TOPI = (int*)(F.ws + WS_TOPI); float* const TOPG = (float*)(F.ws + WS_TOPG); int* const RANK = (int*)(F.ws + WS_RANK); int* const BLKCNT = (int*)(F.ws + WS_BLKCNT);
    const float* lg1 = A.in[10]; const float* lb1 = A.in[11]; const float* wr = A.in[12]; const float* br = A.in[13];
    float wreg[64];
    { const float* bp = wr + (size_t)(128 * F.wave + (F.lane >> 5)) * 32 + (F.lane & 31);
#pragma unroll
      for (int st = 0; st < 64; ++st) wreg[st] = bp[64 * st]; }
    for (int rb = blockIdx.x; rb < S / 64; rb += F.G) {
        for (int half = 0; half < 2; ++half) {
            f32x4 vr[4][4];
#pragma unroll
            for (int j = 0; j < 4; ++j)
#pragma unroll
                for (int q = 0; q < 4; ++q) { const v2u t = *((const v2u*)(R1 + ((size_t)rb * 64 + half * 32 + F.wave * 4 + j) * DM) + F.lane + 64 * q);
                    vr[j][q] = (f32x4){__builtin_bit_cast(float, t.x << 16), __builtin_bit_cast(float, t.x & 0xffff0000u), __builtin_bit_cast(float, t.y << 16), __builtin_bit_cast(float, t.y & 0xffff0000u)}; }
#pragma unroll
            for (int j = 0; j < 4; ++j) {
                const int lr = F.wave * 4 + j; const size_t row = (size_t)rb * 64 + half * 32 + lr;
                f32x4 v[4]; float s = 0.f;
#pragma unroll
                for (int q = 0; q < 4; ++q) { v[q] = vr[j][q]; s += (v[q].x + v[q].y) + (v[q].z + v[q].w); }
                const float mean = wave_sum(s) * (1.f / DM); float s2 = 0.f;
#pragma unroll
                for (int q = 0; q < 4; ++q) { v[q] = v[q] - mean; s2 += (v[q].x * v[q].x + v[q].y * v[q].y) + (v[q].z * v[q].z + v[q].w * v[q].w); }
                const float rstd = 1.f / sqrtf(wave_sum(s2) * (1.f / DM) + LN_EPS);
#pragma unroll
                for (int q = 0; q < 4; ++q) { const f32x4 gv = *((const f32x4*)lg1 + F.lane + 64 * q), bv = *((const f32x4*)lb1 + F.lane + 64 * q); const f32x4 h = v[q] * rstd * gv + bv;
                    *((v2u*)(H1B + row * DM) + F.lane + 64 * q) = (v2u){pk2(h.x, h.y), pk2(h.z, h.w)};
                    *((unsigned*)(H1F8 + row * DM) + F.lane + 64 * q) = pk4_fp8(h.x, h.y, h.z, h.w);
                    LAS float* d = hl + lr * 1025 + 4 * F.lane + 256 * q; d[0] = h.x; d[1] = h.y; d[2] = h.z; d[3] = h.w; }
            }
            __syncthreads();
            f32x16m acc = {0.f, 0.f, 0.f, 0.f, 0.f, 0.f, 0.f, 0.f, 0.f, 0.f, 0.f, 0.f, 0.f, 0.f, 0.f, 0.f};
            { const int kk = F.lane >> 5; const LAS float* ap = hl + (F.lane & 31) * 1025 + 128 * F.wave + kk;
#pragma unroll
              for (int st = 0; st < 64; ++st) acc = __builtin_amdgcn_mfma_f32_32x32x2f32(ap[2 * st], wreg[st], acc, 0, 0, 0); }
            __syncthreads();
            { const int kk = F.lane >> 5;
#pragma unroll
              for (int r = 0; r < 16; ++r) part[(F.wave * 32 + ((r & 3) + 8 * (r >> 2) + 4 * kk)) * 32 + (F.lane & 31)] = acc[r]; }
            __syncthreads();
#pragma unroll
            for (int q = 0; q < 2; ++q) { const int p = F.tid + 512 * q, i = p >> 5, jx = p & 31; float sm = 0.f;
#pragma unroll
                for (int w = 0; w < 8; ++w) sm += part[(w * 32 + i) * 32 + jx];
                lgt[i * 33 + jx] = sm + br[jx]; }
            __syncthreads();
            if (F.tid < 32) { const int i = F.tid; const size_t row = (size_t)rb * 64 + half * 32 + i; float bv[4]; int bi[4];
                unsigned taken = 0u;
#pragma unroll
                for (int kx = 0; kx < 4; ++kx) { float best = -INFINITY; int be = 0;
                    for (int e = 0; e < 32; ++e) { const float x = lgt[i * 33 + e]; const bool take = (((taken >> e) & 1u) == 0u) && (x > best); best = take ? x : best; be = take ? e : be; }
                    bv[kx] = best; bi[kx] = be; taken |= 1u << be; }
                const float e1 = expf(bv[1] - bv[0]), e2 = expf(bv[2] - bv[0]), e3 = expf(bv[3] - bv[0]); const float inv = 1.f / (1.f + e1 + e2 + e3);
                *(int4*)(TOPI + row * 4) = make_int4(bi[0], bi[1], bi[2], bi[3]); *(f32x4*)(TOPG + row * 4) = (f32x4){inv, e1 * inv, e2 * inv, e3 * inv};
                const int lrow = half * 32 + i; se[lrow * 4 + 0] = bi[0]; se[lrow * 4 + 1] = bi[1]; se[lrow * 4 + 2] = bi[2]; se[lrow * 4 + 3] = bi[3]; }
            __syncthreads();
        }
        if (F.tid < 256) { const int e = se[F.tid]; int rk = 0; for (int q = 0; q < F.tid; ++q) rk += (se[q] == e) ? 1 : 0; RANK[rb * 256 + F.tid] = rk; }
        else if (F.tid < 288) { const int e = F.tid - 256; int c = 0; for (int q = 0; q < 256; ++q) c += (se[q] == e) ? 1 : 0; BLKCNT[rb * 32 + e] = c; }
        __syncthreads();
    }
}
__device__ __forceinline__ void p7_scatter(Frame& F) {
    LAS int* ptot = (LAS int*)(F.lds + RING_OFF); LAS int* ppre = ptot + 512; LAS int* epre = ppre + 512; LAS int* tst = epre + 32; LAS int* dsts = tst + 64;
    const int* BLKCNT = (const int*)(F.ws + WS_BLKCNT); const int* TOPI = (const int*)(F.ws + WS_TOPI); const int* RANK = (const int*)(F.ws + WS_RANK);
    int* const DEST = (int*)(F.ws + WS_DEST); int* const TST = (int*)(F.ws + WS_TST); int* const TOKROW = (int*)(F.ws + WS_TOKROW);
    { int* const IDM = (int*)(F.ws + WS_IDMAP); for (int i = blockIdx.x * (NWAVES * 64) + F.tid; i < MAXROWS; i += F.G * NWAVES * 64) IDM[i] = i; }
    for (int rb = blockIdx.x; rb < S / 64; rb += F.G) {
        { const int part = F.tid >> 5, e = F.tid & 31; int tot = 0, pre = 0;
          for (int b = part * 16; b < part * 16 + 16; ++b) { const int c = BLKCNT[b * 32 + e]; tot += c; pre += (b < rb) ? c : 0; }
          ptot[part * 32 + e] = tot; ppre[part * 32 + e] = pre; }
        __syncthreads();
        if (F.tid < 32) { int T = 0, P = 0; for (int p = 0; p < 16; ++p) { T += ptot[p * 32 + F.tid]; P += ppre[p * 32 + F.tid]; } ptot[F.tid] = T; epre[F.tid] = P; }
        __syncthreads();
        if (F.tid == 0) { int t = 0; for (int e = 0; e < 32; ++e) { tst[e] = t; t += (ptot[e] + 255) >> 8; } tst[32] = t;
            if (rb == 0) { for (int e = 0; e <= 32; ++e) TST[e] = tst[e]; } }
        __syncthreads();
        if (F.tid < 256) { const size_t a = (size_t)rb * 256 + F.tid; const int e = TOPI[a]; const int d = tst[e] * 256 + epre[e] + RANK[a]; DEST[a] = d; TOKROW[d] = (int)(a >> 2); }
        if (rb == 0) { for (int e = 0; e < 32; ++e) { const int c = ptot[e], base = tst[e] * 256, padn = (tst[e + 1] - tst[e]) * 256 - c; for (int p = F.tid; p < padn; p += NWAVES * 64) TOKROW[base + c + p] = 0; } }
        __syncthreads();
    }
}
__device__ __forceinline__ void p10_combine(Frame& F, const Args& A) {
    const int gw = F.vcu * NWAVES + F.wave, NGW = F.G * NWAVES;
    const bf16* H1B = (const bf16*)(F.ws + WS_H1B); const bf16* Y = (const bf16*)(F.ws + WS_Y); const int* DEST = (const int*)(F.ws + WS_DEST); const float* TOPG = (const float*)(F.ws + WS_TOPG);
    const float* g2 = A.in[18]; const float* b2 = A.in[19];
    int4 ddn; f32x4 ggn; v2u hbn[4]; unsigned yn[4][4];
#define P10_LOAD_IDX(m_) do { ddn = *(const int4*)(DEST + (size_t)(m_) * 4); ggn = *(const f32x4*)(TOPG + (size_t)(m_) * 4); } while (0)
#define P10_LOAD_ROWS(m_) do { _Pragma("unroll") for (int j = 0; j < 4; ++j) hbn[j] = *((const v2u*)(H1B + (size_t)(m_) * DM) + F.lane + 64 * j); \
        _Pragma("unroll") for (int k = 0; k < 4; ++k) { const int d_ = k == 0 ? ddn.x : (k == 1 ? ddn.y : (k == 2 ? ddn.z : ddn.w)); \
            _Pragma("unroll") for (int j = 0; j < 4; ++j) yn[k][j] = *((const unsigned*)((const unsigned char*)Y + (size_t)d_ * DM) + F.lane + 64 * j); } } while (0)
    int m = gw; if (m >= S) return;
    P10_LOAD_IDX(m); P10_LOAD_ROWS(m);
    for (; m < S; m += NGW) {
        const f32x4 gg = ggn; f32x4 v[4]; float s = 0.f;
#pragma unroll
        for (int j = 0; j < 4; ++j) v[j] = (f32x4){__uint_as_float(hbn[j].x << 16), __uint_as_float(hbn[j].x & 0xffff0000u), __uint_as_float(hbn[j].y << 16), __uint_as_float(hbn[j].y & 0xffff0000u)} * ALPHA;
#pragma unroll
        for (int k = 0; k < 4; ++k) { const float g = k == 0 ? gg.x : (k == 1 ? gg.y : (k == 2 ? gg.z : gg.w));
#pragma unroll
            for (int j = 0; j < 4; ++j) { const unsigned y = yn[k][j]; typedef float f2_ __attribute__((ext_vector_type(2)));
                const f2_ lo = __builtin_amdgcn_cvt_pk_f32_fp8((int)y, false), hi = __builtin_amdgcn_cvt_pk_f32_fp8((int)y, true);
                v[j].x += g * lo.x; v[j].y += g * lo.y; v[j].z += g * hi.x; v[j].w += g * hi.y; } }
        const int mn = m + NGW;
        if (mn < S) { P10_LOAD_IDX(mn); P10_LOAD_ROWS(mn); }
#pragma unroll
        for (int j = 0; j < 4; ++j) s += (v[j].x + v[j].y) + (v[j].z + v[j].w);
        const float mean = wave_sum(s) * (1.f / DM); float s2 = 0.f;
#pragma unroll
        for (int j = 0; j < 4; ++j) { v[j] = v[j] - mean; s2 += (v[j].x * v[j].x + v[j].y * v[j].y) + (v[j].z * v[j].z + v[j].w * v[j].w); }
        const float rstd = 1.f / sqrtf(wave_sum(s2) * (1.f / DM) + LN_EPS);
#pragma unroll
        for (int j = 0; j < 4; ++j) { const f32x4 gv = *((const f32x4*)g2 + F.lane + 64 * j), bv = *((const f32x4*)b2 + F.lane + 64 * j);
            *((f32x4*)(F.out + (size_t)m * DM) + F.lane + 64 * j) = v[j] * rstd * gv + bv; }
    }
#undef P10_LOAD_IDX
#undef P10_LOAD_ROWS
}

__global__ void __launch_bounds__(NWAVES * 64, 2) mk_fwd(Args args) {
    extern __shared__ __attribute__((aligned(16))) unsigned char lds[];
    Frame F;
    F.lds = (LAS unsigned char*)lds;
    F.MISC = (volatile LAS unsigned*)(F.lds + MISC_OFF);
    F.tid = threadIdx.x; F.lane = F.tid & 63; F.wave = __builtin_amdgcn_readfirstlane(F.tid >> 6);
    F.G = gridDim.x; { const int bx = blockIdx.x; F.vcu = (F.G % 8 == 0) ? (bx % 8) * (F.G / 8) + bx / 8 : bx; }
    F.ws = args.ws; F.out = args.out; F.ctl = (gu32*)(args.ws + WS_CTL);
    unsigned char* const ws = args.ws;
    for (int u = F.tid; u < (LDS_BYTES - LDSCTL_OFF) / 4; u += NWAVES * 64) ((LAS unsigned*)(F.lds + LDSCTL_OFF))[u] = 0u;
    __syncthreads();
    XcdBarrier bar = xcd_barrier_post((unsigned*)(F.ctl + CW_BAR) + args.li * XCD_BAR_WORDS, F.MISC + 8);
#define GRID_BAR() xcd_barrier(bar)
    const int lo = args.ph_lo, hi = args.ph_hi;
#ifndef PHASE_MASK
#define PHASE_MASK 0x7ff
#endif
#define IN(k) (((PHASE_MASK >> (k)) & 1) && lo <= (k) && (k) < hi)
#define BOTH(k) (IN(k) && IN((k) + 1))
    typedef pg8::bf16_t pbf;
    pbf* const PBUF = (pbf*)(ws + WS_PBUF);

    if (IN(0)) { p0_prologue(F, args); if (BOTH(0)) GRID_BAR(); }

    if (IN(1)) {
        { pg8::Gemm g{(const pbf*)(ws + WS_XF8), (const pbf*)(ws + WS_WGF8), S, NPROJ, DM / 2, nullptr, 0x7C7C7C7C, 0x7C7C7C7C}; pg8::StaticOrder So; So.init(S, NPROJ, F.G, (int)blockIdx.x); So.lightA = F.G / 2; So.lightB = F.G / 2 + 1; So.RL = 4;
          pg8::EpiProj E{PBUF, NPROJ, PC_GT / 256, (unsigned*)(F.ctl + CW_NRM)};
          pg8::gemm_phase<pg8::EpiProj, pg8::StaticOrder, true, true, true, true>(F.lds + RING_OFF, g, So, E); }
        { pg8::Gemm g{(const pbf*)(ws + WS_MEMB), (const pbf*)(ws + WS_WMKV), MEML, 512, DM, nullptr, 0, 0}; pg8::StaticOrder So; So.init(MEML, 512, F.G, (int)((blockIdx.x + F.G / 2) % F.G));
          pg8::EpiBf16Plain E{(pbf*)(ws + WS_MEMKV), 512};
          pg8::gemm_phase<pg8::EpiBf16Plain, pg8::StaticOrder, true, true>(F.lds + RING_OFF, g, So, E); }
        if ((int)blockIdx.x >= F.G - 6) p1_cumsum(F, F.G - 1 - (int)blockIdx.x);
        if (BOTH(1)) GRID_BAR();
    }

    if (IN(2)) { p2_attention(F, args, (char*)lds + RING_OFF, args.li); if (BOTH(2)) GRID_BAR(); }

    if (IN(3)) { p3_fox_combine(F); p3_dil_weights(F); if (BOTH(3)) GRID_BAR(); }

    if (IN(4)) {
        pg8::Gemm g{(const pbf*)(ws + WS_OFOX), (const pbf*)(ws + WS_WBF), S, DM, 384, nullptr, 0, 0, (size_t)S * 384 * 2, (size_t)DM * 384 * 2};
        pg8::MergeOrder So; So.so.init(S, DM, F.G, (int)blockIdx.x);
        pg8::EpiMergeChain E{PBUF + PC_GT, NPROJ, (pbf*)(ws + WS_MERGED), DM};
        pg8::gemm_phase<pg8::EpiMergeChain, pg8::MergeOrder, true, true>(F.lds + RING_OFF, g, So, E);
        if (BOTH(4)) GRID_BAR();
    }

    if (IN(5)) {
        pg8::Gemm g{(const pbf*)(ws + WS_MERGED), (const pbf*)(ws + WS_WOUT), S, DM, DM, nullptr, 0, 0}; pg8::StaticOrder So; So.init(S, DM, F.G, (int)blockIdx.x);
        pg8::EpiRes E{args.in[0], (pbf*)(ws + WS_R1), DM, ALPHA};
        pg8::gemm_phase<pg8::EpiRes, pg8::StaticOrder, true, true>(F.lds + RING_OFF, g, So, E);
        if (BOTH(5)) GRID_BAR();
    }

    if (IN(6)) { p6_ln_router(F, args); if (BOTH(6)) GRID_BAR(); }

    if (IN(7)) { p7_scatter(F); if (BOTH(7)) GRID_BAR(); }

    if (IN(8)) {
        LAS int* tbl = (LAS int*)(F.lds + TBL_OFF);
        if (F.tid < 33) tbl[F.tid] = ((const int*)(ws + WS_TST))[F.tid];
        __syncthreads();
        pg8::Gemm g{(const pbf*)(ws + WS_H1F8), (const pbf*)(ws + WS_W1), MAXROWS, 2048, DM / 2, (const int*)(ws + WS_TOKROW), 0x7F7F7F7F, 0x7F7F7F7F}; pg8::MoeOrder So{tbl, 8, F.G, F.vcu};
        pg8::EpiSwiglu E{(pbf*)(ws + WS_ACT), args.in[15], 1.0f / (float)(1 << W1_SHIFT), (const LAS float*)(F.lds + RING_OFF + pg8::STAGE_BYTES + 5120)};
        pg8::gemm_phase<pg8::EpiSwiglu, pg8::MoeOrder, true, true, true, true>(F.lds + RING_OFF, g, So, E);
        if (BOTH(8)) GRID_BAR();
    }

    if (IN(9)) {
        LAS int* tbl = (LAS int*)(F.lds + TBL_OFF);
        if (F.tid < 33) tbl[F.tid] = ((const int*)(ws + WS_TST))[F.tid];
        __syncthreads();
        pg8::Gemm g{(const pbf*)(ws + WS_ACT), (const pbf*)(ws + WS_W2), MAXROWS, 1024, DM / 2, nullptr, 0x7F7F7F7F, 0x7F7F7F7F}; pg8::MoeOrder So{tbl, 4, F.G, F.vcu};
        pg8::EpiY E{(pbf*)(ws + WS_Y), args.in[17], 1.0f / (float)(1 << W1_SHIFT), (const LAS float*)(F.lds + RING_OFF + pg8::STAGE_BYTES + 5120)};
        pg8::gemm_phase<pg8::EpiY, pg8::MoeOrder, true, true, true, true>(F.lds + RING_OFF, g, So, E);
        if (BOTH(9)) GRID_BAR();
    }

    if (IN(10)) { p10_combine(F, args); }
#undef IN
#undef BOTH
#undef GRID_BAR
}

extern "C" void kernel_launch(void* const* d_in, const int* in_sizes, int n_in, void* d_out, int out_size, void* d_ws, size_t ws_size, hipStream_t stream) {
    static int grid = 0;
    if (grid == 0) {
        if (n_in != 20 || in_sizes[0] != S * DM || out_size != S * DM || ws_size < WS_END) { fprintf(stderr, "kernel_launch: built for 20 inputs, x/out of %d floats, >= %zu bytes of workspace; got n_in %d, in0 %d, out %d, ws %zu; nothing launched\n", S * DM, (size_t)WS_END, n_in, n_in > 0 ? in_sizes[0] : -1, out_size, ws_size); grid = -1; return; }
        int dev = 0, cus = 0, per_cu = 0;
        if (hipGetDevice(&dev) != hipSuccess || hipDeviceGetAttribute(&cus, hipDeviceAttributeMultiprocessorCount, dev) != hipSuccess) { fprintf(stderr, "kernel_launch: hipGetDevice / hipDeviceGetAttribute failed; nothing launched\n"); grid = -1; return; }
        if (hipFuncSetAttribute((const void*)mk_fwd, hipFuncAttributeMaxDynamicSharedMemorySize, LDS_BYTES) != hipSuccess) { fprintf(stderr, "kernel_launch: hipFuncSetAttribute failed (%d bytes of dynamic LDS); nothing launched\n", LDS_BYTES); grid = -1; return; }
        if (hipOccupancyMaxActiveBlocksPerMultiprocessor(&per_cu, (const void*)mk_fwd, NWAVES * 64, LDS_BYTES) != hipSuccess || per_cu < 1)
            fprintf(stderr, "kernel_launch: note: the occupancy query reports %d workgroups per CU\n", per_cu);
        (void)hipGetLastError();
        grid = cus;
    }
    if (grid < 0) return;
    if (hipMemsetAsync((char*)d_ws + WS_CTL, 0, CTL_ZERO_BYTES, stream) != hipSuccess) { fprintf(stderr, "kernel_launch: hipMemsetAsync of the control words failed; nothing launched\n"); return; }
    Args a{};
    for (int i = 0; i < 20; ++i) a.in[i] = (const float*)d_in[i];
    a.out = (float*)d_out; a.ws = (unsigned char*)d_ws;
#ifdef PROBE_PHASE
    const int nl = (PROBE_PHASE + 1 < NPHASE) ? 3 : 2; const int cut_lo[3] = {0, PROBE_PHASE, PROBE_PHASE + 1}, cut_hi[3] = {PROBE_PHASE + 1, PROBE_PHASE + 1, NPHASE};
#else
    const int nl = N_LAUNCHES; int cut_lo[NPHASE], cut_hi[NPHASE]; for (int i = 0; i < NPHASE; ++i) { cut_lo[i] = (N_LAUNCHES == 1) ? 0 : i; cut_hi[i] = (N_LAUNCHES == 1) ? NPHASE : i + 1; }
#endif
    for (int li = 0; li < nl; ++li) {
        a.ph_lo = cut_lo[li]; a.ph_hi = cut_hi[li]; a.li = li;
        hipLaunchKernelGGL(mk_fwd, dim3(grid), dim3(NWAVES * 64), LDS_BYTES, stream, a);
        const hipError_t le = hipPeekAtLastError();
        if (le != hipSuccess) { fprintf(stderr, "kernel_launch: launch %d failed: %s\n", li, hipGetErrorName(le)); break; }
    }
}
```
